# Optimizing an MI355X kernel written in HIP

```python
import math
import jax
import jax.numpy as jnp
from jax import lax
import numpy as np

D_MODEL = 1024
BATCH = 16
SEQ = 2048
DEPTH = 2

N_MIXERS = 2
ATTN_PATTERNS = ((128, 1), (512, 4), (2048, 16))
N_ATTN_GROUPS = len(ATTN_PATTERNS)
HEADS_PER_GROUP = 8
HEAD_DIM = 64
ATTN_WIDTH = HEADS_PER_GROUP * HEAD_DIM
ROT_DIM = HEAD_DIM // 4
ROPE_THETA = 500000.0
ATTN_BLOCK = 128
POOL_WINDOWS = (2, 4, 8, 16)
N_POOL_GROUPS = len(POOL_WINDOWS)
POOL_GROUP_DIM = D_MODEL // N_POOL_GROUPS
N_EXPERT_GROUPS = 4
EXPERTS_PER_GROUP = 4
N_EXPERTS = N_EXPERT_GROUPS * EXPERTS_PER_GROUP
EXPERT_TOP_K = 2
D_EXPERT = D_MODEL // 2
MOE_BLOCK = 256
RMS_EPS = 1e-6

kernel_name = "hybrid_dilated_attn_pool_hmoe"


def rmsnorm(x, g):
    xf = x.astype(jnp.float32)
    y = xf * lax.rsqrt(jnp.mean(xf * xf, axis=-1, keepdims=True) + RMS_EPS)
    return (y * g.astype(jnp.float32)).astype(x.dtype)


def rotary_tables(positions):
    inv_freq = ROPE_THETA ** (-(jnp.arange(ROT_DIM // 2, dtype=jnp.float32) * 2.0 / ROT_DIM))
    ang = positions.astype(jnp.float32)[..., None] * inv_freq
    return jnp.cos(ang)[:, :, None, :], jnp.sin(ang)[:, :, None, :]


def partial_rotary(t, cos, sin):
    half = ROT_DIM // 2
    cos = cos.astype(t.dtype)
    sin = sin.astype(t.dtype)
    t1, t2, rest = t[..., :half], t[..., half:ROT_DIM], t[..., ROT_DIM:]
    return jnp.concatenate([t1 * cos - t2 * sin, t2 * cos + t1 * sin, rest], axis=-1)


def dilated_window_attention(q, k, v, dil, steps):
    B, S, H, Dh = q.shape
    L = S // dil
    nb = -(-L // ATTN_BLOCK)
    Lp = nb * ATTN_BLOCK

    def to_phase(t):
        t = t.reshape(B, L, dil, H, Dh).transpose(0, 2, 3, 1, 4).reshape(B * dil, H, L, Dh)
        t = jnp.pad(t, ((0, 0), (0, 0), (0, Lp - L), (0, 0)))
        return t.reshape(B * dil, H, nb, ATTN_BLOCK, Dh)

    def with_prev(t):
        prev = jnp.pad(t[:, :, :-1], ((0, 0), (0, 0), (1, 0), (0, 0), (0, 0)))
        return jnp.concatenate([prev, t], axis=3)

    qb = to_phase(q)
    kw = with_prev(to_phase(k))
    vw = with_prev(to_phase(v))
    s = jnp.einsum('nhbqd,nhbkd->nhbqk', qb, kw).astype(jnp.float32) * (1.0 / math.sqrt(Dh))
    blk = jnp.arange(nb)[:, None, None] * ATTN_BLOCK
    qpos = blk + jnp.arange(ATTN_BLOCK)[None, :, None]
    kpos = blk - ATTN_BLOCK + jnp.arange(2 * ATTN_BLOCK)[None, None, :]
    dist = qpos - kpos
    valid = (dist >= 0) & (dist <= steps) & (kpos >= 0)
    s = jnp.where(valid, s, -jnp.inf)
    lse = jax.nn.logsumexp(s, axis=-1)
    p = jnp.exp(s - lse[..., None]).astype(v.dtype)
    o = jnp.einsum('nhbqk,nhbkd->nhbqd', p, vw)
    o = o.reshape(B, dil, H, Lp, Dh)[:, :, :, :L].transpose(0, 3, 1, 2, 4).reshape(B, S, H, Dh)
    lse = lse.reshape(B, dil, H, Lp)[:, :, :, :L].transpose(0, 3, 1, 2).reshape(B, S, H)
    return o, lse


def dilated_attention_mixer(y, w_in, w_out, cos, sin):
    B, S, _ = y.shape
    qkv = (y @ w_in).reshape(B, S, N_ATTN_GROUPS, 3, HEADS_PER_GROUP, HEAD_DIM)
    outs, lses = [], []
    for g, (window, dil) in enumerate(ATTN_PATTERNS):
        q = partial_rotary(qkv[:, :, g, 0], cos, sin)
        k = partial_rotary(qkv[:, :, g, 1], cos, sin)
        o, lse = dilated_window_attention(q, k, qkv[:, :, g, 2], dil, window // dil)
        outs.append(o)
        lses.append(lse)
    wts = jax.nn.softmax(jnp.stack(lses, axis=0), axis=0)
    o = jnp.sum(wts[..., None].astype(y.dtype) * jnp.stack(outs, axis=0), axis=0)
    return o.reshape(B, S, ATTN_WIDTH) @ w_out


def multiscale_pool_mixer(y, w_in, w_group, scale, w_out):
    B, S, D = y.shape
    u = (y @ w_in).reshape(B, S, N_POOL_GROUPS, POOL_GROUP_DIM)
    c = jnp.cumsum(u.astype(jnp.float32), axis=1)
    t1 = jnp.arange(S, dtype=jnp.int32) + 1
    outs = []
    for g, w in enumerate(POOL_WINDOWS):
        cg = c[:, :, g]
        shifted = jnp.pad(cg[:, :S - w], ((0, 0), (w, 0), (0, 0)))
        count = jnp.minimum(t1, w).astype(jnp.float32)[None, :, None]
        outs.append((cg - shifted) / count - u[:, :, g].astype(jnp.float32))
    pooled = jnp.stack(outs, axis=2).astype(y.dtype)
    z = jnp.einsum('bsgc,gce->bsge', pooled, w_group).reshape(B, S, D) * scale
    return z @ w_out


def routed_experts(xf, expert_idx, gates, w1, w3, w2):
    T, Dm = xf.shape
    K = expert_idx.shape[1]
    E = w1.shape[0]
    N = T * K
    flat_e = expert_idx.reshape(N)
    flat_tok = jnp.repeat(jnp.arange(T, dtype=jnp.int32), K)
    flat_g = gates.reshape(N).astype(xf.dtype)
    order = jnp.argsort(flat_e)
    se = flat_e[order]
    counts = jnp.bincount(flat_e, length=E)
    starts = jnp.cumsum(counts) - counts
    padded = ((counts + MOE_BLOCK - 1) // MOE_BLOCK) * MOE_BLOCK
    pends = jnp.cumsum(padded)
    pstarts = pends - padded
    dest = pstarts[se] + (jnp.arange(N, dtype=jnp.int32) - starts[se])
    n_blocks = -(-(N + E * (MOE_BLOCK - 1)) // MOE_BLOCK)
    P = n_blocks * MOE_BLOCK
    row_tok = jnp.full((P,), T, dtype=jnp.int32).at[dest].set(flat_tok[order])
    row_gate = jnp.zeros((P,), xf.dtype).at[dest].set(flat_g[order])
    block_e = jnp.minimum(
        jnp.searchsorted(pends, jnp.arange(n_blocks, dtype=jnp.int32) * MOE_BLOCK, side='right'), E - 1)
    xs = jnp.concatenate([xf, jnp.zeros((1, Dm), xf.dtype)], axis=0)[row_tok]
    xs = xs.reshape(n_blocks, MOE_BLOCK, Dm)

    def expert_block(args):
        xb, e = args
        hmid = jax.nn.silu(xb @ w1[e]) * (xb @ w3[e])
        return hmid @ w2[e]

    ys = lax.map(expert_block, (xs, block_e)).reshape(P, Dm) * row_gate[:, None]
    return jnp.zeros((T + 1, Dm), ys.dtype).at[row_tok].add(ys)[:T]


def hierarchical_moe(y, wg, bg, we, be, w1, w3, w2):
    B, S, D = y.shape
    xf = y.reshape(B * S, D)
    lg = (xf @ wg).astype(jnp.float32) + bg.astype(jnp.float32)
    pg = jax.nn.softmax(lg, axis=-1)
    g_star = jnp.argmax(pg, axis=-1).astype(jnp.int32)
    gate1 = jnp.take_along_axis(pg, g_star[:, None], axis=1)[:, 0]
    le = jnp.einsum('td,gde->tge', xf, we).astype(jnp.float32) + be.astype(jnp.float32)
    le = jnp.take_along_axis(le, g_star[:, None, None], axis=1)[:, 0]
    top_vals, top_idx = lax.top_k(le, EXPERT_TOP_K)
    gates = gate1[:, None] * jax.nn.softmax(top_vals, axis=-1)
    expert_idx = g_star[:, None] * EXPERTS_PER_GROUP + top_idx.astype(jnp.int32)
    out = routed_experts(xf, expert_idx, gates, w1, w3, w2)
    return out.reshape(B, S, D)


def setup_inputs(seed: int = 0) -> dict:
    key = jax.random.key(seed)
    ks = jax.random.split(key, 20)
    n_a = (DEPTH + 1) // 2
    n_b = DEPTH // 2
    D = D_MODEL
    nrm = jax.random.normal
    x = nrm(ks[0], (BATCH, SEQ, D), jnp.float32)
    offs = jax.random.randint(ks[1], (BATCH, 1), 0, 4096, dtype=jnp.int32)
    positions = (offs + jnp.arange(SEQ, dtype=jnp.int32)[None, :]).astype(jnp.int32)
    return {
        "x": x,
        "positions": positions,
        "norm_mix": 1.0 + 0.05 * nrm(ks[2], (DEPTH, D), jnp.float32),
        "norm_ffn": 1.0 + 0.05 * nrm(ks[3], (DEPTH, D), jnp.float32),
        "norm_final": 1.0 + 0.05 * nrm(ks[4], (D,), jnp.float32),
        "attn_w_in": nrm(ks[5], (n_a, D, N_ATTN_GROUPS * 3 * ATTN_WIDTH), jnp.float32) * D ** -0.5,
        "attn_w_out": nrm(ks[6], (n_a, ATTN_WIDTH, D), jnp.float32) * ATTN_WIDTH ** -0.5,
        "pool_w_in": nrm(ks[7], (n_b, D, D), jnp.float32) * D ** -0.5,
        "pool_w_group": nrm(ks[8], (n_b, N_POOL_GROUPS, POOL_GROUP_DIM, POOL_GROUP_DIM), jnp.float32) * POOL_GROUP_DIM ** -0.5,
        "pool_scale": 1.0 + 0.1 * nrm(ks[9], (n_b, D), jnp.float32),
        "pool_w_out": nrm(ks[10], (n_b, D, D), jnp.float32) * D ** -0.5,
        "router_group_w": nrm(ks[11], (DEPTH, D, N_EXPERT_GROUPS), jnp.float32) * D ** -0.5,
        "router_group_b": 0.01 * nrm(ks[12], (DEPTH, N_EXPERT_GROUPS), jnp.float32),
        "router_expert_w": nrm(ks[13], (DEPTH, N_EXPERT_GROUPS, D, EXPERTS_PER_GROUP), jnp.float32) * D ** -0.5,
        "router_expert_b": 0.01 * nrm(ks[14], (DEPTH, N_EXPERT_GROUPS, EXPERTS_PER_GROUP), jnp.float32),
        "expert_w1": nrm(ks[15], (DEPTH, N_EXPERTS, D, D_EXPERT), jnp.float32) * D ** -0.5,
        "expert_w3": nrm(ks[16], (DEPTH, N_EXPERTS, D, D_EXPERT), jnp.float32) * D ** -0.5,
        "expert_w2": nrm(ks[17], (DEPTH, N_EXPERTS, D_EXPERT, D), jnp.float32) * D_EXPERT ** -0.5,
    }


def reference(x, positions, norm_mix, norm_ffn, norm_final, attn_w_in, attn_w_out,
              pool_w_in, pool_w_group, pool_scale, pool_w_out,
              router_group_w, router_group_b, router_expert_w, router_expert_b,
              expert_w1, expert_w3, expert_w2):
    cos, sin = rotary_tables(positions)
    h = x
    for i in range(DEPTH):
        y = rmsnorm(h, norm_mix[i])
        j = i // N_MIXERS
        if i % N_MIXERS == 0:
            h = h + dilated_attention_mixer(y, attn_w_in[j], attn_w_out[j], cos, sin)
        else:
            h = h + multiscale_pool_mixer(y, pool_w_in[j], pool_w_group[j], pool_scale[j], pool_w_out[j])
        y = rmsnorm(h, norm_ffn[i])
        h = h + hierarchical_moe(y, router_group_w[i], router_group_b[i],
                                 router_expert_w[i], router_expert_b[i],
                                 expert_w1[i], expert_w3[i], expert_w2[i])
    return rmsnorm(h, norm_final)
```

```cpp
#include <hip/hip_runtime.h>
#include <hip/hip_cooperative_groups.h>
#include <cstdio>
#include <cstdint>
namespace cg = cooperative_groups;

#ifndef MK_N_LAUNCHES
#define MK_N_LAUNCHES 1
#endif

#define LAS __attribute__((address_space(3)))
#define GAS __attribute__((address_space(1)))
typedef unsigned short bf16;
typedef short bf16x8 __attribute__((ext_vector_type(8)));
typedef float f32x4 __attribute__((ext_vector_type(4)));
typedef float f32x2 __attribute__((ext_vector_type(2)));
typedef float f32x16 __attribute__((ext_vector_type(16)));
typedef unsigned u32x4 __attribute__((ext_vector_type(4)));
typedef unsigned u32x2 __attribute__((ext_vector_type(2)));
typedef short s16x4 __attribute__((ext_vector_type(4)));
typedef __bf16 bf16x2_t __attribute__((ext_vector_type(2)));

constexpr int BATCH = 16, SEQ = 2048, D = 1024, T = BATCH * SEQ;
constexpr int NG = 3, HPG = 8, HD = 64, AW = 512, QKVW = NG * 3 * AW;
constexpr int NE = 16, DE = 512, SLOTS = 2 * T;
constexpr int MAXTILES = SLOTS / 256 + NE;
constexpr float RMS_EPS = 1e-6f;
constexpr int NWAVES = 8, NTHREADS = 512;

constexpr size_t MiB = 1u << 20;
constexpr size_t WS_CTL = 0, CTL_ZERO_BYTES = 64 * 1024;
constexpr size_t WS_CS = 1 * MiB;
constexpr size_t WS_LSE = 3 * MiB;
constexpr size_t WS_SLOTREF = 6 * MiB;
constexpr size_t WS_WGS = 7 * MiB;
constexpr size_t WS_LIST = 8 * MiB;
constexpr size_t WS_GATEL = 12 * MiB;
constexpr size_t WS_WIN = 16 * MiB;
constexpr size_t WS_WOUT = 25 * MiB;
constexpr size_t WS_WPIN = 26 * MiB;
constexpr size_t WS_WC = 28 * MiB;
constexpr size_t WS_WPO = 30 * MiB;
constexpr size_t WS_W13 = 32 * MiB;
constexpr size_t WS_W2 = 96 * MiB;
constexpr size_t WS_Y = 128 * MiB;
constexpr size_t WS_BIG = 192 * MiB;
constexpr size_t WS_OM = WS_BIG;
constexpr size_t WS_HMID = WS_BIG;
constexpr size_t WS_YS = WS_BIG + 72 * MiB;
constexpr size_t WS_U = WS_BIG;
constexpr size_t WS_POOLED = WS_BIG + 64 * MiB;
constexpr size_t WS_END = WS_BIG + 288 * MiB;
constexpr int CW_CNT = 0;

constexpr int RING_BYTES = 131072;
constexpr int AOFS_OFF = RING_BYTES;
constexpr int MISC_OFF = AOFS_OFF + 8192;
constexpr int LDS_BYTES = 147456;

__device__ __forceinline__ unsigned cvtpk(float lo, float hi) { f32x2 v = {lo, hi}; bf16x2_t b = __builtin_convertvector(v, bf16x2_t); return __builtin_bit_cast(unsigned, b); }
__device__ __forceinline__ float bf_lo(unsigned u) { return __uint_as_float(u << 16); }
__device__ __forceinline__ float bf_hi(unsigned u) { return __uint_as_float(u & 0xffff0000u); }
__device__ __forceinline__ float wave_sum(float v) {
#pragma unroll
    for (int o = 1; o < 64; o <<= 1) v += __shfl_xor(v, o);
    return v;
}

namespace pg8 {
constexpr int BM = 256, BK = 64, HALF = 128, HTB = HALF * BK * 2, STAGE_BYTES = 8 * HTB, NXCD = 8, WGM = 8;
__host__ __device__ __forceinline__ int lds_byte(int r, int c) { const int st = (r >> 4) * 2 + (c >> 5), rr = r & 15, cc = c & 31, ob = rr * 64 + cc * 2; return st * 1024 + (ob ^ (((ob >> 9) & 1) << 5)); }
__host__ __device__ __forceinline__ void stage_rc(int b, int& R, int& C) { const int st = b / 1024, sb = b % 1024, swz = sb ^ (((sb >> 9) & 1) << 5); R = (st >> 1) * 16 + swz / 64; C = (st & 1) * 32 + (swz % 64) / 2; }
__host__ __device__ __forceinline__ int perm32(int rho) { const int n = rho >> 4, i = rho & 15; return 8 * (i >> 2) + 4 * n + (i & 3); }

struct Unit { int pm, pn; };

struct StaticOrder {
    int nM, nN, nwg, G, c;
    __device__ void init(int nM_, int nN_, int G_, int c_) { nM = nM_; nN = nN_; nwg = nM * nN; G = G_; c = c_; }
    __device__ bool next(int i, Unit& u) const {
        const long L = (long)i * G + c; if (L >= nwg) return false;
        int wgid = (int)L; { const int q = nwg / NXCD, r = nwg % NXCD, xcd = wgid % NXCD, off = wgid / NXCD; wgid = (xcd < r ? xcd * (q + 1) : r * (q + 1) + (xcd - r) * q) + off; }
        const int nig = WGM * nN, gid = wgid / nig, fm = gid * WGM, gsz = (nM - fm) < WGM ? (nM - fm) : WGM;
        u.pm = fm + ((wgid % nig) % gsz); u.pn = (wgid % nig) / gsz; return true;
    }
};

template <class Prob, class Epi, class Sched, bool ALIGN_EPI>
__device__ __forceinline__ void gemm_phase(LAS unsigned char* lds, const Prob& P, const Sched& S, const Epi& E) {
    int tid_ = threadIdx.x; asm volatile("" : "+v"(tid_));
    const int tid = tid_, wid = __builtin_amdgcn_readfirstlane(tid >> 6), lane = tid & 63, wr = wid >> 2, wc = wid & 3, fr = lane & 15, fq = lane >> 4;
    const int K = P.K, nt = K / BK;
    int Rr[2], Cc[2]; unsigned voffB[2];
#pragma unroll
    for (int i = 0; i < 2; ++i) { int R, C; stage_rc(tid * 16 + i * 8192, R, C); Rr[i] = R; Cc[i] = C; const int Rb = Epi::PERM ? ((R & ~31) + perm32(R & 31)) : R; voffB[i] = (unsigned)(Rb * K + C) * 2u; }
    const unsigned kstep = (unsigned)(BK * 2);
    const unsigned hstep = (unsigned)(HALF * K * 2);
    const unsigned ldsw = (unsigned)wid * 1024u;
    const int aoff = lds_byte(wr * 64 + fr, fq * 8), boff = lds_byte(wc * 32 + fr, fq * 8);
    const __amdgpu_buffer_rsrc_t rsA = __builtin_amdgcn_make_buffer_rsrc((void*)P.A, 0, 0xFFFFFFFF, 0x00020000);
    const __amdgpu_buffer_rsrc_t rsB = __builtin_amdgcn_make_buffer_rsrc((void*)P.Bt, 0, 0xFFFFFFFF, 0x00020000);
#define PG8_SA(b, h) (((b) * 2 + (h)) * HTB)
#define PG8_SB(b, h) ((4 + (b) * 2 + (h)) * HTB)
#define PG8_STAGE_B(bufoff, sB) do { _Pragma("unroll") for (int _i = 0; _i < 2; ++_i) \
        __builtin_amdgcn_raw_ptr_buffer_load_lds(rsB, (LAS void*)(lds + (bufoff) + ldsw + _i * 8192), 16, (int)voffB[_i], (int)(sB), 0, 0); } while (0)
#define PG8_STAGE_A(bufoff, kb, o) do { _Pragma("unroll") for (int _i = 0; _i < 2; ++_i) \
        __builtin_amdgcn_raw_ptr_buffer_load_lds(rsA, (LAS void*)(lds + (bufoff) + ldsw + _i * 8192), 16, (int)(o)[_i], (int)(kb), 0, 0); } while (0)
#define PG8_LDA(dst, b, h) do { _Pragma("unroll") for (int m = 0; m < 4; ++m) _Pragma("unroll") for (int k = 0; k < 2; ++k) dst[m][k] = *(const LAS bf16x8*)(lds + PG8_SA(b, h) + aoff + m * 2048 + k * 1024); } while (0)
#define PG8_LDB(dst, b, h) do { _Pragma("unroll") for (int n = 0; n < 2; ++n) _Pragma("unroll") for (int k = 0; k < 2; ++k) dst[n][k] = *(const LAS bf16x8*)(lds + PG8_SB(b, h) + boff + n * 2048 + k * 1024); } while (0)
#define PG8_MMA(ai, bj, At, Bt) do { __builtin_amdgcn_s_setprio(1); _Pragma("unroll") for (int m = 0; m < 4; ++m) _Pragma("unroll") for (int n = 0; n < 2; ++n) _Pragma("unroll") for (int k = 0; k < 2; ++k) \
        acc[ai][bj][m][n] = __builtin_amdgcn_mfma_f32_16x16x32_bf16(Bt[n][k], At[m][k], acc[ai][bj][m][n], 0, 0, 0); __builtin_amdgcn_s_setprio(0); } while (0)
#define PG8_WAIT_V(n) asm volatile("s_waitcnt vmcnt(" #n ")" ::: "memory")
#define PG8_WAIT_L(n) asm volatile("s_waitcnt lgkmcnt(" #n ")" ::: "memory")
#define PG8_BAR __builtin_amdgcn_s_barrier()
#define PG8_SCHED __builtin_amdgcn_sched_barrier(0)
    Unit cur, nxt; int ui = 0;
    if (!S.next(0, cur)) return;
    f32x4 acc[2][2][4][2];
#pragma unroll
    for (int a = 0; a < 2; ++a)
#pragma unroll
        for (int b = 0; b < 2; ++b)
#pragma unroll
            for (int m = 0; m < 4; ++m)
#pragma unroll
                for (int n = 0; n < 2; ++n) acc[a][b][m][n] = (f32x4){0.f, 0.f, 0.f, 0.f};
    bf16x8 At[4][2], B0[2][2], B1[2][2];
    unsigned ca0[2], ca1[2];
    P.a_offs(0, cur, Rr, Cc, ca0, ca1);
    unsigned cB = P.b_off(cur);
    PG8_STAGE_B(PG8_SB(0, 0), cB); PG8_STAGE_B(PG8_SB(0, 1), cB + hstep); PG8_STAGE_A(PG8_SA(0, 0), 0, ca0); PG8_STAGE_A(PG8_SA(0, 1), 0, ca1);
    if (wr == 1) PG8_BAR;
    PG8_WAIT_V(2); PG8_BAR;
    PG8_STAGE_B(PG8_SB(1, 0), cB + kstep); PG8_STAGE_A(PG8_SA(1, 0), kstep, ca0); PG8_STAGE_B(PG8_SB(1, 1), cB + hstep + kstep);
    PG8_WAIT_V(6); PG8_BAR;
    for (;;) {
        const bool has_next = S.next(ui + 1, nxt);
        unsigned nB = cB;
        if (has_next) nB = P.b_off(nxt);
        for (int t = 0; t < nt; t += 2) {
            const bool last = (t == nt - 2);
            const unsigned k1 = (unsigned)(t + 1) * kstep;
            const unsigned k2 = last ? 0u : (unsigned)(t + 2) * kstep, k3 = k2 + kstep;
            const unsigned b2 = last ? nB : cB + (unsigned)(t + 2) * kstep; const unsigned b3 = b2 + kstep;
            unsigned x0[2], x1[2];
            x0[0] = ca0[0]; x0[1] = ca0[1]; x1[0] = ca1[0]; x1[1] = ca1[1];
            if (last && has_next) P.a_offs(ui + 1, nxt, Rr, Cc, x0, x1);
            PG8_LDB(B0, 0, 0); PG8_LDB(B1, 0, 1); PG8_SCHED; PG8_LDA(At, 0, 0); PG8_STAGE_A(PG8_SA(1, 1), k1, ca1);
            PG8_WAIT_V(8); PG8_WAIT_L(0); PG8_BAR; PG8_MMA(0, 0, At, B0); PG8_MMA(0, 1, At, B1); PG8_BAR; PG8_SCHED;
            PG8_LDA(At, 0, 1); PG8_STAGE_B(PG8_SB(0, 0), b2); PG8_STAGE_B(PG8_SB(0, 1), b2 + hstep); PG8_STAGE_A(PG8_SA(0, 0), k2, x0);
            PG8_WAIT_V(8); PG8_WAIT_L(0); PG8_BAR; PG8_MMA(1, 0, At, B0); PG8_MMA(1, 1, At, B1); PG8_BAR; PG8_SCHED;
            PG8_LDB(B0, 1, 0); PG8_LDB(B1, 1, 1); PG8_SCHED; PG8_LDA(At, 1, 0); PG8_STAGE_A(PG8_SA(0, 1), k2, x1);
            PG8_WAIT_V(8); PG8_WAIT_L(0); PG8_BAR; PG8_MMA(0, 0, At, B0); PG8_MMA(0, 1, At, B1); PG8_BAR; PG8_SCHED;
            PG8_LDA(At, 1, 1); PG8_STAGE_B(PG8_SB(1, 0), b3); PG8_STAGE_B(PG8_SB(1, 1), b3 + hstep); PG8_STAGE_A(PG8_SA(1, 0), k3, x0);
            PG8_WAIT_V(8); PG8_WAIT_L(0); PG8_BAR; PG8_MMA(1, 0, At, B0); PG8_MMA(1, 1, At, B1); PG8_BAR; PG8_SCHED;
        }
        if constexpr (ALIGN_EPI) { if (wr == 0) PG8_BAR; }
        E(acc, cur, wr, wc, fr, fq);
        if (!has_next) break;
#pragma unroll
        for (int a = 0; a < 2; ++a)
#pragma unroll
            for (int b = 0; b < 2; ++b)
#pragma unroll
                for (int m = 0; m < 4; ++m)
#pragma unroll
                    for (int n = 0; n < 2; ++n) acc[a][b][m][n] = (f32x4){0.f, 0.f, 0.f, 0.f};
        cur = nxt; cB = nB; ++ui; P.a_offs(ui, cur, Rr, Cc, ca0, ca1);
        if constexpr (ALIGN_EPI) { if (wr == 1) PG8_BAR; }
    }
    PG8_WAIT_V(0);
    if constexpr (!ALIGN_EPI) { if (wr == 0) PG8_BAR; }
    PG8_BAR;
#undef PG8_SA
#undef PG8_SB
#undef PG8_STAGE_A
#undef PG8_STAGE_B
#undef PG8_LDA
#undef PG8_LDB
#undef PG8_MMA
#undef PG8_WAIT_V
#undef PG8_WAIT_L
#undef PG8_BAR
#undef PG8_SCHED
}

struct DenseProb {
    const bf16* A; const bf16* Bt; int K, lda, acolstep; size_t bstep_pn;
    __device__ __forceinline__ void a_offs(int, const Unit& u, const int (&R)[2], const int (&C)[2], unsigned (&o0)[2], unsigned (&o1)[2]) const {
#pragma unroll
        for (int i = 0; i < 2; ++i) { const unsigned b = (unsigned)((u.pm * BM + R[i]) * lda + u.pn * acolstep + C[i]) * 2u; o0[i] = b; o1[i] = b + (unsigned)(HALF * lda * 2); }
    }
    __device__ __forceinline__ unsigned b_off(const Unit& u) const { return (unsigned)((size_t)u.pn * bstep_pn * 2); }
};
}

struct Params {
    const float* x; const int* positions; const float* norm_mix; const float* norm_ffn; const float* norm_final;
    const float* attn_w_in; const float* attn_w_out; const float* pool_w_in; const float* pool_w_group; const float* pool_scale; const float* pool_w_out;
    const float* router_group_w; const float* router_group_b; const float* router_expert_w; const float* router_expert_b;
    const float* expert_w1; const float* expert_w3; const float* expert_w2;
    float* out; unsigned char* ws;
    int ph_lo, ph_hi;
};

template <class MapN>
__device__ __forceinline__ void transpose_item(const float* W, int ldw, int K, bf16* WT, MapN mapn, LAS float* scr, int k0, int n0, int lane) {
#pragma unroll 8
    for (int i = 0; i < 32; ++i) { const int kk = 2 * i + (lane >> 5); scr[kk * 33 + (lane & 31)] = W[(size_t)(k0 + kk) * ldw + n0 + (lane & 31)]; }
    asm volatile("s_waitcnt lgkmcnt(0)" ::: "memory");
    const int c = lane & 7;
#pragma unroll
    for (int j = 0; j < 4; ++j) { const int n = (lane >> 3) + 8 * j; const LAS float* s = scr + (8 * c) * 33 + n;
        u32x4 o; o.x = cvtpk(s[0 * 33], s[1 * 33]); o.y = cvtpk(s[2 * 33], s[3 * 33]); o.z = cvtpk(s[4 * 33], s[5 * 33]); o.w = cvtpk(s[6 * 33], s[7 * 33]);
        *(u32x4*)(WT + (size_t)mapn(n0 + n) * K + k0 + 8 * c) = o; }
    asm volatile("s_waitcnt lgkmcnt(0)" ::: "memory");
}
struct MapId { __device__ __forceinline__ int operator()(int n) const { return n; } };
struct MapQKV {
    __device__ __forceinline__ int operator()(int n) const { const int rem = n % 1536, kind = rem / 512, d = n & 63; if (kind < 2 && d < 16) return n - d + (d < 8 ? 2 * d : 2 * (d - 8) + 1); return n; }
};
struct MapW13 { int add; __device__ __forceinline__ int operator()(int n) const { return (n >> 7) * 256 + add + (n & 127); } };

struct RowPassCfg {
    const float* hin;
    const bf16* ys; const int* slotref; const int* cnt_prev;
    float* hout;
    const float* gain;
    bf16* yout;
    float* fout;
    const float* rgw; const float* rgb; const float* rew; const float* reb;
    int* cnt; int* list; float* gatel; int* slotref_out;
};

__device__ __forceinline__ void row_pass(LAS unsigned char* lds, const RowPassCfg& c, int vcu, int tid_in, int wave, int lane_in) {
    int tid = tid_in; asm volatile("" : "+v"(tid)); const int lane = tid & 63;
    LAS float* Wr = (LAS float*)lds;
    LAS int* selE = (LAS int*)(lds + 81920);
    LAS float* selG = (LAS float*)(lds + 81920 + 1024);
    LAS int* tb = (LAS int*)(lds + MISC_OFF);
    const bool router = c.rgw != nullptr, combine = c.ys != nullptr;
    if (router) {
        for (int k = tid; k < 1024; k += NTHREADS) {
            const f32x4 g4 = *(const f32x4*)(c.rgw + (size_t)k * 4);
            Wr[0 * 1024 + k] = g4.x; Wr[1 * 1024 + k] = g4.y; Wr[2 * 1024 + k] = g4.z; Wr[3 * 1024 + k] = g4.w;
#pragma unroll
            for (int g = 0; g < 4; ++g) { const f32x4 e4 = *(const f32x4*)(c.rew + ((size_t)g * 1024 + k) * 4);
                Wr[(4 + g * 4 + 0) * 1024 + k] = e4.x; Wr[(4 + g * 4 + 1) * 1024 + k] = e4.y; Wr[(4 + g * 4 + 2) * 1024 + k] = e4.z; Wr[(4 + g * 4 + 3) * 1024 + k] = e4.w; }
        }
    }
    if (combine) {
        if (tid == 0) { int s = 0; for (int e = 0; e < NE; ++e) { tb[e] = s; s += (c.cnt_prev[e] + 255) >> 8; } tb[NE] = s; }
    }
    __syncthreads();
    f32x4 gn[4];
#pragma unroll
    for (int j = 0; j < 4; ++j) gn[j] = *(const f32x4*)(c.gain + 4 * lane + 256 * j);
    for (int rb = vcu; rb < T / 128; rb += gridDim.x) {
    const int row0 = rb * 128;
    for (int i = 0; i < 16; ++i) {
        const int rl = wave * 16 + i, row = row0 + rl;
        f32x4 v[4];
#pragma unroll
        for (int j = 0; j < 4; ++j) v[j] = *(const f32x4*)(c.hin + (size_t)row * D + 4 * lane + 256 * j);
        if (combine) {
#pragma unroll
            for (int s = 0; s < 2; ++s) {
                const int ref = c.slotref[row * 2 + s]; const int e = ref >> 15, pos = ref & 32767;
                const bf16* yr = c.ys + ((size_t)tb[e] * 256 + pos) * D;
#pragma unroll
                for (int j = 0; j < 4; ++j) { const u32x2 w = *(const u32x2*)(yr + 4 * lane + 256 * j); v[j].x += bf_lo(w.x); v[j].y += bf_hi(w.x); v[j].z += bf_lo(w.y); v[j].w += bf_hi(w.y); }
            }
        }
        if (c.hout) {
#pragma unroll
            for (int j = 0; j < 4; ++j) *(f32x4*)(c.hout + (size_t)row * D + 4 * lane + 256 * j) = v[j];
        }
        float ss = 0.f;
#pragma unroll
        for (int j = 0; j < 4; ++j) ss += (v[j].x * v[j].x + v[j].y * v[j].y) + (v[j].z * v[j].z + v[j].w * v[j].w);
        const float rstd = 1.0f / sqrtf(wave_sum(ss) * (1.0f / D) + RMS_EPS);
#pragma unroll
        for (int j = 0; j < 4; ++j) { v[j].x = v[j].x * rstd * gn[j].x; v[j].y = v[j].y * rstd * gn[j].y; v[j].z = v[j].z * rstd * gn[j].z; v[j].w = v[j].w * rstd * gn[j].w; }
        if (c.yout) {
#pragma unroll
            for (int j = 0; j < 4; ++j) { u32x2 w; w.x = cvtpk(v[j].x, v[j].y); w.y = cvtpk(v[j].z, v[j].w); *(u32x2*)(c.yout + (size_t)row * D + 4 * lane + 256 * j) = w; }
        }
        if (c.fout) {
#pragma unroll
            for (int j = 0; j < 4; ++j) *(f32x4*)(c.fout + (size_t)row * D + 4 * lane + 256 * j) = v[j];
        }
        if (router) {
            float a[20];
#pragma unroll
            for (int o = 0; o < 20; ++o) {
                float s = 0.f;
#pragma unroll
                for (int j = 0; j < 4; ++j) { const f32x4 w = *(const LAS f32x4*)(Wr + o * 1024 + 4 * lane + 256 * j); s += (v[j].x * w.x + v[j].y * w.y) + (v[j].z * w.z + v[j].w * w.w); }
                a[o] = wave_sum(s);
            }
            float lg[4];
#pragma unroll
            for (int g = 0; g < 4; ++g) lg[g] = a[g] + c.rgb[g];
            int gs = 0; float gm = lg[0];
#pragma unroll
            for (int g = 1; g < 4; ++g) if (lg[g] > gm) { gm = lg[g]; gs = g; }
            float den = 0.f;
#pragma unroll
            for (int g = 0; g < 4; ++g) den += __expf(lg[g] - gm);
            const float gate1 = 1.0f / den;
            float le[4];
#pragma unroll
            for (int e = 0; e < 4; ++e) { const float sel = gs == 0 ? a[4 + e] : gs == 1 ? a[8 + e] : gs == 2 ? a[12 + e] : a[16 + e]; le[e] = sel + c.reb[gs * 4 + e]; }
            int i0 = 0; float v0 = le[0];
#pragma unroll
            for (int e = 1; e < 4; ++e) if (le[e] > v0) { v0 = le[e]; i0 = e; }
            int i1 = -1; float v1 = -INFINITY;
#pragma unroll
            for (int e = 0; e < 4; ++e) if (e != i0 && le[e] > v1) { v1 = le[e]; i1 = e; }
            const float ex = __expf(v1 - v0), p0 = 1.0f / (1.0f + ex), p1 = ex * p0;
            if (lane == 0) { selE[rl * 2] = gs * 4 + i0; selE[rl * 2 + 1] = gs * 4 + i1; selG[rl * 2] = gate1 * p0; selG[rl * 2 + 1] = gate1 * p1; }
        }
    }
    if (router) {
        __syncthreads();
        if (tid < NE) {
            const int e = tid; int n = 0;
            for (int s = 0; s < 256; ++s) n += (selE[s] == e) ? 1 : 0;
            int base = 0; if (n) base = atomicAdd(c.cnt + e, n);
            int k = 0;
            for (int s = 0; s < 256; ++s) if (selE[s] == e) { const int pos = base + k; ++k; const int tok = row0 + (s >> 1);
                c.list[e * T + pos] = tok; c.gatel[e * T + pos] = selG[s]; c.slotref_out[tok * 2 + (s & 1)] = e * 32768 + pos; }
        }
        __syncthreads();
    }
    }
    __syncthreads();
}

namespace att {
constexpr float C2 = 0.125f * 1.4426950408889634f;
constexpr float LN2 = 0.6931471805599453f;
__device__ __forceinline__ int crow(int r, int hi) { return (r & 3) + 8 * (r >> 2) + 4 * hi; }
typedef short v4i16_t __attribute__((ext_vector_type(4)));
__device__ __forceinline__ s16x4 vtr(const LAS unsigned char* p) { return __builtin_bit_cast(s16x4, __builtin_amdgcn_ds_read_tr16_b64_v4i16((LAS v4i16_t*)p)); }

__device__ __forceinline__ void attn_phase(LAS unsigned char* lds, const bf16* qkv, bf16* og, float* lse, int vcu, int G) {
    int tid_ = threadIdx.x; asm volatile("" : "+v"(tid_));
    const int tid = tid_, lane = tid & 63, wid = __builtin_amdgcn_readfirstlane(tid >> 6);
    const int half = wid >> 2, w = wid & 3, r32 = lane & 31, hi = lane >> 5, th = tid & 255;
    LAS unsigned char* Kl = lds + half * 65536;
    LAS unsigned char* Vl = Kl + 32768;
    for (int pp = vcu; pp < 3072; pp += G) {
        const int hh = pp & 7, q8 = (pp >> 3) & 7, g = (pp >> 6) % 3, b = pp / 192;
        const int idx16 = q8 * 2 + half;
        const int dil = g == 0 ? 1 : (g == 1 ? 4 : 16), nb = 16 / dil, j = idx16 % nb, ph = idx16 / nb;
        const size_t rstride = (size_t)dil * QKVW;
        const bf16* base = qkv + (size_t)(b * SEQ + ph) * QKVW + g * 1536 + hh * 64;
        const int l0 = 128 * (j - 1);
        const int tt_lo = (j == 0) ? 2 : 0;
        for (int tt = tt_lo; tt < 4; ++tt) {
#pragma unroll
            for (int i = 0; i < 2; ++i) {
                const int p = th + 256 * i;
                { const int chunk = p >> 6, kv = p & 63; const u32x4 val = *(const u32x4*)(base + 512 + (size_t)(l0 + 64 * tt + kv) * rstride + chunk * 8); *(LAS u32x4*)(Kl + tt * 8192 + p * 16) = val; }
                { const int dh = p >> 8, kv = (p >> 2) & 63, c4 = p & 3; const u32x4 val = *(const u32x4*)(base + 1024 + (size_t)(l0 + 64 * tt + kv) * rstride + dh * 32 + c4 * 8); *(LAS u32x4*)(Vl + tt * 8192 + p * 16) = val; }
            }
        }
        const int lq = 128 * j + 32 * w + r32;
        const bf16* qrow = base + (size_t)lq * rstride;
        bf16x8 qr[4];
#pragma unroll
        for (int d0 = 0; d0 < 4; ++d0) qr[d0] = *(const bf16x8*)(qrow + d0 * 16 + hi * 8);
        __syncthreads();
        float m = -1e30f, l = 0.f; f32x16 oT[2]; oT[0] = f32x16{}; oT[1] = f32x16{};
        const int t_lo = (w >= 2) ? (tt_lo > 1 ? tt_lo : 1) : tt_lo, t_hi = (w < 2) ? 2 : 3;
        for (int tt = t_lo; tt <= t_hi; ++tt) {
            const LAS unsigned char* kb = Kl + tt * 8192 + hi * 1024 + r32 * 16;
            f32x16 p0 = f32x16{}, p1 = f32x16{};
#pragma unroll
            for (int d0 = 0; d0 < 4; ++d0) {
                const bf16x8 k0 = *(const LAS bf16x8*)(kb + d0 * 2048), k1 = *(const LAS bf16x8*)(kb + d0 * 2048 + 512);
                p0 = __builtin_amdgcn_mfma_f32_32x32x16_bf16(k0, qr[d0], p0, 0, 0, 0);
                p1 = __builtin_amdgcn_mfma_f32_32x32x16_bf16(k1, qr[d0], p1, 0, 0, 0);
            }
            const int dbase = 128 + 32 * w + r32 - 64 * tt;
            float mx = -INFINITY;
#pragma unroll
            for (int r = 0; r < 16; ++r) {
                const int d0_ = dbase - crow(r, hi), d1_ = d0_ - 32;
                p0[r] = (d0_ >= 0 && d0_ <= 128) ? p0[r] * C2 : -INFINITY;
                p1[r] = (d1_ >= 0 && d1_ <= 128) ? p1[r] * C2 : -INFINITY;
                mx = fmaxf(mx, fmaxf(p0[r], p1[r]));
            }
            mx = fmaxf(mx, __shfl_xor(mx, 32));
            const float mn = fmaxf(m, mx), alpha = __builtin_amdgcn_exp2f(m - mn);
            float rs = 0.f;
#pragma unroll
            for (int r = 0; r < 16; ++r) { p0[r] = __builtin_amdgcn_exp2f(p0[r] - mn); p1[r] = __builtin_amdgcn_exp2f(p1[r] - mn); rs += p0[r] + p1[r]; }
            l = l * alpha + rs; m = mn;
#pragma unroll
            for (int r = 0; r < 16; ++r) { oT[0][r] *= alpha; oT[1][r] *= alpha; }
            u32x4 pw[4];
            pw[0] = (u32x4){cvtpk(p0[0], p0[1]), cvtpk(p0[2], p0[3]), cvtpk(p0[4], p0[5]), cvtpk(p0[6], p0[7])};
            pw[1] = (u32x4){cvtpk(p0[8], p0[9]), cvtpk(p0[10], p0[11]), cvtpk(p0[12], p0[13]), cvtpk(p0[14], p0[15])};
            pw[2] = (u32x4){cvtpk(p1[0], p1[1]), cvtpk(p1[2], p1[3]), cvtpk(p1[4], p1[5]), cvtpk(p1[6], p1[7])};
            pw[3] = (u32x4){cvtpk(p1[8], p1[9]), cvtpk(p1[10], p1[11]), cvtpk(p1[12], p1[13]), cvtpk(p1[14], p1[15])};
            const LAS unsigned char* vp = Vl + tt * 8192 + ((lane >> 4) & 1) * 32 + (lane & 3) * 8 + (4 * hi + ((lane & 15) >> 2)) * 64;
#pragma unroll
            for (int d0 = 0; d0 < 2; ++d0)
#pragma unroll
                for (int ks = 0; ks < 4; ++ks) {
                    const s16x4 lo = vtr(vp + d0 * 4096 + ks * 1024), hh4 = vtr(vp + d0 * 4096 + ks * 1024 + 512);
                    const bf16x8 vf = (bf16x8){lo[0], lo[1], lo[2], lo[3], hh4[0], hh4[1], hh4[2], hh4[3]};
                    oT[d0] = __builtin_amdgcn_mfma_f32_32x32x16_bf16(vf, __builtin_bit_cast(bf16x8, pw[ks]), oT[d0], 0, 0, 0);
                }
        }
        const float lt = l + __shfl_xor(l, 32);
        const float inv = 1.0f / lt;
        const size_t tok = (size_t)b * SEQ + (size_t)lq * dil + ph;
        bf16* orow = og + tok * (NG * AW) + g * AW + hh * 64;
#pragma unroll
        for (int d0 = 0; d0 < 2; ++d0)
#pragma unroll
            for (int rg = 0; rg < 4; ++rg) {
                u32x2 wv; wv.x = cvtpk(oT[d0][4 * rg] * inv, oT[d0][4 * rg + 1] * inv); wv.y = cvtpk(oT[d0][4 * rg + 2] * inv, oT[d0][4 * rg + 3] * inv);
                *(u32x2*)(orow + 32 * d0 + 8 * rg + 4 * hi) = wv;
            }
        if (hi == 0) lse[tok * 24 + g * 8 + hh] = (m + __builtin_amdgcn_logf(lt)) * LN2;
        __syncthreads();
    }
}
}

using pg8::Unit; using pg8::BM; using pg8::HALF;
struct EpiQKV {
    static constexpr bool PERM = true;
    bf16* O; const float* cs;
    __device__ __forceinline__ void operator()(const f32x4 (&acc)[2][2][4][2], const Unit& u, int wr, int wc, int fr, int fq) const {
        const int colt = u.pn * BM; const int kind = (colt % 1536) / 512;
        const bool rot = (kind < 2) && ((wc & 1) == 0) && (fq < 2);
#pragma unroll
        for (int ai = 0; ai < 2; ++ai)
#pragma unroll
            for (int m = 0; m < 4; ++m) {
                const int row = u.pm * BM + ai * HALF + wr * 64 + m * 16 + fr;
                f32x4 c0 = {1.f, 0.f, 1.f, 0.f}, c1 = {1.f, 0.f, 1.f, 0.f};
                if (rot) { c0 = *(const f32x4*)(cs + (size_t)row * 16 + fq * 8); c1 = *(const f32x4*)(cs + (size_t)row * 16 + fq * 8 + 4); }
                bf16* rowp = O + (size_t)row * QKVW + colt + wc * 32 + 8 * fq;
#pragma unroll
                for (int bj = 0; bj < 2; ++bj) {
                    f32x4 v0 = acc[ai][bj][m][0], v1 = acc[ai][bj][m][1];
                    f32x4 o0, o1;
                    o0.x = v0.x * c0.x - v0.y * c0.y; o0.y = v0.y * c0.x + v0.x * c0.y; o0.z = v0.z * c0.z - v0.w * c0.w; o0.w = v0.w * c0.z + v0.z * c0.w;
                    o1.x = v1.x * c1.x - v1.y * c1.y; o1.y = v1.y * c1.x + v1.x * c1.y; o1.z = v1.z * c1.z - v1.w * c1.w; o1.w = v1.w * c1.z + v1.z * c1.w;
                    u32x4 w; w.x = cvtpk(o0.x, o0.y); w.y = cvtpk(o0.z, o0.w); w.z = cvtpk(o1.x, o1.y); w.w = cvtpk(o1.z, o1.w);
                    *(u32x4*)(rowp + bj * HALF) = w;
                }
            }
    }
};
struct EpiBf16 {
    static constexpr bool PERM = true;
    bf16* O; int ldc;
    __device__ __forceinline__ void operator()(const f32x4 (&acc)[2][2][4][2], const Unit& u, int wr, int wc, int fr, int fq) const {
#pragma unroll
        for (int ai = 0; ai < 2; ++ai)
#pragma unroll
            for (int m = 0; m < 4; ++m) {
                bf16* rowp = O + (size_t)(u.pm * BM + ai * HALF + wr * 64 + m * 16 + fr) * ldc + u.pn * BM + wc * 32 + 8 * fq;
#pragma unroll
                for (int bj = 0; bj < 2; ++bj) { const f32x4 v0 = acc[ai][bj][m][0], v1 = acc[ai][bj][m][1];
                    u32x4 w; w.x = cvtpk(v0.x, v0.y); w.y = cvtpk(v0.z, v0.w); w.z = cvtpk(v1.x, v1.y); w.w = cvtpk(v1.z, v1.w);
                    *(u32x4*)(rowp + bj * HALF) = w; }
            }
    }
};
struct EpiResF32 {
    static constexpr bool PERM = false;
    const float* res; float* out;
    __device__ __forceinline__ void operator()(const f32x4 (&acc)[2][2][4][2], const Unit& u, int wr, int wc, int fr, int fq) const {
#pragma unroll
        for (int ai = 0; ai < 2; ++ai)
#pragma unroll
            for (int m = 0; m < 4; ++m) {
                const size_t off = (size_t)(u.pm * BM + ai * HALF + wr * 64 + m * 16 + fr) * D + u.pn * BM + wc * 32 + 4 * fq;
#pragma unroll
                for (int bj = 0; bj < 2; ++bj)
#pragma unroll
                    for (int n = 0; n < 2; ++n) { const f32x4 r = *(const f32x4*)(res + off + bj * HALF + n * 16); *(f32x4*)(out + off + bj * HALF + n * 16) = r + acc[ai][bj][m][n]; }
            }
    }
};
struct EpiSwiGLU {
    static constexpr bool PERM = true;
    bf16* O;
    __device__ __forceinline__ void operator()(const f32x4 (&acc)[2][2][4][2], const Unit& u, int wr, int wc, int fr, int fq) const {
#pragma unroll
        for (int ai = 0; ai < 2; ++ai)
#pragma unroll
            for (int m = 0; m < 4; ++m) {
                bf16* rowp = O + (size_t)(u.pm * BM + ai * HALF + wr * 64 + m * 16 + fr) * DE + u.pn * HALF + wc * 32 + 8 * fq;
                float h[8];
#pragma unroll
                for (int n = 0; n < 2; ++n)
#pragma unroll
                    for (int e = 0; e < 4; ++e) { const float a = acc[ai][0][m][n][e], b = acc[ai][1][m][n][e];
                        h[n * 4 + e] = a * __builtin_amdgcn_rcpf(1.0f + __builtin_amdgcn_exp2f(-1.4426950408889634f * a)) * b; }
                u32x4 w; w.x = cvtpk(h[0], h[1]); w.y = cvtpk(h[2], h[3]); w.z = cvtpk(h[4], h[5]); w.w = cvtpk(h[6], h[7]);
                *(u32x4*)rowp = w;
            }
    }
};
struct EpiGate {
    static constexpr bool PERM = true;
    bf16* O; const float* gatel; const int* cnt; const LAS int* tb;
    __device__ __forceinline__ void operator()(const f32x4 (&acc)[2][2][4][2], const Unit& u, int wr, int wc, int fr, int fq) const {
        int e = 0;
#pragma unroll
        for (int k = 1; k < NE; ++k) e += (u.pm >= tb[k]) ? 1 : 0;
        const int lbase = (u.pm - tb[e]) * BM, n_e = cnt[e];
#pragma unroll
        for (int ai = 0; ai < 2; ++ai)
#pragma unroll
            for (int m = 0; m < 4; ++m) {
                const int rl = ai * HALF + wr * 64 + m * 16 + fr, li = lbase + rl;
                const float gt = (li < n_e) ? gatel[(size_t)e * T + li] : 0.f;
                bf16* rowp = O + (size_t)(u.pm * BM + rl) * D + u.pn * BM + wc * 32 + 8 * fq;
#pragma unroll
                for (int bj = 0; bj < 2; ++bj) { const f32x4 v0 = acc[ai][bj][m][0] * gt, v1 = acc[ai][bj][m][1] * gt;
                    u32x4 w; w.x = cvtpk(v0.x, v0.y); w.y = cvtpk(v0.z, v0.w); w.z = cvtpk(v1.x, v1.y); w.w = cvtpk(v1.z, v1.w);
                    *(u32x4*)(rowp + bj * HALF) = w; }
            }
    }
};

struct MoeProb1 {
    const bf16* A; const bf16* Bt; int K; const LAS int* tb; const LAS unsigned* aofs;
    __device__ __forceinline__ void a_offs(int i, const Unit&, const int (&R)[2], const int (&C)[2], unsigned (&o0)[2], unsigned (&o1)[2]) const {
#pragma unroll
        for (int k = 0; k < 2; ++k) { o0[k] = aofs[i * 256 + R[k]] + (unsigned)C[k] * 2u; o1[k] = aofs[i * 256 + 128 + R[k]] + (unsigned)C[k] * 2u; }
    }
    __device__ __forceinline__ unsigned b_off(const Unit& u) const {
        int e = 0;
#pragma unroll
        for (int k = 1; k < NE; ++k) e += (u.pm >= tb[k]) ? 1 : 0;
        return (unsigned)((e * 1024 + u.pn * 256) * 1024 * 2);
    }
};
struct MoeProb2 {
    const bf16* A; const bf16* Bt; int K; const LAS int* tb;
    __device__ __forceinline__ void a_offs(int, const Unit& u, const int (&R)[2], const int (&C)[2], unsigned (&o0)[2], unsigned (&o1)[2]) const {
#pragma unroll
        for (int k = 0; k < 2; ++k) { const unsigned b = (unsigned)((u.pm * BM + R[k]) * DE + C[k]) * 2u; o0[k] = b; o1[k] = b + (unsigned)(HALF * DE * 2); }
    }
    __device__ __forceinline__ unsigned b_off(const Unit& u) const {
        int e = 0;
#pragma unroll
        for (int k = 1; k < NE; ++k) e += (u.pm >= tb[k]) ? 1 : 0;
        return (unsigned)((e * 1024 + u.pn * 256) * DE * 2);
    }
};
struct FoldOrder { int G, c; __device__ bool next(int i, Unit& u) const { const int L = i * G + c; if (L >= 16) return false; u.pm = L >> 2; u.pn = L & 3; return true; } };

constexpr int N_PHASES = 16;

__global__ void __launch_bounds__(NTHREADS, 2) fwd_kernel(Params p) {
    extern __shared__ __attribute__((aligned(16))) unsigned char lds_raw[];
    LAS unsigned char* lds = (LAS unsigned char*)lds_raw;
    const int tid = threadIdx.x, lane = tid & 63, wave = __builtin_amdgcn_readfirstlane(tid >> 6);
    const int G = gridDim.x, bx = blockIdx.x;
    const int vcu = (G % 8 == 0) ? (bx % 8) * (G / 8) + bx / 8 : bx;
    unsigned char* ws = p.ws;
    int* ctl = (int*)(ws + WS_CTL);
    float* cs = (float*)(ws + WS_CS);
    float* lse = (float*)(ws + WS_LSE);
    int* slotref = (int*)(ws + WS_SLOTREF);
    bf16* Wgs = (bf16*)(ws + WS_WGS);
    int* list = (int*)(ws + WS_LIST);
    float* gatel = (float*)(ws + WS_GATEL);
    bf16* Win_t = (bf16*)(ws + WS_WIN); bf16* Wout_t = (bf16*)(ws + WS_WOUT); bf16* Wpin_t = (bf16*)(ws + WS_WPIN); bf16* Wc_t = (bf16*)(ws + WS_WC); bf16* Wpo_t = (bf16*)(ws + WS_WPO);
    bf16* W13 = (bf16*)(ws + WS_W13); bf16* W2 = (bf16*)(ws + WS_W2);
    bf16* Y = (bf16*)(ws + WS_Y); bf16* QKV = (bf16*)(ws + WS_BIG); bf16* OM = (bf16*)(ws + WS_OM);
    bf16* HMID = (bf16*)(ws + WS_HMID); bf16* YS = (bf16*)(ws + WS_YS); bf16* U = (bf16*)(ws + WS_U); bf16* POOLED = (bf16*)(ws + WS_POOLED);
    bf16* OG = (bf16*)p.out;
    float* H = p.out;
    LAS int* tb = (LAS int*)(lds + MISC_OFF);
    LAS unsigned* aofs = (LAS unsigned*)(lds + AOFS_OFF);

    const int lo = p.ph_lo, hi = p.ph_hi;
#if MK_N_LAUNCHES == 1
    cg::grid_group grid = cg::this_grid();
#define GRID_BAR() grid.sync()
#else
#define GRID_BAR() do { } while (0)
#endif
#ifndef PHASE_MASK
#define PHASE_MASK 0xffff
#endif
#define IN(k) (((PHASE_MASK >> (k)) & 1) && lo <= (k) && (k) < hi)
#define SEAM(k) do { if (IN(k) && IN((k) + 1)) GRID_BAR(); } while (0)

    if (IN(0)) {
        LAS float* scr = (LAS float*)(lds + wave * 16384);
        const int gw = vcu * NWAVES + wave, NGW = G * NWAVES;
        constexpr int I_IN = (D / 64) * (QKVW / 32);
        constexpr int I_OUT = (AW / 64) * (D / 32);
        constexpr int I_PIN = (D / 64) * (D / 32);
        constexpr int I_PO = I_PIN;
        constexpr int I_W1 = (D / 64) * (DE / 32);
        constexpr int I_W2 = (DE / 64) * (D / 32);
        constexpr int NITEMS = I_IN + I_OUT + I_PIN + I_PO + 32 * (2 * I_W1 + I_W2);
        for (int it = gw; it < NITEMS; it += NGW) {
            int r = it;
            if (r < I_IN) { const int nblk = QKVW / 32; transpose_item(p.attn_w_in, QKVW, D, Win_t, MapQKV{}, scr, 64 * (r / nblk), 32 * (r % nblk), lane); continue; } r -= I_IN;
            if (r < I_OUT) { const int nblk = D / 32; transpose_item(p.attn_w_out, D, AW, Wout_t, MapId{}, scr, 64 * (r / nblk), 32 * (r % nblk), lane); continue; } r -= I_OUT;
            if (r < I_PIN) { const int nblk = D / 32; transpose_item(p.pool_w_in, D, D, Wpin_t, MapId{}, scr, 64 * (r / nblk), 32 * (r % nblk), lane); continue; } r -= I_PIN;
            if (r < I_PO) { const int nblk = D / 32; transpose_item(p.pool_w_out, D, D, Wpo_t, MapId{}, scr, 64 * (r / nblk), 32 * (r % nblk), lane); continue; } r -= I_PO;
            const int le = r / (2 * I_W1 + I_W2); r -= le * (2 * I_W1 + I_W2);
            if (r < I_W1) { const int nblk = DE / 32; transpose_item(p.expert_w1 + (size_t)le * D * DE, DE, D, W13 + (size_t)le * 1024 * 1024, MapW13{0}, scr, 64 * (r / nblk), 32 * (r % nblk), lane); continue; } r -= I_W1;
            if (r < I_W1) { const int nblk = DE / 32; transpose_item(p.expert_w3 + (size_t)le * D * DE, DE, D, W13 + (size_t)le * 1024 * 1024, MapW13{128}, scr, 64 * (r / nblk), 32 * (r % nblk), lane); continue; } r -= I_W1;
            { const int nblk = D / 32; transpose_item(p.expert_w2 + (size_t)le * DE * D, D, DE, W2 + (size_t)le * 1024 * DE, MapId{}, scr, 64 * (r / nblk), 32 * (r % nblk), lane); }
        }
        for (int i = vcu * NTHREADS + tid; i < 4 * 256 * 256 / 4; i += G * NTHREADS) {
            const int e4 = (i & 63) * 4, gidx = i >> 14;
            const f32x4 wv = *(const f32x4*)(p.pool_w_group + (size_t)i * 4); const f32x4 sc = *(const f32x4*)(p.pool_scale + gidx * 256 + e4);
            u32x2 o; o.x = cvtpk(wv.x * sc.x, wv.y * sc.y); o.y = cvtpk(wv.z * sc.z, wv.w * sc.w); *(u32x2*)(Wgs + (size_t)i * 4) = o;
        }
        for (int i = vcu * NTHREADS + tid; i < T * 8; i += G * NTHREADS) {
            const int tok = i >> 3, f = i & 7;
            const double invf = exp2(-(double)f * 0.125 * 18.931568569324174);
            const float ang = (float)p.positions[tok] * (float)invf;
            double sn, cn; sincos((double)ang, &sn, &cn);
            cs[(size_t)i * 2] = (float)cn; cs[(size_t)i * 2 + 1] = (float)sn;
        }
        RowPassCfg c{}; c.hin = p.x; c.gain = p.norm_mix; c.yout = Y;
        row_pass(lds, c, vcu, tid, wave, lane);
    }
    SEAM(0);
    if (IN(1)) {
        pg8::DenseProb P{Y, Win_t, D, D, 0, (size_t)256 * D};
        pg8::StaticOrder S; S.init(T / 256, QKVW / 256, G, bx);
        EpiQKV E{QKV, cs};
        pg8::gemm_phase<pg8::DenseProb, EpiQKV, pg8::StaticOrder, true>(lds, P, S, E);
    }
    SEAM(1);
    if (IN(2)) {
        att::attn_phase(lds, QKV, OG, lse, vcu, G);
        pg8::DenseProb P{Wpo_t, Wgs, 256, D, 256, (size_t)256 * 256};
        FoldOrder S{G, bx};
        EpiBf16 E{Wc_t, D};
        pg8::gemm_phase<pg8::DenseProb, EpiBf16, FoldOrder, true>(lds, P, S, E);
    }
    SEAM(2);
    if (IN(3)) {
        for (int row = vcu * NWAVES + wave; row < T; row += G * NWAVES) {
            const int h = lane >> 3;
            const float l0 = lse[(size_t)row * 24 + h], l1 = lse[(size_t)row * 24 + 8 + h], l2 = lse[(size_t)row * 24 + 16 + h];
            const float mx = fmaxf(l0, fmaxf(l1, l2));
            float w0 = __expf(l0 - mx), w1 = __expf(l1 - mx), w2 = __expf(l2 - mx); const float inv = 1.0f / (w0 + w1 + w2); w0 *= inv; w1 *= inv; w2 *= inv;
            const bf16* src = OG + (size_t)row * 1536 + lane * 8;
            const u32x4 a = *(const u32x4*)(src), b = *(const u32x4*)(src + 512), c = *(const u32x4*)(src + 1024);
            u32x4 o;
#pragma unroll
            for (int k = 0; k < 4; ++k) { const float lo_ = w0 * bf_lo(a[k]) + w1 * bf_lo(b[k]) + w2 * bf_lo(c[k]), hi_ = w0 * bf_hi(a[k]) + w1 * bf_hi(b[k]) + w2 * bf_hi(c[k]); o[k] = cvtpk(lo_, hi_); }
            *(u32x4*)(OM + (size_t)row * AW + lane * 8) = o;
        }
    }
    SEAM(3);
    if (IN(4)) {
        pg8::DenseProb P{OM, Wout_t, AW, AW, 0, (size_t)256 * AW};
        pg8::StaticOrder S; S.init(T / 256, D / 256, G, bx);
        EpiResF32 E{p.x, H};
        pg8::gemm_phase<pg8::DenseProb, EpiResF32, pg8::StaticOrder, true>(lds, P, S, E);
    }
    SEAM(4);
#pragma unroll 1
    for (int L = 0; L < 2; ++L) {
        const int pb = (L == 0) ? 5 : 12;
        int* cnt = ctl + CW_CNT + L * NE;
        if (IN(pb)) {
            RowPassCfg c{}; c.hin = H; c.gain = p.norm_ffn + L * D; c.yout = Y;
            c.rgw = p.router_group_w + (size_t)L * D * 4; c.rgb = p.router_group_b + L * 4; c.rew = p.router_expert_w + (size_t)L * 4 * D * 4; c.reb = p.router_expert_b + L * 16;
            c.cnt = cnt; c.list = list + (size_t)L * NE * T; c.gatel = gatel + (size_t)L * NE * T; c.slotref_out = slotref + (size_t)L * T * 2;
            row_pass(lds, c, vcu, tid, wave, lane);
        }
        SEAM(pb);
        if (IN(pb + 1) || IN(pb + 2)) {
            if (tid == 0) { int s = 0; for (int e = 0; e < NE; ++e) { tb[e] = s; tb[32 + e] = cnt[e]; s += (cnt[e] + 255) >> 8; } tb[NE] = s; }
            __syncthreads();
        }
        if (IN(pb + 1)) {
            const int NT = tb[NE];
            pg8::StaticOrder S; S.init(NT, 4, G, bx);
            for (int i = 0; i < 8; ++i) { Unit u; if (!S.next(i, u)) break;
                int e = 0;
                for (int k = 1; k < NE; ++k) e += (u.pm >= tb[k]) ? 1 : 0;
                if (tid < 256) { const int li = (u.pm - tb[e]) * 256 + tid; const int tok = (li < tb[32 + e]) ? list[((size_t)L * NE + e) * T + li] : 0; aofs[i * 256 + tid] = (unsigned)tok * (unsigned)(D * 2); } }
            __syncthreads();
            MoeProb1 P{Y, W13 + (size_t)L * NE * 1024 * 1024, D, tb, aofs};
            EpiSwiGLU E{HMID};
            pg8::gemm_phase<MoeProb1, EpiSwiGLU, pg8::StaticOrder, true>(lds, P, S, E);
        }
        SEAM(pb + 1);
        if (IN(pb + 2)) {
            const int NT = tb[NE];
            pg8::StaticOrder S; S.init(NT, 4, G, bx);
            MoeProb2 P{HMID, W2 + (size_t)L * NE * 1024 * DE, DE, tb};
            EpiGate E{YS, gatel + (size_t)L * NE * T, cnt, tb};
            pg8::gemm_phase<MoeProb2, EpiGate, pg8::StaticOrder, true>(lds, P, S, E);
        }
        SEAM(pb + 2);
        if (L == 0) {
            if (IN(8)) {
                RowPassCfg c{}; c.hin = H; c.ys = YS; c.slotref = slotref; c.cnt_prev = cnt; c.hout = H; c.gain = p.norm_mix + D; c.yout = Y;
                row_pass(lds, c, vcu, tid, wave, lane);
            }
            SEAM(8);
            if (IN(9)) {
                pg8::DenseProb P{Y, Wpin_t, D, D, 0, (size_t)256 * D};
                pg8::StaticOrder S; S.init(T / 256, D / 256, G, bx);
                EpiBf16 E{U, D};
                pg8::gemm_phase<pg8::DenseProb, EpiBf16, pg8::StaticOrder, true>(lds, P, S, E);
            }
            SEAM(9);
            if (IN(10)) {
                for (int it = vcu * NTHREADS + tid; it < (T / 32) * 128; it += G * NTHREADS) {
                    const int ch = (it & 127) * 8, run = it >> 7, t0 = run * 32, s0 = t0 & (SEQ - 1);
                    const int wdw = 2 << (ch >> 8);
                    float sum[8];
#pragma unroll
                    for (int k = 0; k < 8; ++k) sum[k] = 0.f;
                    for (int i = 1; i < wdw; ++i) { if (s0 - i < 0) break; const u32x4 a = *(const u32x4*)(U + (size_t)(t0 - i) * D + ch);
#pragma unroll
                        for (int k = 0; k < 4; ++k) { sum[2 * k] += bf_lo(a[k]); sum[2 * k + 1] += bf_hi(a[k]); } }
                    for (int i = 0; i < 32; ++i) {
                        const int tk = t0 + i, s = s0 + i;
                        const u32x4 a = *(const u32x4*)(U + (size_t)tk * D + ch);
                        float cur[8];
#pragma unroll
                        for (int k = 0; k < 4; ++k) { cur[2 * k] = bf_lo(a[k]); cur[2 * k + 1] = bf_hi(a[k]); }
#pragma unroll
                        for (int k = 0; k < 8; ++k) sum[k] += cur[k];
                        const float invc = 1.0f / (float)((s + 1) < wdw ? (s + 1) : wdw);
                        u32x4 w;
#pragma unroll
                        for (int k = 0; k < 4; ++k) w[k] = cvtpk(sum[2 * k] * invc - cur[2 * k], sum[2 * k + 1] * invc - cur[2 * k + 1]);
                        *(u32x4*)(POOLED + (size_t)tk * D + ch) = w;
                        if (s - wdw + 1 >= 0) { const u32x4 o = *(const u32x4*)(U + (size_t)(tk - wdw + 1) * D + ch);
#pragma unroll
                            for (int k = 0; k < 4; ++k) { sum[2 * k] -= bf_lo(o[k]); sum[2 * k + 1] -= bf_hi(o[k]); } }
                    }
                }
            }
            SEAM(10);
            if (IN(11)) {
                pg8::DenseProb P{POOLED, Wc_t, D, D, 0, (size_t)256 * D};
                pg8::StaticOrder S; S.init(T / 256, D / 256, G, bx);
                EpiResF32 E{H, H};
                pg8::gemm_phase<pg8::DenseProb, EpiResF32, pg8::StaticOrder, true>(lds, P, S, E);
            }
            SEAM(11);
        }
    }
    if (IN(15)) {
        RowPassCfg c{}; c.hin = H; c.ys = YS; c.slotref = slotref + (size_t)T * 2; c.cnt_prev = ctl + CW_CNT + NE; c.gain = p.norm_final; c.fout = p.out;
        row_pass(lds, c, vcu, tid, wave, lane);
    }
#undef IN
#undef SEAM
#undef GRID_BAR
}

extern "C" void kernel_launch(void* const* d_in, const int* in_sizes, int n_in, void* d_out, int out_size, void* d_ws, size_t ws_size, hipStream_t stream) {
    static int grid = 0;
    if (grid == 0) {
        if (n_in != 18 || in_sizes[0] != T * D || out_size != T * D || ws_size < WS_END) { fprintf(stderr, "kernel_launch: unexpected shapes (n_in %d, in0 %d, out %d, ws %zu)\n", n_in, n_in > 0 ? in_sizes[0] : -1, out_size, ws_size); grid = -1; return; }
        int dev = 0, cus = 0, per_cu = 0;
        if (hipGetDevice(&dev) != hipSuccess || hipDeviceGetAttribute(&cus, hipDeviceAttributeMultiprocessorCount, dev) != hipSuccess) { grid = -1; return; }
        if (hipFuncSetAttribute((const void*)fwd_kernel, hipFuncAttributeMaxDynamicSharedMemorySize, LDS_BYTES) != hipSuccess) { fprintf(stderr, "kernel_launch: hipFuncSetAttribute failed\n"); grid = -1; return; }
        if (hipOccupancyMaxActiveBlocksPerMultiprocessor(&per_cu, (const void*)fwd_kernel, NTHREADS, LDS_BYTES) != hipSuccess || per_cu < 1) { fprintf(stderr, "kernel_launch: occupancy query says %d\n", per_cu); per_cu = 1; }
        (void)hipGetLastError();
        grid = cus;
    }
    if (grid < 0) return;
    (void)hipMemsetAsync((char*)d_ws + WS_CTL, 0, CTL_ZERO_BYTES, stream);
    Params p{};
    p.x = (const float*)d_in[0]; p.positions = (const int*)d_in[1]; p.norm_mix = (const float*)d_in[2]; p.norm_ffn = (const float*)d_in[3]; p.norm_final = (const float*)d_in[4];
    p.attn_w_in = (const float*)d_in[5]; p.attn_w_out = (const float*)d_in[6]; p.pool_w_in = (const float*)d_in[7]; p.pool_w_group = (const float*)d_in[8]; p.pool_scale = (const float*)d_in[9]; p.pool_w_out = (const float*)d_in[10];
    p.router_group_w = (const float*)d_in[11]; p.router_group_b = (const float*)d_in[12]; p.router_expert_w = (const float*)d_in[13]; p.router_expert_b = (const float*)d_in[14];
    p.expert_w1 = (const float*)d_in[15]; p.expert_w3 = (const float*)d_in[16]; p.expert_w2 = (const float*)d_in[17];
    p.out = (float*)d_out; p.ws = (unsigned char*)d_ws;
#if MK_N_LAUNCHES == 1
    p.ph_lo = 0; p.ph_hi = N_PHASES;
    void* args[] = {&p};
    hipError_t e = hipLaunchCooperativeKernel((const void*)fwd_kernel, dim3(grid), dim3(NTHREADS), args, LDS_BYTES, stream);
    if (e != hipSuccess) fprintf(stderr, "cooperative launch failed: %s (grid %d)\n", hipGetErrorString(e), grid);
#else
    for (int ph = 0; ph < N_PHASES; ++ph) {
        p.ph_lo = ph; p.ph_hi = ph + 1;
        hipLaunchKernelGGL(fwd_kernel, dim3(grid), dim3(NTHREADS), LDS_BYTES, stream, p);
    }
#endif
}
```

```cpp
#include <hip/hip_runtime.h>
#include <hip/hip_cooperative_groups.h>
#include <cstdio>
#include <cstdint>
namespace cg = cooperative_groups;

#ifndef MK_N_LAUNCHES
#define MK_N_LAUNCHES 1
#endif

#define LAS __attribute__((address_space(3)))
#define GAS __attribute__((address_space(1)))
typedef unsigned short bf16;
typedef short bf16x8 __attribute__((ext_vector_type(8)));
typedef float f32x4 __attribute__((ext_vector_type(4)));
typedef float f32x2 __attribute__((ext_vector_type(2)));
typedef float f32x16 __attribute__((ext_vector_type(16)));
typedef unsigned u32x4 __attribute__((ext_vector_type(4)));
typedef unsigned u32x2 __attribute__((ext_vector_type(2)));
typedef short s16x4 __attribute__((ext_vector_type(4)));
typedef __bf16 bf16x2_t __attribute__((ext_vector_type(2)));

constexpr int BATCH = 16, SEQ = 2048, D = 1024, T = BATCH * SEQ;
constexpr int NG = 3, HPG = 8, HD = 64, AW = 512, QKVW = NG * 3 * AW;
constexpr int NE = 16, DE = 512, SLOTS = 2 * T;
constexpr int MAXTILES = SLOTS / 256 + NE;
constexpr float RMS_EPS = 1e-6f;
constexpr int NWAVES = 8, NTHREADS = 512;

constexpr size_t MiB = 1u << 20;
constexpr size_t WS_CTL = 0, CTL_ZERO_BYTES = 64 * 1024;
constexpr size_t WS_CS = 1 * MiB;
constexpr size_t WS_LSE = 3 * MiB;
constexpr size_t WS_SLOTREF = 6 * MiB;
constexpr size_t WS_WGS = 7 * MiB;
constexpr size_t WS_LIST = 8 * MiB;
constexpr size_t WS_GATEL = 12 * MiB;
constexpr size_t WS_WIN = 16 * MiB;
constexpr size_t WS_WOUT = 25 * MiB;
constexpr size_t WS_WPIN = 26 * MiB;
constexpr size_t WS_WC = 28 * MiB;
constexpr size_t WS_WPO = 30 * MiB;
constexpr size_t WS_W13 = 32 * MiB;
constexpr size_t WS_W2 = 96 * MiB;
constexpr size_t WS_Y = 128 * MiB;
constexpr size_t WS_BIG = 192 * MiB;
constexpr size_t WS_OM = WS_BIG;
constexpr size_t WS_HMID = WS_BIG;
constexpr size_t WS_YS = WS_BIG + 72 * MiB;
constexpr size_t WS_U = WS_BIG;
constexpr size_t WS_POOLED = WS_BIG + 64 * MiB;
constexpr size_t WS_END = WS_BIG + 288 * MiB;
constexpr int CW_CNT = 0;
constexpr int CW_BAR = 1024;
#ifndef CG_SEAM
#define CG_SEAM 0
#endif

constexpr int RING_BYTES = 131072;
constexpr int AOFS_OFF = RING_BYTES;
constexpr int MISC_OFF = AOFS_OFF + 8192;
constexpr int LDS_BYTES = 147456;

__device__ __forceinline__ unsigned cvtpk(float lo, float hi) { f32x2 v = {lo, hi}; bf16x2_t b = __builtin_convertvector(v, bf16x2_t); return __builtin_bit_cast(unsigned, b); }
__device__ __forceinline__ float bf_lo(unsigned u) { return __uint_as_float(u << 16); }
__device__ __forceinline__ float bf_hi(unsigned u) { return __uint_as_float(u & 0xffff0000u); }
#define DPP_ADD(v, ctrl) ((v) + __builtin_bit_cast(float, __builtin_amdgcn_update_dpp(0, __builtin_bit_cast(int, (v)), (ctrl), 0xF, 0xF, true)))
__device__ __forceinline__ float wave_sum(float v) {
    v = DPP_ADD(v, 0xB1);
    v = DPP_ADD(v, 0x4E);
    v = DPP_ADD(v, 0x141);
    v = DPP_ADD(v, 0x140);
    const int vi = __builtin_bit_cast(int, v);
    const float r0 = __builtin_bit_cast(float, __builtin_amdgcn_readlane(vi, 0)), r1 = __builtin_bit_cast(float, __builtin_amdgcn_readlane(vi, 16));
    const float r2 = __builtin_bit_cast(float, __builtin_amdgcn_readlane(vi, 32)), r3 = __builtin_bit_cast(float, __builtin_amdgcn_readlane(vi, 48));
    return (r0 + r1) + (r2 + r3);
}

namespace pg8 {
constexpr int BM = 256, BK = 64, HALF = 128, HTB = HALF * BK * 2, STAGE_BYTES = 8 * HTB, NXCD = 8, WGM = 8;
__host__ __device__ __forceinline__ int lds_byte(int r, int c) { const int st = (r >> 4) * 2 + (c >> 5), rr = r & 15, cc = c & 31, ob = rr * 64 + cc * 2; return st * 1024 + (ob ^ (((ob >> 9) & 1) << 5)); }
__host__ __device__ __forceinline__ void stage_rc(int b, int& R, int& C) { const int st = b / 1024, sb = b % 1024, swz = sb ^ (((sb >> 9) & 1) << 5); R = (st >> 1) * 16 + swz / 64; C = (st & 1) * 32 + (swz % 64) / 2; }
__host__ __device__ __forceinline__ int perm32(int rho) { const int n = rho >> 4, i = rho & 15; return 8 * (i >> 2) + 4 * n + (i & 3); }

struct Unit { int pm, pn; };

struct StaticOrder {
    int nM, nN, nwg, G, c;
    __device__ void init(int nM_, int nN_, int G_, int c_) { nM = nM_; nN = nN_; nwg = nM * nN; G = G_; c = c_; }
    __device__ bool next(int i, Unit& u) const {
        const long L = (long)i * G + c; if (L >= nwg) return false;
        int wgid = (int)L; { const int q = nwg / NXCD, r = nwg % NXCD, xcd = wgid % NXCD, off = wgid / NXCD; wgid = (xcd < r ? xcd * (q + 1) : r * (q + 1) + (xcd - r) * q) + off; }
        const int nig = WGM * nN, gid = wgid / nig, fm = gid * WGM, gsz = (nM - fm) < WGM ? (nM - fm) : WGM;
        u.pm = fm + ((wgid % nig) % gsz); u.pn = (wgid % nig) / gsz; return true;
    }
};

template <class Prob, class Epi, class Sched, bool ALIGN_EPI>
__device__ __forceinline__ void gemm_phase(LAS unsigned char* lds, const Prob& P, const Sched& S, const Epi& E) {
    int tid_ = threadIdx.x; asm volatile("" : "+v"(tid_));
    const int tid = tid_, wid = __builtin_amdgcn_readfirstlane(tid >> 6), lane = tid & 63, wr = wid >> 2, wc = wid & 3, fr = lane & 15, fq = lane >> 4;
    const int K = P.K, nt = K / BK;
    int Rr[2], Cc[2]; unsigned voffB[2];
#pragma unroll
    for (int i = 0; i < 2; ++i) { int R, C; stage_rc(tid * 16 + i * 8192, R, C); Rr[i] = R; Cc[i] = C; const int Rb = Epi::PERM ? ((R & ~31) + perm32(R & 31)) : R; voffB[i] = (unsigned)(Rb * K + C) * 2u; }
    const unsigned kstep = (unsigned)(BK * 2);
    const unsigned hstep = (unsigned)(HALF * K * 2);
    const unsigned ldsw = (unsigned)wid * 1024u;
    const int aoff = lds_byte(wr * 64 + fr, fq * 8), boff = lds_byte(wc * 32 + fr, fq * 8);
    const __amdgpu_buffer_rsrc_t rsA = __builtin_amdgcn_make_buffer_rsrc((void*)P.A, 0, 0xFFFFFFFF, 0x00020000);
    const __amdgpu_buffer_rsrc_t rsB = __builtin_amdgcn_make_buffer_rsrc((void*)P.Bt, 0, 0xFFFFFFFF, 0x00020000);
#define PG8_SA(b, h) (((b) * 2 + (h)) * HTB)
#define PG8_SB(b, h) ((4 + (b) * 2 + (h)) * HTB)
#define PG8_STAGE_B(bufoff, sB) do { _Pragma("unroll") for (int _i = 0; _i < 2; ++_i) \
        __builtin_amdgcn_raw_ptr_buffer_load_lds(rsB, (LAS void*)(lds + (bufoff) + ldsw + _i * 8192), 16, (int)voffB[_i], (int)(sB), 0, 0); } while (0)
#define PG8_STAGE_A(bufoff, kb, o) do { _Pragma("unroll") for (int _i = 0; _i < 2; ++_i) \
        __builtin_amdgcn_raw_ptr_buffer_load_lds(rsA, (LAS void*)(lds + (bufoff) + ldsw + _i * 8192), 16, (int)(o)[_i], (int)(kb), 0, 0); } while (0)
#define PG8_LDA(dst, b, h) do { _Pragma("unroll") for (int m = 0; m < 4; ++m) _Pragma("unroll") for (int k = 0; k < 2; ++k) dst[m][k] = *(const LAS bf16x8*)(lds + PG8_SA(b, h) + aoff + m * 2048 + k * 1024); } while (0)
#define PG8_LDB(dst, b, h) do { _Pragma("unroll") for (int n = 0; n < 2; ++n) _Pragma("unroll") for (int k = 0; k < 2; ++k) dst[n][k] = *(const LAS bf16x8*)(lds + PG8_SB(b, h) + boff + n * 2048 + k * 1024); } while (0)
#define PG8_MMA(ai, bj, At, Bt) do { __builtin_amdgcn_s_setprio(1); _Pragma("unroll") for (int m = 0; m < 4; ++m) _Pragma("unroll") for (int n = 0; n < 2; ++n) _Pragma("unroll") for (int k = 0; k < 2; ++k) \
        acc[ai][bj][m][n] = __builtin_amdgcn_mfma_f32_16x16x32_bf16(Bt[n][k], At[m][k], acc[ai][bj][m][n], 0, 0, 0); __builtin_amdgcn_s_setprio(0); } while (0)
#define PG8_WAIT_V(n) asm volatile("s_waitcnt vmcnt(" #n ")" ::: "memory")
#define PG8_WAIT_L(n) asm volatile("s_waitcnt lgkmcnt(" #n ")" ::: "memory")
#define PG8_BAR __builtin_amdgcn_s_barrier()
#define PG8_SCHED __builtin_amdgcn_sched_barrier(0)
    Unit cur, nxt; int ui = 0;
    if (!S.next(0, cur)) return;
    f32x4 acc[2][2][4][2];
#pragma unroll
    for (int a = 0; a < 2; ++a)
#pragma unroll
        for (int b = 0; b < 2; ++b)
#pragma unroll
            for (int m = 0; m < 4; ++m)
#pragma unroll
                for (int n = 0; n < 2; ++n) acc[a][b][m][n] = (f32x4){0.f, 0.f, 0.f, 0.f};
    bf16x8 At[4][2], B0[2][2], B1[2][2];
    unsigned ca0[2], ca1[2];
    P.a_offs(0, cur, Rr, Cc, ca0, ca1);
    unsigned cB = P.b_off(cur);
    PG8_STAGE_B(PG8_SB(0, 0), cB); PG8_STAGE_B(PG8_SB(0, 1), cB + hstep); PG8_STAGE_A(PG8_SA(0, 0), 0, ca0); PG8_STAGE_A(PG8_SA(0, 1), 0, ca1);
    if (wr == 1) PG8_BAR;
    PG8_WAIT_V(2); PG8_BAR;
    PG8_STAGE_B(PG8_SB(1, 0), cB + kstep); PG8_STAGE_A(PG8_SA(1, 0), kstep, ca0); PG8_STAGE_B(PG8_SB(1, 1), cB + hstep + kstep);
    PG8_WAIT_V(6); PG8_BAR;
    for (;;) {
        const bool has_next = S.next(ui + 1, nxt);
        unsigned nB = cB;
        if (has_next) nB = P.b_off(nxt);
        for (int t = 0; t < nt; t += 2) {
            const bool last = (t == nt - 2);
            const unsigned k1 = (unsigned)(t + 1) * kstep;
            const unsigned k2 = last ? 0u : (unsigned)(t + 2) * kstep, k3 = k2 + kstep;
            const unsigned b2 = last ? nB : cB + (unsigned)(t + 2) * kstep; const unsigned b3 = b2 + kstep;
            unsigned x0[2], x1[2];
            x0[0] = ca0[0]; x0[1] = ca0[1]; x1[0] = ca1[0]; x1[1] = ca1[1];
            if (last && has_next) P.a_offs(ui + 1, nxt, Rr, Cc, x0, x1);
            PG8_LDB(B0, 0, 0); PG8_LDB(B1, 0, 1); PG8_SCHED; PG8_LDA(At, 0, 0); PG8_STAGE_A(PG8_SA(1, 1), k1, ca1);
            PG8_WAIT_V(8); PG8_WAIT_L(0); PG8_BAR; PG8_MMA(0, 0, At, B0); PG8_MMA(0, 1, At, B1); PG8_BAR; PG8_SCHED;
            PG8_LDA(At, 0, 1); PG8_STAGE_B(PG8_SB(0, 0), b2); PG8_STAGE_B(PG8_SB(0, 1), b2 + hstep); PG8_STAGE_A(PG8_SA(0, 0), k2, x0);
            PG8_WAIT_V(8); PG8_WAIT_L(0); PG8_BAR; PG8_MMA(1, 0, At, B0); PG8_MMA(1, 1, At, B1); PG8_BAR; PG8_SCHED;
            PG8_LDB(B0, 1, 0); PG8_LDB(B1, 1, 1); PG8_SCHED; PG8_LDA(At, 1, 0); PG8_STAGE_A(PG8_SA(0, 1), k2, x1);
            PG8_WAIT_V(8); PG8_WAIT_L(0); PG8_BAR; PG8_MMA(0, 0, At, B0); PG8_MMA(0, 1, At, B1); PG8_BAR; PG8_SCHED;
            PG8_LDA(At, 1, 1); PG8_STAGE_B(PG8_SB(1, 0), b3); PG8_STAGE_B(PG8_SB(1, 1), b3 + hstep); PG8_STAGE_A(PG8_SA(1, 0), k3, x0);
            PG8_WAIT_V(8); PG8_WAIT_L(0); PG8_BAR; PG8_MMA(1, 0, At, B0); PG8_MMA(1, 1, At, B1); PG8_BAR; PG8_SCHED;
        }
        if constexpr (ALIGN_EPI) { if (wr == 0) PG8_BAR; }
        E(acc, cur, wr, wc, fr, fq);
        if (!has_next) break;
#pragma unroll
        for (int a = 0; a < 2; ++a)
#pragma unroll
            for (int b = 0; b < 2; ++b)
#pragma unroll
                for (int m = 0; m < 4; ++m)
#pragma unroll
                    for (int n = 0; n < 2; ++n) acc[a][b][m][n] = (f32x4){0.f, 0.f, 0.f, 0.f};
        cur = nxt; cB = nB; ++ui; P.a_offs(ui, cur, Rr, Cc, ca0, ca1);
        if constexpr (ALIGN_EPI) { if (wr == 1) PG8_BAR; }
    }
    PG8_WAIT_V(0);
    if constexpr (!ALIGN_EPI) { if (wr == 0) PG8_BAR; }
    PG8_BAR;
#undef PG8_SA
#undef PG8_SB
#undef PG8_STAGE_A
#undef PG8_STAGE_B
#undef PG8_LDA
#undef PG8_LDB
#undef PG8_MMA
#undef PG8_WAIT_V
#undef PG8_WAIT_L
#undef PG8_BAR
#undef PG8_SCHED
}

struct DenseProb {
    const bf16* A; const bf16* Bt; int K, lda, acolstep; size_t bstep_pn;
    __device__ __forceinline__ void a_offs(int, const Unit& u, const int (&R)[2], const int (&C)[2], unsigned (&o0)[2], unsigned (&o1)[2]) const {
#pragma unroll
        for (int i = 0; i < 2; ++i) { const unsigned b = (unsigned)((u.pm * BM + R[i]) * lda + u.pn * acolstep + C[i]) * 2u; o0[i] = b; o1[i] = b + (unsigned)(HALF * lda * 2); }
    }
    __device__ __forceinline__ unsigned b_off(const Unit& u) const { return (unsigned)((size_t)u.pn * bstep_pn * 2); }
};
}

struct Params {
    const float* x; const int* positions; const float* norm_mix; const float* norm_ffn; const float* norm_final;
    const float* attn_w_in; const float* attn_w_out; const float* pool_w_in; const float* pool_w_group; const float* pool_scale; const float* pool_w_out;
    const float* router_group_w; const float* router_group_b; const float* router_expert_w; const float* router_expert_b;
    const float* expert_w1; const float* expert_w3; const float* expert_w2;
    float* out; unsigned char* ws;
    int ph_lo, ph_hi;
};

template <class MapN>
__device__ __forceinline__ void transpose_item(const float* W, int ldw, int K, bf16* WT, MapN mapn, LAS float* scr, int k0, int n0, int lane) {
#pragma unroll 8
    for (int i = 0; i < 32; ++i) { const int kk = 2 * i + (lane >> 5); scr[kk * 33 + (lane & 31)] = W[(size_t)(k0 + kk) * ldw + n0 + (lane & 31)]; }
    asm volatile("s_waitcnt lgkmcnt(0)" ::: "memory");
    const int c = lane & 7;
#pragma unroll
    for (int j = 0; j < 4; ++j) { const int n = (lane >> 3) + 8 * j; const LAS float* s = scr + (8 * c) * 33 + n;
        u32x4 o; o.x = cvtpk(s[0 * 33], s[1 * 33]); o.y = cvtpk(s[2 * 33], s[3 * 33]); o.z = cvtpk(s[4 * 33], s[5 * 33]); o.w = cvtpk(s[6 * 33], s[7 * 33]);
        *(u32x4*)(WT + (size_t)mapn(n0 + n) * K + k0 + 8 * c) = o; }
    asm volatile("s_waitcnt lgkmcnt(0)" ::: "memory");
}
struct MapId { __device__ __forceinline__ int operator()(int n) const { return n; } };
struct MapQKV {
    __device__ __forceinline__ int operator()(int n) const { const int rem = n % 1536, kind = rem / 512, d = n & 63; if (kind < 2 && d < 16) return n - d + (d < 8 ? 2 * d : 2 * (d - 8) + 1); return n; }
};
struct MapW13 { int add; __device__ __forceinline__ int operator()(int n) const { return (n >> 7) * 256 + add + (n & 127); } };

struct RowPassCfg {
    const float* hin;
    const bf16* ys; const int* slotref; const int* cnt_prev;
    float* hout;
    const float* gain;
    bf16* yout;
    float* fout;
    const float* rgw; const float* rgb; const float* rew; const float* reb;
    int* cnt; int* list; float* gatel; int* slotref_out;
};

__device__ __forceinline__ void route_decide(const float (&a)[20], const float* rgb, const float* reb, int& e0, int& e1, float& g0, float& g1) {
    float lg[4];
#pragma unroll
    for (int g = 0; g < 4; ++g) lg[g] = a[g] + rgb[g];
    int gs = 0; float gm = lg[0];
#pragma unroll
    for (int g = 1; g < 4; ++g) if (lg[g] > gm) { gm = lg[g]; gs = g; }
    float den = 0.f;
#pragma unroll
    for (int g = 0; g < 4; ++g) den += __expf(lg[g] - gm);
    const float gate1 = 1.0f / den;
    float le[4];
#pragma unroll
    for (int e = 0; e < 4; ++e) { const float sel = gs == 0 ? a[4 + e] : gs == 1 ? a[8 + e] : gs == 2 ? a[12 + e] : a[16 + e]; le[e] = sel + reb[gs * 4 + e]; }
    int i0 = 0; float v0 = le[0];
#pragma unroll
    for (int e = 1; e < 4; ++e) if (le[e] > v0) { v0 = le[e]; i0 = e; }
    int i1 = -1; float v1 = -INFINITY;
#pragma unroll
    for (int e = 0; e < 4; ++e) if (e != i0 && le[e] > v1) { v1 = le[e]; i1 = e; }
    const float ex = __expf(v1 - v0), p0 = 1.0f / (1.0f + ex), p1 = ex * p0;
    e0 = gs * 4 + i0; e1 = gs * 4 + i1; g0 = gate1 * p0; g1 = gate1 * p1;
}

template <bool COMBINE, bool ROUTER>
__device__ __forceinline__ void row_pass(LAS unsigned char* lds, const RowPassCfg& c, int vcu, int wave) {
    int tid = threadIdx.x; asm volatile("" : "+v"(tid)); const int lane = tid & 63;
    LAS float* Wr = (LAS float*)lds;
    LAS int* selE = (LAS int*)(lds + 81920);
    LAS float* selG = (LAS float*)(lds + 81920 + 1024);
    LAS int* wcnt = (LAS int*)(lds + 81920 + 2048);
    LAS int* tb = (LAS int*)(lds + MISC_OFF);
    if (ROUTER) {
        for (int k = tid; k < 1024; k += NTHREADS) {
            const f32x4 g4 = *(const f32x4*)(c.rgw + (size_t)k * 4);
            Wr[0 * 1024 + k] = g4.x; Wr[1 * 1024 + k] = g4.y; Wr[2 * 1024 + k] = g4.z; Wr[3 * 1024 + k] = g4.w;
#pragma unroll
            for (int g = 0; g < 4; ++g) { const f32x4 e4 = *(const f32x4*)(c.rew + ((size_t)g * 1024 + k) * 4);
                Wr[(4 + g * 4 + 0) * 1024 + k] = e4.x; Wr[(4 + g * 4 + 1) * 1024 + k] = e4.y; Wr[(4 + g * 4 + 2) * 1024 + k] = e4.z; Wr[(4 + g * 4 + 3) * 1024 + k] = e4.w; }
        }
    }
    if (COMBINE) {
        if (tid == 0) { int sacc = 0; for (int e = 0; e < NE; ++e) { tb[e] = sacc; sacc += (c.cnt_prev[e] + 255) >> 8; } tb[NE] = sacc; }
    }
    __syncthreads();
    f32x4 gn[4];
#pragma unroll
    for (int j = 0; j < 4; ++j) gn[j] = *(const f32x4*)(c.gain + 4 * lane + 256 * j);
    for (int rb = vcu; rb < T / 128; rb += gridDim.x) {
        const int rbase = rb * 128 + wave * 16;
        int refs = 0;
        if (COMBINE) { if (lane < 32) refs = c.slotref[rbase * 2 + lane]; }
        f32x4 hv[2][2][4]; u32x2 yv[2][2][2][4];
#define RP_ISSUE(buf, pr) do { _Pragma("unroll") for (int r = 0; r < 2; ++r) { const int row = rbase + 2 * (pr) + r; \
            _Pragma("unroll") for (int j = 0; j < 4; ++j) hv[buf][r][j] = *(const f32x4*)(c.hin + (size_t)row * D + 4 * lane + 256 * j); \
            if (COMBINE) { _Pragma("unroll") for (int sl = 0; sl < 2; ++sl) { const int ref = __builtin_amdgcn_readlane(refs, (2 * (pr) + r) * 2 + sl); const int e = ref >> 15, pos = ref & 32767; \
                const bf16* yr = c.ys + ((size_t)tb[e] * 256 + pos) * D; \
                _Pragma("unroll") for (int j = 0; j < 4; ++j) yv[buf][r][sl][j] = *(const u32x2*)(yr + 4 * lane + 256 * j); } } } } while (0)
#define RP_PROCESS(buf, pr) do { f32x4 v[2][4]; \
            _Pragma("unroll") for (int r = 0; r < 2; ++r) { const int row = rbase + 2 * (pr) + r; \
                _Pragma("unroll") for (int j = 0; j < 4; ++j) { v[r][j] = hv[buf][r][j]; \
                    if (COMBINE) { _Pragma("unroll") for (int sl = 0; sl < 2; ++sl) { const u32x2 w = yv[buf][r][sl][j]; v[r][j].x += bf_lo(w.x); v[r][j].y += bf_hi(w.x); v[r][j].z += bf_lo(w.y); v[r][j].w += bf_hi(w.y); } } } \
                if (c.hout) { _Pragma("unroll") for (int j = 0; j < 4; ++j) *(f32x4*)(c.hout + (size_t)row * D + 4 * lane + 256 * j) = v[r][j]; } \
                float ss = 0.f; \
                _Pragma("unroll") for (int j = 0; j < 4; ++j) ss += (v[r][j].x * v[r][j].x + v[r][j].y * v[r][j].y) + (v[r][j].z * v[r][j].z + v[r][j].w * v[r][j].w); \
                const float rstd = 1.0f / sqrtf(wave_sum(ss) * (1.0f / D) + RMS_EPS); \
                _Pragma("unroll") for (int j = 0; j < 4; ++j) { v[r][j].x = v[r][j].x * rstd * gn[j].x; v[r][j].y = v[r][j].y * rstd * gn[j].y; v[r][j].z = v[r][j].z * rstd * gn[j].z; v[r][j].w = v[r][j].w * rstd * gn[j].w; } \
                if (c.yout) { _Pragma("unroll") for (int j = 0; j < 4; ++j) { u32x2 w; w.x = cvtpk(v[r][j].x, v[r][j].y); w.y = cvtpk(v[r][j].z, v[r][j].w); *(u32x2*)(c.yout + (size_t)row * D + 4 * lane + 256 * j) = w; } } \
                if (c.fout) { _Pragma("unroll") for (int j = 0; j < 4; ++j) *(f32x4*)(c.fout + (size_t)row * D + 4 * lane + 256 * j) = v[r][j]; } } \
            if (ROUTER) { LAS float* lg_ = (LAS float*)(lds + 81920 + 4096) + wave * 40; \
                _Pragma("unroll 2") for (int o = 0; o < 20; ++o) { float s0 = 0.f, s1 = 0.f; \
                    _Pragma("unroll") for (int j = 0; j < 4; ++j) { const f32x4 w = *(const LAS f32x4*)(Wr + o * 1024 + 4 * lane + 256 * j); \
                        s0 += (v[0][j].x * w.x + v[0][j].y * w.y) + (v[0][j].z * w.z + v[0][j].w * w.w); s1 += (v[1][j].x * w.x + v[1][j].y * w.y) + (v[1][j].z * w.z + v[1][j].w * w.w); } \
                    s0 = wave_sum(s0); s1 = wave_sum(s1); if (lane == 0) { lg_[o] = s0; lg_[20 + o] = s1; } } \
                float a0[20], a1[20]; \
                _Pragma("unroll") for (int o = 0; o < 20; ++o) { a0[o] = lg_[o]; a1[o] = lg_[20 + o]; } \
                int e0, e1; float g0, g1; const int rl = wave * 16 + 2 * (pr); \
                route_decide(a0, c.rgb, c.reb, e0, e1, g0, g1); if (lane == 0) { selE[rl * 2] = e0; selE[rl * 2 + 1] = e1; selG[rl * 2] = g0; selG[rl * 2 + 1] = g1; } \
                route_decide(a1, c.rgb, c.reb, e0, e1, g0, g1); if (lane == 0) { selE[rl * 2 + 2] = e0; selE[rl * 2 + 3] = e1; selG[rl * 2 + 2] = g0; selG[rl * 2 + 3] = g1; } } } while (0)
        RP_ISSUE(0, 0);
#pragma unroll 1
        for (int it = 0; it < 4; ++it) {
            RP_ISSUE(1, 2 * it + 1);
            RP_PROCESS(0, 2 * it);
            if (it < 3) RP_ISSUE(0, 2 * it + 2);
            RP_PROCESS(1, 2 * it + 1);
        }
#undef RP_ISSUE
#undef RP_PROCESS
        if (ROUTER) {
            __syncthreads();
            int e = 0, rank = 0;
            if (tid < 256) {
                e = selE[tid]; int mycount = 0;
#pragma unroll
                for (int x = 0; x < NE; ++x) { const unsigned long long mask = __ballot(e == x); if (e == x) rank = __popcll(mask & ((1ull << lane) - 1ull)); if (lane == x) mycount = __popcll(mask); }
                if (lane < NE) wcnt[(tid >> 6) * 16 + lane] = mycount;
            }
            __syncthreads();
            if (tid < NE) { const int c0 = wcnt[tid], c1 = wcnt[16 + tid], c2 = wcnt[32 + tid], c3 = wcnt[48 + tid]; const int tot = c0 + c1 + c2 + c3;
                int base = 0; if (tot) base = atomicAdd(c.cnt + tid, tot);
                wcnt[tid] = base; wcnt[16 + tid] = base + c0; wcnt[32 + tid] = base + c0 + c1; wcnt[48 + tid] = base + c0 + c1 + c2; }
            __syncthreads();
            if (tid < 256) { const int pos = wcnt[(tid >> 6) * 16 + e] + rank; const int tok = rb * 128 + (tid >> 1);
                c.list[e * T + pos] = tok; c.gatel[e * T + pos] = selG[tid]; c.slotref_out[tok * 2 + (tid & 1)] = e * 32768 + pos; }
            __syncthreads();
        }
    }
    __syncthreads();
}

namespace att {
constexpr float C2 = 0.125f * 1.4426950408889634f;
constexpr float LN2 = 0.6931471805599453f;
__device__ __forceinline__ int crow(int r, int hi) { return (r & 3) + 8 * (r >> 2) + 4 * hi; }
typedef short v4i16_t __attribute__((ext_vector_type(4)));
__device__ __forceinline__ s16x4 vtr(const LAS unsigned char* p) { return __builtin_bit_cast(s16x4, __builtin_amdgcn_ds_read_tr16_b64_v4i16((LAS v4i16_t*)p)); }

__device__ __forceinline__ void attn_phase(LAS unsigned char* lds, const bf16* qkv, bf16* og, float* lse, int vcu, int G) {
    int tid_ = threadIdx.x; asm volatile("" : "+v"(tid_));
    const int tid = tid_, lane = tid & 63, wid = __builtin_amdgcn_readfirstlane(tid >> 6);
    const int half = wid >> 2, w = wid & 3, r32 = lane & 31, hi = lane >> 5, th = tid & 255;
    LAS unsigned char* Kl = lds + half * 65536;
    LAS unsigned char* Vl = Kl + 32768;
    for (int pp = vcu; pp < 3072; pp += G) {
        const int hh = pp & 7, q8 = (pp >> 3) & 7, g = (pp >> 6) % 3, b = pp / 192;
        const int idx16 = q8 * 2 + half;
        const int dil = g == 0 ? 1 : (g == 1 ? 4 : 16), nb = 16 / dil, j = idx16 % nb, ph = idx16 / nb;
        const size_t rstride = (size_t)dil * QKVW;
        const bf16* base = qkv + (size_t)(b * SEQ + ph) * QKVW + g * 1536 + hh * 64;
        const int l0 = 128 * (j - 1);
        const int tt_lo = (j == 0) ? 2 : 0;
        for (int tt = tt_lo; tt < 4; ++tt) {
#pragma unroll
            for (int i = 0; i < 2; ++i) {
                const int p = th + 256 * i;
                { const int chunk = p >> 6, kv = p & 63; const u32x4 val = *(const u32x4*)(base + 512 + (size_t)(l0 + 64 * tt + kv) * rstride + chunk * 8); *(LAS u32x4*)(Kl + tt * 8192 + p * 16) = val; }
                { const int dh = p >> 8, kv = (p >> 2) & 63, c4 = p & 3; const u32x4 val = *(const u32x4*)(base + 1024 + (size_t)(l0 + 64 * tt + kv) * rstride + dh * 32 + c4 * 8); *(LAS u32x4*)(Vl + tt * 8192 + p * 16) = val; }
            }
        }
        const int lq = 128 * j + 32 * w + r32;
        const bf16* qrow = base + (size_t)lq * rstride;
        bf16x8 qr[4];
#pragma unroll
        for (int d0 = 0; d0 < 4; ++d0) qr[d0] = *(const bf16x8*)(qrow + d0 * 16 + hi * 8);
        __syncthreads();
        float m = -1e30f, l = 0.f; f32x16 oT[2]; oT[0] = f32x16{}; oT[1] = f32x16{};
        const int t_lo = (w >= 2) ? (tt_lo > 1 ? tt_lo : 1) : tt_lo, t_hi = (w < 2) ? 2 : 3;
        for (int tt = t_lo; tt <= t_hi; ++tt) {
            const LAS unsigned char* kb = Kl + tt * 8192 + hi * 1024 + r32 * 16;
            f32x16 p0 = f32x16{}, p1 = f32x16{};
#pragma unroll
            for (int d0 = 0; d0 < 4; ++d0) {
                const bf16x8 k0 = *(const LAS bf16x8*)(kb + d0 * 2048), k1 = *(const LAS bf16x8*)(kb + d0 * 2048 + 512);
                p0 = __builtin_amdgcn_mfma_f32_32x32x16_bf16(k0, qr[d0], p0, 0, 0, 0);
                p1 = __builtin_amdgcn_mfma_f32_32x32x16_bf16(k1, qr[d0], p1, 0, 0, 0);
            }
            const int dbase = 128 + 32 * w + r32 - 64 * tt;
            float mx = -INFINITY;
#pragma unroll
            for (int r = 0; r < 16; ++r) {
                const int d0_ = dbase - crow(r, hi), d1_ = d0_ - 32;
                p0[r] = (d0_ >= 0 && d0_ <= 128) ? p0[r] * C2 : -INFINITY;
                p1[r] = (d1_ >= 0 && d1_ <= 128) ? p1[r] * C2 : -INFINITY;
                mx = fmaxf(mx, fmaxf(p0[r], p1[r]));
            }
            mx = fmaxf(mx, __shfl_xor(mx, 32));
            const float mn = fmaxf(m, mx), alpha = __builtin_amdgcn_exp2f(m - mn);
            float rs = 0.f;
#pragma unroll
            for (int r = 0; r < 16; ++r) { p0[r] = __builtin_amdgcn_exp2f(p0[r] - mn); p1[r] = __builtin_amdgcn_exp2f(p1[r] - mn); rs += p0[r] + p1[r]; }
            l = l * alpha + rs; m = mn;
#pragma unroll
            for (int r = 0; r < 16; ++r) { oT[0][r] *= alpha; oT[1][r] *= alpha; }
            u32x4 pw[4];
            pw[0] = (u32x4){cvtpk(p0[0], p0[1]), cvtpk(p0[2], p0[3]), cvtpk(p0[4], p0[5]), cvtpk(p0[6], p0[7])};
            pw[1] = (u32x4){cvtpk(p0[8], p0[9]), cvtpk(p0[10], p0[11]), cvtpk(p0[12], p0[13]), cvtpk(p0[14], p0[15])};
            pw[2] = (u32x4){cvtpk(p1[0], p1[1]), cvtpk(p1[2], p1[3]), cvtpk(p1[4], p1[5]), cvtpk(p1[6], p1[7])};
            pw[3] = (u32x4){cvtpk(p1[8], p1[9]), cvtpk(p1[10], p1[11]), cvtpk(p1[12], p1[13]), cvtpk(p1[14], p1[15])};
            const LAS unsigned char* vp = Vl + tt * 8192 + ((lane >> 4) & 1) * 32 + (lane & 3) * 8 + (4 * hi + ((lane & 15) >> 2)) * 64;
#pragma unroll
            for (int d0 = 0; d0 < 2; ++d0)
#pragma unroll
                for (int ks = 0; ks < 4; ++ks) {
                    const s16x4 lo = vtr(vp + d0 * 4096 + ks * 1024), hh4 = vtr(vp + d0 * 4096 + ks * 1024 + 512);
                    const bf16x8 vf = (bf16x8){lo[0], lo[1], lo[2], lo[3], hh4[0], hh4[1], hh4[2], hh4[3]};
                    oT[d0] = __builtin_amdgcn_mfma_f32_32x32x16_bf16(vf, __builtin_bit_cast(bf16x8, pw[ks]), oT[d0], 0, 0, 0);
                }
        }
        const float lt = l + __shfl_xor(l, 32);
        const float inv = 1.0f / lt;
        const size_t tok = (size_t)b * SEQ + (size_t)lq * dil + ph;
        bf16* orow = og + tok * (NG * AW) + g * AW + hh * 64;
#pragma unroll
        for (int d0 = 0; d0 < 2; ++d0)
#pragma unroll
            for (int rg = 0; rg < 4; ++rg) {
                u32x2 wv; wv.x = cvtpk(oT[d0][4 * rg] * inv, oT[d0][4 * rg + 1] * inv); wv.y = cvtpk(oT[d0][4 * rg + 2] * inv, oT[d0][4 * rg + 3] * inv);
                *(u32x2*)(orow + 32 * d0 + 8 * rg + 4 * hi) = wv;
            }
        if (hi == 0) lse[tok * 24 + g * 8 + hh] = (m + __builtin_amdgcn_logf(lt)) * LN2;
        __syncthreads();
    }
}
}

using pg8::Unit; using pg8::BM; using pg8::HALF;
struct EpiQKV {
    static constexpr bool PERM = true;
    bf16* O; const float* cs;
    __device__ __forceinline__ void operator()(const f32x4 (&acc)[2][2][4][2], const Unit& u, int wr, int wc, int fr, int fq) const {
        const int colt = u.pn * BM; const int kind = (colt % 1536) / 512;
        const bool rot = (kind < 2) && ((wc & 1) == 0) && (fq < 2);
#pragma unroll
        for (int ai = 0; ai < 2; ++ai)
#pragma unroll
            for (int m = 0; m < 4; ++m) {
                const int row = u.pm * BM + ai * HALF + wr * 64 + m * 16 + fr;
                f32x4 c0 = {1.f, 0.f, 1.f, 0.f}, c1 = {1.f, 0.f, 1.f, 0.f};
                if (rot) { c0 = *(const f32x4*)(cs + (size_t)row * 16 + fq * 8); c1 = *(const f32x4*)(cs + (size_t)row * 16 + fq * 8 + 4); }
                bf16* rowp = O + (size_t)row * QKVW + colt + wc * 32 + 8 * fq;
#pragma unroll
                for (int bj = 0; bj < 2; ++bj) {
                    f32x4 v0 = acc[ai][bj][m][0], v1 = acc[ai][bj][m][1];
                    f32x4 o0, o1;
                    o0.x = v0.x * c0.x - v0.y * c0.y; o0.y = v0.y * c0.x + v0.x * c0.y; o0.z = v0.z * c0.z - v0.w * c0.w; o0.w = v0.w * c0.z + v0.z * c0.w;
                    o1.x = v1.x * c1.x - v1.y * c1.y; o1.y = v1.y * c1.x + v1.x * c1.y; o1.z = v1.z * c1.z - v1.w * c1.w; o1.w = v1.w * c1.z + v1.z * c1.w;
                    u32x4 w; w.x = cvtpk(o0.x, o0.y); w.y = cvtpk(o0.z, o0.w); w.z = cvtpk(o1.x, o1.y); w.w = cvtpk(o1.z, o1.w);
                    *(u32x4*)(rowp + bj * HALF) = w;
                }
            }
    }
};
struct EpiBf16 {
    static constexpr bool PERM = true;
    bf16* O; int ldc;
    __device__ __forceinline__ void operator()(const f32x4 (&acc)[2][2][4][2], const Unit& u, int wr, int wc, int fr, int fq) const {
#pragma unroll
        for (int ai = 0; ai < 2; ++ai)
#pragma unroll
            for (int m = 0; m < 4; ++m) {
                bf16* rowp = O + (size_t)(u.pm * BM + ai * HALF + wr * 64 + m * 16 + fr) * ldc + u.pn * BM + wc * 32 + 8 * fq;
#pragma unroll
                for (int bj = 0; bj < 2; ++bj) { const f32x4 v0 = acc[ai][bj][m][0], v1 = acc[ai][bj][m][1];
                    u32x4 w; w.x = cvtpk(v0.x, v0.y); w.y = cvtpk(v0.z, v0.w); w.z = cvtpk(v1.x, v1.y); w.w = cvtpk(v1.z, v1.w);
                    *(u32x4*)(rowp + bj * HALF) = w; }
            }
    }
};
struct EpiResF32 {
    static constexpr bool PERM = false;
    const float* res; float* out;
    __device__ __forceinline__ void operator()(const f32x4 (&acc)[2][2][4][2], const Unit& u, int wr, int wc, int fr, int fq) const {
#pragma unroll
        for (int ai = 0; ai < 2; ++ai)
#pragma unroll
            for (int m = 0; m < 4; ++m) {
                const size_t off = (size_t)(u.pm * BM + ai * HALF + wr * 64 + m * 16 + fr) * D + u.pn * BM + wc * 32 + 4 * fq;
#pragma unroll
                for (int bj = 0; bj < 2; ++bj)
#pragma unroll
                    for (int n = 0; n < 2; ++n) { const f32x4 r = *(const f32x4*)(res + off + bj * HALF + n * 16); *(f32x4*)(out + off + bj * HALF + n * 16) = r + acc[ai][bj][m][n]; }
            }
    }
};
struct EpiSwiGLU {
    static constexpr bool PERM = true;
    bf16* O;
    __device__ __forceinline__ void operator()(const f32x4 (&acc)[2][2][4][2], const Unit& u, int wr, int wc, int fr, int fq) const {
#pragma unroll
        for (int ai = 0; ai < 2; ++ai)
#pragma unroll
            for (int m = 0; m < 4; ++m) {
                bf16* rowp = O + (size_t)(u.pm * BM + ai * HALF + wr * 64 + m * 16 + fr) * DE + u.pn * HALF + wc * 32 + 8 * fq;
                float h[8];
#pragma unroll
                for (int n = 0; n < 2; ++n)
#pragma unroll
                    for (int e = 0; e < 4; ++e) { const float a = acc[ai][0][m][n][e], b = acc[ai][1][m][n][e];
                        h[n * 4 + e] = a * __builtin_amdgcn_rcpf(1.0f + __builtin_amdgcn_exp2f(-1.4426950408889634f * a)) * b; }
                u32x4 w; w.x = cvtpk(h[0], h[1]); w.y = cvtpk(h[2], h[3]); w.z = cvtpk(h[4], h[5]); w.w = cvtpk(h[6], h[7]);
                *(u32x4*)rowp = w;
            }
    }
};
struct EpiGate {
    static constexpr bool PERM = true;
    bf16* O; const float* gatel; const int* cnt; const LAS int* tb;
    __device__ __forceinline__ void operator()(const f32x4 (&acc)[2][2][4][2], const Unit& u, int wr, int wc, int fr, int fq) const {
        int e = 0;
#pragma unroll
        for (int k = 1; k < NE; ++k) e += (u.pm >= tb[k]) ? 1 : 0;
        const int lbase = (u.pm - tb[e]) * BM, n_e = cnt[e];
#pragma unroll
        for (int ai = 0; ai < 2; ++ai)
#pragma unroll
            for (int m = 0; m < 4; ++m) {
                const int rl = ai * HALF + wr * 64 + m * 16 + fr, li = lbase + rl;
                const float gt = (li < n_e) ? gatel[(size_t)e * T + li] : 0.f;
                bf16* rowp = O + (size_t)(u.pm * BM + rl) * D + u.pn * BM + wc * 32 + 8 * fq;
#pragma unroll
                for (int bj = 0; bj < 2; ++bj) { const f32x4 v0 = acc[ai][bj][m][0] * gt, v1 = acc[ai][bj][m][1] * gt;
                    u32x4 w; w.x = cvtpk(v0.x, v0.y); w.y = cvtpk(v0.z, v0.w); w.z = cvtpk(v1.x, v1.y); w.w = cvtpk(v1.z, v1.w);
                    *(u32x4*)(rowp + bj * HALF) = w; }
            }
    }
};

struct MoeProb1 {
    const bf16* A; const bf16* Bt; int K; const LAS int* tb; const LAS unsigned* aofs;
    __device__ __forceinline__ void a_offs(int i, const Unit&, const int (&R)[2], const int (&C)[2], unsigned (&o0)[2], unsigned (&o1)[2]) const {
#pragma unroll
        for (int k = 0; k < 2; ++k) { o0[k] = aofs[i * 256 + R[k]] + (unsigned)C[k] * 2u; o1[k] = aofs[i * 256 + 128 + R[k]] + (unsigned)C[k] * 2u; }
    }
    __device__ __forceinline__ unsigned b_off(const Unit& u) const {
        int e = 0;
#pragma unroll
        for (int k = 1; k < NE; ++k) e += (u.pm >= tb[k]) ? 1 : 0;
        return (unsigned)((e * 1024 + u.pn * 256) * 1024 * 2);
    }
};
struct MoeProb2 {
    const bf16* A; const bf16* Bt; int K; const LAS int* tb;
    __device__ __forceinline__ void a_offs(int, const Unit& u, const int (&R)[2], const int (&C)[2], unsigned (&o0)[2], unsigned (&o1)[2]) const {
#pragma unroll
        for (int k = 0; k < 2; ++k) { const unsigned b = (unsigned)((u.pm * BM + R[k]) * DE + C[k]) * 2u; o0[k] = b; o1[k] = b + (unsigned)(HALF * DE * 2); }
    }
    __device__ __forceinline__ unsigned b_off(const Unit& u) const {
        int e = 0;
#pragma unroll
        for (int k = 1; k < NE; ++k) e += (u.pm >= tb[k]) ? 1 : 0;
        return (unsigned)((e * 1024 + u.pn * 256) * DE * 2);
    }
};
struct FoldOrder { int G, c; __device__ bool next(int i, Unit& u) const { const int L = i * G + c; if (L >= 16) return false; u.pm = L >> 2; u.pn = L & 3; return true; } };


#define XB_TMO      128
#define XB_XCNT(j)  (256  + 64 * (j))
#define XB_XSUB(j)  (1280 + 64 * (j))
#define XB_XGEN(j)  (2304 + 64 * (j))
#define XB_TOP      3328
#define XB_TOPGEN   3392
#define XCD_BAR_WORDS 3456
#define XB_SPIN_CAP (1u << 18)
__device__ __forceinline__ unsigned xb_ld(unsigned* p)              { return __hip_atomic_load(p, __ATOMIC_RELAXED, __HIP_MEMORY_SCOPE_AGENT); }
__device__ __forceinline__ unsigned xb_add(unsigned* p, unsigned v) { return __hip_atomic_fetch_add(p, v, __ATOMIC_RELAXED, __HIP_MEMORY_SCOPE_AGENT); }
__device__ __forceinline__ unsigned xb_xcc_id() { return (unsigned)__builtin_amdgcn_s_getreg((3 << 11) | 20) & 0xFu; }
#define XB_SPIN(cond, bar) do { unsigned _sp = 0; while (cond) { __builtin_amdgcn_s_sleep(1); \
    if ((++_sp & 255u) == 0u) { if (xb_ld(&(bar)[XB_TMO])) break; if (_sp > XB_SPIN_CAP) { atomicAdd(&(bar)[XB_TMO], 1u); break; } } } } while (0)
struct XcdBarrier { unsigned* bar; unsigned x; volatile LAS unsigned* st; };
__device__ __forceinline__ XcdBarrier xcd_barrier_post(unsigned* bar, volatile LAS unsigned* st) {
    XcdBarrier b; b.bar = bar; b.x = xb_xcc_id(); b.st = st;
    if (threadIdx.x == 0) (void)xb_add(&bar[XB_XCNT(b.x)], 1u);
    return b;
}
__device__ __forceinline__ void xcd_barrier_complete(unsigned* bar, unsigned x, unsigned& nloc, unsigned& nx) {
    const unsigned G = gridDim.x * gridDim.y * gridDim.z;
    unsigned sum, cnt, mine, sp = 0u;
    for (;;) {
        sum = 0u; cnt = 0u; mine = 0u;
#pragma unroll
        for (unsigned j = 0; j < 16; ++j) { const unsigned c = xb_ld(&bar[XB_XCNT(j)]); sum += c; cnt += (c > 0u) ? 1u : 0u; mine = (j == x) ? c : mine; }
        if (sum == G) break;
        __builtin_amdgcn_s_sleep(1);
        if ((++sp & 255u) == 0u) { if (xb_ld(&bar[XB_TMO])) break; if (sp > XB_SPIN_CAP) { atomicAdd(&bar[XB_TMO], 1u); break; } }
    }
    nloc = mine > 0u ? mine : 1u; nx = cnt > 0u ? cnt : 1u;
}
__device__ __forceinline__ void xcd_barrier(const XcdBarrier& b) {
    asm volatile("s_waitcnt vmcnt(0)" ::: "memory");
    __syncthreads();
    if (threadIdx.x == 0) {
        unsigned* bar = b.bar;
        __builtin_amdgcn_s_waitcnt(0);
        unsigned nloc = b.st[0], nx = b.st[1];
        if (nloc == 0u) { xcd_barrier_complete(bar, b.x, nloc, nx); b.st[0] = nloc; b.st[1] = nx; }
        const unsigned old = xb_add(&bar[XB_XSUB(b.x)], 1u);
        const unsigned gen = old / nloc;
        if (old + 1u == (gen + 1u) * nloc) {
            __builtin_amdgcn_fence(__ATOMIC_RELEASE, "agent");
            asm volatile("s_waitcnt vmcnt(0)" ::: "memory");
            const unsigned og = xb_add(&bar[XB_TOP], 1u);
            const unsigned tg = og / nx;
            if (og + 1u == (tg + 1u) * nx) xb_add(&bar[XB_TOPGEN], 1u);
            else XB_SPIN(xb_ld(&bar[XB_TOPGEN]) == tg, bar);
            __builtin_amdgcn_fence(__ATOMIC_ACQUIRE, "agent");
            xb_add(&bar[XB_XGEN(b.x)], 1u);
            asm volatile("s_waitcnt vmcnt(0)" ::: "memory");
        } else {
            XB_SPIN(xb_ld(&bar[XB_XGEN(b.x)]) == gen, bar);
            __builtin_amdgcn_fence(__ATOMIC_ACQUIRE, "agent");
            asm volatile("s_waitcnt vmcnt(0)" ::: "memory");
        }
    }
    __syncthreads();
}

constexpr int N_PHASES = 16;

__global__ void __launch_bounds__(NTHREADS, 2) fwd_kernel(Params p) {
    extern __shared__ __attribute__((aligned(16))) unsigned char lds_raw[];
    LAS unsigned char* lds = (LAS unsigned char*)lds_raw;
    const int tid = threadIdx.x, lane = tid & 63, wave = __builtin_amdgcn_readfirstlane(tid >> 6);
    const int G = gridDim.x, bx = blockIdx.x;
    const int vcu = (G % 8 == 0) ? (bx % 8) * (G / 8) + bx / 8 : bx;
    unsigned char* ws = p.ws;
    int* ctl = (int*)(ws + WS_CTL);
    float* cs = (float*)(ws + WS_CS);
    float* lse = (float*)(ws + WS_LSE);
    int* slotref = (int*)(ws + WS_SLOTREF);
    bf16* Wgs = (bf16*)(ws + WS_WGS);
    int* list = (int*)(ws + WS_LIST);
    float* gatel = (float*)(ws + WS_GATEL);
    bf16* Win_t = (bf16*)(ws + WS_WIN); bf16* Wout_t = (bf16*)(ws + WS_WOUT); bf16* Wpin_t = (bf16*)(ws + WS_WPIN); bf16* Wc_t = (bf16*)(ws + WS_WC); bf16* Wpo_t = (bf16*)(ws + WS_WPO);
    bf16* W13 = (bf16*)(ws + WS_W13); bf16* W2 = (bf16*)(ws + WS_W2);
    bf16* Y = (bf16*)(ws + WS_Y); bf16* QKV = (bf16*)(ws + WS_BIG); bf16* OM = (bf16*)(ws + WS_OM);
    bf16* HMID = (bf16*)(ws + WS_HMID); bf16* YS = (bf16*)(ws + WS_YS); bf16* U = (bf16*)(ws + WS_U); bf16* POOLED = (bf16*)(ws + WS_POOLED);
    bf16* OG = (bf16*)p.out;
    float* H = p.out;
    LAS int* tb = (LAS int*)(lds + MISC_OFF);
    LAS unsigned* aofs = (LAS unsigned*)(lds + AOFS_OFF);

    const int lo = p.ph_lo, hi = p.ph_hi;
#if MK_N_LAUNCHES == 1
    cg::grid_group grid = cg::this_grid();
    if (tid < 2) ((volatile LAS unsigned*)(lds + MISC_OFF))[64 + tid] = 0u;
    __syncthreads();
    const XcdBarrier xbar = xcd_barrier_post((unsigned*)(ctl + CW_BAR), (volatile LAS unsigned*)(lds + MISC_OFF) + 64);
#define GRID_BAR(k) do { if ((k) == CG_SEAM) grid.sync(); else xcd_barrier(xbar); } while (0)
#else
#define GRID_BAR(k) do { } while (0)
#endif
#ifndef PHASE_MASK
#define PHASE_MASK 0xffff
#endif
#ifndef REPEAT_MASK
#define REPEAT_MASK 0x0
#endif
#define REP(k) for (int rep_ = 0; rep_ <= ((REPEAT_MASK >> (k)) & 1); ++rep_)
#define IN(k) (((PHASE_MASK >> (k)) & 1) && lo <= (k) && (k) < hi)
#define SEAM(k) do { if (IN(k) && IN((k) + 1)) GRID_BAR(k); } while (0)

    if (IN(0)) REP(0) {
        LAS float* scr = (LAS float*)(lds + wave * 16384);
        const int gw = vcu * NWAVES + wave, NGW = G * NWAVES;
        constexpr int I_IN = (D / 64) * (QKVW / 32);
        constexpr int I_OUT = (AW / 64) * (D / 32);
        constexpr int I_PIN = (D / 64) * (D / 32);
        constexpr int I_PO = I_PIN;
        constexpr int I_W1 = (D / 64) * (DE / 32);
        constexpr int I_W2 = (DE / 64) * (D / 32);
        constexpr int NITEMS = I_IN + I_OUT + I_PIN + I_PO + 32 * (2 * I_W1 + I_W2);
        for (int it = gw; it < NITEMS; it += NGW) {
            int r = it;
            if (r < I_IN) { const int nblk = QKVW / 32; transpose_item(p.attn_w_in, QKVW, D, Win_t, MapQKV{}, scr, 64 * (r / nblk), 32 * (r % nblk), lane); continue; } r -= I_IN;
            if (r < I_OUT) { const int nblk = D / 32; transpose_item(p.attn_w_out, D, AW, Wout_t, MapId{}, scr, 64 * (r / nblk), 32 * (r % nblk), lane); continue; } r -= I_OUT;
            if (r < I_PIN) { const int nblk = D / 32; transpose_item(p.pool_w_in, D, D, Wpin_t, MapId{}, scr, 64 * (r / nblk), 32 * (r % nblk), lane); continue; } r -= I_PIN;
            if (r < I_PO) { const int nblk = D / 32; transpose_item(p.pool_w_out, D, D, Wpo_t, MapId{}, scr, 64 * (r / nblk), 32 * (r % nblk), lane); continue; } r -= I_PO;
            const int le = r / (2 * I_W1 + I_W2); r -= le * (2 * I_W1 + I_W2);
            if (r < I_W1) { const int nblk = DE / 32; transpose_item(p.expert_w1 + (size_t)le * D * DE, DE, D, W13 + (size_t)le * 1024 * 1024, MapW13{0}, scr, 64 * (r / nblk), 32 * (r % nblk), lane); continue; } r -= I_W1;
            if (r < I_W1) { const int nblk = DE / 32; transpose_item(p.expert_w3 + (size_t)le * D * DE, DE, D, W13 + (size_t)le * 1024 * 1024, MapW13{128}, scr, 64 * (r / nblk), 32 * (r % nblk), lane); continue; } r -= I_W1;
            { const int nblk = D / 32; transpose_item(p.expert_w2 + (size_t)le * DE * D, D, DE, W2 + (size_t)le * 1024 * DE, MapId{}, scr, 64 * (r / nblk), 32 * (r % nblk), lane); }
        }
        for (int i = vcu * NTHREADS + tid; i < 4 * 256 * 256 / 4; i += G * NTHREADS) {
            const int e4 = (i & 63) * 4, gidx = i >> 14;
            const f32x4 wv = *(const f32x4*)(p.pool_w_group + (size_t)i * 4); const f32x4 sc = *(const f32x4*)(p.pool_scale + gidx * 256 + e4);
            u32x2 o; o.x = cvtpk(wv.x * sc.x, wv.y * sc.y); o.y = cvtpk(wv.z * sc.z, wv.w * sc.w); *(u32x2*)(Wgs + (size_t)i * 4) = o;
        }
        for (int i = vcu * NTHREADS + tid; i < T * 8; i += G * NTHREADS) {
            const int tok = i >> 3, f = i & 7;
            const double invf = exp2(-(double)f * 0.125 * 18.931568569324174);
            const float ang = (float)p.positions[tok] * (float)invf;
            double sn, cn; sincos((double)ang, &sn, &cn);
            cs[(size_t)i * 2] = (float)cn; cs[(size_t)i * 2 + 1] = (float)sn;
        }
        RowPassCfg c{}; c.hin = p.x; c.gain = p.norm_mix; c.yout = Y;
        row_pass<false, false>(lds, c, vcu, wave);
    }
    SEAM(0);
    if (IN(1)) REP(1) {
        pg8::DenseProb P{Y, Win_t, D, D, 0, (size_t)256 * D};
        pg8::StaticOrder S; S.init(T / 256, QKVW / 256, G, bx);
        EpiQKV E{QKV, cs};
        pg8::gemm_phase<pg8::DenseProb, EpiQKV, pg8::StaticOrder, true>(lds, P, S, E);
    }
    SEAM(1);
    if (IN(2)) REP(2) {
        att::attn_phase(lds, QKV, OG, lse, vcu, G);
        pg8::DenseProb P{Wpo_t, Wgs, 256, D, 256, (size_t)256 * 256};
        FoldOrder S{G, bx};
        EpiBf16 E{Wc_t, D};
        pg8::gemm_phase<pg8::DenseProb, EpiBf16, FoldOrder, true>(lds, P, S, E);
    }
    SEAM(2);
    if (IN(3)) REP(3) {
        for (int row = vcu * NWAVES + wave; row < T; row += G * NWAVES) {
            const int h = lane >> 3;
            const float l0 = lse[(size_t)row * 24 + h], l1 = lse[(size_t)row * 24 + 8 + h], l2 = lse[(size_t)row * 24 + 16 + h];
            const float mx = fmaxf(l0, fmaxf(l1, l2));
            float w0 = __expf(l0 - mx), w1 = __expf(l1 - mx), w2 = __expf(l2 - mx); const float inv = 1.0f / (w0 + w1 + w2); w0 *= inv; w1 *= inv; w2 *= inv;
            const bf16* src = OG + (size_t)row * 1536 + lane * 8;
            const u32x4 a = *(const u32x4*)(src), b = *(const u32x4*)(src + 512), c = *(const u32x4*)(src + 1024);
            u32x4 o;
#pragma unroll
            for (int k = 0; k < 4; ++k) { const float lo_ = w0 * bf_lo(a[k]) + w1 * bf_lo(b[k]) + w2 * bf_lo(c[k]), hi_ = w0 * bf_hi(a[k]) + w1 * bf_hi(b[k]) + w2 * bf_hi(c[k]); o[k] = cvtpk(lo_, hi_); }
            *(u32x4*)(OM + (size_t)row * AW + lane * 8) = o;
        }
    }
    SEAM(3);
    if (IN(4)) REP(4) {
        pg8::DenseProb P{OM, Wout_t, AW, AW, 0, (size_t)256 * AW};
        pg8::StaticOrder S; S.init(T / 256, D / 256, G, bx);
        EpiResF32 E{p.x, H};
        pg8::gemm_phase<pg8::DenseProb, EpiResF32, pg8::StaticOrder, true>(lds, P, S, E);
    }
    SEAM(4);
#pragma unroll 1
    for (int L = 0; L < 2; ++L) {
        const int pb = (L == 0) ? 5 : 12;
        int* cnt = ctl + CW_CNT + L * NE;
        if (IN(pb)) {
            RowPassCfg c{}; c.hin = H; c.gain = p.norm_ffn + L * D; c.yout = Y;
            c.rgw = p.router_group_w + (size_t)L * D * 4; c.rgb = p.router_group_b + L * 4; c.rew = p.router_expert_w + (size_t)L * 4 * D * 4; c.reb = p.router_expert_b + L * 16;
            c.cnt = cnt; c.list = list + (size_t)L * NE * T; c.gatel = gatel + (size_t)L * NE * T; c.slotref_out = slotref + (size_t)L * T * 2;
            if ((REPEAT_MASK >> pb) & 1) {
                RowPassCfg c2 = c; c2.cnt = ctl + 64 + L * NE; c2.list = (int*)(ws + WS_BIG + 200 * MiB); c2.gatel = (float*)(ws + WS_BIG + 204 * MiB); c2.slotref_out = (int*)(ws + WS_BIG + 208 * MiB);
                row_pass<false, true>(lds, c2, vcu, wave);
            }
            row_pass<false, true>(lds, c, vcu, wave);
        }
        SEAM(pb);
        if (IN(pb + 1) || IN(pb + 2)) {
            if (tid == 0) { int s = 0; for (int e = 0; e < NE; ++e) { tb[e] = s; tb[32 + e] = cnt[e]; s += (cnt[e] + 255) >> 8; } tb[NE] = s; }
            __syncthreads();
        }
        if (IN(pb + 1)) REP(pb + 1) {
            const int NT = tb[NE];
            pg8::StaticOrder S; S.init(NT, 4, G, bx);
            for (int i = 0; i < 8; ++i) { Unit u; if (!S.next(i, u)) break;
                int e = 0;
                for (int k = 1; k < NE; ++k) e += (u.pm >= tb[k]) ? 1 : 0;
                if (tid < 256) { const int li = (u.pm - tb[e]) * 256 + tid; const int tok = (li < tb[32 + e]) ? list[((size_t)L * NE + e) * T + li] : 0; aofs[i * 256 + tid] = (unsigned)tok * (unsigned)(D * 2); } }
            __syncthreads();
            MoeProb1 P{Y, W13 + (size_t)L * NE * 1024 * 1024, D, tb, aofs};
            EpiSwiGLU E{HMID};
            pg8::gemm_phase<MoeProb1, EpiSwiGLU, pg8::StaticOrder, true>(lds, P, S, E);
        }
        SEAM(pb + 1);
        if (IN(pb + 2)) REP(pb + 2) {
            const int NT = tb[NE];
            pg8::StaticOrder S; S.init(NT, 4, G, bx);
            MoeProb2 P{HMID, W2 + (size_t)L * NE * 1024 * DE, DE, tb};
            EpiGate E{YS, gatel + (size_t)L * NE * T, cnt, tb};
            pg8::gemm_phase<MoeProb2, EpiGate, pg8::StaticOrder, true>(lds, P, S, E);
        }
        SEAM(pb + 2);
        if (L == 0) {
            if (IN(8)) {
                RowPassCfg c{}; c.hin = H; c.ys = YS; c.slotref = slotref; c.cnt_prev = cnt; c.hout = H; c.gain = p.norm_mix + D; c.yout = Y;
                if ((REPEAT_MASK >> 8) & 1) { RowPassCfg c2 = c; c2.hout = nullptr; row_pass<true, false>(lds, c2, vcu, wave); }
                row_pass<true, false>(lds, c, vcu, wave);
            }
            SEAM(8);
            if (IN(9)) REP(9) {
                pg8::DenseProb P{Y, Wpin_t, D, D, 0, (size_t)256 * D};
                pg8::StaticOrder S; S.init(T / 256, D / 256, G, bx);
                EpiBf16 E{U, D};
                pg8::gemm_phase<pg8::DenseProb, EpiBf16, pg8::StaticOrder, true>(lds, P, S, E);
            }
            SEAM(9);
            if (IN(10)) REP(10) {
                for (int it = vcu * NTHREADS + tid; it < (T / 32) * 128; it += G * NTHREADS) {
                    const int ch = (it & 127) * 8, run = it >> 7, t0 = run * 32, s0 = t0 & (SEQ - 1);
                    const int wdw = 2 << (ch >> 8);
                    float sum[8];
#pragma unroll
                    for (int k = 0; k < 8; ++k) sum[k] = 0.f;
                    for (int i = 1; i < wdw; ++i) { if (s0 - i < 0) break; const u32x4 a = *(const u32x4*)(U + (size_t)(t0 - i) * D + ch);
#pragma unroll
                        for (int k = 0; k < 4; ++k) { sum[2 * k] += bf_lo(a[k]); sum[2 * k + 1] += bf_hi(a[k]); } }
                    for (int i = 0; i < 32; ++i) {
                        const int tk = t0 + i, s = s0 + i;
                        const u32x4 a = *(const u32x4*)(U + (size_t)tk * D + ch);
                        float cur[8];
#pragma unroll
                        for (int k = 0; k < 4; ++k) { cur[2 * k] = bf_lo(a[k]); cur[2 * k + 1] = bf_hi(a[k]); }
#pragma unroll
                        for (int k = 0; k < 8; ++k) sum[k] += cur[k];
                        const float invc = 1.0f / (float)((s + 1) < wdw ? (s + 1) : wdw);
                        u32x4 w;
#pragma unroll
                        for (int k = 0; k < 4; ++k) w[k] = cvtpk(sum[2 * k] * invc - cur[2 * k], sum[2 * k + 1] * invc - cur[2 * k + 1]);
                        *(u32x4*)(POOLED + (size_t)tk * D + ch) = w;
                        if (s - wdw + 1 >= 0) { const u32x4 o = *(const u32x4*)(U + (size_t)(tk - wdw + 1) * D + ch);
#pragma unroll
                            for (int k = 0; k < 4; ++k) { sum[2 * k] -= bf_lo(o[k]); sum[2 * k + 1] -= bf_hi(o[k]); } }
                    }
                }
            }
            SEAM(10);
            if (IN(11)) REP(11) {
                pg8::DenseProb P{POOLED, Wc_t, D, D, 0, (size_t)256 * D};
                pg8::StaticOrder S; S.init(T / 256, D / 256, G, bx);
                EpiResF32 E{H, (((REPEAT_MASK >> 11) & 1) && rep_ == 0) ? (float*)(ws + WS_BIG + 136 * MiB) : H};
                pg8::gemm_phase<pg8::DenseProb, EpiResF32, pg8::StaticOrder, true>(lds, P, S, E);
            }
            SEAM(11);
        }
    }
    if (IN(15)) {
        RowPassCfg c{}; c.hin = H; c.ys = YS; c.slotref = slotref + (size_t)T * 2; c.cnt_prev = ctl + CW_CNT + NE; c.gain = p.norm_final; c.fout = p.out;
        if ((REPEAT_MASK >> 15) & 1) { RowPassCfg c2 = c; c2.fout = nullptr; c2.yout = Y; row_pass<true, false>(lds, c2, vcu, wave); }
        row_pass<true, false>(lds, c, vcu, wave);
    }
#undef IN
#undef SEAM
#undef GRID_BAR
}

extern "C" void kernel_launch(void* const* d_in, const int* in_sizes, int n_in, void* d_out, int out_size, void* d_ws, size_t ws_size, hipStream_t stream) {
    static int grid = 0;
    if (grid == 0) {
        if (n_in != 18 || in_sizes[0] != T * D || out_size != T * D || ws_size < WS_END) { fprintf(stderr, "kernel_launch: unexpected shapes (n_in %d, in0 %d, out %d, ws %zu)\n", n_in, n_in > 0 ? in_sizes[0] : -1, out_size, ws_size); grid = -1; return; }
        int dev = 0, cus = 0, per_cu = 0;
        if (hipGetDevice(&dev) != hipSuccess || hipDeviceGetAttribute(&cus, hipDeviceAttributeMultiprocessorCount, dev) != hipSuccess) { grid = -1; return; }
        if (hipFuncSetAttribute((const void*)fwd_kernel, hipFuncAttributeMaxDynamicSharedMemorySize, LDS_BYTES) != hipSuccess) { fprintf(stderr, "kernel_launch: hipFuncSetAttribute failed\n"); grid = -1; return; }
        if (hipOccupancyMaxActiveBlocksPerMultiprocessor(&per_cu, (const void*)fwd_kernel, NTHREADS, LDS_BYTES) != hipSuccess || per_cu < 1) { fprintf(stderr, "kernel_launch: occupancy query says %d\n", per_cu); per_cu = 1; }
        (void)hipGetLastError();
        grid = cus;
    }
    if (grid < 0) return;
    (void)hipMemsetAsync((char*)d_ws + WS_CTL, 0, CTL_ZERO_BYTES, stream);
    Params p{};
    p.x = (const float*)d_in[0]; p.positions = (const int*)d_in[1]; p.norm_mix = (const float*)d_in[2]; p.norm_ffn = (const float*)d_in[3]; p.norm_final = (const float*)d_in[4];
    p.attn_w_in = (const float*)d_in[5]; p.attn_w_out = (const float*)d_in[6]; p.pool_w_in = (const float*)d_in[7]; p.pool_w_group = (const float*)d_in[8]; p.pool_scale = (const float*)d_in[9]; p.pool_w_out = (const float*)d_in[10];
    p.router_group_w = (const float*)d_in[11]; p.router_group_b = (const float*)d_in[12]; p.router_expert_w = (const float*)d_in[13]; p.router_expert_b = (const float*)d_in[14];
    p.expert_w1 = (const float*)d_in[15]; p.expert_w3 = (const float*)d_in[16]; p.expert_w2 = (const float*)d_in[17];
    p.out = (float*)d_out; p.ws = (unsigned char*)d_ws;
#if MK_N_LAUNCHES == 1
    p.ph_lo = 0; p.ph_hi = N_PHASES;
    void* args[] = {&p};
    hipError_t e = hipLaunchCooperativeKernel((const void*)fwd_kernel, dim3(grid), dim3(NTHREADS), args, LDS_BYTES, stream);
    if (e != hipSuccess) fprintf(stderr, "cooperative launch failed: %s (grid %d)\n", hipGetErrorString(e), grid);
#else
    for (int ph = 0; ph < N_PHASES; ++ph) {
        p.ph_lo = ph; p.ph_hi = ph + 1;
        hipLaunchKernelGGL(fwd_kernel, dim3(grid), dim3(NTHREADS), LDS_BYTES, stream, p);
    }
#endif
}
```

```cpp
#include <hip/hip_runtime.h>
#include <hip/hip_cooperative_groups.h>
#include <cstdio>
#include <cstdint>
namespace cg = cooperative_groups;

#ifndef MK_N_LAUNCHES
#define MK_N_LAUNCHES 1
#endif

#ifndef FP8_MOE1
#define FP8_MOE1 1
#endif
#ifndef FP8_MOE2
#define FP8_MOE2 1
#endif
#ifndef FP8_QKV
#define FP8_QKV 1
#endif
#define LAS __attribute__((address_space(3)))
#define GAS __attribute__((address_space(1)))
typedef unsigned short bf16;
typedef short bf16x8 __attribute__((ext_vector_type(8)));
typedef float f32x4 __attribute__((ext_vector_type(4)));
typedef float f32x2 __attribute__((ext_vector_type(2)));
typedef float f32x16 __attribute__((ext_vector_type(16)));
typedef unsigned u32x4 __attribute__((ext_vector_type(4)));
typedef unsigned u32x2 __attribute__((ext_vector_type(2)));
typedef short s16x4 __attribute__((ext_vector_type(4)));
typedef __bf16 bf16x2_t __attribute__((ext_vector_type(2)));
typedef int i32x4 __attribute__((ext_vector_type(4)));
typedef int i32x8 __attribute__((ext_vector_type(8)));

constexpr int BATCH = 16, SEQ = 2048, D = 1024, T = BATCH * SEQ;
constexpr int NG = 3, HPG = 8, HD = 64, AW = 512, QKVW = NG * 3 * AW;
constexpr int NE = 16, DE = 512, SLOTS = 2 * T;
constexpr int MAXTILES = SLOTS / 256 + NE;
constexpr float RMS_EPS = 1e-6f;
constexpr int NWAVES = 8, NTHREADS = 512;

constexpr size_t MiB = 1u << 20;
constexpr size_t WS_CTL = 0, CTL_ZERO_BYTES = 64 * 1024;
constexpr size_t WS_CS = 1 * MiB;
constexpr size_t WS_LSE = 3 * MiB;
constexpr size_t WS_SLOTREF = 6 * MiB;
constexpr size_t WS_WGS = 7 * MiB;
constexpr size_t WS_LIST = 8 * MiB;
constexpr size_t WS_GATEL = 12 * MiB;
constexpr size_t WS_WIN = 16 * MiB;
constexpr size_t WS_WOUT = 25 * MiB;
constexpr size_t WS_WPIN = 26 * MiB;
constexpr size_t WS_WC = 28 * MiB;
constexpr size_t WS_WPO = 30 * MiB;
constexpr size_t WS_W13 = 32 * MiB;
constexpr size_t WS_W2 = 96 * MiB;
constexpr size_t WS_Y = 128 * MiB;
constexpr size_t WS_BIG = 192 * MiB;
constexpr size_t WS_OM = WS_BIG;
constexpr size_t WS_HMID = WS_BIG;
constexpr size_t WS_YS = WS_BIG + 72 * MiB;
constexpr size_t WS_U = WS_BIG;
constexpr size_t WS_POOLED = WS_BIG + 64 * MiB;
constexpr size_t WS_END = WS_BIG + 288 * MiB;
constexpr int CW_CNT = 0;
constexpr int CW_BAR = 1024;
#ifndef CG_SEAM
#define CG_SEAM 0
#endif

constexpr int RING_BYTES = 131072;
constexpr int AOFS_OFF = RING_BYTES;
constexpr int MISC_OFF = AOFS_OFF + 8192;
constexpr int LDS_BYTES = 147456;

__device__ __forceinline__ unsigned cvtpk(float lo, float hi) { f32x2 v = {lo, hi}; bf16x2_t b = __builtin_convertvector(v, bf16x2_t); return __builtin_bit_cast(unsigned, b); }
__device__ __forceinline__ float clamp8(float v) { return __builtin_amdgcn_fmed3f(v, -448.0f, 448.0f); }
__device__ __forceinline__ unsigned pack_fp8x4(float a, float b, float c, float d) {
    int r = __builtin_amdgcn_cvt_pk_fp8_f32(clamp8(a), clamp8(b), 0, false); r = __builtin_amdgcn_cvt_pk_fp8_f32(clamp8(c), clamp8(d), r, true); return (unsigned)r; }
__device__ __forceinline__ float bf_lo(unsigned u) { return __uint_as_float(u << 16); }
__device__ __forceinline__ float bf_hi(unsigned u) { return __uint_as_float(u & 0xffff0000u); }
#define DPP_ADD(v, ctrl) ((v) + __builtin_bit_cast(float, __builtin_amdgcn_update_dpp(0, __builtin_bit_cast(int, (v)), (ctrl), 0xF, 0xF, true)))
__device__ __forceinline__ float wave_sum(float v) {
    v = DPP_ADD(v, 0xB1);
    v = DPP_ADD(v, 0x4E);
    v = DPP_ADD(v, 0x141);
    v = DPP_ADD(v, 0x140);
    const int vi = __builtin_bit_cast(int, v);
    const float r0 = __builtin_bit_cast(float, __builtin_amdgcn_readlane(vi, 0)), r1 = __builtin_bit_cast(float, __builtin_amdgcn_readlane(vi, 16));
    const float r2 = __builtin_bit_cast(float, __builtin_amdgcn_readlane(vi, 32)), r3 = __builtin_bit_cast(float, __builtin_amdgcn_readlane(vi, 48));
    return (r0 + r1) + (r2 + r3);
}

namespace pg8 {
constexpr int BM = 256, BK = 64, HALF = 128, HTB = HALF * BK * 2, STAGE_BYTES = 8 * HTB, NXCD = 8, WGM = 8;
__host__ __device__ __forceinline__ int lds_byte(int r, int c) { const int st = (r >> 4) * 2 + (c >> 5), rr = r & 15, cc = c & 31, ob = rr * 64 + cc * 2; return st * 1024 + (ob ^ (((ob >> 9) & 1) << 5)); }
__host__ __device__ __forceinline__ void stage_rc(int b, int& R, int& C) { const int st = b / 1024, sb = b % 1024, swz = sb ^ (((sb >> 9) & 1) << 5); R = (st >> 1) * 16 + swz / 64; C = (st & 1) * 32 + (swz % 64) / 2; }
__host__ __device__ __forceinline__ int perm32(int rho) { const int n = rho >> 4, i = rho & 15; return 8 * (i >> 2) + 4 * n + (i & 3); }

struct Unit { int pm, pn; };

struct StaticOrder {
    int nM, nN, nwg, G, c;
    __device__ void init(int nM_, int nN_, int G_, int c_) { nM = nM_; nN = nN_; nwg = nM * nN; G = G_; c = c_; }
    __device__ bool next(int i, Unit& u) const {
        const long L = (long)i * G + c; if (L >= nwg) return false;
        int wgid = (int)L; { const int q = nwg / NXCD, r = nwg % NXCD, xcd = wgid % NXCD, off = wgid / NXCD; wgid = (xcd < r ? xcd * (q + 1) : r * (q + 1) + (xcd - r) * q) + off; }
        const int nig = WGM * nN, gid = wgid / nig, fm = gid * WGM, gsz = (nM - fm) < WGM ? (nM - fm) : WGM;
        u.pm = fm + ((wgid % nig) % gsz); u.pn = (wgid % nig) / gsz; return true;
    }
};

template <class Prob, class Epi, class Sched, bool ALIGN_EPI>
__device__ __forceinline__ void gemm_phase(LAS unsigned char* lds, const Prob& P, const Sched& S, const Epi& E) {
    int tid_ = threadIdx.x; asm volatile("" : "+v"(tid_));
    const int tid = tid_, wid = __builtin_amdgcn_readfirstlane(tid >> 6), lane = tid & 63, wr = wid >> 2, wc = wid & 3, fr = lane & 15, fq = lane >> 4;
    constexpr bool F8 = Prob::F8;
    const int Kb = P.K * (F8 ? 1 : 2), nt = Kb / (BK * 2);
    int Rr[2], Cc[2]; unsigned voffB[2];
#pragma unroll
    for (int i = 0; i < 2; ++i) { int R, C; stage_rc(tid * 16 + i * 8192, R, C); Rr[i] = R; Cc[i] = C; const int Rb = Epi::PERM ? ((R & ~31) + perm32(R & 31)) : R; voffB[i] = (unsigned)(Rb * Kb + C * 2); }
    const unsigned kstep = (unsigned)(BK * 2);
    const unsigned hstep = (unsigned)(HALF * Kb);
    const unsigned ldsw = (unsigned)wid * 1024u;
    const int aoff = lds_byte(wr * 64 + fr, fq * 8), boff = lds_byte(wc * 32 + fr, fq * 8);
    const __amdgpu_buffer_rsrc_t rsA = __builtin_amdgcn_make_buffer_rsrc((void*)P.A, 0, 0xFFFFFFFF, 0x00020000);
    const __amdgpu_buffer_rsrc_t rsB = __builtin_amdgcn_make_buffer_rsrc((void*)P.Bt, 0, 0xFFFFFFFF, 0x00020000);
#define PG8_SA(b, h) (((b) * 2 + (h)) * HTB)
#define PG8_SB(b, h) ((4 + (b) * 2 + (h)) * HTB)
#define PG8_STAGE_B(bufoff, sB) do { _Pragma("unroll") for (int _i = 0; _i < 2; ++_i) \
        __builtin_amdgcn_raw_ptr_buffer_load_lds(rsB, (LAS void*)(lds + (bufoff) + ldsw + _i * 8192), 16, (int)voffB[_i], (int)(sB), 0, 0); } while (0)
#define PG8_STAGE_A(bufoff, kb, o) do { _Pragma("unroll") for (int _i = 0; _i < 2; ++_i) \
        __builtin_amdgcn_raw_ptr_buffer_load_lds(rsA, (LAS void*)(lds + (bufoff) + ldsw + _i * 8192), 16, (int)(o)[_i], (int)(kb), 0, 0); } while (0)
#define PG8_LD2(p_) PG8_CAT(*(const LAS i32x4*)(p_), *(const LAS i32x4*)((p_) + 1024))
#define PG8_LDA(dst, b, h) do { if constexpr (F8) { _Pragma("unroll") for (int m = 0; m < 4; ++m) dst##8[m] = PG8_LD2(lds + PG8_SA(b, h) + aoff + m * 2048); } \
        else { _Pragma("unroll") for (int m = 0; m < 4; ++m) _Pragma("unroll") for (int k = 0; k < 2; ++k) dst[m][k] = *(const LAS bf16x8*)(lds + PG8_SA(b, h) + aoff + m * 2048 + k * 1024); } } while (0)
#define PG8_LDB(dst, b, h) do { if constexpr (F8) { _Pragma("unroll") for (int n = 0; n < 2; ++n) dst##8[n] = PG8_LD2(lds + PG8_SB(b, h) + boff + n * 2048); } \
        else { _Pragma("unroll") for (int n = 0; n < 2; ++n) _Pragma("unroll") for (int k = 0; k < 2; ++k) dst[n][k] = *(const LAS bf16x8*)(lds + PG8_SB(b, h) + boff + n * 2048 + k * 1024); } } while (0)
#define PG8_CAT(x0, x1) __builtin_shufflevector((x0), (x1), 0, 1, 2, 3, 4, 5, 6, 7)
#define PG8_MMA(ai, bj, At, Bt) do { __builtin_amdgcn_s_setprio(1); \
        if constexpr (F8) { _Pragma("unroll") for (int m = 0; m < 4; ++m) _Pragma("unroll") for (int n = 0; n < 2; ++n) \
            acc[ai][bj][m][n] = __builtin_amdgcn_mfma_scale_f32_16x16x128_f8f6f4(Bt##8[n], At##8[m], acc[ai][bj][m][n], 0, 0, 0, 0, 0, 0); } \
        else { _Pragma("unroll") for (int m = 0; m < 4; ++m) _Pragma("unroll") for (int n = 0; n < 2; ++n) _Pragma("unroll") for (int k = 0; k < 2; ++k) \
            acc[ai][bj][m][n] = __builtin_amdgcn_mfma_f32_16x16x32_bf16(Bt[n][k], At[m][k], acc[ai][bj][m][n], 0, 0, 0); } \
        __builtin_amdgcn_s_setprio(0); } while (0)
#define PG8_WAIT_V(n) asm volatile("s_waitcnt vmcnt(" #n ")" ::: "memory")
#define PG8_WAIT_L(n) asm volatile("s_waitcnt lgkmcnt(" #n ")" ::: "memory")
#define PG8_BAR __builtin_amdgcn_s_barrier()
#define PG8_SCHED __builtin_amdgcn_sched_barrier(0)
    Unit cur, nxt; int ui = 0;
    if (!S.next(0, cur)) return;
    f32x4 acc[2][2][4][2];
#pragma unroll
    for (int a = 0; a < 2; ++a)
#pragma unroll
        for (int b = 0; b < 2; ++b)
#pragma unroll
            for (int m = 0; m < 4; ++m)
#pragma unroll
                for (int n = 0; n < 2; ++n) acc[a][b][m][n] = (f32x4){0.f, 0.f, 0.f, 0.f};
    bf16x8 At[4][2], B0[2][2], B1[2][2]; i32x8 At8[4], B08[2], B18[2];
    unsigned ca0[2], ca1[2];
    P.a_offs(0, cur, Rr, Cc, ca0, ca1);
    unsigned cB = P.b_off(cur);
    PG8_STAGE_B(PG8_SB(0, 0), cB); PG8_STAGE_B(PG8_SB(0, 1), cB + hstep); PG8_STAGE_A(PG8_SA(0, 0), 0, ca0); PG8_STAGE_A(PG8_SA(0, 1), 0, ca1);
    if (wr == 1) PG8_BAR;
    PG8_WAIT_V(2); PG8_BAR;
    PG8_STAGE_B(PG8_SB(1, 0), cB + kstep); PG8_STAGE_A(PG8_SA(1, 0), kstep, ca0); PG8_STAGE_B(PG8_SB(1, 1), cB + hstep + kstep);
    PG8_WAIT_V(6); PG8_BAR;
    for (;;) {
        const bool has_next = S.next(ui + 1, nxt);
        unsigned nB = cB;
        if (has_next) nB = P.b_off(nxt);
#pragma unroll 1
        for (int t = 0; t < nt; t += 2) {
            const bool last = (t == nt - 2);
            const unsigned k1 = (unsigned)(t + 1) * kstep;
            const unsigned k2 = last ? 0u : (unsigned)(t + 2) * kstep, k3 = k2 + kstep;
            const unsigned b2 = last ? nB : cB + (unsigned)(t + 2) * kstep; const unsigned b3 = b2 + kstep;
            PG8_LDB(B0, 0, 0); PG8_LDB(B1, 0, 1); PG8_SCHED; PG8_LDA(At, 0, 0); PG8_STAGE_A(PG8_SA(1, 1), k1, ca1);
            if (last && has_next) {
                int tq = threadIdx.x; asm volatile("" : "+v"(tq)); int R2[2], C2[2];
#pragma unroll
                for (int i = 0; i < 2; ++i) stage_rc(tq * 16 + i * 8192, R2[i], C2[i]);
                P.a_offs(ui + 1, nxt, R2, C2, ca0, ca1);
            }
            PG8_WAIT_V(8); PG8_WAIT_L(0); PG8_BAR; PG8_MMA(0, 0, At, B0); PG8_MMA(0, 1, At, B1); PG8_BAR; PG8_SCHED;
            PG8_LDA(At, 0, 1); PG8_STAGE_B(PG8_SB(0, 0), b2); PG8_STAGE_B(PG8_SB(0, 1), b2 + hstep); PG8_STAGE_A(PG8_SA(0, 0), k2, ca0);
            PG8_WAIT_V(8); PG8_WAIT_L(0); PG8_BAR; PG8_MMA(1, 0, At, B0); PG8_MMA(1, 1, At, B1); PG8_BAR; PG8_SCHED;
            PG8_LDB(B0, 1, 0); PG8_LDB(B1, 1, 1); PG8_SCHED; PG8_LDA(At, 1, 0); PG8_STAGE_A(PG8_SA(0, 1), k2, ca1);
            PG8_WAIT_V(8); PG8_WAIT_L(0); PG8_BAR; PG8_MMA(0, 0, At, B0); PG8_MMA(0, 1, At, B1); PG8_BAR; PG8_SCHED;
            PG8_LDA(At, 1, 1); PG8_STAGE_B(PG8_SB(1, 0), b3); PG8_STAGE_B(PG8_SB(1, 1), b3 + hstep); PG8_STAGE_A(PG8_SA(1, 0), k3, ca0);
            PG8_WAIT_V(8); PG8_WAIT_L(0); PG8_BAR; PG8_MMA(1, 0, At, B0); PG8_MMA(1, 1, At, B1); PG8_BAR; PG8_SCHED;
        }
        if constexpr (ALIGN_EPI) { if (wr == 0) PG8_BAR; }
        { int te = threadIdx.x; asm volatile("" : "+v"(te));
          E(acc, cur, wr, wc, te & 15, (te >> 4) & 3); }
        if (!has_next) break;
#pragma unroll
        for (int a = 0; a < 2; ++a)
#pragma unroll
            for (int b = 0; b < 2; ++b)
#pragma unroll
                for (int m = 0; m < 4; ++m)
#pragma unroll
                    for (int n = 0; n < 2; ++n) acc[a][b][m][n] = (f32x4){0.f, 0.f, 0.f, 0.f};
        cur = nxt; cB = nB; ++ui;
        if constexpr (ALIGN_EPI) { if (wr == 1) PG8_BAR; }
    }
    PG8_WAIT_V(0);
    if constexpr (!ALIGN_EPI) { if (wr == 0) PG8_BAR; }
    PG8_BAR;
#undef PG8_SA
#undef PG8_SB
#undef PG8_STAGE_A
#undef PG8_STAGE_B
#undef PG8_LDA
#undef PG8_LD2
#undef PG8_LDB
#undef PG8_MMA
#undef PG8_CAT
#undef PG8_WAIT_V
#undef PG8_WAIT_L
#undef PG8_BAR
#undef PG8_SCHED
}

template <bool F8_>
struct DenseProbT {
    static constexpr bool F8 = F8_;
    const void* A; const void* Bt; int K, lda, acolstep; size_t bstep_pn;
    __device__ __forceinline__ void a_offs(int, const Unit& u, const int (&R)[2], const int (&C)[2], unsigned (&o0)[2], unsigned (&o1)[2]) const {
        constexpr int esz = F8 ? 1 : 2;
#pragma unroll
        for (int i = 0; i < 2; ++i) { const unsigned b = (unsigned)(((u.pm * BM + R[i]) * lda + u.pn * acolstep) * esz + C[i] * 2); o0[i] = b; o1[i] = b + (unsigned)(HALF * lda * esz); }
    }
    __device__ __forceinline__ unsigned b_off(const Unit& u) const { return (unsigned)((size_t)u.pn * bstep_pn * (F8 ? 1 : 2)); }
};
typedef DenseProbT<false> DenseProb;
}

struct Params {
    const float* x; const int* positions; const float* norm_mix; const float* norm_ffn; const float* norm_final;
    const float* attn_w_in; const float* attn_w_out; const float* pool_w_in; const float* pool_w_group; const float* pool_scale; const float* pool_w_out;
    const float* router_group_w; const float* router_group_b; const float* router_expert_w; const float* router_expert_b;
    const float* expert_w1; const float* expert_w3; const float* expert_w2;
    float* out; unsigned char* ws;
    int ph_lo, ph_hi;
};

template <class MapN>
__device__ __forceinline__ void transpose_item(const float* W, int ldw, int K, bf16* WT, MapN mapn, LAS float* scr, int k0, int n0, int lane) {
#pragma unroll 8
    for (int i = 0; i < 32; ++i) { const int kk = 2 * i + (lane >> 5); scr[kk * 33 + (lane & 31)] = W[(size_t)(k0 + kk) * ldw + n0 + (lane & 31)]; }
    asm volatile("s_waitcnt lgkmcnt(0)" ::: "memory");
    const int c = lane & 7;
#pragma unroll
    for (int j = 0; j < 4; ++j) { const int n = (lane >> 3) + 8 * j; const LAS float* s = scr + (8 * c) * 33 + n;
        u32x4 o; o.x = cvtpk(s[0 * 33], s[1 * 33]); o.y = cvtpk(s[2 * 33], s[3 * 33]); o.z = cvtpk(s[4 * 33], s[5 * 33]); o.w = cvtpk(s[6 * 33], s[7 * 33]);
        *(u32x4*)(WT + (size_t)mapn(n0 + n) * K + k0 + 8 * c) = o; }
    asm volatile("s_waitcnt lgkmcnt(0)" ::: "memory");
}
template <class MapN>
__device__ __forceinline__ void transpose_item8(const float* W, int ldw, int K, unsigned char* WT, MapN mapn, float sc, LAS float* scr, int k0, int n0, int lane) {
#pragma unroll 8
    for (int i = 0; i < 32; ++i) { const int kk = 2 * i + (lane >> 5); scr[kk * 33 + (lane & 31)] = W[(size_t)(k0 + kk) * ldw + n0 + (lane & 31)]; }
    asm volatile("s_waitcnt lgkmcnt(0)" ::: "memory");
    const int c = lane & 7;
#pragma unroll
    for (int j = 0; j < 4; ++j) { const int n = (lane >> 3) + 8 * j; const LAS float* s = scr + (8 * c) * 33 + n;
        u32x2 o; o.x = pack_fp8x4(s[0 * 33] * sc, s[1 * 33] * sc, s[2 * 33] * sc, s[3 * 33] * sc); o.y = pack_fp8x4(s[4 * 33] * sc, s[5 * 33] * sc, s[6 * 33] * sc, s[7 * 33] * sc);
        *(u32x2*)(WT + (size_t)mapn(n0 + n) * K + k0 + 8 * c) = o; }
    asm volatile("s_waitcnt lgkmcnt(0)" ::: "memory");
}
struct MapId { __device__ __forceinline__ int operator()(int n) const { return n; } };
struct MapQKV {
    __device__ __forceinline__ int operator()(int n) const { const int rem = n % 1536, kind = rem / 512, d = n & 63; if (kind < 2 && d < 16) return n - d + (d < 8 ? 2 * d : 2 * (d - 8) + 1); return n; }
};
struct MapW13 { int add; __device__ __forceinline__ int operator()(int n) const { return (n >> 7) * 256 + add + (n & 127); } };

struct RowPassCfg {
    const float* hin;
    const bf16* ys; const int* slotref; const int* cnt_prev;
    float* hout;
    const float* gain;
    bf16* yout;
    unsigned char* yout8;
    float* fout;
    const float* rgw; const float* rgb; const float* rew; const float* reb;
    int* cnt; int* list; float* gatel; int* slotref_out;
};

__device__ __forceinline__ void route_decide(const float (&a)[20], const float* rgb, const float* reb, int& e0, int& e1, float& g0, float& g1) {
    float lg[4];
#pragma unroll
    for (int g = 0; g < 4; ++g) lg[g] = a[g] + rgb[g];
    int gs = 0; float gm = lg[0];
#pragma unroll
    for (int g = 1; g < 4; ++g) if (lg[g] > gm) { gm = lg[g]; gs = g; }
    float den = 0.f;
#pragma unroll
    for (int g = 0; g < 4; ++g) den += __expf(lg[g] - gm);
    const float gate1 = 1.0f / den;
    float le[4];
#pragma unroll
    for (int e = 0; e < 4; ++e) { const float sel = gs == 0 ? a[4 + e] : gs == 1 ? a[8 + e] : gs == 2 ? a[12 + e] : a[16 + e]; le[e] = sel + reb[gs * 4 + e]; }
    int i0 = 0; float v0 = le[0];
#pragma unroll
    for (int e = 1; e < 4; ++e) if (le[e] > v0) { v0 = le[e]; i0 = e; }
    int i1 = -1; float v1 = -INFINITY;
#pragma unroll
    for (int e = 0; e < 4; ++e) if (e != i0 && le[e] > v1) { v1 = le[e]; i1 = e; }
    const float ex = __expf(v1 - v0), p0 = 1.0f / (1.0f + ex), p1 = ex * p0;
    e0 = gs * 4 + i0; e1 = gs * 4 + i1; g0 = gate1 * p0; g1 = gate1 * p1;
}

template <bool COMBINE, bool ROUTER>
__device__ __forceinline__ void row_pass(LAS unsigned char* lds, const RowPassCfg& c, int vcu, int wave) {
    int tid = threadIdx.x; asm volatile("" : "+v"(tid)); const int lane = tid & 63;
    LAS float* Wr = (LAS float*)lds;
    LAS int* selE = (LAS int*)(lds + 81920);
    LAS float* selG = (LAS float*)(lds + 81920 + 1024);
    LAS int* wcnt = (LAS int*)(lds + 81920 + 2048);
    LAS int* tb = (LAS int*)(lds + MISC_OFF);
    if (ROUTER) {
        for (int k = tid; k < 1024; k += NTHREADS) {
            const f32x4 g4 = *(const f32x4*)(c.rgw + (size_t)k * 4);
            Wr[0 * 1024 + k] = g4.x; Wr[1 * 1024 + k] = g4.y; Wr[2 * 1024 + k] = g4.z; Wr[3 * 1024 + k] = g4.w;
#pragma unroll
            for (int g = 0; g < 4; ++g) { const f32x4 e4 = *(const f32x4*)(c.rew + ((size_t)g * 1024 + k) * 4);
                Wr[(4 + g * 4 + 0) * 1024 + k] = e4.x; Wr[(4 + g * 4 + 1) * 1024 + k] = e4.y; Wr[(4 + g * 4 + 2) * 1024 + k] = e4.z; Wr[(4 + g * 4 + 3) * 1024 + k] = e4.w; }
        }
    }
    if (COMBINE) {
        if (tid == 0) { int sacc = 0; for (int e = 0; e < NE; ++e) { tb[e] = sacc; sacc += (c.cnt_prev[e] + 255) >> 8; } tb[NE] = sacc; }
    }
    __syncthreads();
    f32x4 gn[4];
#pragma unroll
    for (int j = 0; j < 4; ++j) gn[j] = *(const f32x4*)(c.gain + 4 * lane + 256 * j);
    for (int rb = vcu; rb < T / 128; rb += gridDim.x) {
        const int rbase = rb * 128 + wave * 16;
        int refs = 0;
        if (COMBINE) { if (lane < 32) refs = c.slotref[rbase * 2 + lane]; }
        f32x4 hv[2][2][4]; u32x2 yv[2][2][2][4];
#define RP_ISSUE(buf, pr) do { _Pragma("unroll") for (int r = 0; r < 2; ++r) { const int row = rbase + 2 * (pr) + r; \
            _Pragma("unroll") for (int j = 0; j < 4; ++j) hv[buf][r][j] = *(const f32x4*)(c.hin + (size_t)row * D + 4 * lane + 256 * j); \
            if (COMBINE) { _Pragma("unroll") for (int sl = 0; sl < 2; ++sl) { const int ref = __builtin_amdgcn_readlane(refs, (2 * (pr) + r) * 2 + sl); const int e = ref >> 15, pos = ref & 32767; \
                const bf16* yr = c.ys + ((size_t)tb[e] * 256 + pos) * D; \
                _Pragma("unroll") for (int j = 0; j < 4; ++j) yv[buf][r][sl][j] = *(const u32x2*)(yr + 4 * lane + 256 * j); } } } } while (0)
#define RP_PROCESS(buf, pr) do { f32x4 v[2][4]; \
            _Pragma("unroll") for (int r = 0; r < 2; ++r) { const int row = rbase + 2 * (pr) + r; \
                _Pragma("unroll") for (int j = 0; j < 4; ++j) { v[r][j] = hv[buf][r][j]; \
                    if (COMBINE) { _Pragma("unroll") for (int sl = 0; sl < 2; ++sl) { const u32x2 w = yv[buf][r][sl][j]; v[r][j].x += bf_lo(w.x); v[r][j].y += bf_hi(w.x); v[r][j].z += bf_lo(w.y); v[r][j].w += bf_hi(w.y); } } } \
                if (c.hout) { _Pragma("unroll") for (int j = 0; j < 4; ++j) *(f32x4*)(c.hout + (size_t)row * D + 4 * lane + 256 * j) = v[r][j]; } \
                float ss = 0.f; \
                _Pragma("unroll") for (int j = 0; j < 4; ++j) ss += (v[r][j].x * v[r][j].x + v[r][j].y * v[r][j].y) + (v[r][j].z * v[r][j].z + v[r][j].w * v[r][j].w); \
                const float rstd = 1.0f / sqrtf(wave_sum(ss) * (1.0f / D) + RMS_EPS); \
                _Pragma("unroll") for (int j = 0; j < 4; ++j) { v[r][j].x = v[r][j].x * rstd * gn[j].x; v[r][j].y = v[r][j].y * rstd * gn[j].y; v[r][j].z = v[r][j].z * rstd * gn[j].z; v[r][j].w = v[r][j].w * rstd * gn[j].w; } \
                if (c.yout) { _Pragma("unroll") for (int j = 0; j < 4; ++j) { u32x2 w; w.x = cvtpk(v[r][j].x, v[r][j].y); w.y = cvtpk(v[r][j].z, v[r][j].w); *(u32x2*)(c.yout + (size_t)row * D + 4 * lane + 256 * j) = w; } } \
                if (c.yout8) { _Pragma("unroll") for (int j = 0; j < 4; ++j) *(unsigned*)(c.yout8 + (size_t)row * D + 4 * lane + 256 * j) = pack_fp8x4(v[r][j].x, v[r][j].y, v[r][j].z, v[r][j].w); } \
                if (c.fout) { _Pragma("unroll") for (int j = 0; j < 4; ++j) *(f32x4*)(c.fout + (size_t)row * D + 4 * lane + 256 * j) = v[r][j]; } } \
            if (ROUTER) { LAS float* lg_ = (LAS float*)(lds + 81920 + 4096) + wave * 40; \
                _Pragma("unroll 2") for (int o = 0; o < 20; ++o) { float s0 = 0.f, s1 = 0.f; \
                    _Pragma("unroll") for (int j = 0; j < 4; ++j) { const f32x4 w = *(const LAS f32x4*)(Wr + o * 1024 + 4 * lane + 256 * j); \
                        s0 += (v[0][j].x * w.x + v[0][j].y * w.y) + (v[0][j].z * w.z + v[0][j].w * w.w); s1 += (v[1][j].x * w.x + v[1][j].y * w.y) + (v[1][j].z * w.z + v[1][j].w * w.w); } \
                    s0 = wave_sum(s0); s1 = wave_sum(s1); if (lane == 0) { lg_[o] = s0; lg_[20 + o] = s1; } } \
                float a0[20], a1[20]; \
                _Pragma("unroll") for (int o = 0; o < 20; ++o) { a0[o] = lg_[o]; a1[o] = lg_[20 + o]; } \
                int e0, e1; float g0, g1; const int rl = wave * 16 + 2 * (pr); \
                route_decide(a0, c.rgb, c.reb, e0, e1, g0, g1); if (lane == 0) { selE[rl * 2] = e0; selE[rl * 2 + 1] = e1; selG[rl * 2] = g0; selG[rl * 2 + 1] = g1; } \
                route_decide(a1, c.rgb, c.reb, e0, e1, g0, g1); if (lane == 0) { selE[rl * 2 + 2] = e0; selE[rl * 2 + 3] = e1; selG[rl * 2 + 2] = g0; selG[rl * 2 + 3] = g1; } } } while (0)
        RP_ISSUE(0, 0);
#pragma unroll 1
        for (int it = 0; it < 4; ++it) {
            RP_ISSUE(1, 2 * it + 1);
            RP_PROCESS(0, 2 * it);
            if (it < 3) RP_ISSUE(0, 2 * it + 2);
            RP_PROCESS(1, 2 * it + 1);
        }
#undef RP_ISSUE
#undef RP_PROCESS
        if (ROUTER) {
            __syncthreads();
            int e = 0, rank = 0;
            if (tid < 256) {
                e = selE[tid]; int mycount = 0;
#pragma unroll
                for (int x = 0; x < NE; ++x) { const unsigned long long mask = __ballot(e == x); if (e == x) rank = __popcll(mask & ((1ull << lane) - 1ull)); if (lane == x) mycount = __popcll(mask); }
                if (lane < NE) wcnt[(tid >> 6) * 16 + lane] = mycount;
            }
            __syncthreads();
            if (tid < NE) { const int c0 = wcnt[tid], c1 = wcnt[16 + tid], c2 = wcnt[32 + tid], c3 = wcnt[48 + tid]; const int tot = c0 + c1 + c2 + c3;
                int base = 0; if (tot) base = atomicAdd(c.cnt + tid, tot);
                wcnt[tid] = base; wcnt[16 + tid] = base + c0; wcnt[32 + tid] = base + c0 + c1; wcnt[48 + tid] = base + c0 + c1 + c2; }
            __syncthreads();
            if (tid < 256) { const int pos = wcnt[(tid >> 6) * 16 + e] + rank; const int tok = rb * 128 + (tid >> 1);
                c.list[e * T + pos] = tok; c.gatel[e * T + pos] = selG[tid]; c.slotref_out[tok * 2 + (tid & 1)] = e * 32768 + pos; }
            __syncthreads();
        }
    }
    __syncthreads();
}

namespace att {
constexpr float C2 = 0.125f * 1.4426950408889634f;
constexpr float LN2 = 0.6931471805599453f;
__device__ __forceinline__ int crow(int r, int hi) { return (r & 3) + 8 * (r >> 2) + 4 * hi; }
typedef short v4i16_t __attribute__((ext_vector_type(4)));
__device__ __forceinline__ s16x4 vtr(const LAS unsigned char* p) { return __builtin_bit_cast(s16x4, __builtin_amdgcn_ds_read_tr16_b64_v4i16((LAS v4i16_t*)p)); }

struct Item { int b, g, hh, dil, j, ph; };
__device__ __forceinline__ Item decode_item(int pp, int half) {
    Item it; it.hh = pp & 7; const int q8 = (pp >> 3) & 7; it.g = (pp >> 6) % 3; it.b = pp / 192;
    const int idx16 = q8 * 2 + half; it.dil = it.g == 0 ? 1 : (it.g == 1 ? 4 : 16); const int nb = 16 / it.dil; it.j = idx16 % nb; it.ph = idx16 / nb; return it;
}
__device__ __forceinline__ int kswz(int kv) { return (kv ^ (kv >> 3)) & 7; }

__device__ __forceinline__ void attn_phase(LAS unsigned char* lds, const bf16* qkv, bf16* og, float* lse, int vcu, int G) {
    int tid_ = threadIdx.x; asm volatile("" : "+v"(tid_));
    const int tid = tid_, lane = tid & 63, wid = __builtin_amdgcn_readfirstlane(tid >> 6);
    const int half = wid >> 2, w = wid & 3, r32 = lane & 31, hi = lane >> 5, th = tid & 255;
    LAS unsigned char* Kl = lds + half * 69632;
    LAS unsigned char* Vl = Kl + 36864;
    u32x4 kreg[4][2], vreg[4][2]; bf16x8 qn[4];
    int skv[2], sc[2];
#pragma unroll
    for (int i = 0; i < 2; ++i) { const int P_ = th + 256 * i; skv[i] = P_ >> 3; sc[i] = P_ & 7; }
    const __amdgpu_buffer_rsrc_t rsQ = __builtin_amdgcn_make_buffer_rsrc((void*)qkv, 0, 0xFFFFFFFF, 0x00020000);
    typedef unsigned u32x4v __attribute__((ext_vector_type(4)));
#define ATT_ISSUE(IT) do { const unsigned rstrideB_ = (unsigned)(IT).dil * (unsigned)(QKVW * 2); \
        const unsigned baseB_ = (unsigned)(((IT).b * SEQ + (IT).ph) * QKVW + (IT).g * 1536 + (IT).hh * 64) * 2u; const int l0_ = 128 * ((IT).j - 1); \
        const unsigned vo0_ = (unsigned)skv[0] * rstrideB_ + (unsigned)sc[0] * 16u, vo1_ = (unsigned)skv[1] * rstrideB_ + (unsigned)sc[1] * 16u; \
        _Pragma("unroll") for (int tt = 0; tt < 4; ++tt) { if (tt >= 2 || (IT).j != 0) { const unsigned so_ = baseB_ + (unsigned)(l0_ + 64 * tt) * rstrideB_; \
            kreg[tt][0] = __builtin_bit_cast(u32x4, __builtin_amdgcn_raw_buffer_load_b128(rsQ, (int)vo0_, (int)(so_ + 1024u), 0)); vreg[tt][0] = __builtin_bit_cast(u32x4, __builtin_amdgcn_raw_buffer_load_b128(rsQ, (int)vo0_, (int)(so_ + 2048u), 0)); \
            kreg[tt][1] = __builtin_bit_cast(u32x4, __builtin_amdgcn_raw_buffer_load_b128(rsQ, (int)vo1_, (int)(so_ + 1024u), 0)); vreg[tt][1] = __builtin_bit_cast(u32x4, __builtin_amdgcn_raw_buffer_load_b128(rsQ, (int)vo1_, (int)(so_ + 2048u), 0)); } } \
        const unsigned qo_ = (unsigned)(32 * w + r32) * rstrideB_ + (unsigned)hi * 16u, qs_ = baseB_ + (unsigned)(128 * (IT).j) * rstrideB_; \
        _Pragma("unroll") for (int d0 = 0; d0 < 4; ++d0) qn[d0] = __builtin_bit_cast(bf16x8, __builtin_amdgcn_raw_buffer_load_b128(rsQ, (int)qo_, (int)(qs_ + (unsigned)d0 * 32u), 0)); } while (0)
    int pp = vcu;
    Item cur = decode_item(pp < 3072 ? pp : 0, half);
    if (pp < 3072) ATT_ISSUE(cur);
    const int koff = r32 * 144 + hi * 16;
    const int voff = ((lane >> 4) & 1) * 32 + (lane & 3) * 8 + (4 * hi + ((lane & 15) >> 2)) * 64;
    for (; pp < 3072; pp += G) {
        const int tt_lo = (cur.j == 0) ? 2 : 0;
#pragma unroll
        for (int tt = 0; tt < 4; ++tt) { if (tt >= 2 || cur.j != 0) {
#pragma unroll
            for (int i = 0; i < 2; ++i) {
                *(LAS u32x4*)(Kl + tt * 9216 + skv[i] * 144 + sc[i] * 16) = kreg[tt][i];
                *(LAS u32x4*)(Vl + tt * 8192 + (sc[i] >> 2) * 4096 + skv[i] * 64 + (sc[i] & 3) * 16) = vreg[tt][i]; } } }
        bf16x8 qr[4];
#pragma unroll
        for (int d0 = 0; d0 < 4; ++d0) qr[d0] = qn[d0];
        __syncthreads();
        const Item me = cur;
        if (pp + G < 3072) { cur = decode_item(pp + G, half); ATT_ISSUE(cur); }
        float m = -1e30f, l = 0.f; f32x16 oT[2]; oT[0] = f32x16{}; oT[1] = f32x16{};
        const int t_lo = (w >= 2) ? (tt_lo > 1 ? tt_lo : 1) : tt_lo, t_hi = (w < 2) ? 2 : 3, t_mid = (w < 2) ? 1 : 2;
        for (int tt = t_lo; tt <= t_hi; ++tt) {
            const LAS unsigned char* kb = Kl + tt * 9216 + koff;
            f32x16 p0 = f32x16{}, p1 = f32x16{};
#pragma unroll
            for (int d0 = 0; d0 < 4; ++d0) {
                const bf16x8 k0 = *(const LAS bf16x8*)(kb + d0 * 32), k1 = *(const LAS bf16x8*)(kb + d0 * 32 + 32 * 144);
                p0 = __builtin_amdgcn_mfma_f32_32x32x16_bf16(k0, qr[d0], p0, 0, 0, 0);
                p1 = __builtin_amdgcn_mfma_f32_32x32x16_bf16(k1, qr[d0], p1, 0, 0, 0);
            }
            float mx = -INFINITY;
            if (tt != t_mid) {
                const int dbase = 128 + 32 * w + r32 - 64 * tt;
#pragma unroll
                for (int r = 0; r < 16; ++r) {
                    const int d0_ = dbase - crow(r, hi), d1_ = d0_ - 32;
                    p0[r] = (d0_ >= 0 && d0_ <= 128) ? p0[r] * C2 : -INFINITY;
                    p1[r] = (d1_ >= 0 && d1_ <= 128) ? p1[r] * C2 : -INFINITY;
                    mx = fmaxf(mx, fmaxf(p0[r], p1[r]));
                }
            } else {
#pragma unroll
                for (int r = 0; r < 16; ++r) { p0[r] *= C2; p1[r] *= C2; mx = fmaxf(mx, fmaxf(p0[r], p1[r])); }
            }
            { const auto rr = __builtin_amdgcn_permlane32_swap(__float_as_uint(mx), __float_as_uint(mx), false, false); mx = fmaxf(__uint_as_float(rr[0]), __uint_as_float(rr[1])); }
            const float mn = fmaxf(m, mx), alpha = __builtin_amdgcn_exp2f(m - mn);
            float rs = 0.f;
#pragma unroll
            for (int r = 0; r < 16; ++r) { p0[r] = __builtin_amdgcn_exp2f(p0[r] - mn); p1[r] = __builtin_amdgcn_exp2f(p1[r] - mn); rs += p0[r] + p1[r]; }
            l = l * alpha + rs; m = mn;
#pragma unroll
            for (int r = 0; r < 16; ++r) { oT[0][r] *= alpha; oT[1][r] *= alpha; }
            u32x4 pw[4];
            pw[0] = (u32x4){cvtpk(p0[0], p0[1]), cvtpk(p0[2], p0[3]), cvtpk(p0[4], p0[5]), cvtpk(p0[6], p0[7])};
            pw[1] = (u32x4){cvtpk(p0[8], p0[9]), cvtpk(p0[10], p0[11]), cvtpk(p0[12], p0[13]), cvtpk(p0[14], p0[15])};
            pw[2] = (u32x4){cvtpk(p1[0], p1[1]), cvtpk(p1[2], p1[3]), cvtpk(p1[4], p1[5]), cvtpk(p1[6], p1[7])};
            pw[3] = (u32x4){cvtpk(p1[8], p1[9]), cvtpk(p1[10], p1[11]), cvtpk(p1[12], p1[13]), cvtpk(p1[14], p1[15])};
            const LAS unsigned char* vp = Vl + tt * 8192 + voff;
#pragma unroll
            for (int d0 = 0; d0 < 2; ++d0)
#pragma unroll
                for (int ks = 0; ks < 4; ++ks) {
                    const s16x4 lo = vtr(vp + d0 * 4096 + ks * 1024), hh4 = vtr(vp + d0 * 4096 + ks * 1024 + 512);
                    const bf16x8 vf = (bf16x8){lo[0], lo[1], lo[2], lo[3], hh4[0], hh4[1], hh4[2], hh4[3]};
                    oT[d0] = __builtin_amdgcn_mfma_f32_32x32x16_bf16(vf, __builtin_bit_cast(bf16x8, pw[ks]), oT[d0], 0, 0, 0);
                }
        }
        float lt; { const auto rr = __builtin_amdgcn_permlane32_swap(__float_as_uint(l), __float_as_uint(l), false, false); lt = __uint_as_float(rr[0]) + __uint_as_float(rr[1]); }
        const float inv = 1.0f / lt;
        const int lq = 128 * me.j + 32 * w + r32;
        const size_t tok = (size_t)me.b * SEQ + (size_t)lq * me.dil + me.ph;
        bf16* orow = og + tok * (NG * AW) + me.g * AW + me.hh * 64;
#pragma unroll
        for (int d0 = 0; d0 < 2; ++d0)
#pragma unroll
            for (int rg = 0; rg < 4; ++rg) {
                u32x2 wv; wv.x = cvtpk(oT[d0][4 * rg] * inv, oT[d0][4 * rg + 1] * inv); wv.y = cvtpk(oT[d0][4 * rg + 2] * inv, oT[d0][4 * rg + 3] * inv);
                *(u32x2*)(orow + 32 * d0 + 8 * rg + 4 * hi) = wv;
            }
        if (hi == 0) lse[tok * 24 + me.g * 8 + me.hh] = (m + __builtin_amdgcn_logf(lt)) * LN2;
        __syncthreads();
    }
#undef ATT_ISSUE
}
}

using pg8::Unit; using pg8::BM; using pg8::HALF;
struct EpiQKV {
    static constexpr bool PERM = true;
    bf16* O; const float* cs; float sc;
    __device__ __forceinline__ void operator()(const f32x4 (&acc)[2][2][4][2], const Unit& u, int wr, int wc, int fr, int fq) const {
        const int colt = u.pn * BM; const int kind = (colt % 1536) / 512;
        const bool rot = (kind < 2) && ((wc & 1) == 0) && (fq < 2);
#pragma unroll
        for (int ai = 0; ai < 2; ++ai)
#pragma unroll
            for (int m = 0; m < 4; ++m) {
                const int row = u.pm * BM + ai * HALF + wr * 64 + m * 16 + fr;
                f32x4 c0 = {1.f, 0.f, 1.f, 0.f}, c1 = {1.f, 0.f, 1.f, 0.f};
                if (rot) { c0 = *(const f32x4*)(cs + (size_t)row * 16 + fq * 8); c1 = *(const f32x4*)(cs + (size_t)row * 16 + fq * 8 + 4); }
                bf16* rowp = O + (size_t)row * QKVW + colt + wc * 32 + 8 * fq;
#pragma unroll
                for (int bj = 0; bj < 2; ++bj) {
                    f32x4 v0 = acc[ai][bj][m][0] * sc, v1 = acc[ai][bj][m][1] * sc;
                    f32x4 o0, o1;
                    o0.x = v0.x * c0.x - v0.y * c0.y; o0.y = v0.y * c0.x + v0.x * c0.y; o0.z = v0.z * c0.z - v0.w * c0.w; o0.w = v0.w * c0.z + v0.z * c0.w;
                    o1.x = v1.x * c1.x - v1.y * c1.y; o1.y = v1.y * c1.x + v1.x * c1.y; o1.z = v1.z * c1.z - v1.w * c1.w; o1.w = v1.w * c1.z + v1.z * c1.w;
                    u32x4 w; w.x = cvtpk(o0.x, o0.y); w.y = cvtpk(o0.z, o0.w); w.z = cvtpk(o1.x, o1.y); w.w = cvtpk(o1.z, o1.w);
                    *(u32x4*)(rowp + bj * HALF) = w;
                }
                if (m & 1) asm volatile("" ::: "memory");
            }
    }
};
struct EpiBf16 {
    static constexpr bool PERM = true;
    bf16* O; int ldc;
    __device__ __forceinline__ void operator()(const f32x4 (&acc)[2][2][4][2], const Unit& u, int wr, int wc, int fr, int fq) const {
#pragma unroll
        for (int ai = 0; ai < 2; ++ai)
#pragma unroll
            for (int m = 0; m < 4; ++m) {
                bf16* rowp = O + (size_t)(u.pm * BM + ai * HALF + wr * 64 + m * 16 + fr) * ldc + u.pn * BM + wc * 32 + 8 * fq;
#pragma unroll
                for (int bj = 0; bj < 2; ++bj) { const f32x4 v0 = acc[ai][bj][m][0], v1 = acc[ai][bj][m][1];
                    u32x4 w; w.x = cvtpk(v0.x, v0.y); w.y = cvtpk(v0.z, v0.w); w.z = cvtpk(v1.x, v1.y); w.w = cvtpk(v1.z, v1.w);
                    *(u32x4*)(rowp + bj * HALF) = w; }
            }
    }
};
struct EpiResF32 {
    static constexpr bool PERM = false;
    const float* res; float* out;
    __device__ __forceinline__ void operator()(const f32x4 (&acc)[2][2][4][2], const Unit& u, int wr, int wc, int fr, int fq) const {
#pragma unroll
        for (int ai = 0; ai < 2; ++ai)
#pragma unroll
            for (int m = 0; m < 4; ++m) {
                const size_t off = (size_t)(u.pm * BM + ai * HALF + wr * 64 + m * 16 + fr) * D + u.pn * BM + wc * 32 + 4 * fq;
#pragma unroll
                for (int bj = 0; bj < 2; ++bj)
#pragma unroll
                    for (int n = 0; n < 2; ++n) { const f32x4 r = *(const f32x4*)(res + off + bj * HALF + n * 16); *(f32x4*)(out + off + bj * HALF + n * 16) = r + acc[ai][bj][m][n]; }
            }
    }
};
template <bool OUT8>
struct EpiSwiGLU {
    static constexpr bool PERM = true;
    void* O; float sc;
    __device__ __forceinline__ void operator()(const f32x4 (&acc)[2][2][4][2], const Unit& u, int wr, int wc, int fr, int fq) const {
#pragma unroll
        for (int ai = 0; ai < 2; ++ai)
#pragma unroll
            for (int m = 0; m < 4; ++m) {
                const size_t eoff = (size_t)(u.pm * BM + ai * HALF + wr * 64 + m * 16 + fr) * DE + u.pn * HALF + wc * 32 + 8 * fq;
                float h[8];
#pragma unroll
                for (int n = 0; n < 2; ++n)
#pragma unroll
                    for (int e = 0; e < 4; ++e) { const float a = acc[ai][0][m][n][e] * sc, b = acc[ai][1][m][n][e] * sc;
                        h[n * 4 + e] = a * __builtin_amdgcn_rcpf(1.0f + __builtin_amdgcn_exp2f(-1.4426950408889634f * a)) * b; }
                if constexpr (OUT8) { u32x2 w; w.x = pack_fp8x4(h[0] * 16.f, h[1] * 16.f, h[2] * 16.f, h[3] * 16.f); w.y = pack_fp8x4(h[4] * 16.f, h[5] * 16.f, h[6] * 16.f, h[7] * 16.f); *(u32x2*)((unsigned char*)O + eoff) = w; }
                else { u32x4 w; w.x = cvtpk(h[0], h[1]); w.y = cvtpk(h[2], h[3]); w.z = cvtpk(h[4], h[5]); w.w = cvtpk(h[6], h[7]); *(u32x4*)((bf16*)O + eoff) = w; }
            }
    }
};
struct EpiGate {
    static constexpr bool PERM = true;
    bf16* O; const float* gatel; const int* cnt; const LAS int* tb; float sc;
    __device__ __forceinline__ void operator()(const f32x4 (&acc)[2][2][4][2], const Unit& u, int wr, int wc, int fr, int fq) const {
        int e = 0;
#pragma unroll
        for (int k = 1; k < NE; ++k) e += (u.pm >= tb[k]) ? 1 : 0;
        const int lbase = (u.pm - tb[e]) * BM, n_e = cnt[e];
#pragma unroll
        for (int ai = 0; ai < 2; ++ai)
#pragma unroll
            for (int m = 0; m < 4; ++m) {
                const int rl = ai * HALF + wr * 64 + m * 16 + fr, li = lbase + rl;
                const float gt = (li < n_e) ? gatel[(size_t)e * T + li] * sc : 0.f;
                bf16* rowp = O + (size_t)(u.pm * BM + rl) * D + u.pn * BM + wc * 32 + 8 * fq;
#pragma unroll
                for (int bj = 0; bj < 2; ++bj) { const f32x4 v0 = acc[ai][bj][m][0] * gt, v1 = acc[ai][bj][m][1] * gt;
                    u32x4 w; w.x = cvtpk(v0.x, v0.y); w.y = cvtpk(v0.z, v0.w); w.z = cvtpk(v1.x, v1.y); w.w = cvtpk(v1.z, v1.w);
                    *(u32x4*)(rowp + bj * HALF) = w; }
            }
    }
};

template <bool F8_>
struct MoeProb1T {
    static constexpr bool F8 = F8_;
    const void* A; const void* Bt; int K; const LAS int* tb; const LAS unsigned* aofs;
    __device__ __forceinline__ void a_offs(int i, const Unit&, const int (&R)[2], const int (&C)[2], unsigned (&o0)[2], unsigned (&o1)[2]) const {
#pragma unroll
        for (int k = 0; k < 2; ++k) { o0[k] = aofs[i * 256 + R[k]] + (unsigned)C[k] * 2u; o1[k] = aofs[i * 256 + 128 + R[k]] + (unsigned)C[k] * 2u; }
    }
    __device__ __forceinline__ unsigned b_off(const Unit& u) const {
        int e = 0;
#pragma unroll
        for (int k = 1; k < NE; ++k) e += (u.pm >= tb[k]) ? 1 : 0;
        return (unsigned)((e * 1024 + u.pn * 256) * 1024 * (F8 ? 1 : 2));
    }
};
template <bool F8_>
struct MoeProb2T {
    static constexpr bool F8 = F8_;
    const void* A; const void* Bt; int K; const LAS int* tb;
    __device__ __forceinline__ void a_offs(int, const Unit& u, const int (&R)[2], const int (&C)[2], unsigned (&o0)[2], unsigned (&o1)[2]) const {
        constexpr int esz = F8 ? 1 : 2;
#pragma unroll
        for (int k = 0; k < 2; ++k) { const unsigned b = (unsigned)((u.pm * BM + R[k]) * DE * esz + C[k] * 2); o0[k] = b; o1[k] = b + (unsigned)(HALF * DE * esz); }
    }
    __device__ __forceinline__ unsigned b_off(const Unit& u) const {
        int e = 0;
#pragma unroll
        for (int k = 1; k < NE; ++k) e += (u.pm >= tb[k]) ? 1 : 0;
        return (unsigned)((e * 1024 + u.pn * 256) * DE * (F8 ? 1 : 2));
    }
};
struct FoldOrder { int G, c; __device__ bool next(int i, Unit& u) const { const int L = i * G + c; if (L >= 16) return false; u.pm = L >> 2; u.pn = L & 3; return true; } };


#define XB_TMO      128
#define XB_XCNT(j)  (256  + 64 * (j))
#define XB_XSUB(j)  (1280 + 64 * (j))
#define XB_XGEN(j)  (2304 + 64 * (j))
#define XB_TOP      3328
#define XB_TOPGEN   3392
#define XCD_BAR_WORDS 3456
#define XB_SPIN_CAP (1u << 18)
__device__ __forceinline__ unsigned xb_ld(unsigned* p)              { return __hip_atomic_load(p, __ATOMIC_RELAXED, __HIP_MEMORY_SCOPE_AGENT); }
__device__ __forceinline__ unsigned xb_add(unsigned* p, unsigned v) { return __hip_atomic_fetch_add(p, v, __ATOMIC_RELAXED, __HIP_MEMORY_SCOPE_AGENT); }
__device__ __forceinline__ unsigned xb_xcc_id() { return (unsigned)__builtin_amdgcn_s_getreg((3 << 11) | 20) & 0xFu; }
#define XB_SPIN(cond, bar) do { unsigned _sp = 0; while (cond) { __builtin_amdgcn_s_sleep(1); \
    if ((++_sp & 255u) == 0u) { if (xb_ld(&(bar)[XB_TMO])) break; if (_sp > XB_SPIN_CAP) { atomicAdd(&(bar)[XB_TMO], 1u); break; } } } } while (0)
struct XcdBarrier { unsigned* bar; unsigned x; volatile LAS unsigned* st; };
__device__ __forceinline__ XcdBarrier xcd_barrier_post(unsigned* bar, volatile LAS unsigned* st) {
    XcdBarrier b; b.bar = bar; b.x = xb_xcc_id(); b.st = st;
    if (threadIdx.x == 0) (void)xb_add(&bar[XB_XCNT(b.x)], 1u);
    return b;
}
__device__ __forceinline__ void xcd_barrier_complete(unsigned* bar, unsigned x, unsigned& nloc, unsigned& nx) {
    const unsigned G = gridDim.x * gridDim.y * gridDim.z;
    unsigned sum, cnt, mine, sp = 0u;
    for (;;) {
        sum = 0u; cnt = 0u; mine = 0u;
#pragma unroll
        for (unsigned j = 0; j < 16; ++j) { const unsigned c = xb_ld(&bar[XB_XCNT(j)]); sum += c; cnt += (c > 0u) ? 1u : 0u; mine = (j == x) ? c : mine; }
        if (sum == G) break;
        __builtin_amdgcn_s_sleep(1);
        if ((++sp & 255u) == 0u) { if (xb_ld(&bar[XB_TMO])) break; if (sp > XB_SPIN_CAP) { atomicAdd(&bar[XB_TMO], 1u); break; } }
    }
    nloc = mine > 0u ? mine : 1u; nx = cnt > 0u ? cnt : 1u;
}
__device__ __forceinline__ void xcd_barrier(const XcdBarrier& b) {
    asm volatile("s_waitcnt vmcnt(0)" ::: "memory");
    __syncthreads();
    if (threadIdx.x == 0) {
        unsigned* bar = b.bar;
        __builtin_amdgcn_s_waitcnt(0);
        unsigned nloc = b.st[0], nx = b.st[1];
        if (nloc == 0u) { xcd_barrier_complete(bar, b.x, nloc, nx); b.st[0] = nloc; b.st[1] = nx; }
        const unsigned old = xb_add(&bar[XB_XSUB(b.x)], 1u);
        const unsigned gen = old / nloc;
        if (old + 1u == (gen + 1u) * nloc) {
            __builtin_amdgcn_fence(__ATOMIC_RELEASE, "agent");
            asm volatile("s_waitcnt vmcnt(0)" ::: "memory");
            const unsigned og = xb_add(&bar[XB_TOP], 1u);
            const unsigned tg = og / nx;
            if (og + 1u == (tg + 1u) * nx) xb_add(&bar[XB_TOPGEN], 1u);
            else XB_SPIN(xb_ld(&bar[XB_TOPGEN]) == tg, bar);
            __builtin_amdgcn_fence(__ATOMIC_ACQUIRE, "agent");
            xb_add(&bar[XB_XGEN(b.x)], 1u);
            asm volatile("s_waitcnt vmcnt(0)" ::: "memory");
        } else {
            XB_SPIN(xb_ld(&bar[XB_XGEN(b.x)]) == gen, bar);
            __builtin_amdgcn_fence(__ATOMIC_ACQUIRE, "agent");
            asm volatile("s_waitcnt vmcnt(0)" ::: "memory");
        }
    }
    __syncthreads();
}

constexpr int N_PHASES = 16;

__global__ void __launch_bounds__(NTHREADS, 2) fwd_kernel(Params p) {
    extern __shared__ __attribute__((aligned(16))) unsigned char lds_raw[];
    LAS unsigned char* lds = (LAS unsigned char*)lds_raw;
    const int tid = threadIdx.x, lane = tid & 63, wave = __builtin_amdgcn_readfirstlane(tid >> 6);
    const int G = gridDim.x, bx = blockIdx.x;
    const int vcu = (G % 8 == 0) ? (bx % 8) * (G / 8) + bx / 8 : bx;
    unsigned char* ws = p.ws;
    int* ctl = (int*)(ws + WS_CTL);
    float* cs = (float*)(ws + WS_CS);
    float* lse = (float*)(ws + WS_LSE);
    int* slotref = (int*)(ws + WS_SLOTREF);
    bf16* Wgs = (bf16*)(ws + WS_WGS);
    int* list = (int*)(ws + WS_LIST);
    float* gatel = (float*)(ws + WS_GATEL);
    bf16* Win_t = (bf16*)(ws + WS_WIN); bf16* Wout_t = (bf16*)(ws + WS_WOUT); bf16* Wpin_t = (bf16*)(ws + WS_WPIN); bf16* Wc_t = (bf16*)(ws + WS_WC); bf16* Wpo_t = (bf16*)(ws + WS_WPO);
    bf16* W13 = (bf16*)(ws + WS_W13); bf16* W2 = (bf16*)(ws + WS_W2);
    bf16* Y = (bf16*)(ws + WS_Y); bf16* QKV = (bf16*)(ws + WS_BIG); bf16* OM = (bf16*)(ws + WS_OM);
    bf16* HMID = (bf16*)(ws + WS_HMID); bf16* YS = (bf16*)(ws + WS_YS); bf16* U = (bf16*)(ws + WS_U); bf16* POOLED = (bf16*)(ws + WS_POOLED);
    bf16* OG = (bf16*)p.out;
    float* H = p.out;
    LAS int* tb = (LAS int*)(lds + MISC_OFF);
    LAS unsigned* aofs = (LAS unsigned*)(lds + AOFS_OFF);

    const int lo = p.ph_lo, hi = p.ph_hi;
#if MK_N_LAUNCHES == 1
    cg::grid_group grid = cg::this_grid();
    if (tid < 2) ((volatile LAS unsigned*)(lds + MISC_OFF))[64 + tid] = 0u;
    __syncthreads();
    const XcdBarrier xbar = xcd_barrier_post((unsigned*)(ctl + CW_BAR), (volatile LAS unsigned*)(lds + MISC_OFF) + 64);
#define GRID_BAR(k) do { if ((k) == CG_SEAM) grid.sync(); else xcd_barrier(xbar); } while (0)
#else
#define GRID_BAR(k) do { } while (0)
#endif
#ifndef PHASE_MASK
#define PHASE_MASK 0xffff
#endif
#ifndef REPEAT_MASK
#define REPEAT_MASK 0x0
#endif
#define REP(k) for (int rep_ = 0; rep_ <= ((REPEAT_MASK >> (k)) & 1); ++rep_)
#define IN(k) (((PHASE_MASK >> (k)) & 1) && lo <= (k) && (k) < hi)
#define SEAM(k) do { if (IN(k) && IN((k) + 1)) GRID_BAR(k); } while (0)

    if (IN(0)) REP(0) {
        LAS float* scr = (LAS float*)(lds + wave * 16384);
        const int gw = vcu * NWAVES + wave, NGW = G * NWAVES;
        constexpr int I_IN = (D / 64) * (QKVW / 32);
        constexpr int I_OUT = (AW / 64) * (D / 32);
        constexpr int I_PIN = (D / 64) * (D / 32);
        constexpr int I_PO = I_PIN;
        constexpr int I_W1 = (D / 64) * (DE / 32);
        constexpr int I_W2 = (DE / 64) * (D / 32);
        constexpr int NITEMS = I_IN + I_OUT + I_PIN + I_PO + 32 * (2 * I_W1 + I_W2);
        for (int it = gw; it < NITEMS; it += NGW) {
            int r = it;
            if (r < I_IN) { const int nblk = QKVW / 32;
                if (FP8_QKV) transpose_item8(p.attn_w_in, QKVW, D, (unsigned char*)Win_t, MapQKV{}, 32.f, scr, 64 * (r / nblk), 32 * (r % nblk), lane);
                else transpose_item(p.attn_w_in, QKVW, D, Win_t, MapQKV{}, scr, 64 * (r / nblk), 32 * (r % nblk), lane);
                continue; } r -= I_IN;
            if (r < I_OUT) { const int nblk = D / 32; transpose_item(p.attn_w_out, D, AW, Wout_t, MapId{}, scr, 64 * (r / nblk), 32 * (r % nblk), lane); continue; } r -= I_OUT;
            if (r < I_PIN) { const int nblk = D / 32; transpose_item(p.pool_w_in, D, D, Wpin_t, MapId{}, scr, 64 * (r / nblk), 32 * (r % nblk), lane); continue; } r -= I_PIN;
            if (r < I_PO) { const int nblk = D / 32; transpose_item(p.pool_w_out, D, D, Wpo_t, MapId{}, scr, 64 * (r / nblk), 32 * (r % nblk), lane); continue; } r -= I_PO;
            const int le = r / (2 * I_W1 + I_W2); r -= le * (2 * I_W1 + I_W2);
            if (r < I_W1) { const int nblk = DE / 32;
                if (FP8_MOE1) transpose_item8(p.expert_w1 + (size_t)le * D * DE, DE, D, (unsigned char*)W13 + (size_t)le * 1024 * 1024, MapW13{0}, 32.f, scr, 64 * (r / nblk), 32 * (r % nblk), lane);
                else transpose_item(p.expert_w1 + (size_t)le * D * DE, DE, D, W13 + (size_t)le * 1024 * 1024, MapW13{0}, scr, 64 * (r / nblk), 32 * (r % nblk), lane);
                continue; } r -= I_W1;
            if (r < I_W1) { const int nblk = DE / 32;
                if (FP8_MOE1) transpose_item8(p.expert_w3 + (size_t)le * D * DE, DE, D, (unsigned char*)W13 + (size_t)le * 1024 * 1024, MapW13{128}, 32.f, scr, 64 * (r / nblk), 32 * (r % nblk), lane);
                else transpose_item(p.expert_w3 + (size_t)le * D * DE, DE, D, W13 + (size_t)le * 1024 * 1024, MapW13{128}, scr, 64 * (r / nblk), 32 * (r % nblk), lane);
                continue; } r -= I_W1;
            { const int nblk = D / 32;
                if (FP8_MOE2) transpose_item8(p.expert_w2 + (size_t)le * DE * D, D, DE, (unsigned char*)W2 + (size_t)le * 1024 * DE, MapId{}, 32.f, scr, 64 * (r / nblk), 32 * (r % nblk), lane);
                else transpose_item(p.expert_w2 + (size_t)le * DE * D, D, DE, W2 + (size_t)le * 1024 * DE, MapId{}, scr, 64 * (r / nblk), 32 * (r % nblk), lane); }
        }
        for (int i = vcu * NTHREADS + tid; i < 4 * 256 * 256 / 4; i += G * NTHREADS) {
            const int e4 = (i & 63) * 4, gidx = i >> 14;
            const f32x4 wv = *(const f32x4*)(p.pool_w_group + (size_t)i * 4); const f32x4 sc = *(const f32x4*)(p.pool_scale + gidx * 256 + e4);
            u32x2 o; o.x = cvtpk(wv.x * sc.x, wv.y * sc.y); o.y = cvtpk(wv.z * sc.z, wv.w * sc.w); *(u32x2*)(Wgs + (size_t)i * 4) = o;
        }
        for (int i = vcu * NTHREADS + tid; i < T * 8; i += G * NTHREADS) {
            const int tok = i >> 3, f = i & 7;
            const double invf = exp2(-(double)f * 0.125 * 18.931568569324174);
            const float ang = (float)p.positions[tok] * (float)invf;
            double sn, cn; sincos((double)ang, &sn, &cn);
            cs[(size_t)i * 2] = (float)cn; cs[(size_t)i * 2 + 1] = (float)sn;
        }
        RowPassCfg c{}; c.hin = p.x; c.gain = p.norm_mix; if (FP8_QKV) c.yout8 = (unsigned char*)Y; else c.yout = Y;
        row_pass<false, false>(lds, c, vcu, wave);
    }
    SEAM(0);
    if (IN(1)) REP(1) {
        pg8::DenseProbT<FP8_QKV != 0> P{Y, Win_t, D, D, 0, (size_t)256 * D};
        pg8::StaticOrder S; S.init(T / 256, QKVW / 256, G, bx);
        EpiQKV E{QKV, cs, FP8_QKV ? (1.0f / 32.0f) : 1.0f};
        pg8::gemm_phase<pg8::DenseProbT<FP8_QKV != 0>, EpiQKV, pg8::StaticOrder, true>(lds, P, S, E);
    }
    SEAM(1);
    if (IN(2)) REP(2) {
        att::attn_phase(lds, QKV, OG, lse, vcu, G);
        pg8::DenseProb P{Wpo_t, Wgs, 256, D, 256, (size_t)256 * 256};
        FoldOrder S{G, bx};
        EpiBf16 E{Wc_t, D};
        pg8::gemm_phase<pg8::DenseProb, EpiBf16, FoldOrder, true>(lds, P, S, E);
    }
    SEAM(2);
    if (IN(3)) REP(3) {
        for (int row = vcu * NWAVES + wave; row < T; row += G * NWAVES) {
            const int h = lane >> 3;
            const float l0 = lse[(size_t)row * 24 + h], l1 = lse[(size_t)row * 24 + 8 + h], l2 = lse[(size_t)row * 24 + 16 + h];
            const float mx = fmaxf(l0, fmaxf(l1, l2));
            float w0 = __expf(l0 - mx), w1 = __expf(l1 - mx), w2 = __expf(l2 - mx); const float inv = 1.0f / (w0 + w1 + w2); w0 *= inv; w1 *= inv; w2 *= inv;
            const bf16* src = OG + (size_t)row * 1536 + lane * 8;
            const u32x4 a = *(const u32x4*)(src), b = *(const u32x4*)(src + 512), c = *(const u32x4*)(src + 1024);
            u32x4 o;
#pragma unroll
            for (int k = 0; k < 4; ++k) { const float lo_ = w0 * bf_lo(a[k]) + w1 * bf_lo(b[k]) + w2 * bf_lo(c[k]), hi_ = w0 * bf_hi(a[k]) + w1 * bf_hi(b[k]) + w2 * bf_hi(c[k]); o[k] = cvtpk(lo_, hi_); }
            *(u32x4*)(OM + (size_t)row * AW + lane * 8) = o;
        }
    }
    SEAM(3);
    if (IN(4)) REP(4) {
        pg8::DenseProb P{OM, Wout_t, AW, AW, 0, (size_t)256 * AW};
        pg8::StaticOrder S; S.init(T / 256, D / 256, G, bx);
        EpiResF32 E{p.x, H};
        pg8::gemm_phase<pg8::DenseProb, EpiResF32, pg8::StaticOrder, true>(lds, P, S, E);
    }
    SEAM(4);
#pragma unroll 1
    for (int L = 0; L < 2; ++L) {
        const int pb = (L == 0) ? 5 : 12;
        int* cnt = ctl + CW_CNT + L * NE;
        if (IN(pb)) {
            RowPassCfg c{}; c.hin = H; c.gain = p.norm_ffn + L * D; if (FP8_MOE1) c.yout8 = (unsigned char*)Y; else c.yout = Y;
            c.rgw = p.router_group_w + (size_t)L * D * 4; c.rgb = p.router_group_b + L * 4; c.rew = p.router_expert_w + (size_t)L * 4 * D * 4; c.reb = p.router_expert_b + L * 16;
            c.cnt = cnt; c.list = list + (size_t)L * NE * T; c.gatel = gatel + (size_t)L * NE * T; c.slotref_out = slotref + (size_t)L * T * 2;
            if ((REPEAT_MASK >> pb) & 1) {
                RowPassCfg c2 = c; c2.cnt = ctl + 64 + L * NE; c2.list = (int*)(ws + WS_BIG + 200 * MiB); c2.gatel = (float*)(ws + WS_BIG + 204 * MiB); c2.slotref_out = (int*)(ws + WS_BIG + 208 * MiB);
                row_pass<false, true>(lds, c2, vcu, wave);
            }
            row_pass<false, true>(lds, c, vcu, wave);
        }
        SEAM(pb);
        if (IN(pb + 1) || IN(pb + 2)) {
            if (tid == 0) { int s = 0; for (int e = 0; e < NE; ++e) { tb[e] = s; tb[32 + e] = cnt[e]; s += (cnt[e] + 255) >> 8; } tb[NE] = s; }
            __syncthreads();
        }
        if (IN(pb + 1)) REP(pb + 1) {
            const int NT = tb[NE];
            pg8::StaticOrder S; S.init(NT, 4, G, bx);
            for (int i = 0; i < 8; ++i) { Unit u; if (!S.next(i, u)) break;
                int e = 0;
                for (int k = 1; k < NE; ++k) e += (u.pm >= tb[k]) ? 1 : 0;
                if (tid < 256) { const int li = (u.pm - tb[e]) * 256 + tid; const int tok = (li < tb[32 + e]) ? list[((size_t)L * NE + e) * T + li] : 0; aofs[i * 256 + tid] = (unsigned)tok * (unsigned)(D * (FP8_MOE1 ? 1 : 2)); } }
            __syncthreads();
            MoeProb1T<FP8_MOE1 != 0> P{Y, (const unsigned char*)W13 + (size_t)L * NE * 1024 * 1024 * (FP8_MOE1 ? 1 : 2), D, tb, aofs};
            EpiSwiGLU<FP8_MOE2 != 0> E{HMID, FP8_MOE1 ? (1.0f / 32.0f) : 1.0f};
            pg8::gemm_phase<MoeProb1T<FP8_MOE1 != 0>, EpiSwiGLU<FP8_MOE2 != 0>, pg8::StaticOrder, true>(lds, P, S, E);
        }
        SEAM(pb + 1);
        if (IN(pb + 2)) REP(pb + 2) {
            const int NT = tb[NE];
            pg8::StaticOrder S; S.init(NT, 4, G, bx);
            MoeProb2T<FP8_MOE2 != 0> P{HMID, (const unsigned char*)W2 + (size_t)L * NE * 1024 * DE * (FP8_MOE2 ? 1 : 2), DE, tb};
            EpiGate E{YS, gatel + (size_t)L * NE * T, cnt, tb, FP8_MOE2 ? (1.0f / 512.0f) : 1.0f};
            pg8::gemm_phase<MoeProb2T<FP8_MOE2 != 0>, EpiGate, pg8::StaticOrder, true>(lds, P, S, E);
        }
        SEAM(pb + 2);
        if (L == 0) {
            if (IN(8)) {
                RowPassCfg c{}; c.hin = H; c.ys = YS; c.slotref = slotref; c.cnt_prev = cnt; c.hout = H; c.gain = p.norm_mix + D; c.yout = Y;
                if ((REPEAT_MASK >> 8) & 1) { RowPassCfg c2 = c; c2.hout = nullptr; row_pass<true, false>(lds, c2, vcu, wave); }
                row_pass<true, false>(lds, c, vcu, wave);
            }
            SEAM(8);
            if (IN(9)) REP(9) {
                pg8::DenseProb P{Y, Wpin_t, D, D, 0, (size_t)256 * D};
                pg8::StaticOrder S; S.init(T / 256, D / 256, G, bx);
                EpiBf16 E{U, D};
                pg8::gemm_phase<pg8::DenseProb, EpiBf16, pg8::StaticOrder, true>(lds, P, S, E);
            }
            SEAM(9);
            if (IN(10)) REP(10) {
                for (int it = vcu * NTHREADS + tid; it < (T / 32) * 128; it += G * NTHREADS) {
                    const int ch = (it & 127) * 8, run = it >> 7, t0 = run * 32, s0 = t0 & (SEQ - 1);
                    const int wdw = 2 << (ch >> 8);
                    float sum[8];
#pragma unroll
                    for (int k = 0; k < 8; ++k) sum[k] = 0.f;
                    for (int i = 1; i < wdw; ++i) { if (s0 - i < 0) break; const u32x4 a = *(const u32x4*)(U + (size_t)(t0 - i) * D + ch);
#pragma unroll
                        for (int k = 0; k < 4; ++k) { sum[2 * k] += bf_lo(a[k]); sum[2 * k + 1] += bf_hi(a[k]); } }
                    for (int i = 0; i < 32; ++i) {
                        const int tk = t0 + i, s = s0 + i;
                        const u32x4 a = *(const u32x4*)(U + (size_t)tk * D + ch);
                        float cur[8];
#pragma unroll
                        for (int k = 0; k < 4; ++k) { cur[2 * k] = bf_lo(a[k]); cur[2 * k + 1] = bf_hi(a[k]); }
#pragma unroll
                        for (int k = 0; k < 8; ++k) sum[k] += cur[k];
                        const float invc = 1.0f / (float)((s + 1) < wdw ? (s + 1) : wdw);
                        u32x4 w;
#pragma unroll
                        for (int k = 0; k < 4; ++k) w[k] = cvtpk(sum[2 * k] * invc - cur[2 * k], sum[2 * k + 1] * invc - cur[2 * k + 1]);
                        *(u32x4*)(POOLED + (size_t)tk * D + ch) = w;
                        if (s - wdw + 1 >= 0) { const u32x4 o = *(const u32x4*)(U + (size_t)(tk - wdw + 1) * D + ch);
#pragma unroll
                            for (int k = 0; k < 4; ++k) { sum[2 * k] -= bf_lo(o[k]); sum[2 * k + 1] -= bf_hi(o[k]); } }
                    }
                }
            }
            SEAM(10);
            if (IN(11)) REP(11) {
                pg8::DenseProb P{POOLED, Wc_t, D, D, 0, (size_t)256 * D};
                pg8::StaticOrder S; S.init(T / 256, D / 256, G, bx);
                EpiResF32 E{H, (((REPEAT_MASK >> 11) & 1) && rep_ == 0) ? (float*)(ws + WS_BIG + 136 * MiB) : H};
                pg8::gemm_phase<pg8::DenseProb, EpiResF32, pg8::StaticOrder, true>(lds, P, S, E);
            }
            SEAM(11);
        }
    }
    if (IN(15)) {
        RowPassCfg c{}; c.hin = H; c.ys = YS; c.slotref = slotref + (size_t)T * 2; c.cnt_prev = ctl + CW_CNT + NE; c.gain = p.norm_final; c.fout = p.out;
        if ((REPEAT_MASK >> 15) & 1) { RowPassCfg c2 = c; c2.fout = nullptr; c2.yout = Y; row_pass<true, false>(lds, c2, vcu, wave); }
        row_pass<true, false>(lds, c, vcu, wave);
    }
#undef IN
#undef SEAM
#undef GRID_BAR
}

extern "C" void kernel_launch(void* const* d_in, const int* in_sizes, int n_in, void* d_out, int out_size, void* d_ws, size_t ws_size, hipStream_t stream) {
    static int grid = 0;
    if (grid == 0) {
        if (n_in != 18 || in_sizes[0] != T * D || out_size != T * D || ws_size < WS_END) { fprintf(stderr, "kernel_launch: unexpected shapes (n_in %d, in0 %d, out %d, ws %zu)\n", n_in, n_in > 0 ? in_sizes[0] : -1, out_size, ws_size); grid = -1; return; }
        int dev = 0, cus = 0, per_cu = 0;
        if (hipGetDevice(&dev) != hipSuccess || hipDeviceGetAttribute(&cus, hipDeviceAttributeMultiprocessorCount, dev) != hipSuccess) { grid = -1; return; }
        if (hipFuncSetAttribute((const void*)fwd_kernel, hipFuncAttributeMaxDynamicSharedMemorySize, LDS_BYTES) != hipSuccess) { fprintf(stderr, "kernel_launch: hipFuncSetAttribute failed\n"); grid = -1; return; }
        if (hipOccupancyMaxActiveBlocksPerMultiprocessor(&per_cu, (const void*)fwd_kernel, NTHREADS, LDS_BYTES) != hipSuccess || per_cu < 1) { fprintf(stderr, "kernel_launch: occupancy query says %d\n", per_cu); per_cu = 1; }
        (void)hipGetLastError();
        grid = cus;
    }
    if (grid < 0) return;
    (void)hipMemsetAsync((char*)d_ws + WS_CTL, 0, CTL_ZERO_BYTES, stream);
    Params p{};
    p.x = (const float*)d_in[0]; p.positions = (const int*)d_in[1]; p.norm_mix = (const float*)d_in[2]; p.norm_ffn = (const float*)d_in[3]; p.norm_final = (const float*)d_in[4];
    p.attn_w_in = (const float*)d_in[5]; p.attn_w_out = (const float*)d_in[6]; p.pool_w_in = (const float*)d_in[7]; p.pool_w_group = (const float*)d_in[8]; p.pool_scale = (const float*)d_in[9]; p.pool_w_out = (const float*)d_in[10];
    p.router_group_w = (const float*)d_in[11]; p.router_group_b = (const float*)d_in[12]; p.router_expert_w = (const float*)d_in[13]; p.router_expert_b = (const float*)d_in[14];
    p.expert_w1 = (const float*)d_in[15]; p.expert_w3 = (const float*)d_in[16]; p.expert_w2 = (const float*)d_in[17];
    p.out = (float*)d_out; p.ws = (unsigned char*)d_ws;
#if MK_N_LAUNCHES == 1
    p.ph_lo = 0; p.ph_hi = N_PHASES;
    void* args[] = {&p};
    hipError_t e = hipLaunchCooperativeKernel((const void*)fwd_kernel, dim3(grid), dim3(NTHREADS), args, LDS_BYTES, stream);
    if (e != hipSuccess) fprintf(stderr, "cooperative launch failed: %s (grid %d)\n", hipGetErrorString(e), grid);
#else
    for (int ph = 0; ph < N_PHASES; ++ph) {
        p.ph_lo = ph; p.ph_hi = ph + 1;
        hipLaunchKernelGGL(fwd_kernel, dim3(grid), dim3(NTHREADS), LDS_BYTES, stream, p);
    }
#endif
}
```

```cpp
#include <hip/hip_runtime.h>
#include <hip/hip_cooperative_groups.h>
#include <cstdio>
#include <cstdint>
namespace cg = cooperative_groups;

#ifndef MK_N_LAUNCHES
#define MK_N_LAUNCHES 1
#endif

#ifndef FP8_MOE1
#define FP8_MOE1 1
#endif
#ifndef FP8_MOE2
#define FP8_MOE2 1
#endif
#ifndef FP8_QKV
#define FP8_QKV 1
#endif
#define LAS __attribute__((address_space(3)))
#define GAS __attribute__((address_space(1)))
typedef unsigned short bf16;
typedef short bf16x8 __attribute__((ext_vector_type(8)));
typedef float f32x4 __attribute__((ext_vector_type(4)));
typedef float f32x2 __attribute__((ext_vector_type(2)));
typedef float f32x16 __attribute__((ext_vector_type(16)));
typedef unsigned u32x4 __attribute__((ext_vector_type(4)));
typedef unsigned u32x2 __attribute__((ext_vector_type(2)));
typedef short s16x4 __attribute__((ext_vector_type(4)));
typedef __bf16 bf16x2_t __attribute__((ext_vector_type(2)));
typedef int i32x4 __attribute__((ext_vector_type(4)));
typedef int i32x8 __attribute__((ext_vector_type(8)));

constexpr int BATCH = 16, SEQ = 2048, D = 1024, T = BATCH * SEQ;
constexpr int NG = 3, HPG = 8, HD = 64, AW = 512, QKVW = NG * 3 * AW;
constexpr int NE = 16, DE = 512, SLOTS = 2 * T;
constexpr int MAXTILES = SLOTS / 256 + NE;
constexpr float RMS_EPS = 1e-6f;
constexpr int NWAVES = 8, NTHREADS = 512;

constexpr size_t MiB = 1u << 20;
constexpr size_t WS_CTL = 0, CTL_ZERO_BYTES = 64 * 1024;
constexpr size_t WS_CS = 1 * MiB;
constexpr size_t WS_LSE = 3 * MiB;
constexpr size_t WS_SLOTREF = 6 * MiB;
constexpr size_t WS_WGS = 7 * MiB;
constexpr size_t WS_LIST = 8 * MiB;
constexpr size_t WS_GATEL = 12 * MiB;
constexpr size_t WS_WIN = 16 * MiB;
constexpr size_t WS_WOUT = 25 * MiB;
constexpr size_t WS_WPIN = 26 * MiB;
constexpr size_t WS_WC = 28 * MiB;
constexpr size_t WS_WPO = 30 * MiB;
constexpr size_t WS_W13 = 32 * MiB;
constexpr size_t WS_W2 = 96 * MiB;
constexpr size_t WS_Y = 128 * MiB;
constexpr size_t WS_BIG = 192 * MiB;
constexpr size_t WS_OM = WS_BIG;
constexpr size_t WS_HMID = WS_BIG;
constexpr size_t WS_YS = WS_BIG + 72 * MiB;
constexpr size_t WS_U = WS_BIG;
constexpr size_t WS_POOLED = WS_BIG + 64 * MiB;
constexpr size_t WS_H = WS_BIG + 208 * MiB;
constexpr size_t WS_END = WS_BIG + 288 * MiB;
constexpr int CW_CNT = 0;
constexpr int CW_BAR = 1024;
#ifndef CG_SEAM
#define CG_SEAM (-1)
#endif

constexpr int RING_BYTES = 131072;
constexpr int AOFS_OFF = RING_BYTES;
constexpr int MISC_OFF = AOFS_OFF + 8192;
constexpr int LDS_BYTES = 147456;

__device__ __forceinline__ unsigned cvtpk(float lo, float hi) { f32x2 v = {lo, hi}; bf16x2_t b = __builtin_convertvector(v, bf16x2_t); return __builtin_bit_cast(unsigned, b); }
__device__ __forceinline__ float clamp8(float v) { return __builtin_amdgcn_fmed3f(v, -448.0f, 448.0f); }
__device__ __forceinline__ unsigned pack_fp8x4(float a, float b, float c, float d) {
    int r = __builtin_amdgcn_cvt_pk_fp8_f32(clamp8(a), clamp8(b), 0, false); r = __builtin_amdgcn_cvt_pk_fp8_f32(clamp8(c), clamp8(d), r, true); return (unsigned)r; }
__device__ __forceinline__ float bf_lo(unsigned u) { return __uint_as_float(u << 16); }
__device__ __forceinline__ float bf_hi(unsigned u) { return __uint_as_float(u & 0xffff0000u); }
#define DPP_ADD(v, ctrl) ((v) + __builtin_bit_cast(float, __builtin_amdgcn_update_dpp(0, __builtin_bit_cast(int, (v)), (ctrl), 0xF, 0xF, true)))
__device__ __forceinline__ float wave_sum(float v) {
    v = DPP_ADD(v, 0xB1);
    v = DPP_ADD(v, 0x4E);
    v = DPP_ADD(v, 0x141);
    v = DPP_ADD(v, 0x140);
    const int vi = __builtin_bit_cast(int, v);
    const float r0 = __builtin_bit_cast(float, __builtin_amdgcn_readlane(vi, 0)), r1 = __builtin_bit_cast(float, __builtin_amdgcn_readlane(vi, 16));
    const float r2 = __builtin_bit_cast(float, __builtin_amdgcn_readlane(vi, 32)), r3 = __builtin_bit_cast(float, __builtin_amdgcn_readlane(vi, 48));
    return (r0 + r1) + (r2 + r3);
}

namespace pg8 {
constexpr int BM = 256, BK = 64, HALF = 128, HTB = HALF * BK * 2, STAGE_BYTES = 8 * HTB, NXCD = 8, WGM = 8;
__host__ __device__ __forceinline__ int lds_byte(int r, int c) { const int st = (r >> 4) * 2 + (c >> 5), rr = r & 15, cc = c & 31, ob = rr * 64 + cc * 2; return st * 1024 + (ob ^ (((ob >> 9) & 1) << 5)); }
__host__ __device__ __forceinline__ void stage_rc(int b, int& R, int& C) { const int st = b / 1024, sb = b % 1024, swz = sb ^ (((sb >> 9) & 1) << 5); R = (st >> 1) * 16 + swz / 64; C = (st & 1) * 32 + (swz % 64) / 2; }
__host__ __device__ __forceinline__ int perm32(int rho) { const int n = rho >> 4, i = rho & 15; return 8 * (i >> 2) + 4 * n + (i & 3); }

struct Unit { int pm, pn; };

struct StaticOrder {
    int nM, nN, nwg, G, c;
    __device__ void init(int nM_, int nN_, int G_, int c_) { nM = nM_; nN = nN_; nwg = nM * nN; G = G_; c = c_; }
    __device__ bool next(int i, Unit& u) const {
        const long L = (long)i * G + c; if (L >= nwg) return false;
        int wgid = (int)L; { const int q = nwg / NXCD, r = nwg % NXCD, xcd = wgid % NXCD, off = wgid / NXCD; wgid = (xcd < r ? xcd * (q + 1) : r * (q + 1) + (xcd - r) * q) + off; }
        const int nig = WGM * nN, gid = wgid / nig, fm = gid * WGM, gsz = (nM - fm) < WGM ? (nM - fm) : WGM;
        u.pm = fm + ((wgid % nig) % gsz); u.pn = (wgid % nig) / gsz; return true;
    }
};

template <class Prob, class Epi, class Sched, bool ALIGN_EPI>
__device__ __forceinline__ void gemm_phase(LAS unsigned char* lds, const Prob& P, const Sched& S, const Epi& E) {
    int tid_ = threadIdx.x; asm volatile("" : "+v"(tid_));
    const int tid = tid_, wid = __builtin_amdgcn_readfirstlane(tid >> 6), lane = tid & 63, wr = wid >> 2, wc = wid & 3, fr = lane & 15, fq = lane >> 4;
    constexpr bool F8 = Prob::F8;
    const int Kb = P.K * (F8 ? 1 : 2), nt = Kb / (BK * 2);
    int Rr[2], Cc[2]; unsigned voffB[2];
#pragma unroll
    for (int i = 0; i < 2; ++i) { int R, C; stage_rc(tid * 16 + i * 8192, R, C); Rr[i] = R; Cc[i] = C; const int Rb = Epi::PERM ? ((R & ~31) + perm32(R & 31)) : R; voffB[i] = (unsigned)(Rb * Kb + C * 2); }
    const unsigned kstep = (unsigned)(BK * 2);
    const unsigned hstep = (unsigned)(HALF * Kb);
    const unsigned ldsw = (unsigned)wid * 1024u;
    const int aoff = lds_byte(wr * 64 + fr, fq * 8), boff = lds_byte(wc * 32 + fr, fq * 8);
    const __amdgpu_buffer_rsrc_t rsA = __builtin_amdgcn_make_buffer_rsrc((void*)P.A, 0, 0xFFFFFFFF, 0x00020000);
    const __amdgpu_buffer_rsrc_t rsB = __builtin_amdgcn_make_buffer_rsrc((void*)P.Bt, 0, 0xFFFFFFFF, 0x00020000);
#define PG8_SA(b, h) (((b) * 2 + (h)) * HTB)
#define PG8_SB(b, h) ((4 + (b) * 2 + (h)) * HTB)
#define PG8_STAGE_B(bufoff, sB) do { _Pragma("unroll") for (int _i = 0; _i < 2; ++_i) \
        __builtin_amdgcn_raw_ptr_buffer_load_lds(rsB, (LAS void*)(lds + (bufoff) + ldsw + _i * 8192), 16, (int)voffB[_i], (int)(sB), 0, 0); } while (0)
#define PG8_STAGE_A(bufoff, kb, o) do { _Pragma("unroll") for (int _i = 0; _i < 2; ++_i) \
        __builtin_amdgcn_raw_ptr_buffer_load_lds(rsA, (LAS void*)(lds + (bufoff) + ldsw + _i * 8192), 16, (int)(o)[_i], (int)(kb), 0, 0); } while (0)
#define PG8_LD2(p_) PG8_CAT(*(const LAS i32x4*)(p_), *(const LAS i32x4*)((p_) + 1024))
#define PG8_LDA(dst, b, h) do { if constexpr (F8) { _Pragma("unroll") for (int m = 0; m < 4; ++m) dst##8[m] = PG8_LD2(lds + PG8_SA(b, h) + aoff + m * 2048); } \
        else { _Pragma("unroll") for (int m = 0; m < 4; ++m) _Pragma("unroll") for (int k = 0; k < 2; ++k) dst[m][k] = *(const LAS bf16x8*)(lds + PG8_SA(b, h) + aoff + m * 2048 + k * 1024); } } while (0)
#define PG8_LDB(dst, b, h) do { if constexpr (F8) { _Pragma("unroll") for (int n = 0; n < 2; ++n) dst##8[n] = PG8_LD2(lds + PG8_SB(b, h) + boff + n * 2048); } \
        else { _Pragma("unroll") for (int n = 0; n < 2; ++n) _Pragma("unroll") for (int k = 0; k < 2; ++k) dst[n][k] = *(const LAS bf16x8*)(lds + PG8_SB(b, h) + boff + n * 2048 + k * 1024); } } while (0)
#define PG8_CAT(x0, x1) __builtin_shufflevector((x0), (x1), 0, 1, 2, 3, 4, 5, 6, 7)
#define PG8_MMA(ai, bj, At, Bt) do { __builtin_amdgcn_s_setprio(1); \
        if constexpr (F8) { _Pragma("unroll") for (int m = 0; m < 4; ++m) _Pragma("unroll") for (int n = 0; n < 2; ++n) \
            acc[ai][bj][m][n] = __builtin_amdgcn_mfma_scale_f32_16x16x128_f8f6f4(Bt##8[n], At##8[m], acc[ai][bj][m][n], 0, 0, 0, 0, 0, 0); } \
        else { _Pragma("unroll") for (int m = 0; m < 4; ++m) _Pragma("unroll") for (int n = 0; n < 2; ++n) _Pragma("unroll") for (int k = 0; k < 2; ++k) \
            acc[ai][bj][m][n] = __builtin_amdgcn_mfma_f32_16x16x32_bf16(Bt[n][k], At[m][k], acc[ai][bj][m][n], 0, 0, 0); } \
        __builtin_amdgcn_s_setprio(0); } while (0)
#define PG8_WAIT_V(n) asm volatile("s_waitcnt vmcnt(" #n ")" ::: "memory")
#define PG8_WAIT_L(n) asm volatile("s_waitcnt lgkmcnt(" #n ")" ::: "memory")
#define PG8_BAR __builtin_amdgcn_s_barrier()
#define PG8_SCHED __builtin_amdgcn_sched_barrier(0)
    Unit cur, nxt; int ui = 0;
    if (!S.next(0, cur)) return;
    f32x4 acc[2][2][4][2];
#pragma unroll
    for (int a = 0; a < 2; ++a)
#pragma unroll
        for (int b = 0; b < 2; ++b)
#pragma unroll
            for (int m = 0; m < 4; ++m)
#pragma unroll
                for (int n = 0; n < 2; ++n) acc[a][b][m][n] = (f32x4){0.f, 0.f, 0.f, 0.f};
    bf16x8 At[4][2], B0[2][2], B1[2][2]; i32x8 At8[4], B08[2], B18[2];
    unsigned ca0[2], ca1[2];
    P.a_offs(0, cur, Rr, Cc, ca0, ca1);
    unsigned cB = P.b_off(cur);
    PG8_STAGE_B(PG8_SB(0, 0), cB); PG8_STAGE_B(PG8_SB(0, 1), cB + hstep); PG8_STAGE_A(PG8_SA(0, 0), 0, ca0); PG8_STAGE_A(PG8_SA(0, 1), 0, ca1);
    if (wr == 1) PG8_BAR;
    PG8_WAIT_V(2); PG8_BAR;
    PG8_STAGE_B(PG8_SB(1, 0), cB + kstep); PG8_STAGE_A(PG8_SA(1, 0), kstep, ca0); PG8_STAGE_B(PG8_SB(1, 1), cB + hstep + kstep);
    PG8_WAIT_V(6); PG8_BAR;
    for (;;) {
        const bool has_next = S.next(ui + 1, nxt);
        unsigned nB = cB;
        if (has_next) nB = P.b_off(nxt);
#pragma unroll 1
        for (int t = 0; t < nt; t += 2) {
            const bool last = (t == nt - 2);
            const unsigned k1 = (unsigned)(t + 1) * kstep;
            const unsigned k2 = last ? 0u : (unsigned)(t + 2) * kstep, k3 = k2 + kstep;
            const unsigned b2 = last ? nB : cB + (unsigned)(t + 2) * kstep; const unsigned b3 = b2 + kstep;
            PG8_LDB(B0, 0, 0); PG8_LDB(B1, 0, 1); PG8_SCHED; PG8_LDA(At, 0, 0); PG8_STAGE_A(PG8_SA(1, 1), k1, ca1);
            if (last && has_next) {
                int tq = threadIdx.x; asm volatile("" : "+v"(tq)); int R2[2], C2[2];
#pragma unroll
                for (int i = 0; i < 2; ++i) stage_rc(tq * 16 + i * 8192, R2[i], C2[i]);
                P.a_offs(ui + 1, nxt, R2, C2, ca0, ca1);
            }
            PG8_WAIT_V(8); PG8_WAIT_L(0); PG8_BAR; PG8_MMA(0, 0, At, B0); PG8_MMA(0, 1, At, B1); PG8_BAR; PG8_SCHED;
            PG8_LDA(At, 0, 1); PG8_STAGE_B(PG8_SB(0, 0), b2); PG8_STAGE_B(PG8_SB(0, 1), b2 + hstep); PG8_STAGE_A(PG8_SA(0, 0), k2, ca0);
            PG8_WAIT_V(8); PG8_WAIT_L(0); PG8_BAR; PG8_MMA(1, 0, At, B0); PG8_MMA(1, 1, At, B1); PG8_BAR; PG8_SCHED;
            PG8_LDB(B0, 1, 0); PG8_LDB(B1, 1, 1); PG8_SCHED; PG8_LDA(At, 1, 0); PG8_STAGE_A(PG8_SA(0, 1), k2, ca1);
            PG8_WAIT_V(8); PG8_WAIT_L(0); PG8_BAR; PG8_MMA(0, 0, At, B0); PG8_MMA(0, 1, At, B1); PG8_BAR; PG8_SCHED;
            PG8_LDA(At, 1, 1); PG8_STAGE_B(PG8_SB(1, 0), b3); PG8_STAGE_B(PG8_SB(1, 1), b3 + hstep); PG8_STAGE_A(PG8_SA(1, 0), k3, ca0);
            PG8_WAIT_V(8); PG8_WAIT_L(0); PG8_BAR; PG8_MMA(1, 0, At, B0); PG8_MMA(1, 1, At, B1); PG8_BAR; PG8_SCHED;
        }
        if constexpr (ALIGN_EPI) { if (wr == 0) PG8_BAR; }
        { int te = threadIdx.x; asm volatile("" : "+v"(te));
          E(acc, cur, wr, wc, te & 15, (te >> 4) & 3); }
        if (!has_next) break;
#pragma unroll
        for (int a = 0; a < 2; ++a)
#pragma unroll
            for (int b = 0; b < 2; ++b)
#pragma unroll
                for (int m = 0; m < 4; ++m)
#pragma unroll
                    for (int n = 0; n < 2; ++n) acc[a][b][m][n] = (f32x4){0.f, 0.f, 0.f, 0.f};
        cur = nxt; cB = nB; ++ui;
        if constexpr (ALIGN_EPI) { if (wr == 1) PG8_BAR; }
    }
    PG8_WAIT_V(0);
    if constexpr (!ALIGN_EPI) { if (wr == 0) PG8_BAR; }
    PG8_BAR;
#undef PG8_SA
#undef PG8_SB
#undef PG8_STAGE_A
#undef PG8_STAGE_B
#undef PG8_LDA
#undef PG8_LD2
#undef PG8_LDB
#undef PG8_MMA
#undef PG8_CAT
#undef PG8_WAIT_V
#undef PG8_WAIT_L
#undef PG8_BAR
#undef PG8_SCHED
}

template <bool F8_>
struct DenseProbT {
    static constexpr bool F8 = F8_;
    const void* A; const void* Bt; int K, lda, acolstep; size_t bstep_pn;
    __device__ __forceinline__ void a_offs(int, const Unit& u, const int (&R)[2], const int (&C)[2], unsigned (&o0)[2], unsigned (&o1)[2]) const {
        constexpr int esz = F8 ? 1 : 2;
#pragma unroll
        for (int i = 0; i < 2; ++i) { const unsigned b = (unsigned)(((u.pm * BM + R[i]) * lda + u.pn * acolstep) * esz + C[i] * 2); o0[i] = b; o1[i] = b + (unsigned)(HALF * lda * esz); }
    }
    __device__ __forceinline__ unsigned b_off(const Unit& u) const { return (unsigned)((size_t)u.pn * bstep_pn * (F8 ? 1 : 2)); }
};
typedef DenseProbT<false> DenseProb;
}

struct Params {
    const float* x; const int* positions; const float* norm_mix; const float* norm_ffn; const float* norm_final;
    const float* attn_w_in; const float* attn_w_out; const float* pool_w_in; const float* pool_w_group; const float* pool_scale; const float* pool_w_out;
    const float* router_group_w; const float* router_group_b; const float* router_expert_w; const float* router_expert_b;
    const float* expert_w1; const float* expert_w3; const float* expert_w2;
    float* out; unsigned char* ws;
    int ph_lo, ph_hi;
};

template <class MapN>
__device__ __forceinline__ void transpose_item(const float* W, int ldw, int K, bf16* WT, MapN mapn, LAS float* scr, int k0, int n0, int lane) {
#pragma unroll 8
    for (int i = 0; i < 32; ++i) { const int kk = 2 * i + (lane >> 5); scr[kk * 33 + (lane & 31)] = W[(size_t)(k0 + kk) * ldw + n0 + (lane & 31)]; }
    asm volatile("s_waitcnt lgkmcnt(0)" ::: "memory");
    const int c = lane & 7;
#pragma unroll
    for (int j = 0; j < 4; ++j) { const int n = (lane >> 3) + 8 * j; const LAS float* s = scr + (8 * c) * 33 + n;
        u32x4 o; o.x = cvtpk(s[0 * 33], s[1 * 33]); o.y = cvtpk(s[2 * 33], s[3 * 33]); o.z = cvtpk(s[4 * 33], s[5 * 33]); o.w = cvtpk(s[6 * 33], s[7 * 33]);
        *(u32x4*)(WT + (size_t)mapn(n0 + n) * K + k0 + 8 * c) = o; }
    asm volatile("s_waitcnt lgkmcnt(0)" ::: "memory");
}
template <class MapN>
__device__ __forceinline__ void transpose_item8(const float* W, int ldw, int K, unsigned char* WT, MapN mapn, float sc, LAS float* scr, int k0, int n0, int lane) {
#pragma unroll 8
    for (int i = 0; i < 32; ++i) { const int kk = 2 * i + (lane >> 5); scr[kk * 33 + (lane & 31)] = W[(size_t)(k0 + kk) * ldw + n0 + (lane & 31)]; }
    asm volatile("s_waitcnt lgkmcnt(0)" ::: "memory");
    const int c = lane & 7;
#pragma unroll
    for (int j = 0; j < 4; ++j) { const int n = (lane >> 3) + 8 * j; const LAS float* s = scr + (8 * c) * 33 + n;
        u32x2 o; o.x = pack_fp8x4(s[0 * 33] * sc, s[1 * 33] * sc, s[2 * 33] * sc, s[3 * 33] * sc); o.y = pack_fp8x4(s[4 * 33] * sc, s[5 * 33] * sc, s[6 * 33] * sc, s[7 * 33] * sc);
        *(u32x2*)(WT + (size_t)mapn(n0 + n) * K + k0 + 8 * c) = o; }
    asm volatile("s_waitcnt lgkmcnt(0)" ::: "memory");
}
struct MapId { __device__ __forceinline__ int operator()(int n) const { return n; } };
struct MapQKV {
    __device__ __forceinline__ int operator()(int n) const { const int rem = n % 1536, kind = rem / 512, d = n & 63; if (kind < 2 && d < 16) return n - d + (d < 8 ? 2 * d : 2 * (d - 8) + 1); return n; }
};
struct MapW13 { int add; __device__ __forceinline__ int operator()(int n) const { return (n >> 7) * 256 + add + (n & 127); } };

struct RowPassCfg {
    const float* hin;
    const bf16* hin16;
    const bf16* ys; const int* slotref; const int* cnt_prev;
    bf16* hout;
    const float* gain;
    bf16* yout;
    unsigned char* yout8;
    float* fout;
    const float* rgw; const float* rgb; const float* rew; const float* reb;
    int* cnt; int* list; float* gatel; int* slotref_out;
};

__device__ __forceinline__ void route_decide(const float (&a)[20], const float* rgb, const float* reb, int& e0, int& e1, float& g0, float& g1) {
    float lg[4];
#pragma unroll
    for (int g = 0; g < 4; ++g) lg[g] = a[g] + rgb[g];
    int gs = 0; float gm = lg[0];
#pragma unroll
    for (int g = 1; g < 4; ++g) if (lg[g] > gm) { gm = lg[g]; gs = g; }
    float den = 0.f;
#pragma unroll
    for (int g = 0; g < 4; ++g) den += __expf(lg[g] - gm);
    const float gate1 = 1.0f / den;
    float le[4];
#pragma unroll
    for (int e = 0; e < 4; ++e) { const float sel = gs == 0 ? a[4 + e] : gs == 1 ? a[8 + e] : gs == 2 ? a[12 + e] : a[16 + e]; le[e] = sel + reb[gs * 4 + e]; }
    int i0 = 0; float v0 = le[0];
#pragma unroll
    for (int e = 1; e < 4; ++e) if (le[e] > v0) { v0 = le[e]; i0 = e; }
    int i1 = -1; float v1 = -INFINITY;
#pragma unroll
    for (int e = 0; e < 4; ++e) if (e != i0 && le[e] > v1) { v1 = le[e]; i1 = e; }
    const float ex = __expf(v1 - v0), p0 = 1.0f / (1.0f + ex), p1 = ex * p0;
    e0 = gs * 4 + i0; e1 = gs * 4 + i1; g0 = gate1 * p0; g1 = gate1 * p1;
}

template <bool COMBINE, bool ROUTER, bool HIN16>
__device__ __forceinline__ void row_pass(LAS unsigned char* lds, const RowPassCfg& c, int vcu, int wave) {
    int tid = threadIdx.x; asm volatile("" : "+v"(tid)); const int lane = tid & 63;
    LAS float* Wr = (LAS float*)lds;
    LAS int* selE = (LAS int*)(lds + 81920);
    LAS float* selG = (LAS float*)(lds + 81920 + 1024);
    LAS int* wcnt = (LAS int*)(lds + 81920 + 2048);
    LAS int* tb = (LAS int*)(lds + MISC_OFF);
    if (ROUTER) {
        for (int k = tid; k < 1024; k += NTHREADS) {
            const f32x4 g4 = *(const f32x4*)(c.rgw + (size_t)k * 4);
            Wr[0 * 1024 + k] = g4.x; Wr[1 * 1024 + k] = g4.y; Wr[2 * 1024 + k] = g4.z; Wr[3 * 1024 + k] = g4.w;
#pragma unroll
            for (int g = 0; g < 4; ++g) { const f32x4 e4 = *(const f32x4*)(c.rew + ((size_t)g * 1024 + k) * 4);
                Wr[(4 + g * 4 + 0) * 1024 + k] = e4.x; Wr[(4 + g * 4 + 1) * 1024 + k] = e4.y; Wr[(4 + g * 4 + 2) * 1024 + k] = e4.z; Wr[(4 + g * 4 + 3) * 1024 + k] = e4.w; }
        }
    }
    if (COMBINE) {
        if (tid == 0) { int sacc = 0; for (int e = 0; e < NE; ++e) { tb[e] = sacc; sacc += (c.cnt_prev[e] + 255) >> 8; } tb[NE] = sacc; }
    }
    __syncthreads();
    f32x4 gn[4];
#pragma unroll
    for (int j = 0; j < 4; ++j) gn[j] = *(const f32x4*)(c.gain + 4 * lane + 256 * j);
    for (int rb = vcu; rb < T / 128; rb += gridDim.x) {
        const int rbase = rb * 128 + wave * 16;
        int refs = 0;
        if (COMBINE) { if (lane < 32) refs = c.slotref[rbase * 2 + lane]; }
        f32x4 hv[2][2][4]; u32x2 hb[2][2][4]; u32x2 yv[2][2][2][4];
#define RP_ISSUE(buf, pr) do { _Pragma("unroll") for (int r = 0; r < 2; ++r) { const int row = rbase + 2 * (pr) + r; \
            if (HIN16) { _Pragma("unroll") for (int j = 0; j < 4; ++j) hb[buf][r][j] = *(const u32x2*)(c.hin16 + (size_t)row * D + 4 * lane + 256 * j); } \
            else { _Pragma("unroll") for (int j = 0; j < 4; ++j) hv[buf][r][j] = *(const f32x4*)(c.hin + (size_t)row * D + 4 * lane + 256 * j); } \
            if (COMBINE) { _Pragma("unroll") for (int sl = 0; sl < 2; ++sl) { const int ref = __builtin_amdgcn_readlane(refs, (2 * (pr) + r) * 2 + sl); const int e = ref >> 15, pos = ref & 32767; \
                const bf16* yr = c.ys + ((size_t)tb[e] * 256 + pos) * D; \
                _Pragma("unroll") for (int j = 0; j < 4; ++j) yv[buf][r][sl][j] = *(const u32x2*)(yr + 4 * lane + 256 * j); } } } } while (0)
#define RP_PROCESS(buf, pr) do { f32x4 v[2][4]; \
            _Pragma("unroll") for (int r = 0; r < 2; ++r) { const int row = rbase + 2 * (pr) + r; \
                _Pragma("unroll") for (int j = 0; j < 4; ++j) { if (HIN16) { const u32x2 w0 = hb[buf][r][j]; v[r][j] = (f32x4){bf_lo(w0.x), bf_hi(w0.x), bf_lo(w0.y), bf_hi(w0.y)}; } else v[r][j] = hv[buf][r][j]; \
                    if (COMBINE) { _Pragma("unroll") for (int sl = 0; sl < 2; ++sl) { const u32x2 w = yv[buf][r][sl][j]; v[r][j].x += bf_lo(w.x); v[r][j].y += bf_hi(w.x); v[r][j].z += bf_lo(w.y); v[r][j].w += bf_hi(w.y); } } } \
                if (c.hout) { _Pragma("unroll") for (int j = 0; j < 4; ++j) { u32x2 w; w.x = cvtpk(v[r][j].x, v[r][j].y); w.y = cvtpk(v[r][j].z, v[r][j].w); *(u32x2*)(c.hout + (size_t)row * D + 4 * lane + 256 * j) = w; \
                    v[r][j] = (f32x4){bf_lo(w.x), bf_hi(w.x), bf_lo(w.y), bf_hi(w.y)}; } } \
                float ss = 0.f; \
                _Pragma("unroll") for (int j = 0; j < 4; ++j) ss += (v[r][j].x * v[r][j].x + v[r][j].y * v[r][j].y) + (v[r][j].z * v[r][j].z + v[r][j].w * v[r][j].w); \
                const float rstd = 1.0f / sqrtf(wave_sum(ss) * (1.0f / D) + RMS_EPS); \
                _Pragma("unroll") for (int j = 0; j < 4; ++j) { v[r][j].x = v[r][j].x * rstd * gn[j].x; v[r][j].y = v[r][j].y * rstd * gn[j].y; v[r][j].z = v[r][j].z * rstd * gn[j].z; v[r][j].w = v[r][j].w * rstd * gn[j].w; } \
                if (c.yout) { _Pragma("unroll") for (int j = 0; j < 4; ++j) { u32x2 w; w.x = cvtpk(v[r][j].x, v[r][j].y); w.y = cvtpk(v[r][j].z, v[r][j].w); *(u32x2*)(c.yout + (size_t)row * D + 4 * lane + 256 * j) = w; } } \
                if (c.yout8) { _Pragma("unroll") for (int j = 0; j < 4; ++j) *(unsigned*)(c.yout8 + (size_t)row * D + 4 * lane + 256 * j) = pack_fp8x4(v[r][j].x, v[r][j].y, v[r][j].z, v[r][j].w); } \
                if (c.fout) { _Pragma("unroll") for (int j = 0; j < 4; ++j) *(f32x4*)(c.fout + (size_t)row * D + 4 * lane + 256 * j) = v[r][j]; } } \
            if (ROUTER) { LAS float* lg_ = (LAS float*)(lds + 81920 + 4096) + wave * 40; \
                _Pragma("unroll 2") for (int o = 0; o < 20; ++o) { float s0 = 0.f, s1 = 0.f; \
                    _Pragma("unroll") for (int j = 0; j < 4; ++j) { const f32x4 w = *(const LAS f32x4*)(Wr + o * 1024 + 4 * lane + 256 * j); \
                        s0 += (v[0][j].x * w.x + v[0][j].y * w.y) + (v[0][j].z * w.z + v[0][j].w * w.w); s1 += (v[1][j].x * w.x + v[1][j].y * w.y) + (v[1][j].z * w.z + v[1][j].w * w.w); } \
                    s0 = wave_sum(s0); s1 = wave_sum(s1); if (lane == 0) { lg_[o] = s0; lg_[20 + o] = s1; } } \
                float a0[20], a1[20]; \
                _Pragma("unroll") for (int o = 0; o < 20; ++o) { a0[o] = lg_[o]; a1[o] = lg_[20 + o]; } \
                int e0, e1; float g0, g1; const int rl = wave * 16 + 2 * (pr); \
                route_decide(a0, c.rgb, c.reb, e0, e1, g0, g1); if (lane == 0) { selE[rl * 2] = e0; selE[rl * 2 + 1] = e1; selG[rl * 2] = g0; selG[rl * 2 + 1] = g1; } \
                route_decide(a1, c.rgb, c.reb, e0, e1, g0, g1); if (lane == 0) { selE[rl * 2 + 2] = e0; selE[rl * 2 + 3] = e1; selG[rl * 2 + 2] = g0; selG[rl * 2 + 3] = g1; } } } while (0)
        RP_ISSUE(0, 0);
#pragma unroll 1
        for (int it = 0; it < 4; ++it) {
            RP_ISSUE(1, 2 * it + 1);
            RP_PROCESS(0, 2 * it);
            if (it < 3) RP_ISSUE(0, 2 * it + 2);
            RP_PROCESS(1, 2 * it + 1);
        }
#undef RP_ISSUE
#undef RP_PROCESS
        if (ROUTER) {
            __syncthreads();
            int e = 0, rank = 0;
            if (tid < 256) {
                e = selE[tid]; int mycount = 0;
#pragma unroll
                for (int x = 0; x < NE; ++x) { const unsigned long long mask = __ballot(e == x); if (e == x) rank = __popcll(mask & ((1ull << lane) - 1ull)); if (lane == x) mycount = __popcll(mask); }
                if (lane < NE) wcnt[(tid >> 6) * 16 + lane] = mycount;
            }
            __syncthreads();
            if (tid < NE) { const int c0 = wcnt[tid], c1 = wcnt[16 + tid], c2 = wcnt[32 + tid], c3 = wcnt[48 + tid]; const int tot = c0 + c1 + c2 + c3;
                int base = 0; if (tot) base = atomicAdd(c.cnt + tid, tot);
                wcnt[tid] = base; wcnt[16 + tid] = base + c0; wcnt[32 + tid] = base + c0 + c1; wcnt[48 + tid] = base + c0 + c1 + c2; }
            __syncthreads();
            if (tid < 256) { const int pos = wcnt[(tid >> 6) * 16 + e] + rank; const int tok = rb * 128 + (tid >> 1);
                c.list[e * T + pos] = tok; c.gatel[e * T + pos] = selG[tid]; c.slotref_out[tok * 2 + (tid & 1)] = e * 32768 + pos; }
            __syncthreads();
        }
    }
    __syncthreads();
}

namespace att {
constexpr float C2 = 0.125f * 1.4426950408889634f;
constexpr float LN2 = 0.6931471805599453f;
__device__ __forceinline__ int crow(int r, int hi) { return (r & 3) + 8 * (r >> 2) + 4 * hi; }
typedef short v4i16_t __attribute__((ext_vector_type(4)));
__device__ __forceinline__ s16x4 vtr(const LAS unsigned char* p) { return __builtin_bit_cast(s16x4, __builtin_amdgcn_ds_read_tr16_b64_v4i16((LAS v4i16_t*)p)); }

struct Item { int b, g, hh, dil, j, ph; };
__device__ __forceinline__ Item decode_item(int pp, int half) {
    Item it; it.hh = pp & 7; const int q8 = (pp >> 3) & 7; it.g = (pp >> 6) % 3; it.b = pp / 192;
    const int idx16 = q8 * 2 + half; it.dil = it.g == 0 ? 1 : (it.g == 1 ? 4 : 16); const int nb = 16 / it.dil; it.j = idx16 % nb; it.ph = idx16 / nb; return it;
}
__device__ __forceinline__ int kswz(int kv) { return (kv ^ (kv >> 3)) & 7; }

__device__ __forceinline__ void attn_phase(LAS unsigned char* lds, const bf16* qkv, bf16* og, float* lse, int vcu, int G) {
    int tid_ = threadIdx.x; asm volatile("" : "+v"(tid_));
    const int tid = tid_, lane = tid & 63, wid = __builtin_amdgcn_readfirstlane(tid >> 6);
    const int half = wid >> 2, w = wid & 3, r32 = lane & 31, hi = lane >> 5, th = tid & 255;
    LAS unsigned char* Kl = lds + half * 69632;
    LAS unsigned char* Vl = Kl + 36864;
    u32x4 kreg[4][2], vreg[4][2]; bf16x8 qn[4];
    int skv[2], sc[2];
#pragma unroll
    for (int i = 0; i < 2; ++i) { const int P_ = th + 256 * i; skv[i] = P_ >> 3; sc[i] = P_ & 7; }
    const __amdgpu_buffer_rsrc_t rsQ = __builtin_amdgcn_make_buffer_rsrc((void*)qkv, 0, 0xFFFFFFFF, 0x00020000);
    typedef unsigned u32x4v __attribute__((ext_vector_type(4)));
#define ATT_ISSUE(IT) do { const unsigned rstrideB_ = (unsigned)(IT).dil * (unsigned)(QKVW * 2); \
        const unsigned baseB_ = (unsigned)(((IT).b * SEQ + (IT).ph) * QKVW + (IT).g * 1536 + (IT).hh * 64) * 2u; const int l0_ = 128 * ((IT).j - 1); \
        const unsigned vo0_ = (unsigned)skv[0] * rstrideB_ + (unsigned)sc[0] * 16u, vo1_ = (unsigned)skv[1] * rstrideB_ + (unsigned)sc[1] * 16u; \
        _Pragma("unroll") for (int tt = 0; tt < 4; ++tt) { if (tt >= 2 || (IT).j != 0) { const unsigned so_ = baseB_ + (unsigned)(l0_ + 64 * tt) * rstrideB_; \
            kreg[tt][0] = __builtin_bit_cast(u32x4, __builtin_amdgcn_raw_buffer_load_b128(rsQ, (int)vo0_, (int)(so_ + 1024u), 0)); vreg[tt][0] = __builtin_bit_cast(u32x4, __builtin_amdgcn_raw_buffer_load_b128(rsQ, (int)vo0_, (int)(so_ + 2048u), 0)); \
            kreg[tt][1] = __builtin_bit_cast(u32x4, __builtin_amdgcn_raw_buffer_load_b128(rsQ, (int)vo1_, (int)(so_ + 1024u), 0)); vreg[tt][1] = __builtin_bit_cast(u32x4, __builtin_amdgcn_raw_buffer_load_b128(rsQ, (int)vo1_, (int)(so_ + 2048u), 0)); } } \
        const unsigned qo_ = (unsigned)(32 * w + r32) * rstrideB_ + (unsigned)hi * 16u, qs_ = baseB_ + (unsigned)(128 * (IT).j) * rstrideB_; \
        _Pragma("unroll") for (int d0 = 0; d0 < 4; ++d0) qn[d0] = __builtin_bit_cast(bf16x8, __builtin_amdgcn_raw_buffer_load_b128(rsQ, (int)qo_, (int)(qs_ + (unsigned)d0 * 32u), 0)); } while (0)
    int pp = vcu;
    Item cur = decode_item(pp < 3072 ? pp : 0, half);
    if (pp < 3072) ATT_ISSUE(cur);
    const int koff = r32 * 144 + hi * 16;
    const int voff = ((lane >> 4) & 1) * 32 + (lane & 3) * 8 + (4 * hi + ((lane & 15) >> 2)) * 64;
    for (; pp < 3072; pp += G) {
        const int tt_lo = (cur.j == 0) ? 2 : 0;
#pragma unroll
        for (int tt = 0; tt < 4; ++tt) { if (tt >= 2 || cur.j != 0) {
#pragma unroll
            for (int i = 0; i < 2; ++i) {
                *(LAS u32x4*)(Kl + tt * 9216 + skv[i] * 144 + sc[i] * 16) = kreg[tt][i];
                *(LAS u32x4*)(Vl + tt * 8192 + (sc[i] >> 2) * 4096 + skv[i] * 64 + (sc[i] & 3) * 16) = vreg[tt][i]; } } }
        bf16x8 qr[4];
#pragma unroll
        for (int d0 = 0; d0 < 4; ++d0) qr[d0] = qn[d0];
        __syncthreads();
        const Item me = cur;
        if (pp + G < 3072) { cur = decode_item(pp + G, half); ATT_ISSUE(cur); }
        float m = -1e30f, l = 0.f; f32x16 oT[2]; oT[0] = f32x16{}; oT[1] = f32x16{};
        const int t_lo = (w >= 2) ? (tt_lo > 1 ? tt_lo : 1) : tt_lo, t_hi = (w < 2) ? 2 : 3, t_mid = (w < 2) ? 1 : 2;
        for (int tt = t_lo; tt <= t_hi; ++tt) {
            const LAS unsigned char* kb = Kl + tt * 9216 + koff;
            f32x16 p0 = f32x16{}, p1 = f32x16{};
#pragma unroll
            for (int d0 = 0; d0 < 4; ++d0) {
                const bf16x8 k0 = *(const LAS bf16x8*)(kb + d0 * 32), k1 = *(const LAS bf16x8*)(kb + d0 * 32 + 32 * 144);
                p0 = __builtin_amdgcn_mfma_f32_32x32x16_bf16(k0, qr[d0], p0, 0, 0, 0);
                p1 = __builtin_amdgcn_mfma_f32_32x32x16_bf16(k1, qr[d0], p1, 0, 0, 0);
            }
            float mx = -INFINITY;
            if (tt != t_mid) {
                const int dbase = 128 + 32 * w + r32 - 64 * tt;
#pragma unroll
                for (int r = 0; r < 16; ++r) {
                    const int d0_ = dbase - crow(r, hi), d1_ = d0_ - 32;
                    p0[r] = (d0_ >= 0 && d0_ <= 128) ? p0[r] * C2 : -INFINITY;
                    p1[r] = (d1_ >= 0 && d1_ <= 128) ? p1[r] * C2 : -INFINITY;
                    mx = fmaxf(mx, fmaxf(p0[r], p1[r]));
                }
            } else {
#pragma unroll
                for (int r = 0; r < 16; ++r) { p0[r] *= C2; p1[r] *= C2; mx = fmaxf(mx, fmaxf(p0[r], p1[r])); }
            }
            { const auto rr = __builtin_amdgcn_permlane32_swap(__float_as_uint(mx), __float_as_uint(mx), false, false); mx = fmaxf(__uint_as_float(rr[0]), __uint_as_float(rr[1])); }
            const float mn = fmaxf(m, mx), alpha = __builtin_amdgcn_exp2f(m - mn);
            float rs = 0.f;
#pragma unroll
            for (int r = 0; r < 16; ++r) { p0[r] = __builtin_amdgcn_exp2f(p0[r] - mn); p1[r] = __builtin_amdgcn_exp2f(p1[r] - mn); rs += p0[r] + p1[r]; }
            l = l * alpha + rs; m = mn;
#pragma unroll
            for (int r = 0; r < 16; ++r) { oT[0][r] *= alpha; oT[1][r] *= alpha; }
            u32x4 pw[4];
            pw[0] = (u32x4){cvtpk(p0[0], p0[1]), cvtpk(p0[2], p0[3]), cvtpk(p0[4], p0[5]), cvtpk(p0[6], p0[7])};
            pw[1] = (u32x4){cvtpk(p0[8], p0[9]), cvtpk(p0[10], p0[11]), cvtpk(p0[12], p0[13]), cvtpk(p0[14], p0[15])};
            pw[2] = (u32x4){cvtpk(p1[0], p1[1]), cvtpk(p1[2], p1[3]), cvtpk(p1[4], p1[5]), cvtpk(p1[6], p1[7])};
            pw[3] = (u32x4){cvtpk(p1[8], p1[9]), cvtpk(p1[10], p1[11]), cvtpk(p1[12], p1[13]), cvtpk(p1[14], p1[15])};
            const LAS unsigned char* vp = Vl + tt * 8192 + voff;
#pragma unroll
            for (int d0 = 0; d0 < 2; ++d0)
#pragma unroll
                for (int ks = 0; ks < 4; ++ks) {
                    const s16x4 lo = vtr(vp + d0 * 4096 + ks * 1024), hh4 = vtr(vp + d0 * 4096 + ks * 1024 + 512);
                    const bf16x8 vf = (bf16x8){lo[0], lo[1], lo[2], lo[3], hh4[0], hh4[1], hh4[2], hh4[3]};
                    oT[d0] = __builtin_amdgcn_mfma_f32_32x32x16_bf16(vf, __builtin_bit_cast(bf16x8, pw[ks]), oT[d0], 0, 0, 0);
                }
        }
        float lt; { const auto rr = __builtin_amdgcn_permlane32_swap(__float_as_uint(l), __float_as_uint(l), false, false); lt = __uint_as_float(rr[0]) + __uint_as_float(rr[1]); }
        const float inv = 1.0f / lt;
        const int lq = 128 * me.j + 32 * w + r32;
        const size_t tok = (size_t)me.b * SEQ + (size_t)lq * me.dil + me.ph;
        bf16* orow = og + tok * (NG * AW) + me.g * AW + me.hh * 64;
#pragma unroll
        for (int d0 = 0; d0 < 2; ++d0)
#pragma unroll
            for (int rg = 0; rg < 4; ++rg) {
                u32x2 wv; wv.x = cvtpk(oT[d0][4 * rg] * inv, oT[d0][4 * rg + 1] * inv); wv.y = cvtpk(oT[d0][4 * rg + 2] * inv, oT[d0][4 * rg + 3] * inv);
                *(u32x2*)(orow + 32 * d0 + 8 * rg + 4 * hi) = wv;
            }
        if (hi == 0) lse[tok * 24 + me.g * 8 + me.hh] = (m + __builtin_amdgcn_logf(lt)) * LN2;
        __syncthreads();
    }
#undef ATT_ISSUE
}
}

using pg8::Unit; using pg8::BM; using pg8::HALF;
struct EpiQKV {
    static constexpr bool PERM = true;
    bf16* O; const float* cs; float sc;
    __device__ __forceinline__ void operator()(const f32x4 (&acc)[2][2][4][2], const Unit& u, int wr, int wc, int fr, int fq) const {
        const int colt = u.pn * BM; const int kind = (colt % 1536) / 512;
        const bool rot = (kind < 2) && ((wc & 1) == 0) && (fq < 2);
#pragma unroll
        for (int ai = 0; ai < 2; ++ai)
#pragma unroll
            for (int m = 0; m < 4; ++m) {
                const int row = u.pm * BM + ai * HALF + wr * 64 + m * 16 + fr;
                f32x4 c0 = {1.f, 0.f, 1.f, 0.f}, c1 = {1.f, 0.f, 1.f, 0.f};
                if (rot) { c0 = *(const f32x4*)(cs + (size_t)row * 16 + fq * 8); c1 = *(const f32x4*)(cs + (size_t)row * 16 + fq * 8 + 4); }
                bf16* rowp = O + (size_t)row * QKVW + colt + wc * 32 + 8 * fq;
#pragma unroll
                for (int bj = 0; bj < 2; ++bj) {
                    f32x4 v0 = acc[ai][bj][m][0] * sc, v1 = acc[ai][bj][m][1] * sc;
                    f32x4 o0, o1;
                    o0.x = v0.x * c0.x - v0.y * c0.y; o0.y = v0.y * c0.x + v0.x * c0.y; o0.z = v0.z * c0.z - v0.w * c0.w; o0.w = v0.w * c0.z + v0.z * c0.w;
                    o1.x = v1.x * c1.x - v1.y * c1.y; o1.y = v1.y * c1.x + v1.x * c1.y; o1.z = v1.z * c1.z - v1.w * c1.w; o1.w = v1.w * c1.z + v1.z * c1.w;
                    u32x4 w; w.x = cvtpk(o0.x, o0.y); w.y = cvtpk(o0.z, o0.w); w.z = cvtpk(o1.x, o1.y); w.w = cvtpk(o1.z, o1.w);
                    *(u32x4*)(rowp + bj * HALF) = w;
                }
                if (m & 1) asm volatile("" ::: "memory");
            }
    }
};
struct EpiBf16 {
    static constexpr bool PERM = true;
    bf16* O; int ldc;
    __device__ __forceinline__ void operator()(const f32x4 (&acc)[2][2][4][2], const Unit& u, int wr, int wc, int fr, int fq) const {
#pragma unroll
        for (int ai = 0; ai < 2; ++ai)
#pragma unroll
            for (int m = 0; m < 4; ++m) {
                bf16* rowp = O + (size_t)(u.pm * BM + ai * HALF + wr * 64 + m * 16 + fr) * ldc + u.pn * BM + wc * 32 + 8 * fq;
#pragma unroll
                for (int bj = 0; bj < 2; ++bj) { const f32x4 v0 = acc[ai][bj][m][0], v1 = acc[ai][bj][m][1];
                    u32x4 w; w.x = cvtpk(v0.x, v0.y); w.y = cvtpk(v0.z, v0.w); w.z = cvtpk(v1.x, v1.y); w.w = cvtpk(v1.z, v1.w);
                    *(u32x4*)(rowp + bj * HALF) = w; }
            }
    }
};
template <bool RES32>
struct EpiResBf16 {
    static constexpr bool PERM = true;
    const void* res; bf16* out;
    __device__ __forceinline__ void operator()(const f32x4 (&acc)[2][2][4][2], const Unit& u, int wr, int wc, int fr, int fq) const {
#pragma unroll
        for (int ai = 0; ai < 2; ++ai)
#pragma unroll
            for (int m = 0; m < 4; ++m) {
                const size_t off = (size_t)(u.pm * BM + ai * HALF + wr * 64 + m * 16 + fr) * D + u.pn * BM + wc * 32 + 8 * fq;
#pragma unroll
                for (int bj = 0; bj < 2; ++bj) {
                    f32x4 r0, r1;
                    if constexpr (RES32) { r0 = *(const f32x4*)((const float*)res + off + bj * HALF); r1 = *(const f32x4*)((const float*)res + off + bj * HALF + 4); }
                    else { const u32x4 rw = *(const u32x4*)((const bf16*)res + off + bj * HALF); r0 = (f32x4){bf_lo(rw.x), bf_hi(rw.x), bf_lo(rw.y), bf_hi(rw.y)}; r1 = (f32x4){bf_lo(rw.z), bf_hi(rw.z), bf_lo(rw.w), bf_hi(rw.w)}; }
                    const f32x4 v0 = r0 + acc[ai][bj][m][0], v1 = r1 + acc[ai][bj][m][1];
                    u32x4 w; w.x = cvtpk(v0.x, v0.y); w.y = cvtpk(v0.z, v0.w); w.z = cvtpk(v1.x, v1.y); w.w = cvtpk(v1.z, v1.w);
                    *(u32x4*)(out + off + bj * HALF) = w;
                }
                if (m & 1) asm volatile("" ::: "memory");
            }
    }
};
template <bool OUT8>
struct EpiSwiGLU {
    static constexpr bool PERM = true;
    void* O; float sc;
    __device__ __forceinline__ void operator()(const f32x4 (&acc)[2][2][4][2], const Unit& u, int wr, int wc, int fr, int fq) const {
#pragma unroll
        for (int ai = 0; ai < 2; ++ai)
#pragma unroll
            for (int m = 0; m < 4; ++m) {
                const size_t eoff = (size_t)(u.pm * BM + ai * HALF + wr * 64 + m * 16 + fr) * DE + u.pn * HALF + wc * 32 + 8 * fq;
                float h[8];
#pragma unroll
                for (int n = 0; n < 2; ++n)
#pragma unroll
                    for (int e = 0; e < 4; ++e) { const float a = acc[ai][0][m][n][e] * sc, b = acc[ai][1][m][n][e] * sc;
                        h[n * 4 + e] = a * __builtin_amdgcn_rcpf(1.0f + __builtin_amdgcn_exp2f(-1.4426950408889634f * a)) * b; }
                if constexpr (OUT8) { u32x2 w; w.x = pack_fp8x4(h[0] * 16.f, h[1] * 16.f, h[2] * 16.f, h[3] * 16.f); w.y = pack_fp8x4(h[4] * 16.f, h[5] * 16.f, h[6] * 16.f, h[7] * 16.f); *(u32x2*)((unsigned char*)O + eoff) = w; }
                else { u32x4 w; w.x = cvtpk(h[0], h[1]); w.y = cvtpk(h[2], h[3]); w.z = cvtpk(h[4], h[5]); w.w = cvtpk(h[6], h[7]); *(u32x4*)((bf16*)O + eoff) = w; }
            }
    }
};
struct EpiGate {
    static constexpr bool PERM = true;
    bf16* O; const float* gatel; const int* cnt; const LAS int* tb; float sc;
    __device__ __forceinline__ void operator()(const f32x4 (&acc)[2][2][4][2], const Unit& u, int wr, int wc, int fr, int fq) const {
        int e = 0;
#pragma unroll
        for (int k = 1; k < NE; ++k) e += (u.pm >= tb[k]) ? 1 : 0;
        const int lbase = (u.pm - tb[e]) * BM, n_e = cnt[e];
#pragma unroll
        for (int ai = 0; ai < 2; ++ai)
#pragma unroll
            for (int m = 0; m < 4; ++m) {
                const int rl = ai * HALF + wr * 64 + m * 16 + fr, li = lbase + rl;
                const float gt = (li < n_e) ? gatel[(size_t)e * T + li] * sc : 0.f;
                bf16* rowp = O + (size_t)(u.pm * BM + rl) * D + u.pn * BM + wc * 32 + 8 * fq;
#pragma unroll
                for (int bj = 0; bj < 2; ++bj) { const f32x4 v0 = acc[ai][bj][m][0] * gt, v1 = acc[ai][bj][m][1] * gt;
                    u32x4 w; w.x = cvtpk(v0.x, v0.y); w.y = cvtpk(v0.z, v0.w); w.z = cvtpk(v1.x, v1.y); w.w = cvtpk(v1.z, v1.w);
                    *(u32x4*)(rowp + bj * HALF) = w; }
            }
    }
};

template <bool F8_>
struct MoeProb1T {
    static constexpr bool F8 = F8_;
    const void* A; const void* Bt; int K; const LAS int* tb; const LAS unsigned* aofs;
    __device__ __forceinline__ void a_offs(int i, const Unit&, const int (&R)[2], const int (&C)[2], unsigned (&o0)[2], unsigned (&o1)[2]) const {
#pragma unroll
        for (int k = 0; k < 2; ++k) { o0[k] = aofs[i * 256 + R[k]] + (unsigned)C[k] * 2u; o1[k] = aofs[i * 256 + 128 + R[k]] + (unsigned)C[k] * 2u; }
    }
    __device__ __forceinline__ unsigned b_off(const Unit& u) const {
        int e = 0;
#pragma unroll
        for (int k = 1; k < NE; ++k) e += (u.pm >= tb[k]) ? 1 : 0;
        return (unsigned)((e * 1024 + u.pn * 256) * 1024 * (F8 ? 1 : 2));
    }
};
template <bool F8_>
struct MoeProb2T {
    static constexpr bool F8 = F8_;
    const void* A; const void* Bt; int K; const LAS int* tb;
    __device__ __forceinline__ void a_offs(int, const Unit& u, const int (&R)[2], const int (&C)[2], unsigned (&o0)[2], unsigned (&o1)[2]) const {
        constexpr int esz = F8 ? 1 : 2;
#pragma unroll
        for (int k = 0; k < 2; ++k) { const unsigned b = (unsigned)((u.pm * BM + R[k]) * DE * esz + C[k] * 2); o0[k] = b; o1[k] = b + (unsigned)(HALF * DE * esz); }
    }
    __device__ __forceinline__ unsigned b_off(const Unit& u) const {
        int e = 0;
#pragma unroll
        for (int k = 1; k < NE; ++k) e += (u.pm >= tb[k]) ? 1 : 0;
        return (unsigned)((e * 1024 + u.pn * 256) * DE * (F8 ? 1 : 2));
    }
};
struct FoldOrder { int G, c; __device__ bool next(int i, Unit& u) const { const int L = i * G + c; if (L >= 16) return false; u.pm = L >> 2; u.pn = L & 3; return true; } };


#define XB_TMO      128
#define XB_XCNT(j)  (256  + 64 * (j))
#define XB_XSUB(j)  (1280 + 64 * (j))
#define XB_XGEN(j)  (2304 + 64 * (j))
#define XB_TOP      3328
#define XB_TOPGEN   3392
#define XCD_BAR_WORDS 3456
#define XB_SPIN_CAP (1u << 18)
__device__ __forceinline__ unsigned xb_ld(unsigned* p)              { return __hip_atomic_load(p, __ATOMIC_RELAXED, __HIP_MEMORY_SCOPE_AGENT); }
__device__ __forceinline__ unsigned xb_add(unsigned* p, unsigned v) { return __hip_atomic_fetch_add(p, v, __ATOMIC_RELAXED, __HIP_MEMORY_SCOPE_AGENT); }
__device__ __forceinline__ unsigned xb_xcc_id() { return (unsigned)__builtin_amdgcn_s_getreg((3 << 11) | 20) & 0xFu; }
#define XB_SPIN(cond, bar) do { unsigned _sp = 0; while (cond) { __builtin_amdgcn_s_sleep(1); \
    if ((++_sp & 255u) == 0u) { if (xb_ld(&(bar)[XB_TMO])) break; if (_sp > XB_SPIN_CAP) { atomicAdd(&(bar)[XB_TMO], 1u); break; } } } } while (0)
struct XcdBarrier { unsigned* bar; unsigned x; volatile LAS unsigned* st; };
__device__ __forceinline__ XcdBarrier xcd_barrier_post(unsigned* bar, volatile LAS unsigned* st) {
    XcdBarrier b; b.bar = bar; b.x = xb_xcc_id(); b.st = st;
    if (threadIdx.x == 0) (void)xb_add(&bar[XB_XCNT(b.x)], 1u);
    return b;
}
__device__ __forceinline__ void xcd_barrier_complete(unsigned* bar, unsigned x, unsigned& nloc, unsigned& nx) {
    const unsigned G = gridDim.x * gridDim.y * gridDim.z;
    unsigned sum, cnt, mine, sp = 0u;
    for (;;) {
        sum = 0u; cnt = 0u; mine = 0u;
#pragma unroll
        for (unsigned j = 0; j < 16; ++j) { const unsigned c = xb_ld(&bar[XB_XCNT(j)]); sum += c; cnt += (c > 0u) ? 1u : 0u; mine = (j == x) ? c : mine; }
        if (sum == G) break;
        __builtin_amdgcn_s_sleep(1);
        if ((++sp & 255u) == 0u) { if (xb_ld(&bar[XB_TMO])) break; if (sp > XB_SPIN_CAP) { atomicAdd(&bar[XB_TMO], 1u); break; } }
    }
    nloc = mine > 0u ? mine : 1u; nx = cnt > 0u ? cnt : 1u;
}
__device__ __forceinline__ void xcd_barrier(const XcdBarrier& b) {
    asm volatile("s_waitcnt vmcnt(0)" ::: "memory");
    __syncthreads();
    if (threadIdx.x == 0) {
        unsigned* bar = b.bar;
        __builtin_amdgcn_s_waitcnt(0);
        unsigned nloc = b.st[0], nx = b.st[1];
        if (nloc == 0u) { xcd_barrier_complete(bar, b.x, nloc, nx); b.st[0] = nloc; b.st[1] = nx; }
        const unsigned old = xb_add(&bar[XB_XSUB(b.x)], 1u);
        const unsigned gen = old / nloc;
        if (old + 1u == (gen + 1u) * nloc) {
            __builtin_amdgcn_fence(__ATOMIC_RELEASE, "agent");
            asm volatile("s_waitcnt vmcnt(0)" ::: "memory");
            const unsigned og = xb_add(&bar[XB_TOP], 1u);
            const unsigned tg = og / nx;
            if (og + 1u == (tg + 1u) * nx) xb_add(&bar[XB_TOPGEN], 1u);
            else XB_SPIN(xb_ld(&bar[XB_TOPGEN]) == tg, bar);
            __builtin_amdgcn_fence(__ATOMIC_ACQUIRE, "agent");
            xb_add(&bar[XB_XGEN(b.x)], 1u);
            asm volatile("s_waitcnt vmcnt(0)" ::: "memory");
        } else {
            XB_SPIN(xb_ld(&bar[XB_XGEN(b.x)]) == gen, bar);
            __builtin_amdgcn_fence(__ATOMIC_ACQUIRE, "agent");
            asm volatile("s_waitcnt vmcnt(0)" ::: "memory");
        }
    }
    __syncthreads();
}

constexpr int N_PHASES = 16;

__global__ void __launch_bounds__(NTHREADS, 2) fwd_kernel(Params p) {
    extern __shared__ __attribute__((aligned(16))) unsigned char lds_raw[];
    LAS unsigned char* lds = (LAS unsigned char*)lds_raw;
    const int tid = threadIdx.x, lane = tid & 63, wave = __builtin_amdgcn_readfirstlane(tid >> 6);
    const int G = gridDim.x, bx = blockIdx.x;
    const int vcu = (G % 8 == 0) ? (bx % 8) * (G / 8) + bx / 8 : bx;
    unsigned char* ws = p.ws;
    int* ctl = (int*)(ws + WS_CTL);
    float* cs = (float*)(ws + WS_CS);
    float* lse = (float*)(ws + WS_LSE);
    int* slotref = (int*)(ws + WS_SLOTREF);
    bf16* Wgs = (bf16*)(ws + WS_WGS);
    int* list = (int*)(ws + WS_LIST);
    float* gatel = (float*)(ws + WS_GATEL);
    bf16* Win_t = (bf16*)(ws + WS_WIN); bf16* Wout_t = (bf16*)(ws + WS_WOUT); bf16* Wpin_t = (bf16*)(ws + WS_WPIN); bf16* Wc_t = (bf16*)(ws + WS_WC); bf16* Wpo_t = (bf16*)(ws + WS_WPO);
    bf16* W13 = (bf16*)(ws + WS_W13); bf16* W2 = (bf16*)(ws + WS_W2);
    bf16* Y = (bf16*)(ws + WS_Y); bf16* QKV = (bf16*)(ws + WS_BIG); bf16* OM = (bf16*)(ws + WS_OM);
    bf16* HMID = (bf16*)(ws + WS_HMID); bf16* YS = (bf16*)(ws + WS_YS); bf16* U = (bf16*)(ws + WS_U); bf16* POOLED = (bf16*)(ws + WS_POOLED);
    bf16* OG = (bf16*)p.out;
    bf16* H = (bf16*)(ws + WS_H);
    LAS int* tb = (LAS int*)(lds + MISC_OFF);
    LAS unsigned* aofs = (LAS unsigned*)(lds + AOFS_OFF);

    const int lo = p.ph_lo, hi = p.ph_hi;
#if MK_N_LAUNCHES == 1
    cg::grid_group grid = cg::this_grid();
    if (tid < 2) ((volatile LAS unsigned*)(lds + MISC_OFF))[64 + tid] = 0u;
    __syncthreads();
    const XcdBarrier xbar = xcd_barrier_post((unsigned*)(ctl + CW_BAR), (volatile LAS unsigned*)(lds + MISC_OFF) + 64);
#define GRID_BAR(k) do { if ((k) == CG_SEAM) grid.sync(); else xcd_barrier(xbar); } while (0)
#else
#define GRID_BAR(k) do { } while (0)
#endif
#ifndef PHASE_MASK
#define PHASE_MASK 0xffff
#endif
#ifndef REPEAT_MASK
#define REPEAT_MASK 0x0
#endif
#define REP(k) for (int rep_ = 0; rep_ <= ((REPEAT_MASK >> (k)) & 1); ++rep_)
#define IN(k) (((PHASE_MASK >> (k)) & 1) && lo <= (k) && (k) < hi)
#define SEAM(k) do { if (IN(k) && IN((k) + 1)) GRID_BAR(k); } while (0)

    if (IN(0)) REP(0) {
        LAS float* scr = (LAS float*)(lds + wave * 16384);
        const int gw = vcu * NWAVES + wave, NGW = G * NWAVES;
        constexpr int I_IN = (D / 64) * (QKVW / 32);
        constexpr int I_OUT = (AW / 64) * (D / 32);
        constexpr int I_PIN = (D / 64) * (D / 32);
        constexpr int I_PO = I_PIN;
        constexpr int I_W1 = (D / 64) * (DE / 32);
        constexpr int I_W2 = (DE / 64) * (D / 32);
        constexpr int NITEMS = I_IN + I_OUT + I_PIN + I_PO + 32 * (2 * I_W1 + I_W2);
        for (int it = gw; it < NITEMS; it += NGW) {
            int r = it;
            if (r < I_IN) { const int nblk = QKVW / 32;
                if (FP8_QKV) transpose_item8(p.attn_w_in, QKVW, D, (unsigned char*)Win_t, MapQKV{}, 32.f, scr, 64 * (r / nblk), 32 * (r % nblk), lane);
                else transpose_item(p.attn_w_in, QKVW, D, Win_t, MapQKV{}, scr, 64 * (r / nblk), 32 * (r % nblk), lane);
                continue; } r -= I_IN;
            if (r < I_OUT) { const int nblk = D / 32; transpose_item(p.attn_w_out, D, AW, Wout_t, MapId{}, scr, 64 * (r / nblk), 32 * (r % nblk), lane); continue; } r -= I_OUT;
            if (r < I_PIN) { const int nblk = D / 32; transpose_item(p.pool_w_in, D, D, Wpin_t, MapId{}, scr, 64 * (r / nblk), 32 * (r % nblk), lane); continue; } r -= I_PIN;
            if (r < I_PO) { const int nblk = D / 32; transpose_item(p.pool_w_out, D, D, Wpo_t, MapId{}, scr, 64 * (r / nblk), 32 * (r % nblk), lane); continue; } r -= I_PO;
            const int le = r / (2 * I_W1 + I_W2); r -= le * (2 * I_W1 + I_W2);
            if (r < I_W1) { const int nblk = DE / 32;
                if (FP8_MOE1) transpose_item8(p.expert_w1 + (size_t)le * D * DE, DE, D, (unsigned char*)W13 + (size_t)le * 1024 * 1024, MapW13{0}, 32.f, scr, 64 * (r / nblk), 32 * (r % nblk), lane);
                else transpose_item(p.expert_w1 + (size_t)le * D * DE, DE, D, W13 + (size_t)le * 1024 * 1024, MapW13{0}, scr, 64 * (r / nblk), 32 * (r % nblk), lane);
                continue; } r -= I_W1;
            if (r < I_W1) { const int nblk = DE / 32;
                if (FP8_MOE1) transpose_item8(p.expert_w3 + (size_t)le * D * DE, DE, D, (unsigned char*)W13 + (size_t)le * 1024 * 1024, MapW13{128}, 32.f, scr, 64 * (r / nblk), 32 * (r % nblk), lane);
                else transpose_item(p.expert_w3 + (size_t)le * D * DE, DE, D, W13 + (size_t)le * 1024 * 1024, MapW13{128}, scr, 64 * (r / nblk), 32 * (r % nblk), lane);
                continue; } r -= I_W1;
            { const int nblk = D / 32;
                if (FP8_MOE2) transpose_item8(p.expert_w2 + (size_t)le * DE * D, D, DE, (unsigned char*)W2 + (size_t)le * 1024 * DE, MapId{}, 32.f, scr, 64 * (r / nblk), 32 * (r % nblk), lane);
                else transpose_item(p.expert_w2 + (size_t)le * DE * D, D, DE, W2 + (size_t)le * 1024 * DE, MapId{}, scr, 64 * (r / nblk), 32 * (r % nblk), lane); }
        }
        for (int i = vcu * NTHREADS + tid; i < 4 * 256 * 256 / 4; i += G * NTHREADS) {
            const int e4 = (i & 63) * 4, gidx = i >> 14;
            const f32x4 wv = *(const f32x4*)(p.pool_w_group + (size_t)i * 4); const f32x4 sc = *(const f32x4*)(p.pool_scale + gidx * 256 + e4);
            u32x2 o; o.x = cvtpk(wv.x * sc.x, wv.y * sc.y); o.y = cvtpk(wv.z * sc.z, wv.w * sc.w); *(u32x2*)(Wgs + (size_t)i * 4) = o;
        }
        for (int i = vcu * NTHREADS + tid; i < T * 8; i += G * NTHREADS) {
            const int tok = i >> 3, f = i & 7;
            const double invf = exp2(-(double)f * 0.125 * 18.931568569324174);
            const float ang = (float)p.positions[tok] * (float)invf;
            double sn, cn; sincos((double)ang, &sn, &cn);
            cs[(size_t)i * 2] = (float)cn; cs[(size_t)i * 2 + 1] = (float)sn;
        }
        RowPassCfg c{}; c.hin = p.x; c.gain = p.norm_mix; if (FP8_QKV) c.yout8 = (unsigned char*)Y; else c.yout = Y;
        row_pass<false, false, false>(lds, c, vcu, wave);
    }
    SEAM(0);
    if (IN(1)) REP(1) {
        pg8::DenseProbT<FP8_QKV != 0> P{Y, Win_t, D, D, 0, (size_t)256 * D};
        pg8::StaticOrder S; S.init(T / 256, QKVW / 256, G, bx);
        EpiQKV E{QKV, cs, FP8_QKV ? (1.0f / 32.0f) : 1.0f};
        pg8::gemm_phase<pg8::DenseProbT<FP8_QKV != 0>, EpiQKV, pg8::StaticOrder, true>(lds, P, S, E);
    }
    SEAM(1);
    if (IN(2)) REP(2) {
        att::attn_phase(lds, QKV, OG, lse, vcu, G);
        pg8::DenseProb P{Wpo_t, Wgs, 256, D, 256, (size_t)256 * 256};
        FoldOrder S{G, bx};
        EpiBf16 E{Wc_t, D};
        pg8::gemm_phase<pg8::DenseProb, EpiBf16, FoldOrder, true>(lds, P, S, E);
    }
    SEAM(2);
    if (IN(3)) REP(3) {
        for (int row = vcu * NWAVES + wave; row < T; row += G * NWAVES) {
            const int h = lane >> 3;
            const float l0 = lse[(size_t)row * 24 + h], l1 = lse[(size_t)row * 24 + 8 + h], l2 = lse[(size_t)row * 24 + 16 + h];
            const float mx = fmaxf(l0, fmaxf(l1, l2));
            float w0 = __expf(l0 - mx), w1 = __expf(l1 - mx), w2 = __expf(l2 - mx); const float inv = 1.0f / (w0 + w1 + w2); w0 *= inv; w1 *= inv; w2 *= inv;
            const bf16* src = OG + (size_t)row * 1536 + lane * 8;
            const u32x4 a = *(const u32x4*)(src), b = *(const u32x4*)(src + 512), c = *(const u32x4*)(src + 1024);
            u32x4 o;
#pragma unroll
            for (int k = 0; k < 4; ++k) { const float lo_ = w0 * bf_lo(a[k]) + w1 * bf_lo(b[k]) + w2 * bf_lo(c[k]), hi_ = w0 * bf_hi(a[k]) + w1 * bf_hi(b[k]) + w2 * bf_hi(c[k]); o[k] = cvtpk(lo_, hi_); }
            *(u32x4*)(OM + (size_t)row * AW + lane * 8) = o;
        }
    }
    SEAM(3);
    if (IN(4)) REP(4) {
        pg8::DenseProb P{OM, Wout_t, AW, AW, 0, (size_t)256 * AW};
        pg8::StaticOrder S; S.init(T / 256, D / 256, G, bx);
        EpiResBf16<true> E{p.x, H};
        pg8::gemm_phase<pg8::DenseProb, EpiResBf16<true>, pg8::StaticOrder, true>(lds, P, S, E);
    }
    SEAM(4);
#pragma unroll 1
    for (int L = 0; L < 2; ++L) {
        const int pb = (L == 0) ? 5 : 12;
        int* cnt = ctl + CW_CNT + L * NE;
        if (IN(pb)) {
            RowPassCfg c{}; c.hin16 = H; c.gain = p.norm_ffn + L * D; if (FP8_MOE1) c.yout8 = (unsigned char*)Y; else c.yout = Y;
            c.rgw = p.router_group_w + (size_t)L * D * 4; c.rgb = p.router_group_b + L * 4; c.rew = p.router_expert_w + (size_t)L * 4 * D * 4; c.reb = p.router_expert_b + L * 16;
            c.cnt = cnt; c.list = list + (size_t)L * NE * T; c.gatel = gatel + (size_t)L * NE * T; c.slotref_out = slotref + (size_t)L * T * 2;
            if ((REPEAT_MASK >> pb) & 1) {
                RowPassCfg c2 = c; c2.cnt = ctl + 64 + L * NE; c2.list = (int*)(ws + WS_BIG + 200 * MiB); c2.gatel = (float*)(ws + WS_BIG + 204 * MiB); c2.slotref_out = (int*)(ws + WS_BIG + 208 * MiB);
                row_pass<false, true, true>(lds, c2, vcu, wave);
            }
            row_pass<false, true, true>(lds, c, vcu, wave);
        }
        SEAM(pb);
        if (IN(pb + 1) || IN(pb + 2)) {
            if (tid == 0) { int s = 0; for (int e = 0; e < NE; ++e) { tb[e] = s; tb[32 + e] = cnt[e]; s += (cnt[e] + 255) >> 8; } tb[NE] = s; }
            __syncthreads();
        }
        if (IN(pb + 1)) REP(pb + 1) {
            const int NT = tb[NE];
            pg8::StaticOrder S; S.init(NT, 4, G, bx);
            for (int i = 0; i < 8; ++i) { Unit u; if (!S.next(i, u)) break;
                int e = 0;
                for (int k = 1; k < NE; ++k) e += (u.pm >= tb[k]) ? 1 : 0;
                if (tid < 256) { const int li = (u.pm - tb[e]) * 256 + tid; const int tok = (li < tb[32 + e]) ? list[((size_t)L * NE + e) * T + li] : 0; aofs[i * 256 + tid] = (unsigned)tok * (unsigned)(D * (FP8_MOE1 ? 1 : 2)); } }
            __syncthreads();
            MoeProb1T<FP8_MOE1 != 0> P{Y, (const unsigned char*)W13 + (size_t)L * NE * 1024 * 1024 * (FP8_MOE1 ? 1 : 2), D, tb, aofs};
            EpiSwiGLU<FP8_MOE2 != 0> E{HMID, FP8_MOE1 ? (1.0f / 32.0f) : 1.0f};
            pg8::gemm_phase<MoeProb1T<FP8_MOE1 != 0>, EpiSwiGLU<FP8_MOE2 != 0>, pg8::StaticOrder, true>(lds, P, S, E);
        }
        SEAM(pb + 1);
        if (IN(pb + 2)) REP(pb + 2) {
            const int NT = tb[NE];
            pg8::StaticOrder S; S.init(NT, 4, G, bx);
            MoeProb2T<FP8_MOE2 != 0> P{HMID, (const unsigned char*)W2 + (size_t)L * NE * 1024 * DE * (FP8_MOE2 ? 1 : 2), DE, tb};
            EpiGate E{YS, gatel + (size_t)L * NE * T, cnt, tb, FP8_MOE2 ? (1.0f / 512.0f) : 1.0f};
            pg8::gemm_phase<MoeProb2T<FP8_MOE2 != 0>, EpiGate, pg8::StaticOrder, true>(lds, P, S, E);
        }
        SEAM(pb + 2);
        if (L == 0) {
            if (IN(8)) {
                RowPassCfg c{}; c.hin16 = H; c.ys = YS; c.slotref = slotref; c.cnt_prev = cnt; c.hout = H; c.gain = p.norm_mix + D; c.yout = Y;
                if ((REPEAT_MASK >> 8) & 1) { RowPassCfg c2 = c; c2.hout = nullptr; row_pass<true, false, true>(lds, c2, vcu, wave); }
                row_pass<true, false, true>(lds, c, vcu, wave);
            }
            SEAM(8);
            if (IN(9)) REP(9) {
                pg8::DenseProb P{Y, Wpin_t, D, D, 0, (size_t)256 * D};
                pg8::StaticOrder S; S.init(T / 256, D / 256, G, bx);
                EpiBf16 E{U, D};
                pg8::gemm_phase<pg8::DenseProb, EpiBf16, pg8::StaticOrder, true>(lds, P, S, E);
            }
            SEAM(9);
            if (IN(10)) REP(10) {
                for (int it = vcu * NTHREADS + tid; it < (T / 32) * 128; it += G * NTHREADS) {
                    const int ch = (it & 127) * 8, run = it >> 7, t0 = run * 32, s0 = t0 & (SEQ - 1);
                    const int wdw = 2 << (ch >> 8);
                    float sum[8];
#pragma unroll
                    for (int k = 0; k < 8; ++k) sum[k] = 0.f;
                    for (int i = 1; i < wdw; ++i) { if (s0 - i < 0) break; const u32x4 a = *(const u32x4*)(U + (size_t)(t0 - i) * D + ch);
#pragma unroll
                        for (int k = 0; k < 4; ++k) { sum[2 * k] += bf_lo(a[k]); sum[2 * k + 1] += bf_hi(a[k]); } }
                    for (int i = 0; i < 32; ++i) {
                        const int tk = t0 + i, s = s0 + i;
                        const u32x4 a = *(const u32x4*)(U + (size_t)tk * D + ch);
                        float cur[8];
#pragma unroll
                        for (int k = 0; k < 4; ++k) { cur[2 * k] = bf_lo(a[k]); cur[2 * k + 1] = bf_hi(a[k]); }
#pragma unroll
                        for (int k = 0; k < 8; ++k) sum[k] += cur[k];
                        const float invc = 1.0f / (float)((s + 1) < wdw ? (s + 1) : wdw);
                        u32x4 w;
#pragma unroll
                        for (int k = 0; k < 4; ++k) w[k] = cvtpk(sum[2 * k] * invc - cur[2 * k], sum[2 * k + 1] * invc - cur[2 * k + 1]);
                        *(u32x4*)(POOLED + (size_t)tk * D + ch) = w;
                        if (s - wdw + 1 >= 0) { const u32x4 o = *(const u32x4*)(U + (size_t)(tk - wdw + 1) * D + ch);
#pragma unroll
                            for (int k = 0; k < 4; ++k) { sum[2 * k] -= bf_lo(o[k]); sum[2 * k + 1] -= bf_hi(o[k]); } }
                    }
                }
            }
            SEAM(10);
            if (IN(11)) REP(11) {
                pg8::DenseProb P{POOLED, Wc_t, D, D, 0, (size_t)256 * D};
                pg8::StaticOrder S; S.init(T / 256, D / 256, G, bx);
                EpiResBf16<false> E{H, (((REPEAT_MASK >> 11) & 1) && rep_ == 0) ? (bf16*)(ws + WS_BIG + 136 * MiB) : H};
                pg8::gemm_phase<pg8::DenseProb, EpiResBf16<false>, pg8::StaticOrder, true>(lds, P, S, E);
            }
            SEAM(11);
        }
    }
    if (IN(15)) {
        RowPassCfg c{}; c.hin16 = H; c.ys = YS; c.slotref = slotref + (size_t)T * 2; c.cnt_prev = ctl + CW_CNT + NE; c.gain = p.norm_final; c.fout = p.out;
        if ((REPEAT_MASK >> 15) & 1) { RowPassCfg c2 = c; c2.fout = nullptr; c2.yout = Y; row_pass<true, false, true>(lds, c2, vcu, wave); }
        row_pass<true, false, true>(lds, c, vcu, wave);
    }
#undef IN
#undef SEAM
#undef GRID_BAR
}

extern "C" void kernel_launch(void* const* d_in, const int* in_sizes, int n_in, void* d_out, int out_size, void* d_ws, size_t ws_size, hipStream_t stream) {
    static int grid = 0;
    if (grid == 0) {
        if (n_in != 18 || in_sizes[0] != T * D || out_size != T * D || ws_size < WS_END) { fprintf(stderr, "kernel_launch: unexpected shapes (n_in %d, in0 %d, out %d, ws %zu)\n", n_in, n_in > 0 ? in_sizes[0] : -1, out_size, ws_size); grid = -1; return; }
        int dev = 0, cus = 0, per_cu = 0;
        if (hipGetDevice(&dev) != hipSuccess || hipDeviceGetAttribute(&cus, hipDeviceAttributeMultiprocessorCount, dev) != hipSuccess) { grid = -1; return; }
        if (hipFuncSetAttribute((const void*)fwd_kernel, hipFuncAttributeMaxDynamicSharedMemorySize, LDS_BYTES) != hipSuccess) { fprintf(stderr, "kernel_launch: hipFuncSetAttribute failed\n"); grid = -1; return; }
        if (hipOccupancyMaxActiveBlocksPerMultiprocessor(&per_cu, (const void*)fwd_kernel, NTHREADS, LDS_BYTES) != hipSuccess || per_cu < 1) { fprintf(stderr, "kernel_launch: occupancy query says %d\n", per_cu); per_cu = 1; }
        (void)hipGetLastError();
        grid = cus;
    }
    if (grid < 0) return;
    (void)hipMemsetAsync((char*)d_ws + WS_CTL, 0, CTL_ZERO_BYTES, stream);
    Params p{};
    p.x = (const float*)d_in[0]; p.positions = (const int*)d_in[1]; p.norm_mix = (const float*)d_in[2]; p.norm_ffn = (const float*)d_in[3]; p.norm_final = (const float*)d_in[4];
    p.attn_w_in = (const float*)d_in[5]; p.attn_w_out = (const float*)d_in[6]; p.pool_w_in = (const float*)d_in[7]; p.pool_w_group = (const float*)d_in[8]; p.pool_scale = (const float*)d_in[9]; p.pool_w_out = (const float*)d_in[10];
    p.router_group_w = (const float*)d_in[11]; p.router_group_b = (const float*)d_in[12]; p.router_expert_w = (const float*)d_in[13]; p.router_expert_b = (const float*)d_in[14];
    p.expert_w1 = (const float*)d_in[15]; p.expert_w3 = (const float*)d_in[16]; p.expert_w2 = (const float*)d_in[17];
    p.out = (float*)d_out; p.ws = (unsigned char*)d_ws;
#if MK_N_LAUNCHES == 1
    p.ph_lo = 0; p.ph_hi = N_PHASES;
    void* args[] = {&p};
    hipError_t e = hipLaunchCooperativeKernel((const void*)fwd_kernel, dim3(grid), dim3(NTHREADS), args, LDS_BYTES, stream);
    if (e != hipSuccess) fprintf(stderr, "cooperative launch failed: %s (grid %d)\n", hipGetErrorString(e), grid);
#else
    for (int ph = 0; ph < N_PHASES; ++ph) {
        p.ph_lo = ph; p.ph_hi = ph + 1;
        hipLaunchKernelGGL(fwd_kernel, dim3(grid), dim3(NTHREADS), LDS_BYTES, stream, p);
    }
#endif
}
```

```cpp
#include <hip/hip_runtime.h>
#include <hip/hip_cooperative_groups.h>
#include <cstdio>
#include <cstdint>
namespace cg = cooperative_groups;

#ifndef MK_N_LAUNCHES
#define MK_N_LAUNCHES 1
#endif

#ifndef FP8_MOE1
#define FP8_MOE1 1
#endif
#ifndef FP8_MOE2
#define FP8_MOE2 1
#endif
#ifndef FP8_QKV
#define FP8_QKV 1
#endif
#define LAS __attribute__((address_space(3)))
#define GAS __attribute__((address_space(1)))
typedef unsigned short bf16;
typedef short bf16x8 __attribute__((ext_vector_type(8)));
typedef float f32x4 __attribute__((ext_vector_type(4)));
typedef float f32x2 __attribute__((ext_vector_type(2)));
typedef float f32x16 __attribute__((ext_vector_type(16)));
typedef unsigned u32x4 __attribute__((ext_vector_type(4)));
typedef unsigned u32x2 __attribute__((ext_vector_type(2)));
typedef short s16x4 __attribute__((ext_vector_type(4)));
typedef __bf16 bf16x2_t __attribute__((ext_vector_type(2)));
typedef int i32x4 __attribute__((ext_vector_type(4)));
typedef int i32x8 __attribute__((ext_vector_type(8)));

constexpr int BATCH = 16, SEQ = 2048, D = 1024, T = BATCH * SEQ;
constexpr int NG = 3, HPG = 8, HD = 64, AW = 512, QKVW = NG * 3 * AW;
constexpr int NE = 16, DE = 512, SLOTS = 2 * T;
constexpr int MAXTILES = SLOTS / 256 + NE;
constexpr float RMS_EPS = 1e-6f;
constexpr int NWAVES = 8, NTHREADS = 512;

constexpr size_t MiB = 1u << 20;
constexpr size_t WS_CTL = 0, CTL_ZERO_BYTES = 64 * 1024;
constexpr size_t WS_CS = 1 * MiB;
constexpr size_t WS_LSE = 3 * MiB;
constexpr size_t WS_SLOTREF = 6 * MiB;
constexpr size_t WS_WGS = 7 * MiB;
constexpr size_t WS_LIST = 8 * MiB;
constexpr size_t WS_GATEL = 12 * MiB;
constexpr size_t WS_WIN = 16 * MiB;
constexpr size_t WS_WOUT = 25 * MiB;
constexpr size_t WS_WPIN = 26 * MiB;
constexpr size_t WS_WC = 28 * MiB;
constexpr size_t WS_WPO = 30 * MiB;
constexpr size_t WS_W13 = 32 * MiB;
constexpr size_t WS_W2 = 96 * MiB;
constexpr size_t WS_Y = 128 * MiB;
constexpr size_t WS_BIG = 192 * MiB;
constexpr size_t WS_OM = WS_BIG;
constexpr size_t WS_HMID = WS_BIG;
constexpr size_t WS_YS = WS_BIG + 72 * MiB;
constexpr size_t WS_U = WS_BIG;
constexpr size_t WS_POOLED = WS_BIG + 64 * MiB;
constexpr size_t WS_H = WS_BIG + 208 * MiB;
constexpr size_t WS_END = WS_BIG + 288 * MiB;
constexpr int CW_CNT = 0;
constexpr int CW_BAR = 1024;
#ifndef CG_SEAM
#define CG_SEAM (-1)
#endif

constexpr int RING_BYTES = 131072;
constexpr int AOFS_OFF = RING_BYTES;
constexpr int MISC_OFF = AOFS_OFF + 8192;
constexpr int LDS_BYTES = 147456;

__device__ __forceinline__ unsigned cvtpk(float lo, float hi) { f32x2 v = {lo, hi}; bf16x2_t b = __builtin_convertvector(v, bf16x2_t); return __builtin_bit_cast(unsigned, b); }
__device__ __forceinline__ float clamp8(float v) { return __builtin_amdgcn_fmed3f(v, -448.0f, 448.0f); }
__device__ __forceinline__ unsigned pack_fp8x4(float a, float b, float c, float d) {
    int r = __builtin_amdgcn_cvt_pk_fp8_f32(clamp8(a), clamp8(b), 0, false); r = __builtin_amdgcn_cvt_pk_fp8_f32(clamp8(c), clamp8(d), r, true); return (unsigned)r; }
__device__ __forceinline__ float bf_lo(unsigned u) { return __uint_as_float(u << 16); }
__device__ __forceinline__ float bf_hi(unsigned u) { return __uint_as_float(u & 0xffff0000u); }
#define DPP_ADD(v, ctrl) ((v) + __builtin_bit_cast(float, __builtin_amdgcn_update_dpp(0, __builtin_bit_cast(int, (v)), (ctrl), 0xF, 0xF, true)))
__device__ __forceinline__ float wave_sum(float v) {
    v = DPP_ADD(v, 0xB1);
    v = DPP_ADD(v, 0x4E);
    v = DPP_ADD(v, 0x141);
    v = DPP_ADD(v, 0x140);
    const int vi = __builtin_bit_cast(int, v);
    const float r0 = __builtin_bit_cast(float, __builtin_amdgcn_readlane(vi, 0)), r1 = __builtin_bit_cast(float, __builtin_amdgcn_readlane(vi, 16));
    const float r2 = __builtin_bit_cast(float, __builtin_amdgcn_readlane(vi, 32)), r3 = __builtin_bit_cast(float, __builtin_amdgcn_readlane(vi, 48));
    return (r0 + r1) + (r2 + r3);
}

namespace pg8 {
constexpr int BM = 256, BK = 64, HALF = 128, HTB = HALF * BK * 2, STAGE_BYTES = 8 * HTB, NXCD = 8, WGM = 8;
__host__ __device__ __forceinline__ int lds_byte(int r, int c) { const int st = (r >> 4) * 2 + (c >> 5), rr = r & 15, cc = c & 31, ob = rr * 64 + cc * 2; return st * 1024 + (ob ^ (((ob >> 9) & 1) << 5)); }
__host__ __device__ __forceinline__ void stage_rc(int b, int& R, int& C) { const int st = b / 1024, sb = b % 1024, swz = sb ^ (((sb >> 9) & 1) << 5); R = (st >> 1) * 16 + swz / 64; C = (st & 1) * 32 + (swz % 64) / 2; }
__host__ __device__ __forceinline__ int perm32(int rho) { const int n = rho >> 4, i = rho & 15; return 8 * (i >> 2) + 4 * n + (i & 3); }

struct Unit { int pm, pn; };

struct StaticOrder {
    int nM, nN, nwg, G, c;
    __device__ void init(int nM_, int nN_, int G_, int c_) { nM = nM_; nN = nN_; nwg = nM * nN; G = G_; c = c_; }
    __device__ bool next(int i, Unit& u) const {
        const long L = (long)i * G + c; if (L >= nwg) return false;
        int wgid = (int)L; { const int q = nwg / NXCD, r = nwg % NXCD, xcd = wgid % NXCD, off = wgid / NXCD; wgid = (xcd < r ? xcd * (q + 1) : r * (q + 1) + (xcd - r) * q) + off; }
        const int nig = WGM * nN, gid = wgid / nig, fm = gid * WGM, gsz = (nM - fm) < WGM ? (nM - fm) : WGM;
        u.pm = fm + ((wgid % nig) % gsz); u.pn = (wgid % nig) / gsz; return true;
    }
};

template <class Prob, class Epi, class Sched, bool ALIGN_EPI>
__device__ __forceinline__ void gemm_phase(LAS unsigned char* lds, const Prob& P, const Sched& S, const Epi& E) {
    int tid_ = threadIdx.x; asm volatile("" : "+v"(tid_));
    const int tid = tid_, wid = __builtin_amdgcn_readfirstlane(tid >> 6), lane = tid & 63, wr = wid >> 2, wc = wid & 3, fr = lane & 15, fq = lane >> 4;
    constexpr bool F8 = Prob::F8;
    const int Kb = P.K * (F8 ? 1 : 2), nt = Kb / (BK * 2);
    int Rr[2], Cc[2]; unsigned voffB[2];
#pragma unroll
    for (int i = 0; i < 2; ++i) { int R, C; stage_rc(tid * 16 + i * 8192, R, C); Rr[i] = R; Cc[i] = C; const int Rb = Epi::PERM ? ((R & ~31) + perm32(R & 31)) : R; voffB[i] = (unsigned)(Rb * Kb + C * 2); }
    const unsigned kstep = (unsigned)(BK * 2);
    const unsigned hstep = (unsigned)(HALF * Kb);
    const unsigned ldsw = (unsigned)wid * 1024u;
    const int aoff = lds_byte(wr * 64 + fr, fq * 8), boff = lds_byte(wc * 32 + fr, fq * 8);
    const __amdgpu_buffer_rsrc_t rsA = __builtin_amdgcn_make_buffer_rsrc((void*)P.A, 0, 0xFFFFFFFF, 0x00020000);
    const __amdgpu_buffer_rsrc_t rsB = __builtin_amdgcn_make_buffer_rsrc((void*)P.Bt, 0, 0xFFFFFFFF, 0x00020000);
#define PG8_SA(b, h) (((b) * 2 + (h)) * HTB)
#define PG8_SB(b, h) ((4 + (b) * 2 + (h)) * HTB)
#define PG8_STAGE_B(bufoff, sB) do { _Pragma("unroll") for (int _i = 0; _i < 2; ++_i) \
        __builtin_amdgcn_raw_ptr_buffer_load_lds(rsB, (LAS void*)(lds + (bufoff) + ldsw + _i * 8192), 16, (int)voffB[_i], (int)(sB), 0, 0); } while (0)
#define PG8_STAGE_A(bufoff, kb, o) do { _Pragma("unroll") for (int _i = 0; _i < 2; ++_i) \
        __builtin_amdgcn_raw_ptr_buffer_load_lds(rsA, (LAS void*)(lds + (bufoff) + ldsw + _i * 8192), 16, (int)(o)[_i], (int)(kb), 0, 0); } while (0)
#define PG8_LD2(p_) PG8_CAT(*(const LAS i32x4*)(p_), *(const LAS i32x4*)((p_) + 1024))
#define PG8_LDA(dst, b, h) do { if constexpr (F8) { _Pragma("unroll") for (int m = 0; m < 4; ++m) dst##8[m] = PG8_LD2(lds + PG8_SA(b, h) + aoff + m * 2048); } \
        else { _Pragma("unroll") for (int m = 0; m < 4; ++m) _Pragma("unroll") for (int k = 0; k < 2; ++k) dst[m][k] = *(const LAS bf16x8*)(lds + PG8_SA(b, h) + aoff + m * 2048 + k * 1024); } } while (0)
#define PG8_LDB(dst, b, h) do { if constexpr (F8) { _Pragma("unroll") for (int n = 0; n < 2; ++n) dst##8[n] = PG8_LD2(lds + PG8_SB(b, h) + boff + n * 2048); } \
        else { _Pragma("unroll") for (int n = 0; n < 2; ++n) _Pragma("unroll") for (int k = 0; k < 2; ++k) dst[n][k] = *(const LAS bf16x8*)(lds + PG8_SB(b, h) + boff + n * 2048 + k * 1024); } } while (0)
#define PG8_CAT(x0, x1) __builtin_shufflevector((x0), (x1), 0, 1, 2, 3, 4, 5, 6, 7)
#define PG8_MMA(ai, bj, At, Bt) do { __builtin_amdgcn_s_setprio(1); \
        if constexpr (F8) { _Pragma("unroll") for (int m = 0; m < 4; ++m) _Pragma("unroll") for (int n = 0; n < 2; ++n) \
            acc[ai][bj][m][n] = __builtin_amdgcn_mfma_scale_f32_16x16x128_f8f6f4(Bt##8[n], At##8[m], acc[ai][bj][m][n], 0, 0, 0, 0, 0, 0); } \
        else { _Pragma("unroll") for (int m = 0; m < 4; ++m) _Pragma("unroll") for (int n = 0; n < 2; ++n) _Pragma("unroll") for (int k = 0; k < 2; ++k) \
            acc[ai][bj][m][n] = __builtin_amdgcn_mfma_f32_16x16x32_bf16(Bt[n][k], At[m][k], acc[ai][bj][m][n], 0, 0, 0); } \
        __builtin_amdgcn_s_setprio(0); } while (0)
#define PG8_WAIT_V(n) asm volatile("s_waitcnt vmcnt(" #n ")" ::: "memory")
#define PG8_WAIT_L(n) asm volatile("s_waitcnt lgkmcnt(" #n ")" ::: "memory")
#define PG8_BAR __builtin_amdgcn_s_barrier()
#define PG8_SCHED __builtin_amdgcn_sched_barrier(0)
    Unit cur, nxt; int ui = 0;
    if (!S.next(0, cur)) return;
    f32x4 acc[2][2][4][2];
#pragma unroll
    for (int a = 0; a < 2; ++a)
#pragma unroll
        for (int b = 0; b < 2; ++b)
#pragma unroll
            for (int m = 0; m < 4; ++m)
#pragma unroll
                for (int n = 0; n < 2; ++n) acc[a][b][m][n] = (f32x4){0.f, 0.f, 0.f, 0.f};
    bf16x8 At[4][2], B0[2][2], B1[2][2]; i32x8 At8[4], B08[2], B18[2];
    unsigned ca0[2], ca1[2];
    P.a_offs(0, cur, Rr, Cc, ca0, ca1);
    unsigned cB = P.b_off(cur);
    PG8_STAGE_B(PG8_SB(0, 0), cB); PG8_STAGE_B(PG8_SB(0, 1), cB + hstep); PG8_STAGE_A(PG8_SA(0, 0), 0, ca0); PG8_STAGE_A(PG8_SA(0, 1), 0, ca1);
    if (wr == 1) PG8_BAR;
    PG8_WAIT_V(2); PG8_BAR;
    PG8_STAGE_B(PG8_SB(1, 0), cB + kstep); PG8_STAGE_A(PG8_SA(1, 0), kstep, ca0); PG8_STAGE_B(PG8_SB(1, 1), cB + hstep + kstep);
    PG8_WAIT_V(6); PG8_BAR;
    for (;;) {
        const bool has_next = S.next(ui + 1, nxt);
        unsigned nB = cB;
        if (has_next) nB = P.b_off(nxt);
#pragma unroll 1
        for (int t = 0; t < nt; t += 2) {
            const bool last = (t == nt - 2);
            const unsigned k1 = (unsigned)(t + 1) * kstep;
            const unsigned k2 = last ? 0u : (unsigned)(t + 2) * kstep, k3 = k2 + kstep;
            const unsigned b2 = last ? nB : cB + (unsigned)(t + 2) * kstep; const unsigned b3 = b2 + kstep;
            PG8_LDB(B0, 0, 0); PG8_LDB(B1, 0, 1); PG8_SCHED; PG8_LDA(At, 0, 0); PG8_STAGE_A(PG8_SA(1, 1), k1, ca1);
            if (last && has_next) {
                int tq = threadIdx.x; asm volatile("" : "+v"(tq)); int R2[2], C2[2];
#pragma unroll
                for (int i = 0; i < 2; ++i) stage_rc(tq * 16 + i * 8192, R2[i], C2[i]);
                P.a_offs(ui + 1, nxt, R2, C2, ca0, ca1);
            }
            PG8_WAIT_V(8); PG8_WAIT_L(0); PG8_BAR; PG8_MMA(0, 0, At, B0); PG8_MMA(0, 1, At, B1); PG8_BAR; PG8_SCHED;
            PG8_LDA(At, 0, 1); PG8_STAGE_B(PG8_SB(0, 0), b2); PG8_STAGE_B(PG8_SB(0, 1), b2 + hstep); PG8_STAGE_A(PG8_SA(0, 0), k2, ca0);
            PG8_WAIT_V(8); PG8_WAIT_L(0); PG8_BAR; PG8_MMA(1, 0, At, B0); PG8_MMA(1, 1, At, B1); PG8_BAR; PG8_SCHED;
            PG8_LDB(B0, 1, 0); PG8_LDB(B1, 1, 1); PG8_SCHED; PG8_LDA(At, 1, 0); PG8_STAGE_A(PG8_SA(0, 1), k2, ca1);
            PG8_WAIT_V(8); PG8_WAIT_L(0); PG8_BAR; PG8_MMA(0, 0, At, B0); PG8_MMA(0, 1, At, B1); PG8_BAR; PG8_SCHED;
            PG8_LDA(At, 1, 1); PG8_STAGE_B(PG8_SB(1, 0), b3); PG8_STAGE_B(PG8_SB(1, 1), b3 + hstep); PG8_STAGE_A(PG8_SA(1, 0), k3, ca0);
            PG8_WAIT_V(8); PG8_WAIT_L(0); PG8_BAR; PG8_MMA(1, 0, At, B0); PG8_MMA(1, 1, At, B1); PG8_BAR; PG8_SCHED;
        }
        if constexpr (ALIGN_EPI) { if (wr == 0) PG8_BAR; }
        { int te = threadIdx.x; asm volatile("" : "+v"(te));
          E(acc, cur, wr, wc, te & 15, (te >> 4) & 3); }
        if (!has_next) break;
#pragma unroll
        for (int a = 0; a < 2; ++a)
#pragma unroll
            for (int b = 0; b < 2; ++b)
#pragma unroll
                for (int m = 0; m < 4; ++m)
#pragma unroll
                    for (int n = 0; n < 2; ++n) acc[a][b][m][n] = (f32x4){0.f, 0.f, 0.f, 0.f};
        cur = nxt; cB = nB; ++ui;
        if constexpr (ALIGN_EPI) { if (wr == 1) PG8_BAR; }
    }
    PG8_WAIT_V(0);
    if constexpr (!ALIGN_EPI) { if (wr == 0) PG8_BAR; }
    PG8_BAR;
#undef PG8_SA
#undef PG8_SB
#undef PG8_STAGE_A
#undef PG8_STAGE_B
#undef PG8_LDA
#undef PG8_LD2
#undef PG8_LDB
#undef PG8_MMA
#undef PG8_CAT
#undef PG8_WAIT_V
#undef PG8_WAIT_L
#undef PG8_BAR
#undef PG8_SCHED
}

template <bool F8_>
struct DenseProbT {
    static constexpr bool F8 = F8_;
    const void* A; const void* Bt; int K, lda, acolstep; size_t bstep_pn;
    __device__ __forceinline__ void a_offs(int, const Unit& u, const int (&R)[2], const int (&C)[2], unsigned (&o0)[2], unsigned (&o1)[2]) const {
        constexpr int esz = F8 ? 1 : 2;
#pragma unroll
        for (int i = 0; i < 2; ++i) { const unsigned b = (unsigned)(((u.pm * BM + R[i]) * lda + u.pn * acolstep) * esz + C[i] * 2); o0[i] = b; o1[i] = b + (unsigned)(HALF * lda * esz); }
    }
    __device__ __forceinline__ unsigned b_off(const Unit& u) const { return (unsigned)((size_t)u.pn * bstep_pn * (F8 ? 1 : 2)); }
};
typedef DenseProbT<false> DenseProb;
}

struct Params {
    const float* x; const int* positions; const float* norm_mix; const float* norm_ffn; const float* norm_final;
    const float* attn_w_in; const float* attn_w_out; const float* pool_w_in; const float* pool_w_group; const float* pool_scale; const float* pool_w_out;
    const float* router_group_w; const float* router_group_b; const float* router_expert_w; const float* router_expert_b;
    const float* expert_w1; const float* expert_w3; const float* expert_w2;
    float* out; unsigned char* ws;
    int ph_lo, ph_hi;
};

template <class MapN>
__device__ __forceinline__ void transpose_item(const float* W, int ldw, int K, bf16* WT, MapN mapn, LAS float* scr, int k0, int n0, int lane) {
#pragma unroll 8
    for (int i = 0; i < 32; ++i) { const int kk = 2 * i + (lane >> 5); scr[kk * 33 + (lane & 31)] = W[(size_t)(k0 + kk) * ldw + n0 + (lane & 31)]; }
    asm volatile("s_waitcnt lgkmcnt(0)" ::: "memory");
    const int c = lane & 7;
#pragma unroll
    for (int j = 0; j < 4; ++j) { const int n = (lane >> 3) + 8 * j; const LAS float* s = scr + (8 * c) * 33 + n;
        u32x4 o; o.x = cvtpk(s[0 * 33], s[1 * 33]); o.y = cvtpk(s[2 * 33], s[3 * 33]); o.z = cvtpk(s[4 * 33], s[5 * 33]); o.w = cvtpk(s[6 * 33], s[7 * 33]);
        *(u32x4*)(WT + (size_t)mapn(n0 + n) * K + k0 + 8 * c) = o; }
    asm volatile("s_waitcnt lgkmcnt(0)" ::: "memory");
}
template <class MapN>
__device__ __forceinline__ void transpose_item8(const float* W, int ldw, int K, unsigned char* WT, MapN mapn, float sc, LAS float* scr, int k0, int n0, int lane) {
#pragma unroll 8
    for (int i = 0; i < 32; ++i) { const int kk = 2 * i + (lane >> 5); scr[kk * 33 + (lane & 31)] = W[(size_t)(k0 + kk) * ldw + n0 + (lane & 31)]; }
    asm volatile("s_waitcnt lgkmcnt(0)" ::: "memory");
    const int c = lane & 7;
#pragma unroll
    for (int j = 0; j < 4; ++j) { const int n = (lane >> 3) + 8 * j; const LAS float* s = scr + (8 * c) * 33 + n;
        u32x2 o; o.x = pack_fp8x4(s[0 * 33] * sc, s[1 * 33] * sc, s[2 * 33] * sc, s[3 * 33] * sc); o.y = pack_fp8x4(s[4 * 33] * sc, s[5 * 33] * sc, s[6 * 33] * sc, s[7 * 33] * sc);
        *(u32x2*)(WT + (size_t)mapn(n0 + n) * K + k0 + 8 * c) = o; }
    asm volatile("s_waitcnt lgkmcnt(0)" ::: "memory");
}
struct MapId { __device__ __forceinline__ int operator()(int n) const { return n; } };
struct MapQKV {
    __device__ __forceinline__ int operator()(int n) const { const int rem = n % 1536, kind = rem / 512, d = n & 63; if (kind < 2 && d < 16) return n - d + (d < 8 ? 2 * d : 2 * (d - 8) + 1); return n; }
};
struct MapW13 { int add; __device__ __forceinline__ int operator()(int n) const { return (n >> 7) * 256 + add + (n & 127); } };

struct RowPassCfg {
    const float* hin;
    const bf16* hin16;
    const bf16* ys; const int* slotref; const int* cnt_prev;
    bf16* hout;
    const float* gain;
    bf16* yout;
    unsigned char* yout8;
    float* fout;
    const float* rgw; const float* rgb; const float* rew; const float* reb;
    int* cnt; int* list; float* gatel; int* slotref_out;
};

__device__ __forceinline__ void route_decide(const float (&a)[20], const float* rgb, const float* reb, int& e0, int& e1, float& g0, float& g1) {
    float lg[4];
#pragma unroll
    for (int g = 0; g < 4; ++g) lg[g] = a[g] + rgb[g];
    int gs = 0; float gm = lg[0];
#pragma unroll
    for (int g = 1; g < 4; ++g) if (lg[g] > gm) { gm = lg[g]; gs = g; }
    float den = 0.f;
#pragma unroll
    for (int g = 0; g < 4; ++g) den += __expf(lg[g] - gm);
    const float gate1 = 1.0f / den;
    float le[4];
#pragma unroll
    for (int e = 0; e < 4; ++e) { const float sel = gs == 0 ? a[4 + e] : gs == 1 ? a[8 + e] : gs == 2 ? a[12 + e] : a[16 + e]; le[e] = sel + reb[gs * 4 + e]; }
    int i0 = 0; float v0 = le[0];
#pragma unroll
    for (int e = 1; e < 4; ++e) if (le[e] > v0) { v0 = le[e]; i0 = e; }
    int i1 = -1; float v1 = -INFINITY;
#pragma unroll
    for (int e = 0; e < 4; ++e) if (e != i0 && le[e] > v1) { v1 = le[e]; i1 = e; }
    const float ex = __expf(v1 - v0), p0 = 1.0f / (1.0f + ex), p1 = ex * p0;
    e0 = gs * 4 + i0; e1 = gs * 4 + i1; g0 = gate1 * p0; g1 = gate1 * p1;
}

template <bool COMBINE, bool ROUTER, bool HIN16>
__device__ __forceinline__ void row_pass(LAS unsigned char* lds, const RowPassCfg& c, int vcu, int wave) {
    int tid = threadIdx.x; asm volatile("" : "+v"(tid)); const int lane = tid & 63;
    LAS float* Wr = (LAS float*)lds;
    LAS int* selE = (LAS int*)(lds + 81920);
    LAS float* selG = (LAS float*)(lds + 81920 + 1024);
    LAS int* wcnt = (LAS int*)(lds + 81920 + 2048);
    LAS int* tb = (LAS int*)(lds + MISC_OFF);
    if (ROUTER) {
        for (int k = tid; k < 1024; k += NTHREADS) {
            const f32x4 g4 = *(const f32x4*)(c.rgw + (size_t)k * 4);
            Wr[0 * 1024 + k] = g4.x; Wr[1 * 1024 + k] = g4.y; Wr[2 * 1024 + k] = g4.z; Wr[3 * 1024 + k] = g4.w;
#pragma unroll
            for (int g = 0; g < 4; ++g) { const f32x4 e4 = *(const f32x4*)(c.rew + ((size_t)g * 1024 + k) * 4);
                Wr[(4 + g * 4 + 0) * 1024 + k] = e4.x; Wr[(4 + g * 4 + 1) * 1024 + k] = e4.y; Wr[(4 + g * 4 + 2) * 1024 + k] = e4.z; Wr[(4 + g * 4 + 3) * 1024 + k] = e4.w; }
        }
    }
    if (COMBINE) {
        if (tid == 0) { int sacc = 0; for (int e = 0; e < NE; ++e) { tb[e] = sacc; sacc += (c.cnt_prev[e] + 255) >> 8; } tb[NE] = sacc; }
    }
    __syncthreads();
    f32x4 gn[4];
#pragma unroll
    for (int j = 0; j < 4; ++j) gn[j] = *(const f32x4*)(c.gain + 4 * lane + 256 * j);
    for (int rb = vcu; rb < T / 128; rb += gridDim.x) {
        const int rbase = rb * 128 + wave * 16;
        int refs = 0;
        if (COMBINE) { if (lane < 32) refs = c.slotref[rbase * 2 + lane]; }
        f32x4 hv[2][2][4]; u32x2 hb[2][2][4]; u32x2 yv[2][2][2][4];
#define RP_ISSUE(buf, pr) do { _Pragma("unroll") for (int r = 0; r < 2; ++r) { const int row = rbase + 2 * (pr) + r; \
            if (HIN16) { _Pragma("unroll") for (int j = 0; j < 4; ++j) hb[buf][r][j] = *(const u32x2*)(c.hin16 + (size_t)row * D + 4 * lane + 256 * j); } \
            else { _Pragma("unroll") for (int j = 0; j < 4; ++j) hv[buf][r][j] = *(const f32x4*)(c.hin + (size_t)row * D + 4 * lane + 256 * j); } \
            if (COMBINE) { _Pragma("unroll") for (int sl = 0; sl < 2; ++sl) { const int ref = __builtin_amdgcn_readlane(refs, (2 * (pr) + r) * 2 + sl); const int e = ref >> 15, pos = ref & 32767; \
                const bf16* yr = c.ys + ((size_t)tb[e] * 256 + pos) * D; \
                _Pragma("unroll") for (int j = 0; j < 4; ++j) yv[buf][r][sl][j] = *(const u32x2*)(yr + 4 * lane + 256 * j); } } } } while (0)
#define RP_PROCESS(buf, pr) do { f32x4 v[2][4]; \
            _Pragma("unroll") for (int r = 0; r < 2; ++r) { const int row = rbase + 2 * (pr) + r; \
                _Pragma("unroll") for (int j = 0; j < 4; ++j) { if (HIN16) { const u32x2 w0 = hb[buf][r][j]; v[r][j] = (f32x4){bf_lo(w0.x), bf_hi(w0.x), bf_lo(w0.y), bf_hi(w0.y)}; } else v[r][j] = hv[buf][r][j]; \
                    if (COMBINE) { _Pragma("unroll") for (int sl = 0; sl < 2; ++sl) { const u32x2 w = yv[buf][r][sl][j]; v[r][j].x += bf_lo(w.x); v[r][j].y += bf_hi(w.x); v[r][j].z += bf_lo(w.y); v[r][j].w += bf_hi(w.y); } } } \
                if (c.hout) { _Pragma("unroll") for (int j = 0; j < 4; ++j) { u32x2 w; w.x = cvtpk(v[r][j].x, v[r][j].y); w.y = cvtpk(v[r][j].z, v[r][j].w); *(u32x2*)(c.hout + (size_t)row * D + 4 * lane + 256 * j) = w; \
                    v[r][j] = (f32x4){bf_lo(w.x), bf_hi(w.x), bf_lo(w.y), bf_hi(w.y)}; } } \
                float ss = 0.f; \
                _Pragma("unroll") for (int j = 0; j < 4; ++j) ss += (v[r][j].x * v[r][j].x + v[r][j].y * v[r][j].y) + (v[r][j].z * v[r][j].z + v[r][j].w * v[r][j].w); \
                const float rstd = 1.0f / sqrtf(wave_sum(ss) * (1.0f / D) + RMS_EPS); \
                _Pragma("unroll") for (int j = 0; j < 4; ++j) { v[r][j].x = v[r][j].x * rstd * gn[j].x; v[r][j].y = v[r][j].y * rstd * gn[j].y; v[r][j].z = v[r][j].z * rstd * gn[j].z; v[r][j].w = v[r][j].w * rstd * gn[j].w; } \
                if (c.yout) { _Pragma("unroll") for (int j = 0; j < 4; ++j) { u32x2 w; w.x = cvtpk(v[r][j].x, v[r][j].y); w.y = cvtpk(v[r][j].z, v[r][j].w); *(u32x2*)(c.yout + (size_t)row * D + 4 * lane + 256 * j) = w; } } \
                if (c.yout8) { _Pragma("unroll") for (int j = 0; j < 4; ++j) *(unsigned*)(c.yout8 + (size_t)row * D + 4 * lane + 256 * j) = pack_fp8x4(v[r][j].x, v[r][j].y, v[r][j].z, v[r][j].w); } \
                if (c.fout) { _Pragma("unroll") for (int j = 0; j < 4; ++j) *(f32x4*)(c.fout + (size_t)row * D + 4 * lane + 256 * j) = v[r][j]; } } \
            if (ROUTER) { LAS float* lg_ = (LAS float*)(lds + 81920 + 4096) + wave * 40; \
                _Pragma("unroll 2") for (int o = 0; o < 20; ++o) { float s0 = 0.f, s1 = 0.f; \
                    _Pragma("unroll") for (int j = 0; j < 4; ++j) { const f32x4 w = *(const LAS f32x4*)(Wr + o * 1024 + 4 * lane + 256 * j); \
                        s0 += (v[0][j].x * w.x + v[0][j].y * w.y) + (v[0][j].z * w.z + v[0][j].w * w.w); s1 += (v[1][j].x * w.x + v[1][j].y * w.y) + (v[1][j].z * w.z + v[1][j].w * w.w); } \
                    s0 = wave_sum(s0); s1 = wave_sum(s1); if (lane == 0) { lg_[o] = s0; lg_[20 + o] = s1; } } \
                float a0[20], a1[20]; \
                _Pragma("unroll") for (int o = 0; o < 20; ++o) { a0[o] = lg_[o]; a1[o] = lg_[20 + o]; } \
                int e0, e1; float g0, g1; const int rl = wave * 16 + 2 * (pr); \
                route_decide(a0, c.rgb, c.reb, e0, e1, g0, g1); if (lane == 0) { selE[rl * 2] = e0; selE[rl * 2 + 1] = e1; selG[rl * 2] = g0; selG[rl * 2 + 1] = g1; } \
                route_decide(a1, c.rgb, c.reb, e0, e1, g0, g1); if (lane == 0) { selE[rl * 2 + 2] = e0; selE[rl * 2 + 3] = e1; selG[rl * 2 + 2] = g0; selG[rl * 2 + 3] = g1; } } } while (0)
        RP_ISSUE(0, 0);
#pragma unroll 1
        for (int it = 0; it < 4; ++it) {
            RP_ISSUE(1, 2 * it + 1);
            RP_PROCESS(0, 2 * it);
            if (it < 3) RP_ISSUE(0, 2 * it + 2);
            RP_PROCESS(1, 2 * it + 1);
        }
#undef RP_ISSUE
#undef RP_PROCESS
        if (ROUTER) {
            __syncthreads();
            int e = 0, rank = 0;
            if (tid < 256) {
                e = selE[tid]; int mycount = 0;
#pragma unroll
                for (int x = 0; x < NE; ++x) { const unsigned long long mask = __ballot(e == x); if (e == x) rank = __popcll(mask & ((1ull << lane) - 1ull)); if (lane == x) mycount = __popcll(mask); }
                if (lane < NE) wcnt[(tid >> 6) * 16 + lane] = mycount;
            }
            __syncthreads();
            if (tid < NE) { const int c0 = wcnt[tid], c1 = wcnt[16 + tid], c2 = wcnt[32 + tid], c3 = wcnt[48 + tid]; const int tot = c0 + c1 + c2 + c3;
                int base = 0; if (tot) base = atomicAdd(c.cnt + tid, tot);
                wcnt[tid] = base; wcnt[16 + tid] = base + c0; wcnt[32 + tid] = base + c0 + c1; wcnt[48 + tid] = base + c0 + c1 + c2; }
            __syncthreads();
            if (tid < 256) { const int pos = wcnt[(tid >> 6) * 16 + e] + rank; const int tok = rb * 128 + (tid >> 1);
                c.list[e * T + pos] = tok; c.gatel[e * T + pos] = selG[tid]; c.slotref_out[tok * 2 + (tid & 1)] = e * 32768 + pos; }
            __syncthreads();
        }
    }
    __syncthreads();
}

namespace att {
constexpr float C2 = 0.125f * 1.4426950408889634f;
constexpr float LN2 = 0.6931471805599453f;
__device__ __forceinline__ int crow(int r, int hi) { return (r & 3) + 8 * (r >> 2) + 4 * hi; }
typedef short v4i16_t __attribute__((ext_vector_type(4)));
__device__ __forceinline__ s16x4 vtr(const LAS unsigned char* p) { return __builtin_bit_cast(s16x4, __builtin_amdgcn_ds_read_tr16_b64_v4i16((LAS v4i16_t*)p)); }

struct Item { int b, g, hh, dil, j, ph; };
__device__ __forceinline__ Item decode_item(int pp, int half) {
    Item it; it.hh = pp & 7; const int q8 = (pp >> 3) & 7; it.g = (pp >> 6) % 3; it.b = pp / 192;
    const int idx16 = q8 * 2 + half; it.dil = it.g == 0 ? 1 : (it.g == 1 ? 4 : 16); const int nb = 16 / it.dil; it.j = idx16 % nb; it.ph = idx16 / nb; return it;
}
__device__ __forceinline__ int kswz(int kv) { return (kv ^ (kv >> 3)) & 7; }

template <int MODE>
__device__ __forceinline__ void attn_phase(LAS unsigned char* lds, const bf16* qkv, bf16* og, float* lse, int vcu, int G) {
    int tid_ = threadIdx.x; asm volatile("" : "+v"(tid_));
    const int tid = tid_, lane = tid & 63, wid = __builtin_amdgcn_readfirstlane(tid >> 6);
    const int half = wid >> 2, w = wid & 3, r32 = lane & 31, hi = lane >> 5, th = tid & 255;
    LAS unsigned char* Kl = lds + half * 69632;
    LAS unsigned char* Vl = Kl + 36864;
    u32x4 kreg[4][2], vreg[4][2]; bf16x8 qbuf[2][4];
    int skv[2], sc[2];
#pragma unroll
    for (int i = 0; i < 2; ++i) { const int P_ = th + 256 * i; skv[i] = P_ >> 3; sc[i] = P_ & 7; }
    const __amdgpu_buffer_rsrc_t rsQ = __builtin_amdgcn_make_buffer_rsrc((void*)qkv, 0, 0xFFFFFFFF, 0x00020000);
    typedef unsigned u32x4v __attribute__((ext_vector_type(4)));
#define ATT_ISSUE(IT, QD) do { const unsigned rstrideB_ = (unsigned)(IT).dil * (unsigned)(QKVW * 2); \
        const unsigned baseB_ = (unsigned)(((IT).b * SEQ + (IT).ph) * QKVW + (IT).g * 1536 + (IT).hh * 64) * 2u; const int l0_ = 128 * ((IT).j - 1); \
        const unsigned vo0_ = (unsigned)skv[0] * rstrideB_ + (unsigned)sc[0] * 16u, vo1_ = (unsigned)skv[1] * rstrideB_ + (unsigned)sc[1] * 16u; \
        _Pragma("unroll") for (int tt = 0; tt < 4; ++tt) { if (tt >= 2 || (IT).j != 0) { const unsigned so_ = baseB_ + (unsigned)(l0_ + 64 * tt) * rstrideB_; \
            kreg[tt][0] = __builtin_bit_cast(u32x4, __builtin_amdgcn_raw_buffer_load_b128(rsQ, (int)vo0_, (int)(so_ + 1024u), 0)); vreg[tt][0] = __builtin_bit_cast(u32x4, __builtin_amdgcn_raw_buffer_load_b128(rsQ, (int)vo0_, (int)(so_ + 2048u), 0)); \
            kreg[tt][1] = __builtin_bit_cast(u32x4, __builtin_amdgcn_raw_buffer_load_b128(rsQ, (int)vo1_, (int)(so_ + 1024u), 0)); vreg[tt][1] = __builtin_bit_cast(u32x4, __builtin_amdgcn_raw_buffer_load_b128(rsQ, (int)vo1_, (int)(so_ + 2048u), 0)); } } \
        const unsigned qo_ = (unsigned)(32 * w + r32) * rstrideB_ + (unsigned)hi * 16u, qs_ = baseB_ + (unsigned)(128 * (IT).j) * rstrideB_; \
        _Pragma("unroll") for (int d0 = 0; d0 < 4; ++d0) (QD)[d0] = __builtin_bit_cast(bf16x8, __builtin_amdgcn_raw_buffer_load_b128(rsQ, (int)qo_, (int)(qs_ + (unsigned)d0 * 32u), 0)); } while (0)
    int pp = vcu;
    Item cur = decode_item(pp < 3072 ? pp : 0, half);
    if (pp < 3072 && MODE != 2) ATT_ISSUE(cur, qbuf[0]);
    const int koff = r32 * 144 + hi * 16;
    const int voff = ((lane >> 4) & 1) * 32 + (lane & 3) * 8 + (4 * hi + ((lane & 15) >> 2)) * 64;
    for (; pp < 3072; pp += 2 * G) {
#pragma unroll
    for (int par = 0; par < 2; ++par) {
        const int ppx = pp + par * G;
        if (ppx >= 3072) break;
        const int tt_lo = (cur.j == 0) ? 2 : 0;
#pragma unroll
        for (int tt = 0; tt < 4; ++tt) { if (MODE != 2 && (tt >= 2 || cur.j != 0)) {
#pragma unroll
            for (int i = 0; i < 2; ++i) {
                *(LAS u32x4*)(Kl + tt * 9216 + skv[i] * 144 + sc[i] * 16) = kreg[tt][i];
                *(LAS u32x4*)(Vl + tt * 8192 + (sc[i] >> 2) * 4096 + skv[i] * 64 + (sc[i] & 3) * 16) = vreg[tt][i]; } } }
        bf16x8 (&qr)[4] = qbuf[par];
        asm volatile("" : "+v"(qr[0]), "+v"(qr[1]), "+v"(qr[2]), "+v"(qr[3]));
        __syncthreads();
        const Item me = cur;
        if (ppx + G < 3072) { cur = decode_item(ppx + G, half); if (MODE != 2) ATT_ISSUE(cur, qbuf[par ^ 1]); }
        if (MODE == 1) { __syncthreads(); continue; }
        float m = -1e30f, l = 0.f; f32x16 oT[2]; oT[0] = f32x16{}; oT[1] = f32x16{};
        const int t_lo = (w >= 2) ? (tt_lo > 1 ? tt_lo : 1) : tt_lo, t_hi = (w < 2) ? 2 : 3, t_mid = (w < 2) ? 1 : 2;
        for (int tt = t_lo; tt <= t_hi; ++tt) {
            const LAS unsigned char* kb = Kl + tt * 9216 + koff;
            f32x16 p0 = f32x16{}, p1 = f32x16{};
#pragma unroll
            for (int d0 = 0; d0 < 4; ++d0) {
                const bf16x8 k0 = *(const LAS bf16x8*)(kb + d0 * 32), k1 = *(const LAS bf16x8*)(kb + d0 * 32 + 32 * 144);
                p0 = __builtin_amdgcn_mfma_f32_32x32x16_bf16(k0, qr[d0], p0, 0, 0, 0);
                p1 = __builtin_amdgcn_mfma_f32_32x32x16_bf16(k1, qr[d0], p1, 0, 0, 0);
            }
            float mx = -INFINITY;
            if (tt != t_mid) {
                const int dbase = 128 + 32 * w + r32 - 64 * tt;
#pragma unroll
                for (int r = 0; r < 16; ++r) {
                    const int d0_ = dbase - crow(r, hi), d1_ = d0_ - 32;
                    p0[r] = (d0_ >= 0 && d0_ <= 128) ? p0[r] * C2 : -INFINITY;
                    p1[r] = (d1_ >= 0 && d1_ <= 128) ? p1[r] * C2 : -INFINITY;
                    mx = fmaxf(mx, fmaxf(p0[r], p1[r]));
                }
            } else {
#pragma unroll
                for (int r = 0; r < 16; ++r) { p0[r] *= C2; p1[r] *= C2; mx = fmaxf(mx, fmaxf(p0[r], p1[r])); }
            }
            { const auto rr = __builtin_amdgcn_permlane32_swap(__float_as_uint(mx), __float_as_uint(mx), false, false); mx = fmaxf(__uint_as_float(rr[0]), __uint_as_float(rr[1])); }
            const float mn = fmaxf(m, mx), alpha = __builtin_amdgcn_exp2f(m - mn);
            float rs = 0.f;
#pragma unroll
            for (int r = 0; r < 16; ++r) { p0[r] = __builtin_amdgcn_exp2f(p0[r] - mn); p1[r] = __builtin_amdgcn_exp2f(p1[r] - mn); rs += p0[r] + p1[r]; }
            l = l * alpha + rs; m = mn;
#pragma unroll
            for (int r = 0; r < 16; ++r) { oT[0][r] *= alpha; oT[1][r] *= alpha; }
            u32x4 pw[4];
            pw[0] = (u32x4){cvtpk(p0[0], p0[1]), cvtpk(p0[2], p0[3]), cvtpk(p0[4], p0[5]), cvtpk(p0[6], p0[7])};
            pw[1] = (u32x4){cvtpk(p0[8], p0[9]), cvtpk(p0[10], p0[11]), cvtpk(p0[12], p0[13]), cvtpk(p0[14], p0[15])};
            pw[2] = (u32x4){cvtpk(p1[0], p1[1]), cvtpk(p1[2], p1[3]), cvtpk(p1[4], p1[5]), cvtpk(p1[6], p1[7])};
            pw[3] = (u32x4){cvtpk(p1[8], p1[9]), cvtpk(p1[10], p1[11]), cvtpk(p1[12], p1[13]), cvtpk(p1[14], p1[15])};
            const LAS unsigned char* vp = Vl + tt * 8192 + voff;
#pragma unroll
            for (int d0 = 0; d0 < 2; ++d0)
#pragma unroll
                for (int ks = 0; ks < 4; ++ks) {
                    const s16x4 lo = vtr(vp + d0 * 4096 + ks * 1024), hh4 = vtr(vp + d0 * 4096 + ks * 1024 + 512);
                    const bf16x8 vf = (bf16x8){lo[0], lo[1], lo[2], lo[3], hh4[0], hh4[1], hh4[2], hh4[3]};
                    oT[d0] = __builtin_amdgcn_mfma_f32_32x32x16_bf16(vf, __builtin_bit_cast(bf16x8, pw[ks]), oT[d0], 0, 0, 0);
                }
        }
        float lt; { const auto rr = __builtin_amdgcn_permlane32_swap(__float_as_uint(l), __float_as_uint(l), false, false); lt = __uint_as_float(rr[0]) + __uint_as_float(rr[1]); }
        const float inv = 1.0f / lt;
        const int lq = 128 * me.j + 32 * w + r32;
        const size_t tok = (size_t)me.b * SEQ + (size_t)lq * me.dil + me.ph;
        bf16* orow = og + tok * (NG * AW) + me.g * AW + me.hh * 64;
#pragma unroll
        for (int d0 = 0; d0 < 2; ++d0)
#pragma unroll
            for (int rp = 0; rp < 2; ++rp) {
                const int rg = 2 * rp;
                unsigned x0 = cvtpk(oT[d0][4 * rg] * inv, oT[d0][4 * rg + 1] * inv), x1 = cvtpk(oT[d0][4 * rg + 2] * inv, oT[d0][4 * rg + 3] * inv);
                unsigned y0 = cvtpk(oT[d0][4 * rg + 4] * inv, oT[d0][4 * rg + 5] * inv), y1 = cvtpk(oT[d0][4 * rg + 6] * inv, oT[d0][4 * rg + 7] * inv);
                const auto s0 = __builtin_amdgcn_permlane32_swap(x0, y0, false, false); const auto s1 = __builtin_amdgcn_permlane32_swap(x1, y1, false, false);
                u32x4 wv; wv.x = s0[0]; wv.y = s1[0]; wv.z = s0[1]; wv.w = s1[1];
                *(u32x4*)(orow + 32 * d0 + 16 * rp + 8 * hi) = wv;
            }
        if (hi == 0) lse[tok * 24 + me.g * 8 + me.hh] = (m + __builtin_amdgcn_logf(lt)) * LN2;
        __syncthreads();
    }
    }
#undef ATT_ISSUE
}
}

using pg8::Unit; using pg8::BM; using pg8::HALF;
struct EpiQKV {
    static constexpr bool PERM = true;
    bf16* O; const float* cs; float sc;
    __device__ __forceinline__ void operator()(const f32x4 (&acc)[2][2][4][2], const Unit& u, int wr, int wc, int fr, int fq) const {
        const int colt = u.pn * BM; const int kind = (colt % 1536) / 512;
        const bool rot = (kind < 2) && ((wc & 1) == 0) && (fq < 2);
#pragma unroll
        for (int ai = 0; ai < 2; ++ai)
#pragma unroll
            for (int m = 0; m < 4; ++m) {
                const int row = u.pm * BM + ai * HALF + wr * 64 + m * 16 + fr;
                f32x4 c0 = {1.f, 0.f, 1.f, 0.f}, c1 = {1.f, 0.f, 1.f, 0.f};
                if (rot) { c0 = *(const f32x4*)(cs + (size_t)row * 16 + fq * 8); c1 = *(const f32x4*)(cs + (size_t)row * 16 + fq * 8 + 4); }
                bf16* rowp = O + (size_t)row * QKVW + colt + wc * 32 + 8 * fq;
#pragma unroll
                for (int bj = 0; bj < 2; ++bj) {
                    f32x4 v0 = acc[ai][bj][m][0] * sc, v1 = acc[ai][bj][m][1] * sc;
                    f32x4 o0, o1;
                    o0.x = v0.x * c0.x - v0.y * c0.y; o0.y = v0.y * c0.x + v0.x * c0.y; o0.z = v0.z * c0.z - v0.w * c0.w; o0.w = v0.w * c0.z + v0.z * c0.w;
                    o1.x = v1.x * c1.x - v1.y * c1.y; o1.y = v1.y * c1.x + v1.x * c1.y; o1.z = v1.z * c1.z - v1.w * c1.w; o1.w = v1.w * c1.z + v1.z * c1.w;
                    u32x4 w; w.x = cvtpk(o0.x, o0.y); w.y = cvtpk(o0.z, o0.w); w.z = cvtpk(o1.x, o1.y); w.w = cvtpk(o1.z, o1.w);
                    *(u32x4*)(rowp + bj * HALF) = w;
                }
                if (m & 1) asm volatile("" ::: "memory");
            }
    }
};
struct EpiBf16 {
    static constexpr bool PERM = true;
    bf16* O; int ldc;
    __device__ __forceinline__ void operator()(const f32x4 (&acc)[2][2][4][2], const Unit& u, int wr, int wc, int fr, int fq) const {
#pragma unroll
        for (int ai = 0; ai < 2; ++ai)
#pragma unroll
            for (int m = 0; m < 4; ++m) {
                bf16* rowp = O + (size_t)(u.pm * BM + ai * HALF + wr * 64 + m * 16 + fr) * ldc + u.pn * BM + wc * 32 + 8 * fq;
#pragma unroll
                for (int bj = 0; bj < 2; ++bj) { const f32x4 v0 = acc[ai][bj][m][0], v1 = acc[ai][bj][m][1];
                    u32x4 w; w.x = cvtpk(v0.x, v0.y); w.y = cvtpk(v0.z, v0.w); w.z = cvtpk(v1.x, v1.y); w.w = cvtpk(v1.z, v1.w);
                    *(u32x4*)(rowp + bj * HALF) = w; }
            }
    }
};
template <bool RES32>
struct EpiResBf16 {
    static constexpr bool PERM = true;
    const void* res; bf16* out;
    __device__ __forceinline__ void operator()(const f32x4 (&acc)[2][2][4][2], const Unit& u, int wr, int wc, int fr, int fq) const {
#pragma unroll
        for (int ai = 0; ai < 2; ++ai)
#pragma unroll
            for (int m = 0; m < 4; ++m) {
                const size_t off = (size_t)(u.pm * BM + ai * HALF + wr * 64 + m * 16 + fr) * D + u.pn * BM + wc * 32 + 8 * fq;
#pragma unroll
                for (int bj = 0; bj < 2; ++bj) {
                    f32x4 r0, r1;
                    if constexpr (RES32) { r0 = *(const f32x4*)((const float*)res + off + bj * HALF); r1 = *(const f32x4*)((const float*)res + off + bj * HALF + 4); }
                    else { const u32x4 rw = *(const u32x4*)((const bf16*)res + off + bj * HALF); r0 = (f32x4){bf_lo(rw.x), bf_hi(rw.x), bf_lo(rw.y), bf_hi(rw.y)}; r1 = (f32x4){bf_lo(rw.z), bf_hi(rw.z), bf_lo(rw.w), bf_hi(rw.w)}; }
                    const f32x4 v0 = r0 + acc[ai][bj][m][0], v1 = r1 + acc[ai][bj][m][1];
                    u32x4 w; w.x = cvtpk(v0.x, v0.y); w.y = cvtpk(v0.z, v0.w); w.z = cvtpk(v1.x, v1.y); w.w = cvtpk(v1.z, v1.w);
                    *(u32x4*)(out + off + bj * HALF) = w;
                }
                if (m & 1) asm volatile("" ::: "memory");
            }
    }
};
template <bool OUT8>
struct EpiSwiGLU {
    static constexpr bool PERM = true;
    void* O; float sc;
    __device__ __forceinline__ void operator()(const f32x4 (&acc)[2][2][4][2], const Unit& u, int wr, int wc, int fr, int fq) const {
#pragma unroll
        for (int ai = 0; ai < 2; ++ai)
#pragma unroll
            for (int m = 0; m < 4; ++m) {
                const size_t eoff = (size_t)(u.pm * BM + ai * HALF + wr * 64 + m * 16 + fr) * DE + u.pn * HALF + wc * 32 + 8 * fq;
                float h[8];
#pragma unroll
                for (int n = 0; n < 2; ++n)
#pragma unroll
                    for (int e = 0; e < 4; ++e) { const float a = acc[ai][0][m][n][e] * sc, b = acc[ai][1][m][n][e] * sc;
                        h[n * 4 + e] = a * __builtin_amdgcn_rcpf(1.0f + __builtin_amdgcn_exp2f(-1.4426950408889634f * a)) * b; }
                if constexpr (OUT8) { u32x2 w; w.x = pack_fp8x4(h[0] * 16.f, h[1] * 16.f, h[2] * 16.f, h[3] * 16.f); w.y = pack_fp8x4(h[4] * 16.f, h[5] * 16.f, h[6] * 16.f, h[7] * 16.f); *(u32x2*)((unsigned char*)O + eoff) = w; }
                else { u32x4 w; w.x = cvtpk(h[0], h[1]); w.y = cvtpk(h[2], h[3]); w.z = cvtpk(h[4], h[5]); w.w = cvtpk(h[6], h[7]); *(u32x4*)((bf16*)O + eoff) = w; }
            }
    }
};
struct EpiGate {
    static constexpr bool PERM = true;
    bf16* O; const float* gatel; const int* cnt; const LAS int* tb; float sc;
    __device__ __forceinline__ void operator()(const f32x4 (&acc)[2][2][4][2], const Unit& u, int wr, int wc, int fr, int fq) const {
        int e = 0;
#pragma unroll
        for (int k = 1; k < NE; ++k) e += (u.pm >= tb[k]) ? 1 : 0;
        const int lbase = (u.pm - tb[e]) * BM, n_e = cnt[e];
#pragma unroll
        for (int ai = 0; ai < 2; ++ai)
#pragma unroll
            for (int m = 0; m < 4; ++m) {
                const int rl = ai * HALF + wr * 64 + m * 16 + fr, li = lbase + rl;
                const float gt = (li < n_e) ? gatel[(size_t)e * T + li] * sc : 0.f;
                bf16* rowp = O + (size_t)(u.pm * BM + rl) * D + u.pn * BM + wc * 32 + 8 * fq;
#pragma unroll
                for (int bj = 0; bj < 2; ++bj) { const f32x4 v0 = acc[ai][bj][m][0] * gt, v1 = acc[ai][bj][m][1] * gt;
                    u32x4 w; w.x = cvtpk(v0.x, v0.y); w.y = cvtpk(v0.z, v0.w); w.z = cvtpk(v1.x, v1.y); w.w = cvtpk(v1.z, v1.w);
                    *(u32x4*)(rowp + bj * HALF) = w; }
            }
    }
};

template <bool F8_>
struct MoeProb1T {
    static constexpr bool F8 = F8_;
    const void* A; const void* Bt; int K; const LAS int* tb; const LAS unsigned* aofs;
    __device__ __forceinline__ void a_offs(int i, const Unit&, const int (&R)[2], const int (&C)[2], unsigned (&o0)[2], unsigned (&o1)[2]) const {
#pragma unroll
        for (int k = 0; k < 2; ++k) { o0[k] = aofs[i * 256 + R[k]] + (unsigned)C[k] * 2u; o1[k] = aofs[i * 256 + 128 + R[k]] + (unsigned)C[k] * 2u; }
    }
    __device__ __forceinline__ unsigned b_off(const Unit& u) const {
        int e = 0;
#pragma unroll
        for (int k = 1; k < NE; ++k) e += (u.pm >= tb[k]) ? 1 : 0;
        return (unsigned)((e * 1024 + u.pn * 256) * 1024 * (F8 ? 1 : 2));
    }
};
template <bool F8_>
struct MoeProb2T {
    static constexpr bool F8 = F8_;
    const void* A; const void* Bt; int K; const LAS int* tb;
    __device__ __forceinline__ void a_offs(int, const Unit& u, const int (&R)[2], const int (&C)[2], unsigned (&o0)[2], unsigned (&o1)[2]) const {
        constexpr int esz = F8 ? 1 : 2;
#pragma unroll
        for (int k = 0; k < 2; ++k) { const unsigned b = (unsigned)((u.pm * BM + R[k]) * DE * esz + C[k] * 2); o0[k] = b; o1[k] = b + (unsigned)(HALF * DE * esz); }
    }
    __device__ __forceinline__ unsigned b_off(const Unit& u) const {
        int e = 0;
#pragma unroll
        for (int k = 1; k < NE; ++k) e += (u.pm >= tb[k]) ? 1 : 0;
        return (unsigned)((e * 1024 + u.pn * 256) * DE * (F8 ? 1 : 2));
    }
};
struct FoldOrder { int G, c; __device__ bool next(int i, Unit& u) const { const int L = i * G + c; if (L >= 16) return false; u.pm = L >> 2; u.pn = L & 3; return true; } };


#define XB_TMO      128
#define XB_XCNT(j)  (256  + 64 * (j))
#define XB_XSUB(j)  (1280 + 64 * (j))
#define XB_XGEN(j)  (2304 + 64 * (j))
#define XB_TOP      3328
#define XB_TOPGEN   3392
#define XCD_BAR_WORDS 3456
#define XB_SPIN_CAP (1u << 18)
__device__ __forceinline__ unsigned xb_ld(unsigned* p)              { return __hip_atomic_load(p, __ATOMIC_RELAXED, __HIP_MEMORY_SCOPE_AGENT); }
__device__ __forceinline__ unsigned xb_add(unsigned* p, unsigned v) { return __hip_atomic_fetch_add(p, v, __ATOMIC_RELAXED, __HIP_MEMORY_SCOPE_AGENT); }
__device__ __forceinline__ unsigned xb_xcc_id() { return (unsigned)__builtin_amdgcn_s_getreg((3 << 11) | 20) & 0xFu; }
#define XB_SPIN(cond, bar) do { unsigned _sp = 0; while (cond) { __builtin_amdgcn_s_sleep(1); \
    if ((++_sp & 255u) == 0u) { if (xb_ld(&(bar)[XB_TMO])) break; if (_sp > XB_SPIN_CAP) { atomicAdd(&(bar)[XB_TMO], 1u); break; } } } } while (0)
struct XcdBarrier { unsigned* bar; unsigned x; volatile LAS unsigned* st; };
__device__ __forceinline__ XcdBarrier xcd_barrier_post(unsigned* bar, volatile LAS unsigned* st) {
    XcdBarrier b; b.bar = bar; b.x = xb_xcc_id(); b.st = st;
    if (threadIdx.x == 0) (void)xb_add(&bar[XB_XCNT(b.x)], 1u);
    return b;
}
__device__ __forceinline__ void xcd_barrier_complete(unsigned* bar, unsigned x, unsigned& nloc, unsigned& nx) {
    const unsigned G = gridDim.x * gridDim.y * gridDim.z;
    unsigned sum, cnt, mine, sp = 0u;
    for (;;) {
        sum = 0u; cnt = 0u; mine = 0u;
#pragma unroll
        for (unsigned j = 0; j < 16; ++j) { const unsigned c = xb_ld(&bar[XB_XCNT(j)]); sum += c; cnt += (c > 0u) ? 1u : 0u; mine = (j == x) ? c : mine; }
        if (sum == G) break;
        __builtin_amdgcn_s_sleep(1);
        if ((++sp & 255u) == 0u) { if (xb_ld(&bar[XB_TMO])) break; if (sp > XB_SPIN_CAP) { atomicAdd(&bar[XB_TMO], 1u); break; } }
    }
    nloc = mine > 0u ? mine : 1u; nx = cnt > 0u ? cnt : 1u;
}
__device__ __forceinline__ void xcd_barrier(const XcdBarrier& b) {
    asm volatile("s_waitcnt vmcnt(0)" ::: "memory");
    __syncthreads();
    if (threadIdx.x == 0) {
        unsigned* bar = b.bar;
        __builtin_amdgcn_s_waitcnt(0);
        unsigned nloc = b.st[0], nx = b.st[1];
        if (nloc == 0u) { xcd_barrier_complete(bar, b.x, nloc, nx); b.st[0] = nloc; b.st[1] = nx; }
        const unsigned old = xb_add(&bar[XB_XSUB(b.x)], 1u);
        const unsigned gen = old / nloc;
        if (old + 1u == (gen + 1u) * nloc) {
            __builtin_amdgcn_fence(__ATOMIC_RELEASE, "agent");
            asm volatile("s_waitcnt vmcnt(0)" ::: "memory");
            const unsigned og = xb_add(&bar[XB_TOP], 1u);
            const unsigned tg = og / nx;
            if (og + 1u == (tg + 1u) * nx) xb_add(&bar[XB_TOPGEN], 1u);
            else XB_SPIN(xb_ld(&bar[XB_TOPGEN]) == tg, bar);
            __builtin_amdgcn_fence(__ATOMIC_ACQUIRE, "agent");
            xb_add(&bar[XB_XGEN(b.x)], 1u);
            asm volatile("s_waitcnt vmcnt(0)" ::: "memory");
        } else {
            XB_SPIN(xb_ld(&bar[XB_XGEN(b.x)]) == gen, bar);
            __builtin_amdgcn_fence(__ATOMIC_ACQUIRE, "agent");
            asm volatile("s_waitcnt vmcnt(0)" ::: "memory");
        }
    }
    __syncthreads();
}

constexpr int N_PHASES = 16;

typedef const __attribute__((address_space(4))) Params* KParamsPtr;
__device__ __forceinline__ KParamsPtr kparams() { KParamsPtr q = (KParamsPtr)__builtin_amdgcn_kernarg_segment_ptr(); asm volatile("" : "+s"(q)); return q; }
__global__ void __launch_bounds__(NTHREADS, 2) fwd_kernel(Params p) {
    extern __shared__ __attribute__((aligned(16))) unsigned char lds_raw[];
    LAS unsigned char* lds = (LAS unsigned char*)lds_raw;
    const int tid = threadIdx.x, lane = tid & 63, wave = __builtin_amdgcn_readfirstlane(tid >> 6);
    const int G = gridDim.x, bx = blockIdx.x;
    const int vcu = (G % 8 == 0) ? (bx % 8) * (G / 8) + bx / 8 : bx;
#define KP() kparams()
#define WSB() ((unsigned char*)KP()->ws)
#define G_ctl ((int*)(WSB() + WS_CTL))
#define G_cs ((float*)(WSB() + WS_CS))
#define G_lse ((float*)(WSB() + WS_LSE))
#define G_slotref ((int*)(WSB() + WS_SLOTREF))
#define Wgs ((bf16*)(WSB() + WS_WGS))
#define G_list ((int*)(WSB() + WS_LIST))
#define G_gatel ((float*)(WSB() + WS_GATEL))
#define Win_t ((bf16*)(WSB() + WS_WIN))
#define Wout_t ((bf16*)(WSB() + WS_WOUT))
#define Wpin_t ((bf16*)(WSB() + WS_WPIN))
#define Wc_t ((bf16*)(WSB() + WS_WC))
#define Wpo_t ((bf16*)(WSB() + WS_WPO))
#define W13 ((bf16*)(WSB() + WS_W13))
#define W2 ((bf16*)(WSB() + WS_W2))
#define Y ((bf16*)(WSB() + WS_Y))
#define QKV ((bf16*)(WSB() + WS_BIG))
#define OM ((bf16*)(WSB() + WS_OM))
#define HMID ((bf16*)(WSB() + WS_HMID))
#define YS ((bf16*)(WSB() + WS_YS))
#define U ((bf16*)(WSB() + WS_U))
#define POOLED ((bf16*)(WSB() + WS_POOLED))
#define OG ((bf16*)KP()->out)
#define H ((bf16*)(WSB() + WS_H))
    LAS int* tb = (LAS int*)(lds + MISC_OFF);
    LAS unsigned* aofs = (LAS unsigned*)(lds + AOFS_OFF);

    const int lo = p.ph_lo, hi = p.ph_hi;
#if MK_N_LAUNCHES == 1
    cg::grid_group grid = cg::this_grid();
    if (tid < 2) ((volatile LAS unsigned*)(lds + MISC_OFF))[64 + tid] = 0u;
    __syncthreads();
    const XcdBarrier xbar = xcd_barrier_post((unsigned*)(G_ctl + CW_BAR), (volatile LAS unsigned*)(lds + MISC_OFF) + 64);
#define GRID_BAR(k) do { if ((k) == CG_SEAM) grid.sync(); else xcd_barrier(xbar); } while (0)
#else
#define GRID_BAR(k) do { } while (0)
#endif
#ifndef PHASE_MASK
#define PHASE_MASK 0xffff
#endif
#ifndef REPEAT_MASK
#define REPEAT_MASK 0x0
#endif
#define REP(k) for (int rep_ = 0; rep_ <= ((REPEAT_MASK >> (k)) & 1); ++rep_)
#define IN(k) (((PHASE_MASK >> (k)) & 1) && lo <= (k) && (k) < hi)
#ifndef DOUBLE_BAR
#define DOUBLE_BAR 0
#endif
#define SEAM(k) do { if (IN(k) && IN((k) + 1)) { _Pragma("unroll 1") for (int nb_ = 0; nb_ < 1 + (DOUBLE_BAR ? (hi > 0 ? 1 : 0) : 0); ++nb_) GRID_BAR(k); } } while (0)

    if (IN(0)) REP(0) {
        LAS float* scr = (LAS float*)(lds + wave * 16384);
        const int gw = vcu * NWAVES + wave, NGW = G * NWAVES;
        constexpr int I_IN = (D / 64) * (QKVW / 32);
        constexpr int I_OUT = (AW / 64) * (D / 32);
        constexpr int I_PIN = (D / 64) * (D / 32);
        constexpr int I_PO = I_PIN;
        constexpr int I_W1 = (D / 64) * (DE / 32);
        constexpr int I_W2 = (DE / 64) * (D / 32);
        constexpr int NITEMS = I_IN + I_OUT + I_PIN + I_PO + 32 * (2 * I_W1 + I_W2);
        for (int it = gw; it < NITEMS; it += NGW) {
            int r = it;
            if (r < I_IN) { const int nblk = QKVW / 32;
                if (FP8_QKV) transpose_item8(KP()->attn_w_in, QKVW, D, (unsigned char*)Win_t, MapQKV{}, 32.f, scr, 64 * (r / nblk), 32 * (r % nblk), lane);
                else transpose_item(KP()->attn_w_in, QKVW, D, Win_t, MapQKV{}, scr, 64 * (r / nblk), 32 * (r % nblk), lane);
                continue; } r -= I_IN;
            if (r < I_OUT) { const int nblk = D / 32; transpose_item(KP()->attn_w_out, D, AW, Wout_t, MapId{}, scr, 64 * (r / nblk), 32 * (r % nblk), lane); continue; } r -= I_OUT;
            if (r < I_PIN) { const int nblk = D / 32; transpose_item(KP()->pool_w_in, D, D, Wpin_t, MapId{}, scr, 64 * (r / nblk), 32 * (r % nblk), lane); continue; } r -= I_PIN;
            if (r < I_PO) { const int nblk = D / 32; transpose_item(KP()->pool_w_out, D, D, Wpo_t, MapId{}, scr, 64 * (r / nblk), 32 * (r % nblk), lane); continue; } r -= I_PO;
            const int le = r / (2 * I_W1 + I_W2); r -= le * (2 * I_W1 + I_W2);
            if (r < I_W1) { const int nblk = DE / 32;
                if (FP8_MOE1) transpose_item8(KP()->expert_w1 + (size_t)le * D * DE, DE, D, (unsigned char*)W13 + (size_t)le * 1024 * 1024, MapW13{0}, 32.f, scr, 64 * (r / nblk), 32 * (r % nblk), lane);
                else transpose_item(KP()->expert_w1 + (size_t)le * D * DE, DE, D, W13 + (size_t)le * 1024 * 1024, MapW13{0}, scr, 64 * (r / nblk), 32 * (r % nblk), lane);
                continue; } r -= I_W1;
            if (r < I_W1) { const int nblk = DE / 32;
                if (FP8_MOE1) transpose_item8(KP()->expert_w3 + (size_t)le * D * DE, DE, D, (unsigned char*)W13 + (size_t)le * 1024 * 1024, MapW13{128}, 32.f, scr, 64 * (r / nblk), 32 * (r % nblk), lane);
                else transpose_item(KP()->expert_w3 + (size_t)le * D * DE, DE, D, W13 + (size_t)le * 1024 * 1024, MapW13{128}, scr, 64 * (r / nblk), 32 * (r % nblk), lane);
                continue; } r -= I_W1;
            { const int nblk = D / 32;
                if (FP8_MOE2) transpose_item8(KP()->expert_w2 + (size_t)le * DE * D, D, DE, (unsigned char*)W2 + (size_t)le * 1024 * DE, MapId{}, 32.f, scr, 64 * (r / nblk), 32 * (r % nblk), lane);
                else transpose_item(KP()->expert_w2 + (size_t)le * DE * D, D, DE, W2 + (size_t)le * 1024 * DE, MapId{}, scr, 64 * (r / nblk), 32 * (r % nblk), lane); }
        }
        for (int i = vcu * NTHREADS + tid; i < 4 * 256 * 256 / 4; i += G * NTHREADS) {
            const int e4 = (i & 63) * 4, gidx = i >> 14;
            const f32x4 wv = *(const f32x4*)(KP()->pool_w_group + (size_t)i * 4); const f32x4 sc = *(const f32x4*)(KP()->pool_scale + gidx * 256 + e4);
            u32x2 o; o.x = cvtpk(wv.x * sc.x, wv.y * sc.y); o.y = cvtpk(wv.z * sc.z, wv.w * sc.w); *(u32x2*)(Wgs + (size_t)i * 4) = o;
        }
        for (int i = vcu * NTHREADS + tid; i < T * 8; i += G * NTHREADS) {
            const int tok = i >> 3, f = i & 7;
            const double invf = exp2(-(double)f * 0.125 * 18.931568569324174);
            const float ang = (float)KP()->positions[tok] * (float)invf;
            double sn, cn; sincos((double)ang, &sn, &cn);
            G_cs[(size_t)i * 2] = (float)cn; G_cs[(size_t)i * 2 + 1] = (float)sn;
        }
        RowPassCfg c{}; c.hin = KP()->x; c.gain = KP()->norm_mix; if (FP8_QKV) c.yout8 = (unsigned char*)Y; else c.yout = Y;
        row_pass<false, false, false>(lds, c, vcu, wave);
    }
    SEAM(0);
    if (IN(1)) REP(1) {
        pg8::DenseProbT<FP8_QKV != 0> P{Y, Win_t, D, D, 0, (size_t)256 * D};
        pg8::StaticOrder S; S.init(T / 256, QKVW / 256, G, bx);
        EpiQKV E{QKV, G_cs, FP8_QKV ? (1.0f / 32.0f) : 1.0f};
        pg8::gemm_phase<pg8::DenseProbT<FP8_QKV != 0>, EpiQKV, pg8::StaticOrder, true>(lds, P, S, E);
    }
    SEAM(1);
    if (IN(2)) REP(2) {
#ifndef ATT_PROBE_MODE
#define ATT_PROBE_MODE 0
#endif
        if (ATT_PROBE_MODE == 1) att::attn_phase<1>(lds, QKV, OG, G_lse, vcu, G);
        if (ATT_PROBE_MODE == 2) att::attn_phase<2>(lds, QKV, OG, G_lse, vcu, G);
        att::attn_phase<0>(lds, QKV, OG, G_lse, vcu, G);
        pg8::DenseProb P{Wpo_t, Wgs, 256, D, 256, (size_t)256 * 256};
        FoldOrder S{G, bx};
        EpiBf16 E{Wc_t, D};
        pg8::gemm_phase<pg8::DenseProb, EpiBf16, FoldOrder, true>(lds, P, S, E);
    }
    SEAM(2);
    if (IN(3)) REP(3) {
        for (int row = vcu * NWAVES + wave; row < T; row += G * NWAVES) {
            const int h = lane >> 3;
            const float l0 = G_lse[(size_t)row * 24 + h], l1 = G_lse[(size_t)row * 24 + 8 + h], l2 = G_lse[(size_t)row * 24 + 16 + h];
            const float mx = fmaxf(l0, fmaxf(l1, l2));
            float w0 = __expf(l0 - mx), w1 = __expf(l1 - mx), w2 = __expf(l2 - mx); const float inv = 1.0f / (w0 + w1 + w2); w0 *= inv; w1 *= inv; w2 *= inv;
            const bf16* src = OG + (size_t)row * 1536 + lane * 8;
            const u32x4 a = *(const u32x4*)(src), b = *(const u32x4*)(src + 512), c = *(const u32x4*)(src + 1024);
            u32x4 o;
#pragma unroll
            for (int k = 0; k < 4; ++k) { const float lo_ = w0 * bf_lo(a[k]) + w1 * bf_lo(b[k]) + w2 * bf_lo(c[k]), hi_ = w0 * bf_hi(a[k]) + w1 * bf_hi(b[k]) + w2 * bf_hi(c[k]); o[k] = cvtpk(lo_, hi_); }
            *(u32x4*)(OM + (size_t)row * AW + lane * 8) = o;
        }
    }
    SEAM(3);
    if (IN(4)) REP(4) {
        pg8::DenseProb P{OM, Wout_t, AW, AW, 0, (size_t)256 * AW};
        pg8::StaticOrder S; S.init(T / 256, D / 256, G, bx);
        EpiResBf16<true> E{KP()->x, H};
        pg8::gemm_phase<pg8::DenseProb, EpiResBf16<true>, pg8::StaticOrder, true>(lds, P, S, E);
    }
    SEAM(4);
#pragma unroll 1
    for (int L = 0; L < 2; ++L) {
        const int pb = (L == 0) ? 5 : 12;
        int* cnt = G_ctl + CW_CNT + L * NE;
        if (IN(pb)) {
            RowPassCfg c{}; c.hin16 = H; c.gain = KP()->norm_ffn + L * D; if (FP8_MOE1) c.yout8 = (unsigned char*)Y; else c.yout = Y;
            c.rgw = KP()->router_group_w + (size_t)L * D * 4; c.rgb = KP()->router_group_b + L * 4; c.rew = KP()->router_expert_w + (size_t)L * 4 * D * 4; c.reb = KP()->router_expert_b + L * 16;
            c.cnt = cnt; c.list = G_list + (size_t)L * NE * T; c.gatel = G_gatel + (size_t)L * NE * T; c.slotref_out = G_slotref + (size_t)L * T * 2;
            if ((REPEAT_MASK >> pb) & 1) {
                RowPassCfg c2 = c; c2.cnt = G_ctl + 64 + L * NE; c2.list = (int*)(WSB() + WS_BIG + 200 * MiB); c2.gatel = (float*)(WSB() + WS_BIG + 204 * MiB); c2.slotref_out = (int*)(WSB() + WS_BIG + 208 * MiB);
                row_pass<false, true, true>(lds, c2, vcu, wave);
            }
            row_pass<false, true, true>(lds, c, vcu, wave);
        }
        SEAM(pb);
        if (IN(pb + 1) || IN(pb + 2)) {
            if (tid == 0) { int s = 0; for (int e = 0; e < NE; ++e) { tb[e] = s; tb[32 + e] = cnt[e]; s += (cnt[e] + 255) >> 8; } tb[NE] = s; }
            __syncthreads();
        }
        if (IN(pb + 1)) REP(pb + 1) {
            const int NT = tb[NE];
            pg8::StaticOrder S; S.init(NT, 4, G, bx);
            for (int i = 0; i < 8; ++i) { Unit u; if (!S.next(i, u)) break;
                int e = 0;
                for (int k = 1; k < NE; ++k) e += (u.pm >= tb[k]) ? 1 : 0;
                if (tid < 256) { const int li = (u.pm - tb[e]) * 256 + tid; const int tok = (li < tb[32 + e]) ? G_list[((size_t)L * NE + e) * T + li] : 0; aofs[i * 256 + tid] = (unsigned)tok * (unsigned)(D * (FP8_MOE1 ? 1 : 2)); } }
            __syncthreads();
            MoeProb1T<FP8_MOE1 != 0> P{Y, (const unsigned char*)W13 + (size_t)L * NE * 1024 * 1024 * (FP8_MOE1 ? 1 : 2), D, tb, aofs};
            EpiSwiGLU<FP8_MOE2 != 0> E{HMID, FP8_MOE1 ? (1.0f / 32.0f) : 1.0f};
            pg8::gemm_phase<MoeProb1T<FP8_MOE1 != 0>, EpiSwiGLU<FP8_MOE2 != 0>, pg8::StaticOrder, true>(lds, P, S, E);
        }
        SEAM(pb + 1);
        if (IN(pb + 2)) REP(pb + 2) {
            const int NT = tb[NE];
            pg8::StaticOrder S; S.init(NT, 4, G, bx);
            MoeProb2T<FP8_MOE2 != 0> P{HMID, (const unsigned char*)W2 + (size_t)L * NE * 1024 * DE * (FP8_MOE2 ? 1 : 2), DE, tb};
            EpiGate E{YS, G_gatel + (size_t)L * NE * T, cnt, tb, FP8_MOE2 ? (1.0f / 512.0f) : 1.0f};
            pg8::gemm_phase<MoeProb2T<FP8_MOE2 != 0>, EpiGate, pg8::StaticOrder, true>(lds, P, S, E);
        }
        SEAM(pb + 2);
        if (L == 0) {
            if (IN(8)) {
                RowPassCfg c{}; c.hin16 = H; c.ys = YS; c.slotref = G_slotref; c.cnt_prev = cnt; c.hout = H; c.gain = KP()->norm_mix + D; c.yout = Y;
                if ((REPEAT_MASK >> 8) & 1) { RowPassCfg c2 = c; c2.hout = nullptr; row_pass<true, false, true>(lds, c2, vcu, wave); }
                row_pass<true, false, true>(lds, c, vcu, wave);
            }
            SEAM(8);
            if (IN(9)) REP(9) {
                pg8::DenseProb P{Y, Wpin_t, D, D, 0, (size_t)256 * D};
                pg8::StaticOrder S; S.init(T / 256, D / 256, G, bx);
                EpiBf16 E{U, D};
                pg8::gemm_phase<pg8::DenseProb, EpiBf16, pg8::StaticOrder, true>(lds, P, S, E);
            }
            SEAM(9);
            if (IN(10)) REP(10) {
                for (int it = vcu * NTHREADS + tid; it < (T / 32) * 128; it += G * NTHREADS) {
                    const int ch = (it & 127) * 8, run = it >> 7, t0 = run * 32, s0 = t0 & (SEQ - 1);
                    const int wdw = 2 << (ch >> 8);
                    float sum[8];
#pragma unroll
                    for (int k = 0; k < 8; ++k) sum[k] = 0.f;
                    for (int i = 1; i < wdw; ++i) { if (s0 - i < 0) break; const u32x4 a = *(const u32x4*)(U + (size_t)(t0 - i) * D + ch);
#pragma unroll
                        for (int k = 0; k < 4; ++k) { sum[2 * k] += bf_lo(a[k]); sum[2 * k + 1] += bf_hi(a[k]); } }
                    for (int i = 0; i < 32; ++i) {
                        const int tk = t0 + i, s = s0 + i;
                        const u32x4 a = *(const u32x4*)(U + (size_t)tk * D + ch);
                        float cur[8];
#pragma unroll
                        for (int k = 0; k < 4; ++k) { cur[2 * k] = bf_lo(a[k]); cur[2 * k + 1] = bf_hi(a[k]); }
#pragma unroll
                        for (int k = 0; k < 8; ++k) sum[k] += cur[k];
                        const float invc = 1.0f / (float)((s + 1) < wdw ? (s + 1) : wdw);
                        u32x4 w;
#pragma unroll
                        for (int k = 0; k < 4; ++k) w[k] = cvtpk(sum[2 * k] * invc - cur[2 * k], sum[2 * k + 1] * invc - cur[2 * k + 1]);
                        *(u32x4*)(POOLED + (size_t)tk * D + ch) = w;
                        if (s - wdw + 1 >= 0) { const u32x4 o = *(const u32x4*)(U + (size_t)(tk - wdw + 1) * D + ch);
#pragma unroll
                            for (int k = 0; k < 4; ++k) { sum[2 * k] -= bf_lo(o[k]); sum[2 * k + 1] -= bf_hi(o[k]); } }
                    }
                }
            }
            SEAM(10);
            if (IN(11)) REP(11) {
                pg8::DenseProb P{POOLED, Wc_t, D, D, 0, (size_t)256 * D};
                pg8::StaticOrder S; S.init(T / 256, D / 256, G, bx);
                EpiResBf16<false> E{H, (((REPEAT_MASK >> 11) & 1) && rep_ == 0) ? (bf16*)(WSB() + WS_BIG + 136 * MiB) : H};
                pg8::gemm_phase<pg8::DenseProb, EpiResBf16<false>, pg8::StaticOrder, true>(lds, P, S, E);
            }
            SEAM(11);
        }
    }
    if (IN(15)) {
        RowPassCfg c{}; c.hin16 = H; c.ys = YS; c.slotref = G_slotref + (size_t)T * 2; c.cnt_prev = G_ctl + CW_CNT + NE; c.gain = KP()->norm_final; c.fout = KP()->out;
        if ((REPEAT_MASK >> 15) & 1) { RowPassCfg c2 = c; c2.fout = nullptr; c2.yout = Y; row_pass<true, false, true>(lds, c2, vcu, wave); }
        row_pass<true, false, true>(lds, c, vcu, wave);
    }
#undef IN
#undef SEAM
#undef GRID_BAR
}

#undef KP
#undef WSB
#undef G_ctl
#undef G_cs
#undef G_lse
#undef G_slotref
#undef Wgs
#undef G_list
#undef G_gatel
#undef Win_t
#undef Wout_t
#undef Wpin_t
#undef Wc_t
#undef Wpo_t
#undef W13
#undef W2
#undef Y
#undef QKV
#undef OM
#undef HMID
#undef YS
#undef U
#undef POOLED
#undef OG
#undef H
extern "C" void kernel_launch(void* const* d_in, const int* in_sizes, int n_in, void* d_out, int out_size, void* d_ws, size_t ws_size, hipStream_t stream) {
    static int grid = 0;
    if (grid == 0) {
        if (n_in != 18 || in_sizes[0] != T * D || out_size != T * D || ws_size < WS_END) { fprintf(stderr, "kernel_launch: unexpected shapes (n_in %d, in0 %d, out %d, ws %zu)\n", n_in, n_in > 0 ? in_sizes[0] : -1, out_size, ws_size); grid = -1; return; }
        int dev = 0, cus = 0, per_cu = 0;
        if (hipGetDevice(&dev) != hipSuccess || hipDeviceGetAttribute(&cus, hipDeviceAttributeMultiprocessorCount, dev) != hipSuccess) { grid = -1; return; }
        if (hipFuncSetAttribute((const void*)fwd_kernel, hipFuncAttributeMaxDynamicSharedMemorySize, LDS_BYTES) != hipSuccess) { fprintf(stderr, "kernel_launch: hipFuncSetAttribute failed\n"); grid = -1; return; }
        if (hipOccupancyMaxActiveBlocksPerMultiprocessor(&per_cu, (const void*)fwd_kernel, NTHREADS, LDS_BYTES) != hipSuccess || per_cu < 1) { fprintf(stderr, "kernel_launch: occupancy query says %d\n", per_cu); per_cu = 1; }
        (void)hipGetLastError();
        grid = cus;
    }
    if (grid < 0) return;
    (void)hipMemsetAsync((char*)d_ws + WS_CTL, 0, CTL_ZERO_BYTES, stream);
    Params p{};
    p.x = (const float*)d_in[0]; p.positions = (const int*)d_in[1]; p.norm_mix = (const float*)d_in[2]; p.norm_ffn = (const float*)d_in[3]; p.norm_final = (const float*)d_in[4];
    p.attn_w_in = (const float*)d_in[5]; p.attn_w_out = (const float*)d_in[6]; p.pool_w_in = (const float*)d_in[7]; p.pool_w_group = (const float*)d_in[8]; p.pool_scale = (const float*)d_in[9]; p.pool_w_out = (const float*)d_in[10];
    p.router_group_w = (const float*)d_in[11]; p.router_group_b = (const float*)d_in[12]; p.router_expert_w = (const float*)d_in[13]; p.router_expert_b = (const float*)d_in[14];
    p.expert_w1 = (const float*)d_in[15]; p.expert_w3 = (const float*)d_in[16]; p.expert_w2 = (const float*)d_in[17];
    p.out = (float*)d_out; p.ws = (unsigned char*)d_ws;
#if MK_N_LAUNCHES == 1
    p.ph_lo = 0; p.ph_hi = N_PHASES;
    void* args[] = {&p};
    hipError_t e = hipLaunchCooperativeKernel((const void*)fwd_kernel, dim3(grid), dim3(NTHREADS), args, LDS_BYTES, stream);
    if (e != hipSuccess) fprintf(stderr, "cooperative launch failed: %s (grid %d)\n", hipGetErrorString(e), grid);
#else
    for (int ph = 0; ph < N_PHASES; ++ph) {
        p.ph_lo = ph; p.ph_hi = ph + 1;
        hipLaunchKernelGGL(fwd_kernel, dim3(grid), dim3(NTHREADS), LDS_BYTES, stream, p);
    }
#endif
}
```

```cpp
#include <hip/hip_runtime.h>
#include <hip/hip_cooperative_groups.h>
#include <cstdio>
#include <cstdint>
namespace cg = cooperative_groups;

#ifndef MK_N_LAUNCHES
#define MK_N_LAUNCHES 1
#endif

#ifndef FP8_MOE1
#define FP8_MOE1 1
#endif
#ifndef FP8_MOE2
#define FP8_MOE2 1
#endif
#ifndef FP8_QKV
#define FP8_QKV 1
#endif
#define LAS __attribute__((address_space(3)))
#define GAS __attribute__((address_space(1)))
typedef unsigned short bf16;
typedef short bf16x8 __attribute__((ext_vector_type(8)));
typedef float f32x4 __attribute__((ext_vector_type(4)));
typedef float f32x2 __attribute__((ext_vector_type(2)));
typedef float f32x16 __attribute__((ext_vector_type(16)));
typedef unsigned u32x4 __attribute__((ext_vector_type(4)));
typedef unsigned u32x2 __attribute__((ext_vector_type(2)));
typedef short s16x4 __attribute__((ext_vector_type(4)));
typedef __bf16 bf16x2_t __attribute__((ext_vector_type(2)));
typedef int i32x4 __attribute__((ext_vector_type(4)));
typedef int i32x8 __attribute__((ext_vector_type(8)));

constexpr int BATCH = 16, SEQ = 2048, D = 1024, T = BATCH * SEQ;
constexpr int NG = 3, HPG = 8, HD = 64, AW = 512, QKVW = NG * 3 * AW;
constexpr int NE = 16, DE = 512, SLOTS = 2 * T;
constexpr int MAXTILES = SLOTS / 256 + NE;
constexpr float RMS_EPS = 1e-6f;
constexpr int NWAVES = 8, NTHREADS = 512;

constexpr size_t MiB = 1u << 20;
constexpr size_t WS_CTL = 0, CTL_ZERO_BYTES = 64 * 1024;
constexpr size_t WS_CS = 1 * MiB;
constexpr size_t WS_LSE = 3 * MiB;
constexpr size_t WS_SLOTREF = 6 * MiB;
constexpr size_t WS_WGS = 7 * MiB;
constexpr size_t WS_LIST = 8 * MiB;
constexpr size_t WS_GATEL = 12 * MiB;
constexpr size_t WS_WIN = 16 * MiB;
constexpr size_t WS_WOUT = 25 * MiB;
constexpr size_t WS_WPIN = 26 * MiB;
constexpr size_t WS_WC = 28 * MiB;
constexpr size_t WS_WPO = 30 * MiB;
constexpr size_t WS_W13 = 32 * MiB;
constexpr size_t WS_W2 = 96 * MiB;
constexpr size_t WS_Y = 128 * MiB;
constexpr size_t WS_BIG = 192 * MiB;
constexpr size_t WS_OM = WS_BIG;
constexpr size_t WS_HMID = WS_BIG;
constexpr size_t WS_YS = WS_BIG + 72 * MiB;
constexpr size_t WS_U = WS_BIG;
constexpr size_t WS_POOLED = WS_BIG + 64 * MiB;
constexpr size_t WS_H = WS_BIG + 208 * MiB;
constexpr size_t WS_END = WS_BIG + 288 * MiB;
constexpr int CW_CNT = 0;
constexpr int CW_BAR = 1024;
#ifndef CG_SEAM
#define CG_SEAM (-1)
#endif

constexpr int RING_BYTES = 131072;
constexpr int AOFS_OFF = RING_BYTES;
constexpr int MISC_OFF = AOFS_OFF + 8192;
constexpr int LDS_BYTES = 147456;

__device__ __forceinline__ unsigned cvtpk(float lo, float hi) { f32x2 v = {lo, hi}; bf16x2_t b = __builtin_convertvector(v, bf16x2_t); return __builtin_bit_cast(unsigned, b); }
__device__ __forceinline__ float clamp8(float v) { return __builtin_amdgcn_fmed3f(v, -448.0f, 448.0f); }
__device__ __forceinline__ unsigned pack_fp8x4(float a, float b, float c, float d) {
    int r = __builtin_amdgcn_cvt_pk_fp8_f32(clamp8(a), clamp8(b), 0, false); r = __builtin_amdgcn_cvt_pk_fp8_f32(clamp8(c), clamp8(d), r, true); return (unsigned)r; }
__device__ __forceinline__ float bf_lo(unsigned u) { return __uint_as_float(u << 16); }
__device__ __forceinline__ float bf_hi(unsigned u) { return __uint_as_float(u & 0xffff0000u); }
#define DPP_ADD(v, ctrl) ((v) + __builtin_bit_cast(float, __builtin_amdgcn_update_dpp(0, __builtin_bit_cast(int, (v)), (ctrl), 0xF, 0xF, true)))
__device__ __forceinline__ float wave_sum(float v) {
    v = DPP_ADD(v, 0xB1);
    v = DPP_ADD(v, 0x4E);
    v = DPP_ADD(v, 0x141);
    v = DPP_ADD(v, 0x140);
    const int vi = __builtin_bit_cast(int, v);
    const float r0 = __builtin_bit_cast(float, __builtin_amdgcn_readlane(vi, 0)), r1 = __builtin_bit_cast(float, __builtin_amdgcn_readlane(vi, 16));
    const float r2 = __builtin_bit_cast(float, __builtin_amdgcn_readlane(vi, 32)), r3 = __builtin_bit_cast(float, __builtin_amdgcn_readlane(vi, 48));
    return (r0 + r1) + (r2 + r3);
}

namespace pg8 {
constexpr int BM = 256, BK = 64, HALF = 128, HTB = HALF * BK * 2, STAGE_BYTES = 8 * HTB, NXCD = 8, WGM = 8;
__host__ __device__ __forceinline__ int lds_byte(int r, int c) { const int st = (r >> 4) * 2 + (c >> 5), rr = r & 15, cc = c & 31, ob = rr * 64 + cc * 2; return st * 1024 + (ob ^ (((ob >> 9) & 1) << 5)); }
__host__ __device__ __forceinline__ void stage_rc(int b, int& R, int& C) { const int st = b / 1024, sb = b % 1024, swz = sb ^ (((sb >> 9) & 1) << 5); R = (st >> 1) * 16 + swz / 64; C = (st & 1) * 32 + (swz % 64) / 2; }
__host__ __device__ __forceinline__ int perm32(int rho) { const int n = rho >> 4, i = rho & 15; return 8 * (i >> 2) + 4 * n + (i & 3); }

struct Unit { int pm, pn; };

struct StaticOrder {
    int nM, nN, nwg, G, c;
    __device__ void init(int nM_, int nN_, int G_, int c_) { nM = nM_; nN = nN_; nwg = nM * nN; G = G_; c = c_; }
    __device__ bool next(int i, Unit& u) const {
        const long L = (long)i * G + c; if (L >= nwg) return false;
        int wgid = (int)L; { const int q = nwg / NXCD, r = nwg % NXCD, xcd = wgid % NXCD, off = wgid / NXCD; wgid = (xcd < r ? xcd * (q + 1) : r * (q + 1) + (xcd - r) * q) + off; }
        const int nig = WGM * nN, gid = wgid / nig, fm = gid * WGM, gsz = (nM - fm) < WGM ? (nM - fm) : WGM;
        u.pm = fm + ((wgid % nig) % gsz); u.pn = (wgid % nig) / gsz; return true;
    }
};

template <class Prob, class Epi, class Sched, bool ALIGN_EPI>
__device__ __forceinline__ void gemm_phase(LAS unsigned char* lds, const Prob& P, const Sched& S, const Epi& E) {
    int tid_ = threadIdx.x; asm volatile("" : "+v"(tid_));
    const int tid = tid_, wid = __builtin_amdgcn_readfirstlane(tid >> 6), lane = tid & 63, wr = wid >> 2, wc = wid & 3, fr = lane & 15, fq = lane >> 4;
    constexpr bool F8 = Prob::F8;
    const int Kb = P.K * (F8 ? 1 : 2), nt = Kb / (BK * 2);
    int Rr[2], Cc[2]; unsigned voffB[2];
#pragma unroll
    for (int i = 0; i < 2; ++i) { int R, C; stage_rc(tid * 16 + i * 8192, R, C); Rr[i] = R; Cc[i] = C; const int Rb = Epi::PERM ? ((R & ~31) + perm32(R & 31)) : R; voffB[i] = (unsigned)(Rb * Kb + C * 2); }
    const unsigned kstep = (unsigned)(BK * 2);
    const unsigned hstep = (unsigned)(HALF * Kb);
    const unsigned ldsw = (unsigned)wid * 1024u;
    const int aoff = lds_byte(wr * 64 + fr, fq * 8), boff = lds_byte(wc * 32 + fr, fq * 8);
    const __amdgpu_buffer_rsrc_t rsA = __builtin_amdgcn_make_buffer_rsrc((void*)P.A, 0, 0xFFFFFFFF, 0x00020000);
    const __amdgpu_buffer_rsrc_t rsB = __builtin_amdgcn_make_buffer_rsrc((void*)P.Bt, 0, 0xFFFFFFFF, 0x00020000);
#define PG8_SA(b, h) (((b) * 2 + (h)) * HTB)
#define PG8_SB(b, h) ((4 + (b) * 2 + (h)) * HTB)
#define PG8_STAGE_B(bufoff, sB) do { _Pragma("unroll") for (int _i = 0; _i < 2; ++_i) \
        __builtin_amdgcn_raw_ptr_buffer_load_lds(rsB, (LAS void*)(lds + (bufoff) + ldsw + _i * 8192), 16, (int)voffB[_i], (int)(sB), 0, 0); } while (0)
#define PG8_STAGE_A(bufoff, kb, o) do { _Pragma("unroll") for (int _i = 0; _i < 2; ++_i) \
        __builtin_amdgcn_raw_ptr_buffer_load_lds(rsA, (LAS void*)(lds + (bufoff) + ldsw + _i * 8192), 16, (int)(o)[_i], (int)(kb), 0, 0); } while (0)
#define PG8_LD2(p_) PG8_CAT(*(const LAS i32x4*)(p_), *(const LAS i32x4*)((p_) + 1024))
#define PG8_LDA(dst, b, h) do { if constexpr (F8) { _Pragma("unroll") for (int m = 0; m < 4; ++m) dst##8[m] = PG8_LD2(lds + PG8_SA(b, h) + aoff + m * 2048); } \
        else { _Pragma("unroll") for (int m = 0; m < 4; ++m) _Pragma("unroll") for (int k = 0; k < 2; ++k) dst[m][k] = *(const LAS bf16x8*)(lds + PG8_SA(b, h) + aoff + m * 2048 + k * 1024); } } while (0)
#define PG8_LDB(dst, b, h) do { if constexpr (F8) { _Pragma("unroll") for (int n = 0; n < 2; ++n) dst##8[n] = PG8_LD2(lds + PG8_SB(b, h) + boff + n * 2048); } \
        else { _Pragma("unroll") for (int n = 0; n < 2; ++n) _Pragma("unroll") for (int k = 0; k < 2; ++k) dst[n][k] = *(const LAS bf16x8*)(lds + PG8_SB(b, h) + boff + n * 2048 + k * 1024); } } while (0)
#define PG8_CAT(x0, x1) __builtin_shufflevector((x0), (x1), 0, 1, 2, 3, 4, 5, 6, 7)
#define PG8_MMA(ai, bj, At, Bt) do { __builtin_amdgcn_s_setprio(1); \
        if constexpr (F8) { _Pragma("unroll") for (int m = 0; m < 4; ++m) _Pragma("unroll") for (int n = 0; n < 2; ++n) \
            acc[ai][bj][m][n] = __builtin_amdgcn_mfma_scale_f32_16x16x128_f8f6f4(Bt##8[n], At##8[m], acc[ai][bj][m][n], 0, 0, 0, 0, 0, 0); } \
        else { _Pragma("unroll") for (int m = 0; m < 4; ++m) _Pragma("unroll") for (int n = 0; n < 2; ++n) _Pragma("unroll") for (int k = 0; k < 2; ++k) \
            acc[ai][bj][m][n] = __builtin_amdgcn_mfma_f32_16x16x32_bf16(Bt[n][k], At[m][k], acc[ai][bj][m][n], 0, 0, 0); } \
        __builtin_amdgcn_s_setprio(0); } while (0)
#define PG8_WAIT_V(n) asm volatile("s_waitcnt vmcnt(" #n ")" ::: "memory")
#define PG8_WAIT_L(n) asm volatile("s_waitcnt lgkmcnt(" #n ")" ::: "memory")
#define PG8_BAR __builtin_amdgcn_s_barrier()
#define PG8_SCHED __builtin_amdgcn_sched_barrier(0)
    Unit cur, nxt; int ui = 0;
    if (!S.next(0, cur)) return;
    f32x4 acc[2][2][4][2];
#pragma unroll
    for (int a = 0; a < 2; ++a)
#pragma unroll
        for (int b = 0; b < 2; ++b)
#pragma unroll
            for (int m = 0; m < 4; ++m)
#pragma unroll
                for (int n = 0; n < 2; ++n) acc[a][b][m][n] = (f32x4){0.f, 0.f, 0.f, 0.f};
    bf16x8 At[4][2], B0[2][2], B1[2][2]; i32x8 At8[4], B08[2], B18[2];
    unsigned ca0[2], ca1[2];
    P.a_offs(0, cur, Rr, Cc, ca0, ca1);
    unsigned cB = P.b_off(cur);
    PG8_STAGE_B(PG8_SB(0, 0), cB); PG8_STAGE_B(PG8_SB(0, 1), cB + hstep); PG8_STAGE_A(PG8_SA(0, 0), 0, ca0); PG8_STAGE_A(PG8_SA(0, 1), 0, ca1);
    if (wr == 1) PG8_BAR;
    PG8_WAIT_V(2); PG8_BAR;
    PG8_STAGE_B(PG8_SB(1, 0), cB + kstep); PG8_STAGE_A(PG8_SA(1, 0), kstep, ca0); PG8_STAGE_B(PG8_SB(1, 1), cB + hstep + kstep);
    PG8_WAIT_V(6); PG8_BAR;
    for (;;) {
        const bool has_next = S.next(ui + 1, nxt);
        unsigned nB = cB;
        if (has_next) nB = P.b_off(nxt);
#pragma unroll 1
        for (int t = 0; t < nt; t += 2) {
            const bool last = (t == nt - 2);
            const unsigned k1 = (unsigned)(t + 1) * kstep;
            const unsigned k2 = last ? 0u : (unsigned)(t + 2) * kstep, k3 = k2 + kstep;
            const unsigned b2 = last ? nB : cB + (unsigned)(t + 2) * kstep; const unsigned b3 = b2 + kstep;
            PG8_LDB(B0, 0, 0); PG8_LDB(B1, 0, 1); PG8_SCHED; PG8_LDA(At, 0, 0); PG8_STAGE_A(PG8_SA(1, 1), k1, ca1);
            if (last && has_next) {
                int tq = threadIdx.x; asm volatile("" : "+v"(tq)); int R2[2], C2[2];
#pragma unroll
                for (int i = 0; i < 2; ++i) stage_rc(tq * 16 + i * 8192, R2[i], C2[i]);
                P.a_offs(ui + 1, nxt, R2, C2, ca0, ca1);
            }
            PG8_WAIT_V(8); PG8_WAIT_L(0); PG8_BAR; PG8_MMA(0, 0, At, B0); PG8_MMA(0, 1, At, B1); PG8_BAR; PG8_SCHED;
            PG8_LDA(At, 0, 1); PG8_STAGE_B(PG8_SB(0, 0), b2); PG8_STAGE_B(PG8_SB(0, 1), b2 + hstep); PG8_STAGE_A(PG8_SA(0, 0), k2, ca0);
            PG8_WAIT_V(8); PG8_WAIT_L(0); PG8_BAR; PG8_MMA(1, 0, At, B0); PG8_MMA(1, 1, At, B1); PG8_BAR; PG8_SCHED;
            PG8_LDB(B0, 1, 0); PG8_LDB(B1, 1, 1); PG8_SCHED; PG8_LDA(At, 1, 0); PG8_STAGE_A(PG8_SA(0, 1), k2, ca1);
            PG8_WAIT_V(8); PG8_WAIT_L(0); PG8_BAR; PG8_MMA(0, 0, At, B0); PG8_MMA(0, 1, At, B1); PG8_BAR; PG8_SCHED;
            PG8_LDA(At, 1, 1); PG8_STAGE_B(PG8_SB(1, 0), b3); PG8_STAGE_B(PG8_SB(1, 1), b3 + hstep); PG8_STAGE_A(PG8_SA(1, 0), k3, ca0);
            PG8_WAIT_V(8); PG8_WAIT_L(0); PG8_BAR; PG8_MMA(1, 0, At, B0); PG8_MMA(1, 1, At, B1); PG8_BAR; PG8_SCHED;
        }
        if constexpr (ALIGN_EPI) { if (wr == 0) PG8_BAR; }
        { int te = threadIdx.x; asm volatile("" : "+v"(te));
          E(acc, cur, wr, wc, te & 15, (te >> 4) & 3); }
        if (!has_next) break;
#pragma unroll
        for (int a = 0; a < 2; ++a)
#pragma unroll
            for (int b = 0; b < 2; ++b)
#pragma unroll
                for (int m = 0; m < 4; ++m)
#pragma unroll
                    for (int n = 0; n < 2; ++n) acc[a][b][m][n] = (f32x4){0.f, 0.f, 0.f, 0.f};
        cur = nxt; cB = nB; ++ui;
        if constexpr (ALIGN_EPI) { if (wr == 1) PG8_BAR; }
    }
    PG8_WAIT_V(0);
    if constexpr (!ALIGN_EPI) { if (wr == 0) PG8_BAR; }
    PG8_BAR;
#undef PG8_SA
#undef PG8_SB
#undef PG8_STAGE_A
#undef PG8_STAGE_B
#undef PG8_LDA
#undef PG8_LD2
#undef PG8_LDB
#undef PG8_MMA
#undef PG8_CAT
#undef PG8_WAIT_V
#undef PG8_WAIT_L
#undef PG8_BAR
#undef PG8_SCHED
}

template <bool F8_>
struct DenseProbT {
    static constexpr bool F8 = F8_;
    const void* A; const void* Bt; int K, lda, acolstep; size_t bstep_pn;
    __device__ __forceinline__ void a_offs(int, const Unit& u, const int (&R)[2], const int (&C)[2], unsigned (&o0)[2], unsigned (&o1)[2]) const {
        constexpr int esz = F8 ? 1 : 2;
#pragma unroll
        for (int i = 0; i < 2; ++i) { const unsigned b = (unsigned)(((u.pm * BM + R[i]) * lda + u.pn * acolstep) * esz + C[i] * 2); o0[i] = b; o1[i] = b + (unsigned)(HALF * lda * esz); }
    }
    __device__ __forceinline__ unsigned b_off(const Unit& u) const { return (unsigned)((size_t)u.pn * bstep_pn * (F8 ? 1 : 2)); }
};
typedef DenseProbT<false> DenseProb;
}

struct Params {
    const float* x; const int* positions; const float* norm_mix; const float* norm_ffn; const float* norm_final;
    const float* attn_w_in; const float* attn_w_out; const float* pool_w_in; const float* pool_w_group; const float* pool_scale; const float* pool_w_out;
    const float* router_group_w; const float* router_group_b; const float* router_expert_w; const float* router_expert_b;
    const float* expert_w1; const float* expert_w3; const float* expert_w2;
    float* out; unsigned char* ws;
    int ph_lo, ph_hi;
};

template <class MapN>
__device__ __forceinline__ void transpose_item(const float* W, int ldw, int K, bf16* WT, MapN mapn, LAS float* scr, int k0, int n0, int lane) {
#pragma unroll 8
    for (int i = 0; i < 32; ++i) { const int kk = 2 * i + (lane >> 5); scr[kk * 33 + (lane & 31)] = W[(size_t)(k0 + kk) * ldw + n0 + (lane & 31)]; }
    asm volatile("s_waitcnt lgkmcnt(0)" ::: "memory");
    const int c = lane & 7;
#pragma unroll
    for (int j = 0; j < 4; ++j) { const int n = (lane >> 3) + 8 * j; const LAS float* s = scr + (8 * c) * 33 + n;
        u32x4 o; o.x = cvtpk(s[0 * 33], s[1 * 33]); o.y = cvtpk(s[2 * 33], s[3 * 33]); o.z = cvtpk(s[4 * 33], s[5 * 33]); o.w = cvtpk(s[6 * 33], s[7 * 33]);
        *(u32x4*)(WT + (size_t)mapn(n0 + n) * K + k0 + 8 * c) = o; }
    asm volatile("s_waitcnt lgkmcnt(0)" ::: "memory");
}
template <class MapN>
__device__ __forceinline__ void transpose_item8(const float* W, int ldw, int K, unsigned char* WT, MapN mapn, float sc, LAS float* scr, int k0, int n0, int lane) {
#pragma unroll 8
    for (int i = 0; i < 32; ++i) { const int kk = 2 * i + (lane >> 5); scr[kk * 33 + (lane & 31)] = W[(size_t)(k0 + kk) * ldw + n0 + (lane & 31)]; }
    asm volatile("s_waitcnt lgkmcnt(0)" ::: "memory");
    const int c = lane & 7;
#pragma unroll
    for (int j = 0; j < 4; ++j) { const int n = (lane >> 3) + 8 * j; const LAS float* s = scr + (8 * c) * 33 + n;
        u32x2 o; o.x = pack_fp8x4(s[0 * 33] * sc, s[1 * 33] * sc, s[2 * 33] * sc, s[3 * 33] * sc); o.y = pack_fp8x4(s[4 * 33] * sc, s[5 * 33] * sc, s[6 * 33] * sc, s[7 * 33] * sc);
        *(u32x2*)(WT + (size_t)mapn(n0 + n) * K + k0 + 8 * c) = o; }
    asm volatile("s_waitcnt lgkmcnt(0)" ::: "memory");
}
struct MapId { __device__ __forceinline__ int operator()(int n) const { return n; } };
struct MapQKV {
    __device__ __forceinline__ int operator()(int n) const { const int rem = n % 1536, kind = rem / 512, d = n & 63; if (kind < 2 && d < 16) return n - d + (d < 8 ? 2 * d : 2 * (d - 8) + 1); return n; }
};
struct MapW13 { int add; __device__ __forceinline__ int operator()(int n) const { return (n >> 7) * 256 + add + (n & 127); } };

struct RowPassCfg {
    const float* hin;
    const bf16* hin16;
    const bf16* ys; const int* slotref; const int* cnt_prev;
    bf16* hout;
    const float* gain;
    bf16* yout;
    unsigned char* yout8;
    float* fout;
    const float* rgw; const float* rgb; const float* rew; const float* reb;
    int* cnt; int* list; float* gatel; int* slotref_out;
};

__device__ __forceinline__ void route_decide(const float (&a)[20], const float* rgb, const float* reb, int& e0, int& e1, float& g0, float& g1) {
    float lg[4];
#pragma unroll
    for (int g = 0; g < 4; ++g) lg[g] = a[g] + rgb[g];
    int gs = 0; float gm = lg[0];
#pragma unroll
    for (int g = 1; g < 4; ++g) if (lg[g] > gm) { gm = lg[g]; gs = g; }
    float den = 0.f;
#pragma unroll
    for (int g = 0; g < 4; ++g) den += __expf(lg[g] - gm);
    const float gate1 = 1.0f / den;
    float le[4];
#pragma unroll
    for (int e = 0; e < 4; ++e) { const float sel = gs == 0 ? a[4 + e] : gs == 1 ? a[8 + e] : gs == 2 ? a[12 + e] : a[16 + e]; le[e] = sel + reb[gs * 4 + e]; }
    int i0 = 0; float v0 = le[0];
#pragma unroll
    for (int e = 1; e < 4; ++e) if (le[e] > v0) { v0 = le[e]; i0 = e; }
    int i1 = -1; float v1 = -INFINITY;
#pragma unroll
    for (int e = 0; e < 4; ++e) if (e != i0 && le[e] > v1) { v1 = le[e]; i1 = e; }
    const float ex = __expf(v1 - v0), p0 = 1.0f / (1.0f + ex), p1 = ex * p0;
    e0 = gs * 4 + i0; e1 = gs * 4 + i1; g0 = gate1 * p0; g1 = gate1 * p1;
}

template <bool COMBINE, bool ROUTER, bool HIN16>
__device__ __forceinline__ void row_pass(LAS unsigned char* lds, const RowPassCfg& c, int vcu, int wave) {
    int tid = threadIdx.x; asm volatile("" : "+v"(tid)); const int lane = tid & 63;
    LAS float* Wr = (LAS float*)lds;
    LAS int* selE = (LAS int*)(lds + 81920);
    LAS float* selG = (LAS float*)(lds + 81920 + 1024);
    LAS int* wcnt = (LAS int*)(lds + 81920 + 2048);
    LAS int* tb = (LAS int*)(lds + MISC_OFF);
    if (ROUTER) {
        for (int k = tid; k < 1024; k += NTHREADS) {
            const f32x4 g4 = *(const f32x4*)(c.rgw + (size_t)k * 4);
            Wr[0 * 1024 + k] = g4.x; Wr[1 * 1024 + k] = g4.y; Wr[2 * 1024 + k] = g4.z; Wr[3 * 1024 + k] = g4.w;
#pragma unroll
            for (int g = 0; g < 4; ++g) { const f32x4 e4 = *(const f32x4*)(c.rew + ((size_t)g * 1024 + k) * 4);
                Wr[(4 + g * 4 + 0) * 1024 + k] = e4.x; Wr[(4 + g * 4 + 1) * 1024 + k] = e4.y; Wr[(4 + g * 4 + 2) * 1024 + k] = e4.z; Wr[(4 + g * 4 + 3) * 1024 + k] = e4.w; }
        }
    }
    if (COMBINE) {
        if (tid == 0) { int sacc = 0; for (int e = 0; e < NE; ++e) { tb[e] = sacc; sacc += (c.cnt_prev[e] + 255) >> 8; } tb[NE] = sacc; }
    }
    __syncthreads();
    f32x4 gn[4];
#pragma unroll
    for (int j = 0; j < 4; ++j) gn[j] = *(const f32x4*)(c.gain + 4 * lane + 256 * j);
    for (int rb = vcu; rb < T / 128; rb += gridDim.x) {
        const int rbase = rb * 128 + wave * 16;
        int refs = 0;
        if (COMBINE) { if (lane < 32) refs = c.slotref[rbase * 2 + lane]; }
        f32x4 hv[2][2][4]; u32x2 hb[2][2][4]; u32x2 yv[2][2][2][4];
#define RP_ISSUE(buf, pr) do { _Pragma("unroll") for (int r = 0; r < 2; ++r) { const int row = rbase + 2 * (pr) + r; \
            if (HIN16) { _Pragma("unroll") for (int j = 0; j < 4; ++j) hb[buf][r][j] = *(const u32x2*)(c.hin16 + (size_t)row * D + 4 * lane + 256 * j); } \
            else { _Pragma("unroll") for (int j = 0; j < 4; ++j) hv[buf][r][j] = *(const f32x4*)(c.hin + (size_t)row * D + 4 * lane + 256 * j); } \
            if (COMBINE) { _Pragma("unroll") for (int sl = 0; sl < 2; ++sl) { const int ref = __builtin_amdgcn_readlane(refs, (2 * (pr) + r) * 2 + sl); const int e = ref >> 15, pos = ref & 32767; \
                const bf16* yr = c.ys + ((size_t)tb[e] * 256 + pos) * D; \
                _Pragma("unroll") for (int j = 0; j < 4; ++j) yv[buf][r][sl][j] = *(const u32x2*)(yr + 4 * lane + 256 * j); } } } } while (0)
#define RP_PROCESS(buf, pr) do { f32x4 v[2][4]; \
            _Pragma("unroll") for (int r = 0; r < 2; ++r) { const int row = rbase + 2 * (pr) + r; \
                _Pragma("unroll") for (int j = 0; j < 4; ++j) { if (HIN16) { const u32x2 w0 = hb[buf][r][j]; v[r][j] = (f32x4){bf_lo(w0.x), bf_hi(w0.x), bf_lo(w0.y), bf_hi(w0.y)}; } else v[r][j] = hv[buf][r][j]; \
                    if (COMBINE) { _Pragma("unroll") for (int sl = 0; sl < 2; ++sl) { const u32x2 w = yv[buf][r][sl][j]; v[r][j].x += bf_lo(w.x); v[r][j].y += bf_hi(w.x); v[r][j].z += bf_lo(w.y); v[r][j].w += bf_hi(w.y); } } } \
                if (c.hout) { _Pragma("unroll") for (int j = 0; j < 4; ++j) { u32x2 w; w.x = cvtpk(v[r][j].x, v[r][j].y); w.y = cvtpk(v[r][j].z, v[r][j].w); *(u32x2*)(c.hout + (size_t)row * D + 4 * lane + 256 * j) = w; \
                    v[r][j] = (f32x4){bf_lo(w.x), bf_hi(w.x), bf_lo(w.y), bf_hi(w.y)}; } } \
                float ss = 0.f; \
                _Pragma("unroll") for (int j = 0; j < 4; ++j) ss += (v[r][j].x * v[r][j].x + v[r][j].y * v[r][j].y) + (v[r][j].z * v[r][j].z + v[r][j].w * v[r][j].w); \
                const float rstd = 1.0f / sqrtf(wave_sum(ss) * (1.0f / D) + RMS_EPS); \
                _Pragma("unroll") for (int j = 0; j < 4; ++j) { v[r][j].x = v[r][j].x * rstd * gn[j].x; v[r][j].y = v[r][j].y * rstd * gn[j].y; v[r][j].z = v[r][j].z * rstd * gn[j].z; v[r][j].w = v[r][j].w * rstd * gn[j].w; } \
                if (c.yout) { _Pragma("unroll") for (int j = 0; j < 4; ++j) { u32x2 w; w.x = cvtpk(v[r][j].x, v[r][j].y); w.y = cvtpk(v[r][j].z, v[r][j].w); *(u32x2*)(c.yout + (size_t)row * D + 4 * lane + 256 * j) = w; } } \
                if (c.yout8) { _Pragma("unroll") for (int j = 0; j < 4; ++j) *(unsigned*)(c.yout8 + (size_t)row * D + 4 * lane + 256 * j) = pack_fp8x4(v[r][j].x, v[r][j].y, v[r][j].z, v[r][j].w); } \
                if (c.fout) { _Pragma("unroll") for (int j = 0; j < 4; ++j) *(f32x4*)(c.fout + (size_t)row * D + 4 * lane + 256 * j) = v[r][j]; } } \
            if (ROUTER) { LAS float* lg_ = (LAS float*)(lds + 81920 + 4096) + wave * 40; \
                _Pragma("unroll 2") for (int o = 0; o < 20; ++o) { float s0 = 0.f, s1 = 0.f; \
                    _Pragma("unroll") for (int j = 0; j < 4; ++j) { const f32x4 w = *(const LAS f32x4*)(Wr + o * 1024 + 4 * lane + 256 * j); \
                        s0 += (v[0][j].x * w.x + v[0][j].y * w.y) + (v[0][j].z * w.z + v[0][j].w * w.w); s1 += (v[1][j].x * w.x + v[1][j].y * w.y) + (v[1][j].z * w.z + v[1][j].w * w.w); } \
                    s0 = wave_sum(s0); s1 = wave_sum(s1); if (lane == 0) { lg_[o] = s0; lg_[20 + o] = s1; } } \
                float a0[20], a1[20]; \
                _Pragma("unroll") for (int o = 0; o < 20; ++o) { a0[o] = lg_[o]; a1[o] = lg_[20 + o]; } \
                int e0, e1; float g0, g1; const int rl = wave * 16 + 2 * (pr); \
                route_decide(a0, c.rgb, c.reb, e0, e1, g0, g1); if (lane == 0) { selE[rl * 2] = e0; selE[rl * 2 + 1] = e1; selG[rl * 2] = g0; selG[rl * 2 + 1] = g1; } \
                route_decide(a1, c.rgb, c.reb, e0, e1, g0, g1); if (lane == 0) { selE[rl * 2 + 2] = e0; selE[rl * 2 + 3] = e1; selG[rl * 2 + 2] = g0; selG[rl * 2 + 3] = g1; } } } while (0)
        RP_ISSUE(0, 0);
#pragma unroll 1
        for (int it = 0; it < 4; ++it) {
            RP_ISSUE(1, 2 * it + 1);
            RP_PROCESS(0, 2 * it);
            if (it < 3) RP_ISSUE(0, 2 * it + 2);
            RP_PROCESS(1, 2 * it + 1);
        }
#undef RP_ISSUE
#undef RP_PROCESS
        if (ROUTER) {
            __syncthreads();
            int e = 0, rank = 0;
            if (tid < 256) {
                e = selE[tid]; int mycount = 0;
#pragma unroll
                for (int x = 0; x < NE; ++x) { const unsigned long long mask = __ballot(e == x); if (e == x) rank = __popcll(mask & ((1ull << lane) - 1ull)); if (lane == x) mycount = __popcll(mask); }
                if (lane < NE) wcnt[(tid >> 6) * 16 + lane] = mycount;
            }
            __syncthreads();
            if (tid < NE) { const int c0 = wcnt[tid], c1 = wcnt[16 + tid], c2 = wcnt[32 + tid], c3 = wcnt[48 + tid]; const int tot = c0 + c1 + c2 + c3;
                int base = 0; if (tot) base = atomicAdd(c.cnt + tid, tot);
                wcnt[tid] = base; wcnt[16 + tid] = base + c0; wcnt[32 + tid] = base + c0 + c1; wcnt[48 + tid] = base + c0 + c1 + c2; }
            __syncthreads();
            if (tid < 256) { const int pos = wcnt[(tid >> 6) * 16 + e] + rank; const int tok = rb * 128 + (tid >> 1);
                c.list[e * T + pos] = tok; c.gatel[e * T + pos] = selG[tid]; c.slotref_out[tok * 2 + (tid & 1)] = e * 32768 + pos; }
            __syncthreads();
        }
    }
    __syncthreads();
}

namespace att {
constexpr float C2 = 0.125f * 1.4426950408889634f;
constexpr float LN2 = 0.6931471805599453f;
__device__ __forceinline__ int crow(int r, int hi) { return (r & 3) + 8 * (r >> 2) + 4 * hi; }
typedef short v4i16_t __attribute__((ext_vector_type(4)));
__device__ __forceinline__ s16x4 vtr(const LAS unsigned char* p) { return __builtin_bit_cast(s16x4, __builtin_amdgcn_ds_read_tr16_b64_v4i16((LAS v4i16_t*)p)); }

struct Item { int b, g, hh, dil, j, ph; };
__device__ __forceinline__ Item decode_item(int pp, int half) {
    Item it; it.hh = pp & 7; const int q8 = (pp >> 3) & 7; it.g = (pp >> 6) % 3; it.b = pp / 192;
    const int idx16 = q8 * 2 + half; it.dil = it.g == 0 ? 1 : (it.g == 1 ? 4 : 16); const int nb = 16 / it.dil; it.j = idx16 % nb; it.ph = idx16 / nb; return it;
}
__device__ __forceinline__ int kswz(int kv) { return (kv ^ (kv >> 3)) & 7; }

template <int MODE>
__device__ __forceinline__ void attn_phase(LAS unsigned char* lds, const bf16* qkv, bf16* og, float* lse, int vcu, int G) {
    int tid_ = threadIdx.x; asm volatile("" : "+v"(tid_));
    const int tid = tid_, lane = tid & 63, wid = __builtin_amdgcn_readfirstlane(tid >> 6);
    const int half = wid >> 2, w = wid & 3, r32 = lane & 31, hi = lane >> 5, th = tid & 255;
    LAS unsigned char* Kl = lds + half * 69632;
    LAS unsigned char* Vl = Kl + 36864;
    u32x4 kreg[4][2], vreg[4][2]; bf16x8 qbuf[2][4];
    int skv[2], sc[2];
#pragma unroll
    for (int i = 0; i < 2; ++i) { const int P_ = th + 256 * i; skv[i] = P_ >> 3; sc[i] = P_ & 7; }
    const __amdgpu_buffer_rsrc_t rsQ = __builtin_amdgcn_make_buffer_rsrc((void*)qkv, 0, 0xFFFFFFFF, 0x00020000);
    typedef unsigned u32x4v __attribute__((ext_vector_type(4)));
#define ATT_ISSUE(IT, QD) do { const unsigned rstrideB_ = (unsigned)(IT).dil * (unsigned)(QKVW * 2); \
        const unsigned baseB_ = (unsigned)(((IT).b * SEQ + (IT).ph) * QKVW + (IT).g * 1536 + (IT).hh * 64) * 2u; const int l0_ = 128 * ((IT).j - 1); \
        const unsigned vo0_ = (unsigned)skv[0] * rstrideB_ + (unsigned)sc[0] * 16u, vo1_ = (unsigned)skv[1] * rstrideB_ + (unsigned)sc[1] * 16u; \
        _Pragma("unroll") for (int tt = 0; tt < 4; ++tt) { if (tt >= 2 || (IT).j != 0) { const unsigned so_ = baseB_ + (unsigned)(l0_ + 64 * tt) * rstrideB_; \
            kreg[tt][0] = __builtin_bit_cast(u32x4, __builtin_amdgcn_raw_buffer_load_b128(rsQ, (int)vo0_, (int)(so_ + 1024u), 0)); vreg[tt][0] = __builtin_bit_cast(u32x4, __builtin_amdgcn_raw_buffer_load_b128(rsQ, (int)vo0_, (int)(so_ + 2048u), 0)); \
            kreg[tt][1] = __builtin_bit_cast(u32x4, __builtin_amdgcn_raw_buffer_load_b128(rsQ, (int)vo1_, (int)(so_ + 1024u), 0)); vreg[tt][1] = __builtin_bit_cast(u32x4, __builtin_amdgcn_raw_buffer_load_b128(rsQ, (int)vo1_, (int)(so_ + 2048u), 0)); } } \
        const unsigned qo_ = (unsigned)(32 * w + r32) * rstrideB_ + (unsigned)hi * 16u, qs_ = baseB_ + (unsigned)(128 * (IT).j) * rstrideB_; \
        _Pragma("unroll") for (int d0 = 0; d0 < 4; ++d0) (QD)[d0] = __builtin_bit_cast(bf16x8, __builtin_amdgcn_raw_buffer_load_b128(rsQ, (int)qo_, (int)(qs_ + (unsigned)d0 * 32u), 0)); } while (0)
    int pp = vcu;
    Item cur = decode_item(pp < 3072 ? pp : 0, half);
    if (pp < 3072 && MODE != 2) ATT_ISSUE(cur, qbuf[0]);
    const int koff = r32 * 144 + hi * 16;
    const int voff = ((lane >> 4) & 1) * 32 + (lane & 3) * 8 + (4 * hi + ((lane & 15) >> 2)) * 64;
    for (; pp < 3072; pp += 2 * G) {
#pragma unroll
    for (int par = 0; par < 2; ++par) {
        const int ppx = pp + par * G;
        if (ppx >= 3072) break;
        const int tt_lo = (cur.j == 0) ? 2 : 0;
#pragma unroll
        for (int tt = 0; tt < 4; ++tt) { if (MODE != 2 && (tt >= 2 || cur.j != 0)) {
#pragma unroll
            for (int i = 0; i < 2; ++i) {
                *(LAS u32x4*)(Kl + tt * 9216 + skv[i] * 144 + sc[i] * 16) = kreg[tt][i];
                *(LAS u32x4*)(Vl + tt * 8192 + (sc[i] >> 2) * 4096 + skv[i] * 64 + (sc[i] & 3) * 16) = vreg[tt][i]; } } }
        bf16x8 (&qr)[4] = qbuf[par];
        asm volatile("" : "+v"(qr[0]), "+v"(qr[1]), "+v"(qr[2]), "+v"(qr[3]));
        __syncthreads();
        const Item me = cur;
        if (ppx + G < 3072) { cur = decode_item(ppx + G, half); if (MODE != 2) ATT_ISSUE(cur, qbuf[par ^ 1]); }
        if (MODE == 1) { __syncthreads(); continue; }
        float m = -1e30f, l = 0.f; f32x16 oT[2]; oT[0] = f32x16{}; oT[1] = f32x16{};
        const int t_lo = (w >= 2) ? (tt_lo > 1 ? tt_lo : 1) : tt_lo, t_hi = (w < 2) ? 2 : 3, t_mid = (w < 2) ? 1 : 2;
        for (int tt = t_lo; tt <= t_hi; ++tt) {
            const LAS unsigned char* kb = Kl + tt * 9216 + koff;
            f32x16 p0 = f32x16{}, p1 = f32x16{};
#pragma unroll
            for (int d0 = 0; d0 < 4; ++d0) {
                const bf16x8 k0 = *(const LAS bf16x8*)(kb + d0 * 32), k1 = *(const LAS bf16x8*)(kb + d0 * 32 + 32 * 144);
                p0 = __builtin_amdgcn_mfma_f32_32x32x16_bf16(k0, qr[d0], p0, 0, 0, 0);
                p1 = __builtin_amdgcn_mfma_f32_32x32x16_bf16(k1, qr[d0], p1, 0, 0, 0);
            }
            float mx = -INFINITY;
            if (tt != t_mid) {
                const int dbase = 128 + 32 * w + r32 - 64 * tt;
#pragma unroll
                for (int r = 0; r < 16; ++r) {
                    const int d0_ = dbase - crow(r, hi), d1_ = d0_ - 32;
                    p0[r] = (d0_ >= 0 && d0_ <= 128) ? p0[r] * C2 : -INFINITY;
                    p1[r] = (d1_ >= 0 && d1_ <= 128) ? p1[r] * C2 : -INFINITY;
                    mx = fmaxf(mx, fmaxf(p0[r], p1[r]));
                }
            } else {
#pragma unroll
                for (int r = 0; r < 16; ++r) { p0[r] *= C2; p1[r] *= C2; mx = fmaxf(mx, fmaxf(p0[r], p1[r])); }
            }
            { const auto rr = __builtin_amdgcn_permlane32_swap(__float_as_uint(mx), __float_as_uint(mx), false, false); mx = fmaxf(__uint_as_float(rr[0]), __uint_as_float(rr[1])); }
            const float mn = fmaxf(m, mx), alpha = __builtin_amdgcn_exp2f(m - mn);
            float rs = 0.f;
#pragma unroll
            for (int r = 0; r < 16; ++r) { p0[r] = __builtin_amdgcn_exp2f(p0[r] - mn); p1[r] = __builtin_amdgcn_exp2f(p1[r] - mn); rs += p0[r] + p1[r]; }
            l = l * alpha + rs; m = mn;
#pragma unroll
            for (int r = 0; r < 16; ++r) { oT[0][r] *= alpha; oT[1][r] *= alpha; }
            u32x4 pw[4];
            pw[0] = (u32x4){cvtpk(p0[0], p0[1]), cvtpk(p0[2], p0[3]), cvtpk(p0[4], p0[5]), cvtpk(p0[6], p0[7])};
            pw[1] = (u32x4){cvtpk(p0[8], p0[9]), cvtpk(p0[10], p0[11]), cvtpk(p0[12], p0[13]), cvtpk(p0[14], p0[15])};
            pw[2] = (u32x4){cvtpk(p1[0], p1[1]), cvtpk(p1[2], p1[3]), cvtpk(p1[4], p1[5]), cvtpk(p1[6], p1[7])};
            pw[3] = (u32x4){cvtpk(p1[8], p1[9]), cvtpk(p1[10], p1[11]), cvtpk(p1[12], p1[13]), cvtpk(p1[14], p1[15])};
            const LAS unsigned char* vp = Vl + tt * 8192 + voff;
#pragma unroll
            for (int d0 = 0; d0 < 2; ++d0)
#pragma unroll
                for (int ks = 0; ks < 4; ++ks) {
                    const s16x4 lo = vtr(vp + d0 * 4096 + ks * 1024), hh4 = vtr(vp + d0 * 4096 + ks * 1024 + 512);
                    const bf16x8 vf = (bf16x8){lo[0], lo[1], lo[2], lo[3], hh4[0], hh4[1], hh4[2], hh4[3]};
                    oT[d0] = __builtin_amdgcn_mfma_f32_32x32x16_bf16(vf, __builtin_bit_cast(bf16x8, pw[ks]), oT[d0], 0, 0, 0);
                }
        }
        float lt; { const auto rr = __builtin_amdgcn_permlane32_swap(__float_as_uint(l), __float_as_uint(l), false, false); lt = __uint_as_float(rr[0]) + __uint_as_float(rr[1]); }
        const float inv = 1.0f / lt;
        const int lq = 128 * me.j + 32 * w + r32;
        const size_t tok = (size_t)me.b * SEQ + (size_t)lq * me.dil + me.ph;
        if (MODE == 3) { asm volatile("" :: "v"(oT[0]), "v"(oT[1]), "v"(inv), "v"(m)); __syncthreads(); continue; }
        bf16* orow = og + tok * (NG * AW) + me.g * AW + me.hh * 64;
#pragma unroll
        for (int d0 = 0; d0 < 2; ++d0)
#pragma unroll
            for (int rp = 0; rp < 2; ++rp) {
                const int rg = 2 * rp;
                unsigned x0 = cvtpk(oT[d0][4 * rg] * inv, oT[d0][4 * rg + 1] * inv), x1 = cvtpk(oT[d0][4 * rg + 2] * inv, oT[d0][4 * rg + 3] * inv);
                unsigned y0 = cvtpk(oT[d0][4 * rg + 4] * inv, oT[d0][4 * rg + 5] * inv), y1 = cvtpk(oT[d0][4 * rg + 6] * inv, oT[d0][4 * rg + 7] * inv);
                const auto s0 = __builtin_amdgcn_permlane32_swap(x0, y0, false, false); const auto s1 = __builtin_amdgcn_permlane32_swap(x1, y1, false, false);
                u32x4 wv; wv.x = s0[0]; wv.y = s1[0]; wv.z = s0[1]; wv.w = s1[1];
                *(u32x4*)(orow + 32 * d0 + 16 * rp + 8 * hi) = wv;
            }
        if (hi == 0) lse[tok * 24 + me.g * 8 + me.hh] = (m + __builtin_amdgcn_logf(lt)) * LN2;
        __syncthreads();
    }
    }
#undef ATT_ISSUE
}
}

using pg8::Unit; using pg8::BM; using pg8::HALF;
struct EpiQKV {
    static constexpr bool PERM = true;
    bf16* O; const float* cs; float sc;
    __device__ __forceinline__ void operator()(const f32x4 (&acc)[2][2][4][2], const Unit& u, int wr, int wc, int fr, int fq) const {
        const int colt = u.pn * BM; const int kind = (colt % 1536) / 512;
        const bool rot = (kind < 2) && ((wc & 1) == 0) && (fq < 2);
#pragma unroll
        for (int ai = 0; ai < 2; ++ai)
#pragma unroll
            for (int m = 0; m < 4; ++m) {
                const int row = u.pm * BM + ai * HALF + wr * 64 + m * 16 + fr;
                f32x4 c0 = {1.f, 0.f, 1.f, 0.f}, c1 = {1.f, 0.f, 1.f, 0.f};
                if (rot) { c0 = *(const f32x4*)(cs + (size_t)row * 16 + fq * 8); c1 = *(const f32x4*)(cs + (size_t)row * 16 + fq * 8 + 4); }
                bf16* rowp = O + (size_t)row * QKVW + colt + wc * 32 + 8 * fq;
#pragma unroll
                for (int bj = 0; bj < 2; ++bj) {
                    f32x4 v0 = acc[ai][bj][m][0] * sc, v1 = acc[ai][bj][m][1] * sc;
                    f32x4 o0, o1;
                    o0.x = v0.x * c0.x - v0.y * c0.y; o0.y = v0.y * c0.x + v0.x * c0.y; o0.z = v0.z * c0.z - v0.w * c0.w; o0.w = v0.w * c0.z + v0.z * c0.w;
                    o1.x = v1.x * c1.x - v1.y * c1.y; o1.y = v1.y * c1.x + v1.x * c1.y; o1.z = v1.z * c1.z - v1.w * c1.w; o1.w = v1.w * c1.z + v1.z * c1.w;
                    u32x4 w; w.x = cvtpk(o0.x, o0.y); w.y = cvtpk(o0.z, o0.w); w.z = cvtpk(o1.x, o1.y); w.w = cvtpk(o1.z, o1.w);
                    *(u32x4*)(rowp + bj * HALF) = w;
                }
                if (m & 1) asm volatile("" ::: "memory");
            }
    }
};
struct EpiBf16 {
    static constexpr bool PERM = true;
    bf16* O; int ldc;
    __device__ __forceinline__ void operator()(const f32x4 (&acc)[2][2][4][2], const Unit& u, int wr, int wc, int fr, int fq) const {
#pragma unroll
        for (int ai = 0; ai < 2; ++ai)
#pragma unroll
            for (int m = 0; m < 4; ++m) {
                bf16* rowp = O + (size_t)(u.pm * BM + ai * HALF + wr * 64 + m * 16 + fr) * ldc + u.pn * BM + wc * 32 + 8 * fq;
#pragma unroll
                for (int bj = 0; bj < 2; ++bj) { const f32x4 v0 = acc[ai][bj][m][0], v1 = acc[ai][bj][m][1];
                    u32x4 w; w.x = cvtpk(v0.x, v0.y); w.y = cvtpk(v0.z, v0.w); w.z = cvtpk(v1.x, v1.y); w.w = cvtpk(v1.z, v1.w);
                    *(u32x4*)(rowp + bj * HALF) = w; }
            }
    }
};
template <bool RES32>
struct EpiResBf16 {
    static constexpr bool PERM = true;
    const void* res; bf16* out;
    __device__ __forceinline__ void operator()(const f32x4 (&acc)[2][2][4][2], const Unit& u, int wr, int wc, int fr, int fq) const {
#pragma unroll
        for (int ai = 0; ai < 2; ++ai)
#pragma unroll
            for (int m = 0; m < 4; ++m) {
                const size_t off = (size_t)(u.pm * BM + ai * HALF + wr * 64 + m * 16 + fr) * D + u.pn * BM + wc * 32 + 8 * fq;
#pragma unroll
                for (int bj = 0; bj < 2; ++bj) {
                    f32x4 r0, r1;
                    if constexpr (RES32) { r0 = *(const f32x4*)((const float*)res + off + bj * HALF); r1 = *(const f32x4*)((const float*)res + off + bj * HALF + 4); }
                    else { const u32x4 rw = *(const u32x4*)((const bf16*)res + off + bj * HALF); r0 = (f32x4){bf_lo(rw.x), bf_hi(rw.x), bf_lo(rw.y), bf_hi(rw.y)}; r1 = (f32x4){bf_lo(rw.z), bf_hi(rw.z), bf_lo(rw.w), bf_hi(rw.w)}; }
                    const f32x4 v0 = r0 + acc[ai][bj][m][0], v1 = r1 + acc[ai][bj][m][1];
                    u32x4 w; w.x = cvtpk(v0.x, v0.y); w.y = cvtpk(v0.z, v0.w); w.z = cvtpk(v1.x, v1.y); w.w = cvtpk(v1.z, v1.w);
                    *(u32x4*)(out + off + bj * HALF) = w;
                }
                if (m & 1) asm volatile("" ::: "memory");
            }
    }
};
template <bool OUT8>
struct EpiSwiGLU {
    static constexpr bool PERM = true;
    void* O; float sc;
    __device__ __forceinline__ void operator()(const f32x4 (&acc)[2][2][4][2], const Unit& u, int wr, int wc, int fr, int fq) const {
#pragma unroll
        for (int ai = 0; ai < 2; ++ai)
#pragma unroll
            for (int m = 0; m < 4; ++m) {
                const size_t eoff = (size_t)(u.pm * BM + ai * HALF + wr * 64 + m * 16 + fr) * DE + u.pn * HALF + wc * 32 + 8 * fq;
                float h[8];
#pragma unroll
                for (int n = 0; n < 2; ++n)
#pragma unroll
                    for (int e = 0; e < 4; ++e) { const float a = acc[ai][0][m][n][e] * sc, b = acc[ai][1][m][n][e] * sc;
                        h[n * 4 + e] = a * __builtin_amdgcn_rcpf(1.0f + __builtin_amdgcn_exp2f(-1.4426950408889634f * a)) * b; }
                if constexpr (OUT8) { u32x2 w; w.x = pack_fp8x4(h[0] * 16.f, h[1] * 16.f, h[2] * 16.f, h[3] * 16.f); w.y = pack_fp8x4(h[4] * 16.f, h[5] * 16.f, h[6] * 16.f, h[7] * 16.f); *(u32x2*)((unsigned char*)O + eoff) = w; }
                else { u32x4 w; w.x = cvtpk(h[0], h[1]); w.y = cvtpk(h[2], h[3]); w.z = cvtpk(h[4], h[5]); w.w = cvtpk(h[6], h[7]); *(u32x4*)((bf16*)O + eoff) = w; }
            }
    }
};
struct EpiGate {
    static constexpr bool PERM = true;
    bf16* O; const float* gatel; const int* cnt; const LAS int* tb; float sc;
    __device__ __forceinline__ void operator()(const f32x4 (&acc)[2][2][4][2], const Unit& u, int wr, int wc, int fr, int fq) const {
        int e = 0;
#pragma unroll
        for (int k = 1; k < NE; ++k) e += (u.pm >= tb[k]) ? 1 : 0;
        const int lbase = (u.pm - tb[e]) * BM, n_e = cnt[e];
#pragma unroll
        for (int ai = 0; ai < 2; ++ai)
#pragma unroll
            for (int m = 0; m < 4; ++m) {
                const int rl = ai * HALF + wr * 64 + m * 16 + fr, li = lbase + rl;
                const float gt = (li < n_e) ? gatel[(size_t)e * T + li] * sc : 0.f;
                bf16* rowp = O + (size_t)(u.pm * BM + rl) * D + u.pn * BM + wc * 32 + 8 * fq;
#pragma unroll
                for (int bj = 0; bj < 2; ++bj) { const f32x4 v0 = acc[ai][bj][m][0] * gt, v1 = acc[ai][bj][m][1] * gt;
                    u32x4 w; w.x = cvtpk(v0.x, v0.y); w.y = cvtpk(v0.z, v0.w); w.z = cvtpk(v1.x, v1.y); w.w = cvtpk(v1.z, v1.w);
                    *(u32x4*)(rowp + bj * HALF) = w; }
            }
    }
};

template <bool F8_>
struct MoeProb1T {
    static constexpr bool F8 = F8_;
    const void* A; const void* Bt; int K; const LAS int* tb; const LAS unsigned* aofs;
    __device__ __forceinline__ void a_offs(int i, const Unit&, const int (&R)[2], const int (&C)[2], unsigned (&o0)[2], unsigned (&o1)[2]) const {
#pragma unroll
        for (int k = 0; k < 2; ++k) { o0[k] = aofs[i * 256 + R[k]] + (unsigned)C[k] * 2u; o1[k] = aofs[i * 256 + 128 + R[k]] + (unsigned)C[k] * 2u; }
    }
    __device__ __forceinline__ unsigned b_off(const Unit& u) const {
        int e = 0;
#pragma unroll
        for (int k = 1; k < NE; ++k) e += (u.pm >= tb[k]) ? 1 : 0;
        return (unsigned)((e * 1024 + u.pn * 256) * 1024 * (F8 ? 1 : 2));
    }
};
template <bool F8_>
struct MoeProb2T {
    static constexpr bool F8 = F8_;
    const void* A; const void* Bt; int K; const LAS int* tb;
    __device__ __forceinline__ void a_offs(int, const Unit& u, const int (&R)[2], const int (&C)[2], unsigned (&o0)[2], unsigned (&o1)[2]) const {
        constexpr int esz = F8 ? 1 : 2;
#pragma unroll
        for (int k = 0; k < 2; ++k) { const unsigned b = (unsigned)((u.pm * BM + R[k]) * DE * esz + C[k] * 2); o0[k] = b; o1[k] = b + (unsigned)(HALF * DE * esz); }
    }
    __device__ __forceinline__ unsigned b_off(const Unit& u) const {
        int e = 0;
#pragma unroll
        for (int k = 1; k < NE; ++k) e += (u.pm >= tb[k]) ? 1 : 0;
        return (unsigned)((e * 1024 + u.pn * 256) * DE * (F8 ? 1 : 2));
    }
};
struct FoldOrder { int G, c; __device__ bool next(int i, Unit& u) const { const int L = i * G + c; if (L >= 16) return false; u.pm = L >> 2; u.pn = L & 3; return true; } };


#define XB_TMO      128
#define XB_XCNT(j)  (256  + 64 * (j))
#define XB_XSUB(j)  (1280 + 64 * (j))
#define XB_XGEN(j)  (2304 + 64 * (j))
#define XB_TOP      3328
#define XB_TOPGEN   3392
#define XCD_BAR_WORDS 3456
#define XB_SPIN_CAP (1u << 18)
__device__ __forceinline__ unsigned xb_ld(unsigned* p)              { return __hip_atomic_load(p, __ATOMIC_RELAXED, __HIP_MEMORY_SCOPE_AGENT); }
__device__ __forceinline__ unsigned xb_add(unsigned* p, unsigned v) { return __hip_atomic_fetch_add(p, v, __ATOMIC_RELAXED, __HIP_MEMORY_SCOPE_AGENT); }
__device__ __forceinline__ unsigned xb_xcc_id() { return (unsigned)__builtin_amdgcn_s_getreg((3 << 11) | 20) & 0xFu; }
#define XB_SPIN(cond, bar) do { unsigned _sp = 0; while (cond) { __builtin_amdgcn_s_sleep(1); \
    if ((++_sp & 255u) == 0u) { if (xb_ld(&(bar)[XB_TMO])) break; if (_sp > XB_SPIN_CAP) { atomicAdd(&(bar)[XB_TMO], 1u); break; } } } } while (0)
struct XcdBarrier { unsigned* bar; unsigned x; volatile LAS unsigned* st; };
__device__ __forceinline__ XcdBarrier xcd_barrier_post(unsigned* bar, volatile LAS unsigned* st) {
    XcdBarrier b; b.bar = bar; b.x = xb_xcc_id(); b.st = st;
    if (threadIdx.x == 0) (void)xb_add(&bar[XB_XCNT(b.x)], 1u);
    return b;
}
__device__ __forceinline__ void xcd_barrier_complete(unsigned* bar, unsigned x, unsigned& nloc, unsigned& nx) {
    const unsigned G = gridDim.x * gridDim.y * gridDim.z;
    unsigned sum, cnt, mine, sp = 0u;
    for (;;) {
        sum = 0u; cnt = 0u; mine = 0u;
#pragma unroll
        for (unsigned j = 0; j < 16; ++j) { const unsigned c = xb_ld(&bar[XB_XCNT(j)]); sum += c; cnt += (c > 0u) ? 1u : 0u; mine = (j == x) ? c : mine; }
        if (sum == G) break;
        __builtin_amdgcn_s_sleep(1);
        if ((++sp & 255u) == 0u) { if (xb_ld(&bar[XB_TMO])) break; if (sp > XB_SPIN_CAP) { atomicAdd(&bar[XB_TMO], 1u); break; } }
    }
    nloc = mine > 0u ? mine : 1u; nx = cnt > 0u ? cnt : 1u;
}
__device__ __forceinline__ void xcd_barrier(const XcdBarrier& b) {
    asm volatile("s_waitcnt vmcnt(0)" ::: "memory");
    __syncthreads();
    if (threadIdx.x == 0) {
        unsigned* bar = b.bar;
        __builtin_amdgcn_s_waitcnt(0);
        unsigned nloc = b.st[0], nx = b.st[1];
        if (nloc == 0u) { xcd_barrier_complete(bar, b.x, nloc, nx); b.st[0] = nloc; b.st[1] = nx; }
        const unsigned old = xb_add(&bar[XB_XSUB(b.x)], 1u);
        const unsigned gen = old / nloc;
        if (old + 1u == (gen + 1u) * nloc) {
            __builtin_amdgcn_fence(__ATOMIC_RELEASE, "agent");
            asm volatile("s_waitcnt vmcnt(0)" ::: "memory");
            const unsigned og = xb_add(&bar[XB_TOP], 1u);
            const unsigned tg = og / nx;
            if (og + 1u == (tg + 1u) * nx) xb_add(&bar[XB_TOPGEN], 1u);
            else XB_SPIN(xb_ld(&bar[XB_TOPGEN]) == tg, bar);
            __builtin_amdgcn_fence(__ATOMIC_ACQUIRE, "agent");
            xb_add(&bar[XB_XGEN(b.x)], 1u);
            asm volatile("s_waitcnt vmcnt(0)" ::: "memory");
        } else {
            XB_SPIN(xb_ld(&bar[XB_XGEN(b.x)]) == gen, bar);
            __builtin_amdgcn_fence(__ATOMIC_ACQUIRE, "agent");
            asm volatile("s_waitcnt vmcnt(0)" ::: "memory");
        }
    }
    __syncthreads();
}

constexpr int N_PHASES = 16;

typedef const __attribute__((address_space(4))) Params* KParamsPtr;
__device__ __forceinline__ KParamsPtr kparams() { KParamsPtr q = (KParamsPtr)__builtin_amdgcn_kernarg_segment_ptr(); asm volatile("" : "+s"(q)); return q; }
__global__ void __launch_bounds__(NTHREADS, 2) fwd_kernel(Params p) {
    extern __shared__ __attribute__((aligned(16))) unsigned char lds_raw[];
    LAS unsigned char* lds = (LAS unsigned char*)lds_raw;
    const int tid = threadIdx.x, lane = tid & 63, wave = __builtin_amdgcn_readfirstlane(tid >> 6);
    const int G = gridDim.x, bx = blockIdx.x;
    const int vcu = (G % 8 == 0) ? (bx % 8) * (G / 8) + bx / 8 : bx;
#define KP() kparams()
#define WSB() ((unsigned char*)KP()->ws)
#define G_ctl ((int*)(WSB() + WS_CTL))
#define G_cs ((float*)(WSB() + WS_CS))
#define G_lse ((float*)(WSB() + WS_LSE))
#define G_slotref ((int*)(WSB() + WS_SLOTREF))
#define Wgs ((bf16*)(WSB() + WS_WGS))
#define G_list ((int*)(WSB() + WS_LIST))
#define G_gatel ((float*)(WSB() + WS_GATEL))
#define Win_t ((bf16*)(WSB() + WS_WIN))
#define Wout_t ((bf16*)(WSB() + WS_WOUT))
#define Wpin_t ((bf16*)(WSB() + WS_WPIN))
#define Wc_t ((bf16*)(WSB() + WS_WC))
#define Wpo_t ((bf16*)(WSB() + WS_WPO))
#define W13 ((bf16*)(WSB() + WS_W13))
#define W2 ((bf16*)(WSB() + WS_W2))
#define Y ((bf16*)(WSB() + WS_Y))
#define QKV ((bf16*)(WSB() + WS_BIG))
#define OM ((bf16*)(WSB() + WS_OM))
#define HMID ((bf16*)(WSB() + WS_HMID))
#define YS ((bf16*)(WSB() + WS_YS))
#define U ((bf16*)(WSB() + WS_U))
#define POOLED ((bf16*)(WSB() + WS_POOLED))
#define OG ((bf16*)KP()->out)
#define H ((bf16*)(WSB() + WS_H))
    LAS int* tb = (LAS int*)(lds + MISC_OFF);
    LAS unsigned* aofs = (LAS unsigned*)(lds + AOFS_OFF);

    const int lo = p.ph_lo, hi = p.ph_hi;
#if MK_N_LAUNCHES == 1
    cg::grid_group grid = cg::this_grid();
    if (tid < 2) ((volatile LAS unsigned*)(lds + MISC_OFF))[64 + tid] = 0u;
    __syncthreads();
    const XcdBarrier xbar = xcd_barrier_post((unsigned*)(G_ctl + CW_BAR), (volatile LAS unsigned*)(lds + MISC_OFF) + 64);
#define GRID_BAR(k) do { if ((k) == CG_SEAM) grid.sync(); else xcd_barrier(xbar); } while (0)
#else
#define GRID_BAR(k) do { } while (0)
#endif
#ifndef PHASE_MASK
#define PHASE_MASK 0xffff
#endif
#ifndef REPEAT_MASK
#define REPEAT_MASK 0x0
#endif
#define REP(k) for (int rep_ = 0; rep_ <= ((REPEAT_MASK >> (k)) & 1); ++rep_)
#define IN(k) (((PHASE_MASK >> (k)) & 1) && lo <= (k) && (k) < hi)
#ifndef DOUBLE_BAR
#define DOUBLE_BAR 0
#endif
#define SEAM(k) do { if (IN(k) && IN((k) + 1)) { _Pragma("unroll 1") for (int nb_ = 0; nb_ < 1 + (DOUBLE_BAR ? (hi > 0 ? 1 : 0) : 0); ++nb_) GRID_BAR(k); } } while (0)

    if (IN(0)) REP(0) {
        LAS float* scr = (LAS float*)(lds + wave * 16384);
        const int gw = vcu * NWAVES + wave, NGW = G * NWAVES;
        constexpr int I_IN = (D / 64) * (QKVW / 32);
        constexpr int I_OUT = (AW / 64) * (D / 32);
        constexpr int I_PIN = (D / 64) * (D / 32);
        constexpr int I_PO = I_PIN;
        constexpr int I_W1 = (D / 64) * (DE / 32);
        constexpr int I_W2 = (DE / 64) * (D / 32);
        constexpr int NITEMS = I_IN + I_OUT + I_PIN + I_PO + 32 * (2 * I_W1 + I_W2);
        for (int it = gw; it < NITEMS; it += NGW) {
            int r = it;
            if (r < I_IN) { const int nblk = QKVW / 32;
                if (FP8_QKV) transpose_item8(KP()->attn_w_in, QKVW, D, (unsigned char*)Win_t, MapQKV{}, 32.f, scr, 64 * (r / nblk), 32 * (r % nblk), lane);
                else transpose_item(KP()->attn_w_in, QKVW, D, Win_t, MapQKV{}, scr, 64 * (r / nblk), 32 * (r % nblk), lane);
                continue; } r -= I_IN;
            if (r < I_OUT) { const int nblk = D / 32; transpose_item(KP()->attn_w_out, D, AW, Wout_t, MapId{}, scr, 64 * (r / nblk), 32 * (r % nblk), lane); continue; } r -= I_OUT;
            if (r < I_PIN) { const int nblk = D / 32; transpose_item(KP()->pool_w_in, D, D, Wpin_t, MapId{}, scr, 64 * (r / nblk), 32 * (r % nblk), lane); continue; } r -= I_PIN;
            if (r < I_PO) { const int nblk = D / 32; transpose_item(KP()->pool_w_out, D, D, Wpo_t, MapId{}, scr, 64 * (r / nblk), 32 * (r % nblk), lane); continue; } r -= I_PO;
            const int le = r / (2 * I_W1 + I_W2); r -= le * (2 * I_W1 + I_W2);
            if (r < I_W1) { const int nblk = DE / 32;
                if (FP8_MOE1) transpose_item8(KP()->expert_w1 + (size_t)le * D * DE, DE, D, (unsigned char*)W13 + (size_t)le * 1024 * 1024, MapW13{0}, 32.f, scr, 64 * (r / nblk), 32 * (r % nblk), lane);
                else transpose_item(KP()->expert_w1 + (size_t)le * D * DE, DE, D, W13 + (size_t)le * 1024 * 1024, MapW13{0}, scr, 64 * (r / nblk), 32 * (r % nblk), lane);
                continue; } r -= I_W1;
            if (r < I_W1) { const int nblk = DE / 32;
                if (FP8_MOE1) transpose_item8(KP()->expert_w3 + (size_t)le * D * DE, DE, D, (unsigned char*)W13 + (size_t)le * 1024 * 1024, MapW13{128}, 32.f, scr, 64 * (r / nblk), 32 * (r % nblk), lane);
                else transpose_item(KP()->expert_w3 + (size_t)le * D * DE, DE, D, W13 + (size_t)le * 1024 * 1024, MapW13{128}, scr, 64 * (r / nblk), 32 * (r % nblk), lane);
                continue; } r -= I_W1;
            { const int nblk = D / 32;
                if (FP8_MOE2) transpose_item8(KP()->expert_w2 + (size_t)le * DE * D, D, DE, (unsigned char*)W2 + (size_t)le * 1024 * DE, MapId{}, 32.f, scr, 64 * (r / nblk), 32 * (r % nblk), lane);
                else transpose_item(KP()->expert_w2 + (size_t)le * DE * D, D, DE, W2 + (size_t)le * 1024 * DE, MapId{}, scr, 64 * (r / nblk), 32 * (r % nblk), lane); }
        }
        for (int i = vcu * NTHREADS + tid; i < 4 * 256 * 256 / 4; i += G * NTHREADS) {
            const int e4 = (i & 63) * 4, gidx = i >> 14;
            const f32x4 wv = *(const f32x4*)(KP()->pool_w_group + (size_t)i * 4); const f32x4 sc = *(const f32x4*)(KP()->pool_scale + gidx * 256 + e4);
            u32x2 o; o.x = cvtpk(wv.x * sc.x, wv.y * sc.y); o.y = cvtpk(wv.z * sc.z, wv.w * sc.w); *(u32x2*)(Wgs + (size_t)i * 4) = o;
        }
        for (int i = vcu * NTHREADS + tid; i < T * 8; i += G * NTHREADS) {
            const int tok = i >> 3, f = i & 7;
            const double invf = exp2(-(double)f * 0.125 * 18.931568569324174);
            const float ang = (float)KP()->positions[tok] * (float)invf;
            double sn, cn; sincos((double)ang, &sn, &cn);
            G_cs[(size_t)i * 2] = (float)cn; G_cs[(size_t)i * 2 + 1] = (float)sn;
        }
        RowPassCfg c{}; c.hin = KP()->x; c.gain = KP()->norm_mix; if (FP8_QKV) c.yout8 = (unsigned char*)Y; else c.yout = Y;
        row_pass<false, false, false>(lds, c, vcu, wave);
    }
    SEAM(0);
    if (IN(1)) REP(1) {
        pg8::DenseProbT<FP8_QKV != 0> P{Y, Win_t, D, D, 0, (size_t)256 * D};
        pg8::StaticOrder S; S.init(T / 256, QKVW / 256, G, bx);
        EpiQKV E{QKV, G_cs, FP8_QKV ? (1.0f / 32.0f) : 1.0f};
        pg8::gemm_phase<pg8::DenseProbT<FP8_QKV != 0>, EpiQKV, pg8::StaticOrder, true>(lds, P, S, E);
    }
    SEAM(1);
    if (IN(2)) REP(2) {
#ifndef ATT_PROBE_MODE
#define ATT_PROBE_MODE 0
#endif
        if (ATT_PROBE_MODE == 1) att::attn_phase<1>(lds, QKV, OG, G_lse, vcu, G);
        if (ATT_PROBE_MODE == 2) att::attn_phase<2>(lds, QKV, OG, G_lse, vcu, G);
        if (ATT_PROBE_MODE == 3) att::attn_phase<3>(lds, QKV, OG, G_lse, vcu, G);
        att::attn_phase<0>(lds, QKV, OG, G_lse, vcu, G);
    }
    SEAM(2);
    if (IN(3)) REP(3) {
        for (int row = vcu * NWAVES + wave; row < T; row += G * NWAVES) {
            const int h = lane >> 3;
            const float l0 = G_lse[(size_t)row * 24 + h], l1 = G_lse[(size_t)row * 24 + 8 + h], l2 = G_lse[(size_t)row * 24 + 16 + h];
            const float mx = fmaxf(l0, fmaxf(l1, l2));
            float w0 = __expf(l0 - mx), w1 = __expf(l1 - mx), w2 = __expf(l2 - mx); const float inv = 1.0f / (w0 + w1 + w2); w0 *= inv; w1 *= inv; w2 *= inv;
            const bf16* src = OG + (size_t)row * 1536 + lane * 8;
            const u32x4 a = *(const u32x4*)(src), b = *(const u32x4*)(src + 512), c = *(const u32x4*)(src + 1024);
            u32x4 o;
#pragma unroll
            for (int k = 0; k < 4; ++k) { const float lo_ = w0 * bf_lo(a[k]) + w1 * bf_lo(b[k]) + w2 * bf_lo(c[k]), hi_ = w0 * bf_hi(a[k]) + w1 * bf_hi(b[k]) + w2 * bf_hi(c[k]); o[k] = cvtpk(lo_, hi_); }
            *(u32x4*)(OM + (size_t)row * AW + lane * 8) = o;
        }
    }
    SEAM(3);
    if (IN(4)) REP(4) {
        pg8::DenseProb P{OM, Wout_t, AW, AW, 0, (size_t)256 * AW};
        pg8::StaticOrder S; S.init(T / 256, D / 256, G, bx);
        EpiResBf16<true> E{KP()->x, H};
        pg8::gemm_phase<pg8::DenseProb, EpiResBf16<true>, pg8::StaticOrder, true>(lds, P, S, E);
    }
    SEAM(4);
#pragma unroll 1
    for (int L = 0; L < 2; ++L) {
        const int pb = (L == 0) ? 5 : 12;
        int* cnt = G_ctl + CW_CNT + L * NE;
        if (IN(pb)) {
            RowPassCfg c{}; c.hin16 = H; c.gain = KP()->norm_ffn + L * D; if (FP8_MOE1) c.yout8 = (unsigned char*)Y; else c.yout = Y;
            c.rgw = KP()->router_group_w + (size_t)L * D * 4; c.rgb = KP()->router_group_b + L * 4; c.rew = KP()->router_expert_w + (size_t)L * 4 * D * 4; c.reb = KP()->router_expert_b + L * 16;
            c.cnt = cnt; c.list = G_list + (size_t)L * NE * T; c.gatel = G_gatel + (size_t)L * NE * T; c.slotref_out = G_slotref + (size_t)L * T * 2;
            if ((REPEAT_MASK >> pb) & 1) {
                RowPassCfg c2 = c; c2.cnt = G_ctl + 64 + L * NE; c2.list = (int*)(WSB() + WS_BIG + 200 * MiB); c2.gatel = (float*)(WSB() + WS_BIG + 204 * MiB); c2.slotref_out = (int*)(WSB() + WS_BIG + 208 * MiB);
                row_pass<false, true, true>(lds, c2, vcu, wave);
            }
            row_pass<false, true, true>(lds, c, vcu, wave);
        }
        SEAM(pb);
        if (IN(pb + 1) || IN(pb + 2)) {
            if (tid == 0) { int s = 0; for (int e = 0; e < NE; ++e) { tb[e] = s; tb[32 + e] = cnt[e]; s += (cnt[e] + 255) >> 8; } tb[NE] = s; }
            __syncthreads();
        }
        if (IN(pb + 1)) REP(pb + 1) {
            const int NT = tb[NE];
            pg8::StaticOrder S; S.init(NT, 4, G, bx);
            for (int i = 0; i < 8; ++i) { Unit u; if (!S.next(i, u)) break;
                int e = 0;
                for (int k = 1; k < NE; ++k) e += (u.pm >= tb[k]) ? 1 : 0;
                if (tid < 256) { const int li = (u.pm - tb[e]) * 256 + tid; const int tok = (li < tb[32 + e]) ? G_list[((size_t)L * NE + e) * T + li] : 0; aofs[i * 256 + tid] = (unsigned)tok * (unsigned)(D * (FP8_MOE1 ? 1 : 2)); } }
            __syncthreads();
            MoeProb1T<FP8_MOE1 != 0> P{Y, (const unsigned char*)W13 + (size_t)L * NE * 1024 * 1024 * (FP8_MOE1 ? 1 : 2), D, tb, aofs};
            EpiSwiGLU<FP8_MOE2 != 0> E{HMID, FP8_MOE1 ? (1.0f / 32.0f) : 1.0f};
            pg8::gemm_phase<MoeProb1T<FP8_MOE1 != 0>, EpiSwiGLU<FP8_MOE2 != 0>, pg8::StaticOrder, true>(lds, P, S, E);
            if (L == 0) {
                pg8::DenseProb Pf{Wpo_t, Wgs, 256, D, 256, (size_t)256 * 256};
                FoldOrder Sf{G, G - 1 - bx};
                EpiBf16 Ef{Wc_t, D};
                pg8::gemm_phase<pg8::DenseProb, EpiBf16, FoldOrder, true>(lds, Pf, Sf, Ef);
            }
        }
        SEAM(pb + 1);
        if (IN(pb + 2)) REP(pb + 2) {
            const int NT = tb[NE];
            pg8::StaticOrder S; S.init(NT, 4, G, bx);
            MoeProb2T<FP8_MOE2 != 0> P{HMID, (const unsigned char*)W2 + (size_t)L * NE * 1024 * DE * (FP8_MOE2 ? 1 : 2), DE, tb};
            EpiGate E{YS, G_gatel + (size_t)L * NE * T, cnt, tb, FP8_MOE2 ? (1.0f / 512.0f) : 1.0f};
            pg8::gemm_phase<MoeProb2T<FP8_MOE2 != 0>, EpiGate, pg8::StaticOrder, true>(lds, P, S, E);
        }
        SEAM(pb + 2);
        if (L == 0) {
            if (IN(8)) {
                RowPassCfg c{}; c.hin16 = H; c.ys = YS; c.slotref = G_slotref; c.cnt_prev = cnt; c.hout = H; c.gain = KP()->norm_mix + D; c.yout = Y;
                if ((REPEAT_MASK >> 8) & 1) { RowPassCfg c2 = c; c2.hout = nullptr; row_pass<true, false, true>(lds, c2, vcu, wave); }
                row_pass<true, false, true>(lds, c, vcu, wave);
            }
            SEAM(8);
            if (IN(9)) REP(9) {
                pg8::DenseProb P{Y, Wpin_t, D, D, 0, (size_t)256 * D};
                pg8::StaticOrder S; S.init(T / 256, D / 256, G, bx);
                EpiBf16 E{U, D};
                pg8::gemm_phase<pg8::DenseProb, EpiBf16, pg8::StaticOrder, true>(lds, P, S, E);
            }
            SEAM(9);
            if (IN(10)) REP(10) {
                for (int it = vcu * NTHREADS + tid; it < (T / 32) * 128; it += G * NTHREADS) {
                    const int ch = (it & 127) * 8, run = it >> 7, t0 = run * 32, s0 = t0 & (SEQ - 1);
                    const int wdw = 2 << (ch >> 8);
                    float sum[8];
#pragma unroll
                    for (int k = 0; k < 8; ++k) sum[k] = 0.f;
                    for (int i = 1; i < wdw; ++i) { if (s0 - i < 0) break; const u32x4 a = *(const u32x4*)(U + (size_t)(t0 - i) * D + ch);
#pragma unroll
                        for (int k = 0; k < 4; ++k) { sum[2 * k] += bf_lo(a[k]); sum[2 * k + 1] += bf_hi(a[k]); } }
                    for (int i0 = 0; i0 < 32; i0 += 8) {
                        u32x4 a8[8], o8[8];
#pragma unroll
                        for (int i = 0; i < 8; ++i) { const int tk = t0 + i0 + i, sq = s0 + i0 + i;
                            a8[i] = *(const u32x4*)(U + (size_t)tk * D + ch);
                            const int tko = tk - wdw + 1; const unsigned msk = (sq - wdw + 1 >= 0) ? 0xffffffffu : 0u;
                            const u32x4 ov = *(const u32x4*)(U + (size_t)(tko < 0 ? 0 : tko) * D + ch); o8[i] = (u32x4){ov.x & msk, ov.y & msk, ov.z & msk, ov.w & msk}; }
#pragma unroll
                        for (int i = 0; i < 8; ++i) { const int tk = t0 + i0 + i, sq = s0 + i0 + i;
                            float cur[8];
#pragma unroll
                            for (int k = 0; k < 4; ++k) { cur[2 * k] = bf_lo(a8[i][k]); cur[2 * k + 1] = bf_hi(a8[i][k]); }
#pragma unroll
                            for (int k = 0; k < 8; ++k) sum[k] += cur[k];
                            const float invc = 1.0f / (float)((sq + 1) < wdw ? (sq + 1) : wdw);
                            u32x4 w;
#pragma unroll
                            for (int k = 0; k < 4; ++k) w[k] = cvtpk(sum[2 * k] * invc - cur[2 * k], sum[2 * k + 1] * invc - cur[2 * k + 1]);
                            *(u32x4*)(POOLED + (size_t)tk * D + ch) = w;
#pragma unroll
                            for (int k = 0; k < 4; ++k) { sum[2 * k] -= bf_lo(o8[i][k]); sum[2 * k + 1] -= bf_hi(o8[i][k]); }
                        }
                    }
                }
            }
            SEAM(10);
            if (IN(11)) REP(11) {
                pg8::DenseProb P{POOLED, Wc_t, D, D, 0, (size_t)256 * D};
                pg8::StaticOrder S; S.init(T / 256, D / 256, G, bx);
                EpiResBf16<false> E{H, (((REPEAT_MASK >> 11) & 1) && rep_ == 0) ? (bf16*)(WSB() + WS_BIG + 136 * MiB) : H};
                pg8::gemm_phase<pg8::DenseProb, EpiResBf16<false>, pg8::StaticOrder, true>(lds, P, S, E);
            }
            SEAM(11);
        }
    }
    if (IN(15)) {
        RowPassCfg c{}; c.hin16 = H; c.ys = YS; c.slotref = G_slotref + (size_t)T * 2; c.cnt_prev = G_ctl + CW_CNT + NE; c.gain = KP()->norm_final; c.fout = KP()->out;
        if ((REPEAT_MASK >> 15) & 1) { RowPassCfg c2 = c; c2.fout = nullptr; c2.yout = Y; row_pass<true, false, true>(lds, c2, vcu, wave); }
        row_pass<true, false, true>(lds, c, vcu, wave);
    }
#undef IN
#undef SEAM
#undef GRID_BAR
}

#undef KP
#undef WSB
#undef G_ctl
#undef G_cs
#undef G_lse
#undef G_slotref
#undef Wgs
#undef G_list
#undef G_gatel
#undef Win_t
#undef Wout_t
#undef Wpin_t
#undef Wc_t
#undef Wpo_t
#undef W13
#undef W2
#undef Y
#undef QKV
#undef OM
#undef HMID
#undef YS
#undef U
#undef POOLED
#undef OG
#undef H
extern "C" void kernel_launch(void* const* d_in, const int* in_sizes, int n_in, void* d_out, int out_size, void* d_ws, size_t ws_size, hipStream_t stream) {
    static int grid = 0;
    if (grid == 0) {
        if (n_in != 18 || in_sizes[0] != T * D || out_size != T * D || ws_size < WS_END) { fprintf(stderr, "kernel_launch: unexpected shapes (n_in %d, in0 %d, out %d, ws %zu)\n", n_in, n_in > 0 ? in_sizes[0] : -1, out_size, ws_size); grid = -1; return; }
        int dev = 0, cus = 0, per_cu = 0;
        if (hipGetDevice(&dev) != hipSuccess || hipDeviceGetAttribute(&cus, hipDeviceAttributeMultiprocessorCount, dev) != hipSuccess) { grid = -1; return; }
        if (hipFuncSetAttribute((const void*)fwd_kernel, hipFuncAttributeMaxDynamicSharedMemorySize, LDS_BYTES) != hipSuccess) { fprintf(stderr, "kernel_launch: hipFuncSetAttribute failed\n"); grid = -1; return; }
        if (hipOccupancyMaxActiveBlocksPerMultiprocessor(&per_cu, (const void*)fwd_kernel, NTHREADS, LDS_BYTES) != hipSuccess || per_cu < 1) { fprintf(stderr, "kernel_launch: occupancy query says %d\n", per_cu); per_cu = 1; }
        (void)hipGetLastError();
        grid = cus;
    }
    if (grid < 0) return;
    (void)hipMemsetAsync((char*)d_ws + WS_CTL, 0, CTL_ZERO_BYTES, stream);
    Params p{};
    p.x = (const float*)d_in[0]; p.positions = (const int*)d_in[1]; p.norm_mix = (const float*)d_in[2]; p.norm_ffn = (const float*)d_in[3]; p.norm_final = (const float*)d_in[4];
    p.attn_w_in = (const float*)d_in[5]; p.attn_w_out = (const float*)d_in[6]; p.pool_w_in = (const float*)d_in[7]; p.pool_w_group = (const float*)d_in[8]; p.pool_scale = (const float*)d_in[9]; p.pool_w_out = (const float*)d_in[10];
    p.router_group_w = (const float*)d_in[11]; p.router_group_b = (const float*)d_in[12]; p.router_expert_w = (const float*)d_in[13]; p.router_expert_b = (const float*)d_in[14];
    p.expert_w1 = (const float*)d_in[15]; p.expert_w3 = (const float*)d_in[16]; p.expert_w2 = (const float*)d_in[17];
    p.out = (float*)d_out; p.ws = (unsigned char*)d_ws;
#if MK_N_LAUNCHES == 1
    p.ph_lo = 0; p.ph_hi = N_PHASES;
    void* args[] = {&p};
    hipError_t e = hipLaunchCooperativeKernel((const void*)fwd_kernel, dim3(grid), dim3(NTHREADS), args, LDS_BYTES, stream);
    if (e != hipSuccess) fprintf(stderr, "cooperative launch failed: %s (grid %d)\n", hipGetErrorString(e), grid);
#else
    for (int ph = 0; ph < N_PHASES; ++ph) {
        p.ph_lo = ph; p.ph_hi = ph + 1;
        hipLaunchKernelGGL(fwd_kernel, dim3(grid), dim3(NTHREADS), LDS_BYTES, stream, p);
    }
#endif
}
```

```cpp
#include <hip/hip_runtime.h>
#include <hip/hip_cooperative_groups.h>
#include <cstdio>
#include <cstdint>
namespace cg = cooperative_groups;

#ifndef MK_N_LAUNCHES
#define MK_N_LAUNCHES 1
#endif

#ifndef FP8_MOE1
#define FP8_MOE1 1
#endif
#ifndef FP8_MOE2
#define FP8_MOE2 1
#endif
#ifndef FP8_QKVS
#define FP8_QKVS 1
#endif
#ifndef ROUTER_MFMA
#define ROUTER_MFMA 1
#endif
#ifndef FP8_OG
#define FP8_OG 1
#endif
#ifndef FP8_YS
#define FP8_YS 1
#endif
#ifndef FP8_QKV
#define FP8_QKV 1
#endif
#define LAS __attribute__((address_space(3)))
#define GAS __attribute__((address_space(1)))
typedef unsigned short bf16;
typedef short bf16x8 __attribute__((ext_vector_type(8)));
typedef float f32x4 __attribute__((ext_vector_type(4)));
typedef float f32x2 __attribute__((ext_vector_type(2)));
typedef float f32x16 __attribute__((ext_vector_type(16)));
typedef unsigned u32x4 __attribute__((ext_vector_type(4)));
typedef unsigned u32x2 __attribute__((ext_vector_type(2)));
typedef short s16x4 __attribute__((ext_vector_type(4)));
typedef __bf16 bf16x2_t __attribute__((ext_vector_type(2)));
typedef int i32x4 __attribute__((ext_vector_type(4)));
typedef int i32x8 __attribute__((ext_vector_type(8)));

constexpr int BATCH = 16, SEQ = 2048, D = 1024, T = BATCH * SEQ;
constexpr int NG = 3, HPG = 8, HD = 64, AW = 512, QKVW = NG * 3 * AW;
constexpr int NE = 16, DE = 512, SLOTS = 2 * T;
constexpr int MAXTILES = SLOTS / 256 + NE;
constexpr float RMS_EPS = 1e-6f;
constexpr int NWAVES = 8, NTHREADS = 512;

constexpr size_t MiB = 1u << 20;
constexpr size_t WS_CTL = 0, CTL_ZERO_BYTES = 64 * 1024;
constexpr size_t WS_CS = 1 * MiB;
constexpr size_t WS_LSE = 3 * MiB;
constexpr size_t WS_SLOTREF = 6 * MiB;
constexpr size_t WS_WGS = 7 * MiB;
constexpr size_t WS_LIST = 8 * MiB;
constexpr size_t WS_GATEL = 12 * MiB;
constexpr size_t WS_WIN = 16 * MiB;
constexpr size_t WS_WOUT = 25 * MiB;
constexpr size_t WS_WPIN = 26 * MiB;
constexpr size_t WS_WC = 28 * MiB;
constexpr size_t WS_WPO = 30 * MiB;
constexpr size_t WS_W13 = 32 * MiB;
constexpr size_t WS_W2 = 96 * MiB;
constexpr size_t WS_Y = 128 * MiB;
constexpr size_t WS_BIG = 192 * MiB;
constexpr size_t WS_OM = WS_BIG;
constexpr size_t WS_HMID = WS_BIG;
constexpr size_t WS_YS = WS_BIG + 72 * MiB;
constexpr size_t WS_U = WS_BIG;
constexpr size_t WS_POOLED = WS_BIG + 64 * MiB;
constexpr size_t WS_H = WS_BIG + 208 * MiB;
constexpr size_t WS_END = WS_BIG + 288 * MiB;
constexpr int CW_CNT = 0;
constexpr int CW_BAR = 1024;
#ifndef CG_SEAM
#define CG_SEAM (-1)
#endif

constexpr int RING_BYTES = 131072;
constexpr int AOFS_OFF = RING_BYTES;
constexpr int MISC_OFF = AOFS_OFF + 8192;
constexpr int LDS_BYTES = 147456;

__device__ __forceinline__ unsigned cvtpk(float lo, float hi) { f32x2 v = {lo, hi}; bf16x2_t b = __builtin_convertvector(v, bf16x2_t); return __builtin_bit_cast(unsigned, b); }
__device__ __forceinline__ float clamp8(float v) { return __builtin_amdgcn_fmed3f(v, -448.0f, 448.0f); }
__device__ __forceinline__ unsigned pack_fp8x4(float a, float b, float c, float d) {
    int r = __builtin_amdgcn_cvt_pk_fp8_f32(clamp8(a), clamp8(b), 0, false); r = __builtin_amdgcn_cvt_pk_fp8_f32(clamp8(c), clamp8(d), r, true); return (unsigned)r; }
__device__ __forceinline__ float bf_lo(unsigned u) { return __uint_as_float(u << 16); }
__device__ __forceinline__ float bf_hi(unsigned u) { return __uint_as_float(u & 0xffff0000u); }
#define DPP_ADD(v, ctrl) ((v) + __builtin_bit_cast(float, __builtin_amdgcn_update_dpp(0, __builtin_bit_cast(int, (v)), (ctrl), 0xF, 0xF, true)))
__device__ __forceinline__ float rows_sum(float v) {
    auto p = __builtin_amdgcn_permlane16_swap(__float_as_uint(v), __float_as_uint(v), false, false);
    const float t = __uint_as_float(p[0]) + __uint_as_float(p[1]);
    auto q = __builtin_amdgcn_permlane32_swap(__float_as_uint(t), __float_as_uint(t), false, false);
    return __uint_as_float(q[0]) + __uint_as_float(q[1]);
}
__device__ __forceinline__ float wave_sum(float v) {
    v = DPP_ADD(v, 0xB1);
    v = DPP_ADD(v, 0x4E);
    v = DPP_ADD(v, 0x141);
    v = DPP_ADD(v, 0x140);
    return rows_sum(v);
}

namespace pg8 {
constexpr int BM = 256, BK = 64, HALF = 128, HTB = HALF * BK * 2, STAGE_BYTES = 8 * HTB, NXCD = 8, WGM = 8;
__host__ __device__ __forceinline__ int lds_byte(int r, int c) { const int st = (r >> 4) * 2 + (c >> 5), rr = r & 15, cc = c & 31, ob = rr * 64 + cc * 2; return st * 1024 + (ob ^ (((ob >> 9) & 1) << 5)); }
__host__ __device__ __forceinline__ void stage_rc(int b, int& R, int& C) { const int st = b / 1024, sb = b % 1024, swz = sb ^ (((sb >> 9) & 1) << 5); R = (st >> 1) * 16 + swz / 64; C = (st & 1) * 32 + (swz % 64) / 2; }
__host__ __device__ __forceinline__ int perm32(int rho) { const int n = rho >> 4, i = rho & 15; return 8 * (i >> 2) + 4 * n + (i & 3); }

struct Unit { int pm, pn, idx; };

struct StaticOrder {
    int nM, nN, nwg, G, c;
    __device__ void init(int nM_, int nN_, int G_, int c_) { nM = nM_; nN = nN_; nwg = nM * nN; G = G_; c = c_; }
    __device__ bool next(int i, Unit& u) const {
        const long L = (long)i * G + c; if (L >= nwg) return false;
        int wgid = (int)L; { const int q = nwg / NXCD, r = nwg % NXCD, xcd = wgid % NXCD, off = wgid / NXCD; wgid = (xcd < r ? xcd * (q + 1) : r * (q + 1) + (xcd - r) * q) + off; }
        const int nig = WGM * nN, gid = wgid / nig, fm = gid * WGM, gsz = (nM - fm) < WGM ? (nM - fm) : WGM;
        u.pm = fm + ((wgid % nig) % gsz); u.pn = (wgid % nig) / gsz; return true;
    }
};

template <class Prob, class Epi, class Sched, bool ALIGN_EPI>
__device__ __forceinline__ void gemm_phase(LAS unsigned char* lds, const Prob& P, const Sched& S, const Epi& E) {
    int tid_ = threadIdx.x; asm volatile("" : "+v"(tid_));
    const int tid = tid_, wid = __builtin_amdgcn_readfirstlane(tid >> 6), lane = tid & 63, wr = wid >> 2, wc = wid & 3, fr = lane & 15, fq = lane >> 4;
    constexpr bool F8 = Prob::F8;
    const int Kb = P.K * (F8 ? 1 : 2), nt = Kb / (BK * 2);
    int Rr[2], Cc[2]; unsigned voffB[2];
#pragma unroll
    for (int i = 0; i < 2; ++i) { int R, C; stage_rc(tid * 16 + i * 8192, R, C); Rr[i] = R; Cc[i] = C; const int Rb = Epi::PERM ? ((R & ~31) + perm32(R & 31)) : R; voffB[i] = (unsigned)(Rb * Kb + C * 2); }
    const unsigned kstep = (unsigned)(BK * 2);
    const unsigned hstep = (unsigned)(HALF * Kb);
    const unsigned ldsw = (unsigned)wid * 1024u;
    const int aoff = lds_byte(wr * 64 + fr, fq * 8), boff = lds_byte(wc * 32 + fr, fq * 8);
    const __amdgpu_buffer_rsrc_t rsA = __builtin_amdgcn_make_buffer_rsrc((void*)P.A, 0, 0xFFFFFFFF, 0x00020000);
    const __amdgpu_buffer_rsrc_t rsB = __builtin_amdgcn_make_buffer_rsrc((void*)P.Bt, 0, 0xFFFFFFFF, 0x00020000);
#define PG8_SA(b, h) (((b) * 2 + (h)) * HTB)
#define PG8_SB(b, h) ((4 + (b) * 2 + (h)) * HTB)
#define PG8_STAGE_B(bufoff, sB) do { _Pragma("unroll") for (int _i = 0; _i < 2; ++_i) \
        __builtin_amdgcn_raw_ptr_buffer_load_lds(rsB, (LAS void*)(lds + (bufoff) + ldsw + _i * 8192), 16, (int)voffB[_i], (int)(sB), 0, 0); } while (0)
#define PG8_STAGE_A(bufoff, kb, o) do { _Pragma("unroll") for (int _i = 0; _i < 2; ++_i) \
        __builtin_amdgcn_raw_ptr_buffer_load_lds(rsA, (LAS void*)(lds + (bufoff) + ldsw + _i * 8192), 16, (int)(o)[_i], (int)(kb), 0, 0); } while (0)
#define PG8_LD2(p_) PG8_CAT(*(const LAS i32x4*)(p_), *(const LAS i32x4*)((p_) + 1024))
#define PG8_LDA(dst, b, h) do { if constexpr (F8) { _Pragma("unroll") for (int m = 0; m < 4; ++m) dst##8[m] = PG8_LD2(lds + PG8_SA(b, h) + aoff + m * 2048); } \
        else { _Pragma("unroll") for (int m = 0; m < 4; ++m) _Pragma("unroll") for (int k = 0; k < 2; ++k) dst[m][k] = *(const LAS bf16x8*)(lds + PG8_SA(b, h) + aoff + m * 2048 + k * 1024); } } while (0)
#define PG8_LDB(dst, b, h) do { if constexpr (F8) { _Pragma("unroll") for (int n = 0; n < 2; ++n) dst##8[n] = PG8_LD2(lds + PG8_SB(b, h) + boff + n * 2048); } \
        else { _Pragma("unroll") for (int n = 0; n < 2; ++n) _Pragma("unroll") for (int k = 0; k < 2; ++k) dst[n][k] = *(const LAS bf16x8*)(lds + PG8_SB(b, h) + boff + n * 2048 + k * 1024); } } while (0)
#define PG8_CAT(x0, x1) __builtin_shufflevector((x0), (x1), 0, 1, 2, 3, 4, 5, 6, 7)
#define PG8_MMA(ai, bj, At, Bt) do { __builtin_amdgcn_s_setprio(1); \
        if constexpr (F8) { _Pragma("unroll") for (int m = 0; m < 4; ++m) _Pragma("unroll") for (int n = 0; n < 2; ++n) \
            acc[ai][bj][m][n] = __builtin_amdgcn_mfma_scale_f32_16x16x128_f8f6f4(Bt##8[n], At##8[m], acc[ai][bj][m][n], 0, 0, 0, 0, 0, 0); } \
        else { _Pragma("unroll") for (int m = 0; m < 4; ++m) _Pragma("unroll") for (int n = 0; n < 2; ++n) _Pragma("unroll") for (int k = 0; k < 2; ++k) \
            acc[ai][bj][m][n] = __builtin_amdgcn_mfma_f32_16x16x32_bf16(Bt[n][k], At[m][k], acc[ai][bj][m][n], 0, 0, 0); } \
        __builtin_amdgcn_s_setprio(0); } while (0)
#define PG8_WAIT_V(n) asm volatile("s_waitcnt vmcnt(" #n ")" ::: "memory")
#define PG8_WAIT_L(n) asm volatile("s_waitcnt lgkmcnt(" #n ")" ::: "memory")
#define PG8_BAR __builtin_amdgcn_s_barrier()
#define PG8_SCHED __builtin_amdgcn_sched_barrier(0)
    Unit cur, nxt; int ui = 0;
    if (!S.next(0, cur)) return;
    cur.idx = 0;
    f32x4 acc[2][2][4][2];
#pragma unroll
    for (int a = 0; a < 2; ++a)
#pragma unroll
        for (int b = 0; b < 2; ++b)
#pragma unroll
            for (int m = 0; m < 4; ++m)
#pragma unroll
                for (int n = 0; n < 2; ++n) acc[a][b][m][n] = (f32x4){0.f, 0.f, 0.f, 0.f};
    bf16x8 At[4][2], B0[2][2], B1[2][2]; i32x8 At8[4], B08[2], B18[2];
    unsigned ca0[2], ca1[2];
    P.a_offs(0, cur, Rr, Cc, ca0, ca1);
    unsigned cB = P.b_off(cur);
    PG8_STAGE_B(PG8_SB(0, 0), cB); PG8_STAGE_B(PG8_SB(0, 1), cB + hstep); PG8_STAGE_A(PG8_SA(0, 0), 0, ca0); PG8_STAGE_A(PG8_SA(0, 1), 0, ca1);
    if (wr == 1) PG8_BAR;
    PG8_WAIT_V(2); PG8_BAR;
    PG8_STAGE_B(PG8_SB(1, 0), cB + kstep); PG8_STAGE_A(PG8_SA(1, 0), kstep, ca0); PG8_STAGE_B(PG8_SB(1, 1), cB + hstep + kstep);
    PG8_WAIT_V(6); PG8_BAR;
    for (;;) {
        const bool has_next = S.next(ui + 1, nxt); nxt.idx = ui + 1;
        unsigned nB = cB;
        if (has_next) nB = P.b_off(nxt);
#pragma unroll 1
        for (int t = 0; t < nt; t += 2) {
            const bool last = (t == nt - 2);
            const unsigned k1 = (unsigned)(t + 1) * kstep;
            const unsigned k2 = last ? 0u : (unsigned)(t + 2) * kstep, k3 = k2 + kstep;
            const unsigned b2 = last ? nB : cB + (unsigned)(t + 2) * kstep; const unsigned b3 = b2 + kstep;
            PG8_LDB(B0, 0, 0); PG8_LDB(B1, 0, 1); PG8_SCHED; PG8_LDA(At, 0, 0); PG8_STAGE_A(PG8_SA(1, 1), k1, ca1);
            if (last && has_next) {
                int tq = threadIdx.x; asm volatile("" : "+v"(tq)); int R2[2], C2[2];
#pragma unroll
                for (int i = 0; i < 2; ++i) stage_rc(tq * 16 + i * 8192, R2[i], C2[i]);
                P.a_offs(ui + 1, nxt, R2, C2, ca0, ca1);
            }
            PG8_WAIT_V(8); PG8_WAIT_L(0); PG8_BAR; PG8_MMA(0, 0, At, B0); PG8_MMA(0, 1, At, B1); PG8_BAR; PG8_SCHED;
            PG8_LDA(At, 0, 1); PG8_STAGE_B(PG8_SB(0, 0), b2); PG8_STAGE_B(PG8_SB(0, 1), b2 + hstep); PG8_STAGE_A(PG8_SA(0, 0), k2, ca0);
            PG8_WAIT_V(8); PG8_WAIT_L(0); PG8_BAR; PG8_MMA(1, 0, At, B0); PG8_MMA(1, 1, At, B1); PG8_BAR; PG8_SCHED;
            PG8_LDB(B0, 1, 0); PG8_LDB(B1, 1, 1); PG8_SCHED; PG8_LDA(At, 1, 0); PG8_STAGE_A(PG8_SA(0, 1), k2, ca1);
            PG8_WAIT_V(8); PG8_WAIT_L(0); PG8_BAR; PG8_MMA(0, 0, At, B0); PG8_MMA(0, 1, At, B1); PG8_BAR; PG8_SCHED;
            PG8_LDA(At, 1, 1); PG8_STAGE_B(PG8_SB(1, 0), b3); PG8_STAGE_B(PG8_SB(1, 1), b3 + hstep); PG8_STAGE_A(PG8_SA(1, 0), k3, ca0);
            PG8_WAIT_V(8); PG8_WAIT_L(0); PG8_BAR; PG8_MMA(1, 0, At, B0); PG8_MMA(1, 1, At, B1); PG8_BAR; PG8_SCHED;
        }
        if constexpr (ALIGN_EPI) { if (wr == 0) PG8_BAR; }
        { int te = threadIdx.x; asm volatile("" : "+v"(te));
          E(acc, cur, wr, wc, te & 15, (te >> 4) & 3); }
        if (!has_next) break;
#pragma unroll
        for (int a = 0; a < 2; ++a)
#pragma unroll
            for (int b = 0; b < 2; ++b)
#pragma unroll
                for (int m = 0; m < 4; ++m)
#pragma unroll
                    for (int n = 0; n < 2; ++n) acc[a][b][m][n] = (f32x4){0.f, 0.f, 0.f, 0.f};
        cur = nxt; cB = nB; ++ui;
        if constexpr (ALIGN_EPI) { if (wr == 1) PG8_BAR; }
    }
    PG8_WAIT_V(0);
    if constexpr (!ALIGN_EPI) { if (wr == 0) PG8_BAR; }
    PG8_BAR;
#undef PG8_SA
#undef PG8_SB
#undef PG8_STAGE_A
#undef PG8_STAGE_B
#undef PG8_LDA
#undef PG8_LD2
#undef PG8_LDB
#undef PG8_MMA
#undef PG8_CAT
#undef PG8_WAIT_V
#undef PG8_WAIT_L
#undef PG8_BAR
#undef PG8_SCHED
}

template <bool F8_>
struct DenseProbT {
    static constexpr bool F8 = F8_;
    const void* A; const void* Bt; int K, lda, acolstep; size_t bstep_pn;
    __device__ __forceinline__ void a_offs(int, const Unit& u, const int (&R)[2], const int (&C)[2], unsigned (&o0)[2], unsigned (&o1)[2]) const {
        constexpr int esz = F8 ? 1 : 2;
#pragma unroll
        for (int i = 0; i < 2; ++i) { const unsigned b = (unsigned)(((u.pm * BM + R[i]) * lda + u.pn * acolstep) * esz + C[i] * 2); o0[i] = b; o1[i] = b + (unsigned)(HALF * lda * esz); }
    }
    __device__ __forceinline__ unsigned b_off(const Unit& u) const { return (unsigned)((size_t)u.pn * bstep_pn * (F8 ? 1 : 2)); }
};
typedef DenseProbT<false> DenseProb;
}

struct Params {
    const float* x; const int* positions; const float* norm_mix; const float* norm_ffn; const float* norm_final;
    const float* attn_w_in; const float* attn_w_out; const float* pool_w_in; const float* pool_w_group; const float* pool_scale; const float* pool_w_out;
    const float* router_group_w; const float* router_group_b; const float* router_expert_w; const float* router_expert_b;
    const float* expert_w1; const float* expert_w3; const float* expert_w2;
    float* out; unsigned char* ws;
    int ph_lo, ph_hi;
};

template <class MapN>
__device__ __forceinline__ void transpose_item(const float* W, int ldw, int K, bf16* WT, MapN mapn, LAS float* scr, int k0, int n0, int lane) {
#pragma unroll 8
    for (int i = 0; i < 32; ++i) { const int kk = 2 * i + (lane >> 5); scr[kk * 33 + (lane & 31)] = W[(size_t)(k0 + kk) * ldw + n0 + (lane & 31)]; }
    asm volatile("s_waitcnt lgkmcnt(0)" ::: "memory");
    const int c = lane & 7;
#pragma unroll
    for (int j = 0; j < 4; ++j) { const int n = (lane >> 3) + 8 * j; const LAS float* s = scr + (8 * c) * 33 + n;
        u32x4 o; o.x = cvtpk(s[0 * 33], s[1 * 33]); o.y = cvtpk(s[2 * 33], s[3 * 33]); o.z = cvtpk(s[4 * 33], s[5 * 33]); o.w = cvtpk(s[6 * 33], s[7 * 33]);
        *(u32x4*)(WT + (size_t)mapn(n0 + n) * K + k0 + 8 * c) = o; }
    asm volatile("s_waitcnt lgkmcnt(0)" ::: "memory");
}
template <class MapN>
__device__ __forceinline__ void transpose_item8(const float* W, int ldw, int K, unsigned char* WT, MapN mapn, float sc, LAS float* scr, int k0, int n0, int lane) {
#pragma unroll 8
    for (int i = 0; i < 32; ++i) { const int kk = 2 * i + (lane >> 5); scr[kk * 33 + (lane & 31)] = W[(size_t)(k0 + kk) * ldw + n0 + (lane & 31)]; }
    asm volatile("s_waitcnt lgkmcnt(0)" ::: "memory");
    const int c = lane & 7;
#pragma unroll
    for (int j = 0; j < 4; ++j) { const int n = (lane >> 3) + 8 * j; const LAS float* s = scr + (8 * c) * 33 + n;
        u32x2 o; o.x = pack_fp8x4(s[0 * 33] * sc, s[1 * 33] * sc, s[2 * 33] * sc, s[3 * 33] * sc); o.y = pack_fp8x4(s[4 * 33] * sc, s[5 * 33] * sc, s[6 * 33] * sc, s[7 * 33] * sc);
        *(u32x2*)(WT + (size_t)mapn(n0 + n) * K + k0 + 8 * c) = o; }
    asm volatile("s_waitcnt lgkmcnt(0)" ::: "memory");
}
struct MapId { __device__ __forceinline__ int operator()(int n) const { return n; } };
struct MapQKV {
    __device__ __forceinline__ int operator()(int n) const { const int rem = n % 1536, kind = rem / 512, d = n & 63; if (kind < 2 && d < 16) return n - d + (d < 8 ? 2 * d : 2 * (d - 8) + 1); return n; }
};
struct MapW13 { int add; __device__ __forceinline__ int operator()(int n) const { return (n >> 7) * 256 + add + (n & 127); } };

struct RowPassCfg {
    const float* hin;
    const bf16* hin16;
    const bf16* ys; const int* slotref; const int* cnt_prev;
    bf16* hout;
    const float* gain;
    bf16* yout;
    unsigned char* yout8;
    float* fout;
    const float* rgw; const float* rgb; const float* rew; const float* reb;
    int* cnt; int* list; float* gatel; int* slotref_out;
};

__device__ __forceinline__ void route_decide(const float (&a)[20], const float* rgb, const float* reb, int& e0, int& e1, float& g0, float& g1) {
    float lg[4];
#pragma unroll
    for (int g = 0; g < 4; ++g) lg[g] = a[g] + rgb[g];
    int gs = 0; float gm = lg[0];
#pragma unroll
    for (int g = 1; g < 4; ++g) if (lg[g] > gm) { gm = lg[g]; gs = g; }
    float den = 0.f;
#pragma unroll
    for (int g = 0; g < 4; ++g) den += __expf(lg[g] - gm);
    const float gate1 = 1.0f / den;
    float le[4];
#pragma unroll
    for (int e = 0; e < 4; ++e) { const float sel = gs == 0 ? a[4 + e] : gs == 1 ? a[8 + e] : gs == 2 ? a[12 + e] : a[16 + e]; le[e] = sel + reb[gs * 4 + e]; }
    int i0 = 0; float v0 = le[0];
#pragma unroll
    for (int e = 1; e < 4; ++e) if (le[e] > v0) { v0 = le[e]; i0 = e; }
    int i1 = -1; float v1 = -INFINITY;
#pragma unroll
    for (int e = 0; e < 4; ++e) if (e != i0 && le[e] > v1) { v1 = le[e]; i1 = e; }
    const float ex = __expf(v1 - v0), p0 = 1.0f / (1.0f + ex), p1 = ex * p0;
    e0 = gs * 4 + i0; e1 = gs * 4 + i1; g0 = gate1 * p0; g1 = gate1 * p1;
}

#define RPCOL(j) (8 * lane + 512 * ((j) >> 1) + 4 * ((j) & 1))
template <bool COMBINE, bool ROUTER, bool HIN16>
__device__ __forceinline__ void row_pass(LAS unsigned char* lds, const RowPassCfg& c, int vcu, int wave) {
    int tid = threadIdx.x; asm volatile("" : "+v"(tid)); const int lane = tid & 63;
    LAS float* Wr = (LAS float*)lds;
    LAS int* selE = (LAS int*)(lds + 81920);
    LAS float* selG = (LAS float*)(lds + 81920 + 1024);
    LAS int* wcnt = (LAS int*)(lds + 81920 + 2048);
    LAS int* tb = (LAS int*)(lds + MISC_OFF);
    if (ROUTER) {
        for (int k = tid; k < 1024; k += NTHREADS) {
            const f32x4 g4 = *(const f32x4*)(c.rgw + (size_t)k * 4);
            Wr[0 * 1024 + k] = g4.x; Wr[1 * 1024 + k] = g4.y; Wr[2 * 1024 + k] = g4.z; Wr[3 * 1024 + k] = g4.w;
#pragma unroll
            for (int g = 0; g < 4; ++g) { const f32x4 e4 = *(const f32x4*)(c.rew + ((size_t)g * 1024 + k) * 4);
                Wr[(4 + g * 4 + 0) * 1024 + k] = e4.x; Wr[(4 + g * 4 + 1) * 1024 + k] = e4.y; Wr[(4 + g * 4 + 2) * 1024 + k] = e4.z; Wr[(4 + g * 4 + 3) * 1024 + k] = e4.w; }
        }
    }
    if (COMBINE) {
        if (tid == 0) { int sacc = 0; for (int e = 0; e < NE; ++e) { tb[e] = sacc; sacc += (c.cnt_prev[e] + 255) >> 8; } tb[NE] = sacc; }
    }
    __syncthreads();
    f32x4 gn[4];
#pragma unroll
    for (int j = 0; j < 4; ++j) gn[j] = *(const f32x4*)(c.gain + RPCOL(j));
    for (int rb = vcu; rb < T / 128; rb += gridDim.x) {
        const int rbase = rb * 128 + wave * 16;
        int refs = 0;
        if (COMBINE) { if (lane < 32) refs = c.slotref[rbase * 2 + lane]; }
        f32x4 hv[2][2][4]; u32x2 hb[2][2][4]; u32x2 yv[2][2][2][4];
#define RP_ISSUE(buf, pr) do { _Pragma("unroll") for (int r = 0; r < 2; ++r) { const int row = rbase + 2 * (pr) + r; \
            if (HIN16) { _Pragma("unroll") for (int j = 0; j < 4; ++j) hb[buf][r][j] = *(const u32x2*)(c.hin16 + (size_t)row * D + RPCOL(j)); } \
            else { _Pragma("unroll") for (int j = 0; j < 4; ++j) hv[buf][r][j] = *(const f32x4*)(c.hin + (size_t)row * D + RPCOL(j)); } \
            if (COMBINE) { _Pragma("unroll") for (int sl = 0; sl < 2; ++sl) { const int ref = __builtin_amdgcn_readlane(refs, (2 * (pr) + r) * 2 + sl); const int e = ref >> 15, pos = ref & 32767; \
                if (FP8_YS) { const unsigned char* yr = (const unsigned char*)c.ys + ((size_t)tb[e] * 256 + pos) * D; \
                    _Pragma("unroll") for (int j = 0; j < 4; ++j) yv[buf][r][sl][j].x = *(const unsigned*)(yr + RPCOL(j)); } \
                else { const bf16* yr = c.ys + ((size_t)tb[e] * 256 + pos) * D; \
                    _Pragma("unroll") for (int j = 0; j < 4; ++j) yv[buf][r][sl][j] = *(const u32x2*)(yr + RPCOL(j)); } } } } } while (0)
#define RP_PROCESS(buf, pr) do { f32x4 v[2][4]; \
            _Pragma("unroll") for (int r = 0; r < 2; ++r) { const int row = rbase + 2 * (pr) + r; \
                _Pragma("unroll") for (int j = 0; j < 4; ++j) { if (HIN16) { const u32x2 w0 = hb[buf][r][j]; v[r][j] = (f32x4){bf_lo(w0.x), bf_hi(w0.x), bf_lo(w0.y), bf_hi(w0.y)}; } else v[r][j] = hv[buf][r][j]; \
                    if (COMBINE) { _Pragma("unroll") for (int sl = 0; sl < 2; ++sl) { const u32x2 w = yv[buf][r][sl][j]; \
                        if (FP8_YS) { const f32x2 lo2 = __builtin_amdgcn_cvt_pk_f32_fp8((int)w.x, false), hi2 = __builtin_amdgcn_cvt_pk_f32_fp8((int)w.x, true); \
                            v[r][j].x += lo2.x * (1.0f / 64.0f); v[r][j].y += lo2.y * (1.0f / 64.0f); v[r][j].z += hi2.x * (1.0f / 64.0f); v[r][j].w += hi2.y * (1.0f / 64.0f); } \
                        else { v[r][j].x += bf_lo(w.x); v[r][j].y += bf_hi(w.x); v[r][j].z += bf_lo(w.y); v[r][j].w += bf_hi(w.y); } } } } \
                if (c.hout) { _Pragma("unroll") for (int j = 0; j < 4; ++j) { u32x2 w; w.x = cvtpk(v[r][j].x, v[r][j].y); w.y = cvtpk(v[r][j].z, v[r][j].w); *(u32x2*)(c.hout + (size_t)row * D + RPCOL(j)) = w; \
                    v[r][j] = (f32x4){bf_lo(w.x), bf_hi(w.x), bf_lo(w.y), bf_hi(w.y)}; } } \
                float ss = 0.f; \
                _Pragma("unroll") for (int j = 0; j < 4; ++j) ss += (v[r][j].x * v[r][j].x + v[r][j].y * v[r][j].y) + (v[r][j].z * v[r][j].z + v[r][j].w * v[r][j].w); \
                const float rstd = 1.0f / sqrtf(wave_sum(ss) * (1.0f / D) + RMS_EPS); \
                _Pragma("unroll") for (int j = 0; j < 4; ++j) { v[r][j].x = v[r][j].x * rstd * gn[j].x; v[r][j].y = v[r][j].y * rstd * gn[j].y; v[r][j].z = v[r][j].z * rstd * gn[j].z; v[r][j].w = v[r][j].w * rstd * gn[j].w; } \
                if (c.yout) { _Pragma("unroll") for (int j = 0; j < 4; ++j) { u32x2 w; w.x = cvtpk(v[r][j].x, v[r][j].y); w.y = cvtpk(v[r][j].z, v[r][j].w); *(u32x2*)(c.yout + (size_t)row * D + RPCOL(j)) = w; } } \
                if (c.yout8) { _Pragma("unroll") for (int j = 0; j < 4; ++j) *(unsigned*)(c.yout8 + (size_t)row * D + RPCOL(j)) = pack_fp8x4(v[r][j].x, v[r][j].y, v[r][j].z, v[r][j].w); } \
                if (c.fout) { _Pragma("unroll") for (int j = 0; j < 4; ++j) *(f32x4*)(c.fout + (size_t)row * D + RPCOL(j)) = v[r][j]; } } \
            if (ROUTER) { float a0[20], a1[20]; f32x2 vv[4][4];        \
                _Pragma("unroll") for (int j = 0; j < 4; ++j) { vv[j][0] = (f32x2){v[0][j].x, v[1][j].x}; vv[j][1] = (f32x2){v[0][j].y, v[1][j].y}; vv[j][2] = (f32x2){v[0][j].z, v[1][j].z}; vv[j][3] = (f32x2){v[0][j].w, v[1][j].w}; } \
                _Pragma("unroll") for (int o = 0; o < 20; ++o) { f32x2 s2 = {0.f, 0.f}; \
                    _Pragma("unroll") for (int j = 0; j < 4; ++j) { const f32x4 w = *(const LAS f32x4*)(Wr + o * 1024 + RPCOL(j)); \
                        s2 = __builtin_elementwise_fma(vv[j][0], (f32x2){w.x, w.x}, s2); s2 = __builtin_elementwise_fma(vv[j][1], (f32x2){w.y, w.y}, s2); \
                        s2 = __builtin_elementwise_fma(vv[j][2], (f32x2){w.z, w.z}, s2); s2 = __builtin_elementwise_fma(vv[j][3], (f32x2){w.w, w.w}, s2); } \
                    a0[o] = s2.x; a1[o] = s2.y; if ((o & 3) == 3) __builtin_amdgcn_sched_barrier(0); } \
                _Pragma("unroll") for (int o = 0; o < 20; ++o) { a0[o] = DPP_ADD(a0[o], 0xB1); a1[o] = DPP_ADD(a1[o], 0xB1); } \
                _Pragma("unroll") for (int o = 0; o < 20; ++o) { a0[o] = DPP_ADD(a0[o], 0x4E); a1[o] = DPP_ADD(a1[o], 0x4E); } \
                _Pragma("unroll") for (int o = 0; o < 20; ++o) { a0[o] = DPP_ADD(a0[o], 0x141); a1[o] = DPP_ADD(a1[o], 0x141); } \
                _Pragma("unroll") for (int o = 0; o < 20; ++o) { a0[o] = DPP_ADD(a0[o], 0x140); a1[o] = DPP_ADD(a1[o], 0x140); } \
                _Pragma("unroll") for (int o = 0; o < 20; ++o) { a0[o] = rows_sum(a0[o]); a1[o] = rows_sum(a1[o]); if (o & 1) __builtin_amdgcn_sched_barrier(0); } \
                int e0, e1; float g0, g1; const int rl = wave * 16 + 2 * (pr); \
                route_decide(a0, c.rgb, c.reb, e0, e1, g0, g1); if (lane == 0) { selE[rl * 2] = e0; selE[rl * 2 + 1] = e1; selG[rl * 2] = g0; selG[rl * 2 + 1] = g1; } \
                route_decide(a1, c.rgb, c.reb, e0, e1, g0, g1); if (lane == 0) { selE[rl * 2 + 2] = e0; selE[rl * 2 + 3] = e1; selG[rl * 2 + 2] = g0; selG[rl * 2 + 3] = g1; } } } while (0)
        RP_ISSUE(0, 0);
#pragma unroll 1
        for (int it = 0; it < 4; ++it) {
            RP_ISSUE(1, 2 * it + 1);
            RP_PROCESS(0, 2 * it);
            if (it < 3) RP_ISSUE(0, 2 * it + 2);
            RP_PROCESS(1, 2 * it + 1);
        }
#undef RP_ISSUE
#undef RP_PROCESS
        if (ROUTER) {
            __syncthreads();
            int e = 0, rank = 0;
            if (tid < 256) {
                e = selE[tid]; int mycount = 0;
#pragma unroll
                for (int x = 0; x < NE; ++x) { const unsigned long long mask = __ballot(e == x); if (e == x) rank = __popcll(mask & ((1ull << lane) - 1ull)); if (lane == x) mycount = __popcll(mask); }
                if (lane < NE) wcnt[(tid >> 6) * 16 + lane] = mycount;
            }
            __syncthreads();
            if (tid < NE) { const int c0 = wcnt[tid], c1 = wcnt[16 + tid], c2 = wcnt[32 + tid], c3 = wcnt[48 + tid]; const int tot = c0 + c1 + c2 + c3;
                int base = 0; if (tot) base = atomicAdd(c.cnt + tid, tot);
                wcnt[tid] = base; wcnt[16 + tid] = base + c0; wcnt[32 + tid] = base + c0 + c1; wcnt[48 + tid] = base + c0 + c1 + c2; }
            __syncthreads();
            if (tid < 256) { const int pos = wcnt[(tid >> 6) * 16 + e] + rank; const int tok = rb * 128 + (tid >> 1);
                c.list[e * T + pos] = tok; c.gatel[e * T + pos] = selG[tid]; c.slotref_out[tok * 2 + (tid & 1)] = e * 32768 + pos; }
            __syncthreads();
        }
    }
    __syncthreads();
}
#undef RPCOL

constexpr int RW_STRIDE = 2064;
__device__ __forceinline__ void router_pass(LAS unsigned char* lds, const RowPassCfg& c, int vcu, int wave) {
    int tid = threadIdx.x; asm volatile("" : "+v"(tid)); const int lane = tid & 63, r16 = lane & 15, kg = lane >> 4;
    LAS unsigned char* Wh = lds;
    LAS unsigned char* Wl = lds + 20 * RW_STRIDE;
    LAS float* gl = (LAS float*)(lds + 40 * RW_STRIDE);
    LAS int* selE = (LAS int*)(lds + 86656);
    LAS float* selG = (LAS float*)(lds + 86656 + 1024);
    LAS int* wcnt = (LAS int*)(lds + 86656 + 2048);
    LAS float* tr = (LAS float*)(lds + 90112) + wave * 512;
    for (int kp = tid; kp < 512; kp += NTHREADS) {
        const int k = 2 * kp;
#pragma unroll 1
        for (int v5 = 0; v5 < 5; ++v5) {
            const float* src = (v5 == 0) ? (c.rgw + (size_t)k * 4) : (c.rew + ((size_t)(v5 - 1) * 1024 + k) * 4);
            const f32x4 a = *(const f32x4*)src, b = *(const f32x4*)(src + 4);
#pragma unroll
            for (int q = 0; q < 4; ++q) { const int o = v5 * 4 + q; const unsigned hi = cvtpk(a[q], b[q]); const unsigned lo = cvtpk(a[q] - bf_lo(hi), b[q] - bf_hi(hi));
                *(LAS unsigned*)(Wh + o * RW_STRIDE + k * 2) = hi; *(LAS unsigned*)(Wl + o * RW_STRIDE + k * 2) = lo; }
        }
    }
    for (int k = tid; k < 1024; k += NTHREADS) gl[k] = c.gain[k];
    __syncthreads();
    typedef unsigned u32x2v __attribute__((ext_vector_type(2)));
    const __amdgpu_buffer_rsrc_t rsH = __builtin_amdgcn_make_buffer_rsrc((void*)c.hin16, 0, 0xFFFFFFFF, 0x00020000);
    const __amdgpu_buffer_rsrc_t rsY = __builtin_amdgcn_make_buffer_rsrc((void*)c.yout8, 0, 0xFFFFFFFF, 0x00020000);
    const int oc0 = r16, oc1 = (16 + r16) < 20 ? (16 + r16) : 19;
    for (int rb = vcu; rb < T / 128; rb += gridDim.x) {
        const int row = rb * 128 + wave * 16 + r16;
        u32x4 hreg[32];
        const unsigned voff = (unsigned)row * (unsigned)(D * 2) + (unsigned)kg * 16u;
#pragma unroll
        for (int s_ = 0; s_ < 32; ++s_) hreg[s_] = __builtin_bit_cast(u32x4, __builtin_amdgcn_raw_buffer_load_b128(rsH, (int)voff + s_ * 64, 0, 0));
        const unsigned yoff = (unsigned)row * (unsigned)D + (unsigned)kg * 8u;
        float ss = 0.f;
#pragma unroll
        for (int s_ = 0; s_ < 32; ++s_)
#pragma unroll
            for (int q = 0; q < 4; ++q) { unsigned hw = hreg[s_][q]; asm volatile("" : "+v"(hw));
                const float a = bf_lo(hw), b = bf_hi(hw); ss = __builtin_fmaf(a, a, ss); ss = __builtin_fmaf(b, b, ss); }
        const float rstd = 1.0f / sqrtf(rows_sum(ss) * (1.0f / D) + RMS_EPS);
        f32x4 acc0 = {0.f, 0.f, 0.f, 0.f}, acc1 = {0.f, 0.f, 0.f, 0.f};
#pragma unroll
        for (int s_ = 0; s_ < 32; ++s_) {
            const int kb = 32 * s_ + 8 * kg;
            const f32x4 g0 = *(const LAS f32x4*)(gl + kb), g1 = *(const LAS f32x4*)(gl + kb + 4);
            float y[8];
            y[0] = bf_lo(hreg[s_][0]) * rstd * g0.x; y[1] = bf_hi(hreg[s_][0]) * rstd * g0.y; y[2] = bf_lo(hreg[s_][1]) * rstd * g0.z; y[3] = bf_hi(hreg[s_][1]) * rstd * g0.w;
            y[4] = bf_lo(hreg[s_][2]) * rstd * g1.x; y[5] = bf_hi(hreg[s_][2]) * rstd * g1.y; y[6] = bf_lo(hreg[s_][3]) * rstd * g1.z; y[7] = bf_hi(hreg[s_][3]) * rstd * g1.w;
            u32x4 yh, yl;
#pragma unroll
            for (int q = 0; q < 4; ++q) { yh[q] = cvtpk(y[2 * q], y[2 * q + 1]); yl[q] = cvtpk(y[2 * q] - bf_lo(yh[q]), y[2 * q + 1] - bf_hi(yh[q])); }
            { u32x2 w8; w8.x = pack_fp8x4(y[0], y[1], y[2], y[3]); w8.y = pack_fp8x4(y[4], y[5], y[6], y[7]); __builtin_amdgcn_raw_buffer_store_b64(__builtin_bit_cast(u32x2v, w8), rsY, (int)yoff + s_ * 32, 0, 0); }
            const bf16x8 bh0 = *(const LAS bf16x8*)(Wh + oc0 * RW_STRIDE + kb * 2), bh1 = *(const LAS bf16x8*)(Wh + oc1 * RW_STRIDE + kb * 2);
            const bf16x8 bl0 = *(const LAS bf16x8*)(Wl + oc0 * RW_STRIDE + kb * 2), bl1 = *(const LAS bf16x8*)(Wl + oc1 * RW_STRIDE + kb * 2);
            const bf16x8 ah = __builtin_bit_cast(bf16x8, yh), al = __builtin_bit_cast(bf16x8, yl);
            acc0 = __builtin_amdgcn_mfma_f32_16x16x32_bf16(ah, bh0, acc0, 0, 0, 0); acc1 = __builtin_amdgcn_mfma_f32_16x16x32_bf16(ah, bh1, acc1, 0, 0, 0);
            acc0 = __builtin_amdgcn_mfma_f32_16x16x32_bf16(al, bh0, acc0, 0, 0, 0); acc1 = __builtin_amdgcn_mfma_f32_16x16x32_bf16(al, bh1, acc1, 0, 0, 0);
            acc0 = __builtin_amdgcn_mfma_f32_16x16x32_bf16(ah, bl0, acc0, 0, 0, 0); acc1 = __builtin_amdgcn_mfma_f32_16x16x32_bf16(ah, bl1, acc1, 0, 0, 0);
            __builtin_amdgcn_sched_barrier(0);
        }
#pragma unroll
        for (int e = 0; e < 4; ++e) { tr[(4 * kg + e) * 32 + r16] = acc0[e]; tr[(4 * kg + e) * 32 + 16 + r16] = acc1[e]; }
        asm volatile("s_waitcnt lgkmcnt(0)" ::: "memory");
        if (lane < 16) {
            float a[20];
#pragma unroll
            for (int o = 0; o < 20; ++o) a[o] = tr[lane * 32 + o];
            int e0, e1; float g0_, g1_; route_decide(a, c.rgb, c.reb, e0, e1, g0_, g1_);
            const int rl = wave * 16 + lane;
            selE[rl * 2] = e0; selE[rl * 2 + 1] = e1; selG[rl * 2] = g0_; selG[rl * 2 + 1] = g1_;
        }
        __syncthreads();
        int e = 0, rank = 0;
        if (tid < 256) {
            e = selE[tid]; int mycount = 0;
#pragma unroll
            for (int x = 0; x < NE; ++x) { const unsigned long long mask = __ballot(e == x); if (e == x) rank = __popcll(mask & ((1ull << lane) - 1ull)); if (lane == x) mycount = __popcll(mask); }
            if (lane < NE) wcnt[(tid >> 6) * 16 + lane] = mycount;
        }
        __syncthreads();
        if (tid < NE) { const int c0 = wcnt[tid], c1 = wcnt[16 + tid], c2 = wcnt[32 + tid], c3 = wcnt[48 + tid]; const int tot = c0 + c1 + c2 + c3;
            int base = 0; if (tot) base = atomicAdd(c.cnt + tid, tot);
            wcnt[tid] = base; wcnt[16 + tid] = base + c0; wcnt[32 + tid] = base + c0 + c1; wcnt[48 + tid] = base + c0 + c1 + c2; }
        __syncthreads();
        if (tid < 256) { const int pos = wcnt[(tid >> 6) * 16 + e] + rank; const int tok = rb * 128 + (tid >> 1);
            c.list[e * T + pos] = tok; c.gatel[e * T + pos] = selG[tid]; c.slotref_out[tok * 2 + (tid & 1)] = e * 32768 + pos; }
        __syncthreads();
    }
    __syncthreads();
}

namespace att {
constexpr float C2 = 0.125f * 1.4426950408889634f;
constexpr float LN2 = 0.6931471805599453f;
__device__ __forceinline__ int crow(int r, int hi) { return (r & 3) + 8 * (r >> 2) + 4 * hi; }
typedef short v4i16_t __attribute__((ext_vector_type(4)));
__device__ __forceinline__ s16x4 vtr(const LAS unsigned char* p) { return __builtin_bit_cast(s16x4, __builtin_amdgcn_ds_read_tr16_b64_v4i16((LAS v4i16_t*)p)); }

struct Item { int b, g, hh, dil, j, ph; };
__device__ __forceinline__ Item decode_item(int pp, int half) {
    Item it; it.hh = pp & 7; const int q8 = (pp >> 3) & 7; it.g = (pp >> 6) % 3; it.b = pp / 192;
    const int idx16 = q8 * 2 + half; it.dil = it.g == 0 ? 1 : (it.g == 1 ? 4 : 16); const int nb = 16 / it.dil; it.j = idx16 % nb; it.ph = idx16 / nb; return it;
}
__device__ __forceinline__ int kswz(int kv) { return (kv ^ (kv >> 3)) & 7; }
__device__ __forceinline__ u32x4 fp8x8_to_bf16(unsigned a, unsigned b) {
    const f32x2 a0 = __builtin_amdgcn_cvt_pk_f32_fp8((int)a, false), a1 = __builtin_amdgcn_cvt_pk_f32_fp8((int)a, true), b0 = __builtin_amdgcn_cvt_pk_f32_fp8((int)b, false), b1 = __builtin_amdgcn_cvt_pk_f32_fp8((int)b, true);
    return (u32x4){cvtpk(a0.x, a0.y), cvtpk(a1.x, a1.y), cvtpk(b0.x, b0.y), cvtpk(b1.x, b1.y)};
}

template <int MODE>
__device__ __forceinline__ void attn_phase(LAS unsigned char* lds, const bf16* qkv, bf16* og, float* lse, int vcu, int G) {
    int tid_ = threadIdx.x; asm volatile("" : "+v"(tid_));
    const int tid = tid_, lane = tid & 63, wid = __builtin_amdgcn_readfirstlane(tid >> 6);
    const int half = wid >> 2, w = wid & 3, r32 = lane & 31, hi = lane >> 5, th = tid & 255;
    LAS unsigned char* Kl = lds + half * 69632;
    LAS unsigned char* Vl = Kl + 36864;
    u32x4 kreg[4][2], vreg[4][2]; bf16x8 qbuf[2][4];
    u32x2 qraw[2][4];
    int skv[2], sc[2];
#pragma unroll
    for (int i = 0; i < 2; ++i) { const int P_ = th + 256 * i; skv[i] = P_ >> 3; sc[i] = P_ & 7; }
    const int skv8 = th >> 2, sc16 = th & 3;
    const __amdgpu_buffer_rsrc_t rsQ = __builtin_amdgcn_make_buffer_rsrc((void*)qkv, 0, 0xFFFFFFFF, 0x00020000);
    typedef unsigned u32x4v __attribute__((ext_vector_type(4)));
#if FP8_QKVS
#define ATT_ISSUE(IT, PAR) do { const unsigned rstrideB_ = (unsigned)(IT).dil * (unsigned)QKVW; \
        const unsigned baseB_ = (unsigned)(((IT).b * SEQ + (IT).ph) * QKVW + (IT).g * 1536 + (IT).hh * 64); const int l0_ = 128 * ((IT).j - 1); \
        const unsigned vo_ = (unsigned)skv8 * rstrideB_ + (unsigned)sc16 * 16u; \
        _Pragma("unroll") for (int tt = 0; tt < 4; ++tt) { if (tt >= 2 || (IT).j != 0) { const unsigned so_ = baseB_ + (unsigned)(l0_ + 64 * tt) * rstrideB_; \
            kreg[tt][0] = __builtin_bit_cast(u32x4, __builtin_amdgcn_raw_buffer_load_b128(rsQ, (int)vo_, (int)(so_ + 512u), 0)); vreg[tt][0] = __builtin_bit_cast(u32x4, __builtin_amdgcn_raw_buffer_load_b128(rsQ, (int)vo_, (int)(so_ + 1024u), 0)); } } \
        const unsigned qo_ = (unsigned)(32 * w + r32) * rstrideB_ + (unsigned)hi * 8u, qs_ = baseB_ + (unsigned)(128 * (IT).j) * rstrideB_; \
        _Pragma("unroll") for (int d0 = 0; d0 < 4; ++d0) qraw[PAR][d0] = __builtin_bit_cast(u32x2, __builtin_amdgcn_raw_buffer_load_b64(rsQ, (int)qo_, (int)(qs_ + (unsigned)d0 * 16u), 0)); } while (0)
#else
#define ATT_ISSUE(IT, PAR) do { const unsigned rstrideB_ = (unsigned)(IT).dil * (unsigned)(QKVW * 2); \
        const unsigned baseB_ = (unsigned)(((IT).b * SEQ + (IT).ph) * QKVW + (IT).g * 1536 + (IT).hh * 64) * 2u; const int l0_ = 128 * ((IT).j - 1); \
        const unsigned vo0_ = (unsigned)skv[0] * rstrideB_ + (unsigned)sc[0] * 16u, vo1_ = (unsigned)skv[1] * rstrideB_ + (unsigned)sc[1] * 16u; \
        _Pragma("unroll") for (int tt = 0; tt < 4; ++tt) { if (tt >= 2 || (IT).j != 0) { const unsigned so_ = baseB_ + (unsigned)(l0_ + 64 * tt) * rstrideB_; \
            kreg[tt][0] = __builtin_bit_cast(u32x4, __builtin_amdgcn_raw_buffer_load_b128(rsQ, (int)vo0_, (int)(so_ + 1024u), 0)); vreg[tt][0] = __builtin_bit_cast(u32x4, __builtin_amdgcn_raw_buffer_load_b128(rsQ, (int)vo0_, (int)(so_ + 2048u), 0)); \
            kreg[tt][1] = __builtin_bit_cast(u32x4, __builtin_amdgcn_raw_buffer_load_b128(rsQ, (int)vo1_, (int)(so_ + 1024u), 0)); vreg[tt][1] = __builtin_bit_cast(u32x4, __builtin_amdgcn_raw_buffer_load_b128(rsQ, (int)vo1_, (int)(so_ + 2048u), 0)); } } \
        const unsigned qo_ = (unsigned)(32 * w + r32) * rstrideB_ + (unsigned)hi * 16u, qs_ = baseB_ + (unsigned)(128 * (IT).j) * rstrideB_; \
        _Pragma("unroll") for (int d0 = 0; d0 < 4; ++d0) qbuf[PAR][d0] = __builtin_bit_cast(bf16x8, __builtin_amdgcn_raw_buffer_load_b128(rsQ, (int)qo_, (int)(qs_ + (unsigned)d0 * 32u), 0)); } while (0)
#endif
    int pp = vcu;
    Item cur = decode_item(pp < 3072 ? pp : 0, half);
    if (pp < 3072 && MODE != 2) ATT_ISSUE(cur, 0);
    const int koff = r32 * 144 + hi * 16;
    const int voff = ((lane >> 4) & 1) * 32 + (lane & 3) * 8 + (4 * hi + ((lane & 15) >> 2)) * 64;
    for (; pp < 3072; pp += 2 * G) {
#pragma unroll
    for (int par = 0; par < 2; ++par) {
        const int ppx = pp + par * G;
        if (ppx >= 3072) break;
        const int tt_lo = (cur.j == 0) ? 2 : 0;
#pragma unroll
        for (int tt = 0; tt < 4; ++tt) { if (MODE != 2 && (tt >= 2 || cur.j != 0)) {
            if (FP8_QKVS) {
                LAS unsigned char* kd = Kl + tt * 9216 + skv8 * 144 + sc16 * 32;
                *(LAS u32x4*)(kd) = fp8x8_to_bf16(kreg[tt][0].x, kreg[tt][0].y); *(LAS u32x4*)(kd + 16) = fp8x8_to_bf16(kreg[tt][0].z, kreg[tt][0].w);
                LAS unsigned char* vd = Vl + tt * 8192 + (sc16 >> 1) * 4096 + skv8 * 64 + (sc16 & 1) * 32;
                *(LAS u32x4*)(vd) = fp8x8_to_bf16(vreg[tt][0].x, vreg[tt][0].y); *(LAS u32x4*)(vd + 16) = fp8x8_to_bf16(vreg[tt][0].z, vreg[tt][0].w);
            } else {
#pragma unroll
            for (int i = 0; i < 2; ++i) {
                *(LAS u32x4*)(Kl + tt * 9216 + skv[i] * 144 + sc[i] * 16) = kreg[tt][i];
                *(LAS u32x4*)(Vl + tt * 8192 + (sc[i] >> 2) * 4096 + skv[i] * 64 + (sc[i] & 3) * 16) = vreg[tt][i]; } } } }
        bf16x8 qr[4];
        if (FP8_QKVS) {
            asm volatile("" : "+v"(qraw[par][0]), "+v"(qraw[par][1]), "+v"(qraw[par][2]), "+v"(qraw[par][3]));
#pragma unroll
            for (int d0 = 0; d0 < 4; ++d0) qr[d0] = __builtin_bit_cast(bf16x8, fp8x8_to_bf16(qraw[par][d0].x, qraw[par][d0].y));
        } else {
            asm volatile("" : "+v"(qbuf[par][0]), "+v"(qbuf[par][1]), "+v"(qbuf[par][2]), "+v"(qbuf[par][3]));
#pragma unroll
            for (int d0 = 0; d0 < 4; ++d0) qr[d0] = qbuf[par][d0];
        }
        __syncthreads();
        const Item me = cur;
        if (ppx + G < 3072) { cur = decode_item(ppx + G, half); if (MODE != 2) ATT_ISSUE(cur, par ^ 1); }
        if (MODE == 1) { __syncthreads(); continue; }
        float m = -1e30f, l = 0.f; f32x16 oT[2]; oT[0] = f32x16{}; oT[1] = f32x16{};
        const int t_lo = (w >= 2) ? (tt_lo > 1 ? tt_lo : 1) : tt_lo, t_hi = (w < 2) ? 2 : 3, t_mid = (w < 2) ? 1 : 2;
        for (int tt = t_lo; tt <= t_hi; ++tt) {
            const LAS unsigned char* kb = Kl + tt * 9216 + koff;
            f32x16 p0 = f32x16{}, p1 = f32x16{};
#pragma unroll
            for (int d0 = 0; d0 < 4; ++d0) {
                const bf16x8 k0 = *(const LAS bf16x8*)(kb + d0 * 32), k1 = *(const LAS bf16x8*)(kb + d0 * 32 + 32 * 144);
                p0 = __builtin_amdgcn_mfma_f32_32x32x16_bf16(k0, qr[d0], p0, 0, 0, 0);
                p1 = __builtin_amdgcn_mfma_f32_32x32x16_bf16(k1, qr[d0], p1, 0, 0, 0);
            }
            float mx = -INFINITY;
            if (tt != t_mid) {
                const int dbase = 128 + 32 * w + r32 - 64 * tt;
#pragma unroll
                for (int r = 0; r < 16; ++r) {
                    const int d0_ = dbase - crow(r, hi), d1_ = d0_ - 32;
                    p0[r] = (d0_ >= 0 && d0_ <= 128) ? p0[r] * C2 : -INFINITY;
                    p1[r] = (d1_ >= 0 && d1_ <= 128) ? p1[r] * C2 : -INFINITY;
                    mx = fmaxf(mx, fmaxf(p0[r], p1[r]));
                }
            } else {
#pragma unroll
                for (int r = 0; r < 16; ++r) { p0[r] *= C2; p1[r] *= C2; mx = fmaxf(mx, fmaxf(p0[r], p1[r])); }
            }
            { const auto rr = __builtin_amdgcn_permlane32_swap(__float_as_uint(mx), __float_as_uint(mx), false, false); mx = fmaxf(__uint_as_float(rr[0]), __uint_as_float(rr[1])); }
            const float mn = fmaxf(m, mx), alpha = __builtin_amdgcn_exp2f(m - mn);
            float rs = 0.f;
#pragma unroll
            for (int r = 0; r < 16; ++r) { p0[r] = __builtin_amdgcn_exp2f(p0[r] - mn); p1[r] = __builtin_amdgcn_exp2f(p1[r] - mn); rs += p0[r] + p1[r]; }
            l = l * alpha + rs; m = mn;
#pragma unroll
            for (int r = 0; r < 16; ++r) { oT[0][r] *= alpha; oT[1][r] *= alpha; }
            u32x4 pw[4];
            pw[0] = (u32x4){cvtpk(p0[0], p0[1]), cvtpk(p0[2], p0[3]), cvtpk(p0[4], p0[5]), cvtpk(p0[6], p0[7])};
            pw[1] = (u32x4){cvtpk(p0[8], p0[9]), cvtpk(p0[10], p0[11]), cvtpk(p0[12], p0[13]), cvtpk(p0[14], p0[15])};
            pw[2] = (u32x4){cvtpk(p1[0], p1[1]), cvtpk(p1[2], p1[3]), cvtpk(p1[4], p1[5]), cvtpk(p1[6], p1[7])};
            pw[3] = (u32x4){cvtpk(p1[8], p1[9]), cvtpk(p1[10], p1[11]), cvtpk(p1[12], p1[13]), cvtpk(p1[14], p1[15])};
            const LAS unsigned char* vp = Vl + tt * 8192 + voff;
#pragma unroll
            for (int d0 = 0; d0 < 2; ++d0)
#pragma unroll
                for (int ks = 0; ks < 4; ++ks) {
                    const s16x4 lo = vtr(vp + d0 * 4096 + ks * 1024), hh4 = vtr(vp + d0 * 4096 + ks * 1024 + 512);
                    const bf16x8 vf = (bf16x8){lo[0], lo[1], lo[2], lo[3], hh4[0], hh4[1], hh4[2], hh4[3]};
                    oT[d0] = __builtin_amdgcn_mfma_f32_32x32x16_bf16(vf, __builtin_bit_cast(bf16x8, pw[ks]), oT[d0], 0, 0, 0);
                }
        }
        float lt; { const auto rr = __builtin_amdgcn_permlane32_swap(__float_as_uint(l), __float_as_uint(l), false, false); lt = __uint_as_float(rr[0]) + __uint_as_float(rr[1]); }
        const float inv = 1.0f / lt;
        const int lq = 128 * me.j + 32 * w + r32;
        const size_t tok = (size_t)me.b * SEQ + (size_t)lq * me.dil + me.ph;
        if (MODE == 3) { asm volatile("" :: "v"(oT[0]), "v"(oT[1]), "v"(inv), "v"(m)); __syncthreads(); continue; }
        bf16* orow = og + tok * (NG * AW) + me.g * AW + me.hh * 64;
#pragma unroll
        for (int d0 = 0; d0 < 2; ++d0)
#pragma unroll
            for (int rp = 0; rp < 2; ++rp) {
                const int rg = 2 * rp;
                if (FP8_OG) {
                    const float i16 = inv * 16.0f;
                    const unsigned x = pack_fp8x4(oT[d0][4 * rg] * i16, oT[d0][4 * rg + 1] * i16, oT[d0][4 * rg + 2] * i16, oT[d0][4 * rg + 3] * i16);
                    const unsigned y = pack_fp8x4(oT[d0][4 * rg + 4] * i16, oT[d0][4 * rg + 5] * i16, oT[d0][4 * rg + 6] * i16, oT[d0][4 * rg + 7] * i16);
                    auto s0 = __builtin_amdgcn_permlane32_swap(x, y, false, false);
                    u32x2 wv; wv.x = s0[0]; wv.y = s0[1];
                    *(u32x2*)((unsigned char*)og + tok * (NG * AW) + me.g * AW + me.hh * 64 + 32 * d0 + 16 * rp + 8 * hi) = wv;
                } else {
                    unsigned x0 = cvtpk(oT[d0][4 * rg] * inv, oT[d0][4 * rg + 1] * inv), x1 = cvtpk(oT[d0][4 * rg + 2] * inv, oT[d0][4 * rg + 3] * inv);
                    unsigned y0 = cvtpk(oT[d0][4 * rg + 4] * inv, oT[d0][4 * rg + 5] * inv), y1 = cvtpk(oT[d0][4 * rg + 6] * inv, oT[d0][4 * rg + 7] * inv);
                    auto s0 = __builtin_amdgcn_permlane32_swap(x0, y0, false, false); auto s1 = __builtin_amdgcn_permlane32_swap(x1, y1, false, false);
                    u32x4 wv; wv.x = s0[0]; wv.y = s1[0]; wv.z = s0[1]; wv.w = s1[1];
                    *(u32x4*)(orow + 32 * d0 + 16 * rp + 8 * hi) = wv;
                }
            }
        if (hi == 0) lse[tok * 24 + me.g * 8 + me.hh] = (m + __builtin_amdgcn_logf(lt)) * LN2;
        __syncthreads();
    }
    }
#undef ATT_ISSUE
}
}

__device__ __forceinline__ u32x4 widen16(u32x2 x, u32x2 y) {
    auto s0 = __builtin_amdgcn_permlane16_swap(x.x, y.x, false, false); auto s1 = __builtin_amdgcn_permlane16_swap(x.y, y.y, false, false);
    return (u32x4){s0[0], s1[0], s0[1], s1[1]};
}
using pg8::Unit; using pg8::BM; using pg8::HALF;
struct EpiQKV {
    static constexpr bool PERM = true;
    bf16* O; const float* cs; float sc;
    __device__ __forceinline__ void operator()(const f32x4 (&acc)[2][2][4][2], const Unit& u, int wr, int wc, int fr, int fq) const {
        const int colt = u.pn * BM; const int kind = (colt % 1536) / 512;
        const bool rot = (kind < 2) && ((wc & 1) == 0) && (fq < 2);
#pragma unroll
        for (int ai = 0; ai < 2; ++ai)
#pragma unroll
            for (int m = 0; m < 4; ++m) {
                const int row = u.pm * BM + ai * HALF + wr * 64 + m * 16 + fr;
                f32x4 c0 = {1.f, 0.f, 1.f, 0.f}, c1 = {1.f, 0.f, 1.f, 0.f};
                if (rot) { c0 = *(const f32x4*)(cs + (size_t)row * 16 + fq * 8); c1 = *(const f32x4*)(cs + (size_t)row * 16 + fq * 8 + 4); }
                bf16* rowp = O + (size_t)row * QKVW + colt + wc * 32 + 8 * fq;
                u32x2 w8[2];
#pragma unroll
                for (int bj = 0; bj < 2; ++bj) {
                    f32x4 v0 = acc[ai][bj][m][0] * sc, v1 = acc[ai][bj][m][1] * sc;
                    f32x4 o0, o1;
                    o0.x = v0.x * c0.x - v0.y * c0.y; o0.y = v0.y * c0.x + v0.x * c0.y; o0.z = v0.z * c0.z - v0.w * c0.w; o0.w = v0.w * c0.z + v0.z * c0.w;
                    o1.x = v1.x * c1.x - v1.y * c1.y; o1.y = v1.y * c1.x + v1.x * c1.y; o1.z = v1.z * c1.z - v1.w * c1.w; o1.w = v1.w * c1.z + v1.z * c1.w;
                    if (FP8_QKVS) { w8[bj].x = pack_fp8x4(o0.x, o0.y, o0.z, o0.w); w8[bj].y = pack_fp8x4(o1.x, o1.y, o1.z, o1.w); }
                    else { u32x4 w; w.x = cvtpk(o0.x, o0.y); w.y = cvtpk(o0.z, o0.w); w.z = cvtpk(o1.x, o1.y); w.w = cvtpk(o1.z, o1.w);
                        *(u32x4*)(rowp + bj * HALF) = w; }
                }
                if (FP8_QKVS) {
                    const u32x4 w16 = widen16(w8[0], w8[1]);
                    *(u32x4*)((unsigned char*)O + (size_t)row * QKVW + colt + wc * 32 + 8 * (fq & ~1) + (fq & 1) * HALF) = w16; }
                if (m & 1) asm volatile("" ::: "memory");
            }
    }
};
struct EpiBf16 {
    static constexpr bool PERM = true;
    bf16* O; int ldc;
    __device__ __forceinline__ void operator()(const f32x4 (&acc)[2][2][4][2], const Unit& u, int wr, int wc, int fr, int fq) const {
#pragma unroll
        for (int ai = 0; ai < 2; ++ai)
#pragma unroll
            for (int m = 0; m < 4; ++m) {
                bf16* rowp = O + (size_t)(u.pm * BM + ai * HALF + wr * 64 + m * 16 + fr) * ldc + u.pn * BM + wc * 32 + 8 * fq;
#pragma unroll
                for (int bj = 0; bj < 2; ++bj) { const f32x4 v0 = acc[ai][bj][m][0], v1 = acc[ai][bj][m][1];
                    u32x4 w; w.x = cvtpk(v0.x, v0.y); w.y = cvtpk(v0.z, v0.w); w.z = cvtpk(v1.x, v1.y); w.w = cvtpk(v1.z, v1.w);
                    *(u32x4*)(rowp + bj * HALF) = w; }
            }
    }
};
template <bool RES32>
struct EpiResBf16 {
    static constexpr bool PERM = true;
    const void* res; bf16* out;
    __device__ __forceinline__ void operator()(const f32x4 (&acc)[2][2][4][2], const Unit& u, int wr, int wc, int fr, int fq) const {
#pragma unroll
        for (int ai = 0; ai < 2; ++ai)
#pragma unroll
            for (int m = 0; m < 4; ++m) {
                const size_t off = (size_t)(u.pm * BM + ai * HALF + wr * 64 + m * 16 + fr) * D + u.pn * BM + wc * 32 + 8 * fq;
#pragma unroll
                for (int bj = 0; bj < 2; ++bj) {
                    f32x4 r0, r1;
                    if constexpr (RES32) { r0 = *(const f32x4*)((const float*)res + off + bj * HALF); r1 = *(const f32x4*)((const float*)res + off + bj * HALF + 4); }
                    else { const u32x4 rw = *(const u32x4*)((const bf16*)res + off + bj * HALF); r0 = (f32x4){bf_lo(rw.x), bf_hi(rw.x), bf_lo(rw.y), bf_hi(rw.y)}; r1 = (f32x4){bf_lo(rw.z), bf_hi(rw.z), bf_lo(rw.w), bf_hi(rw.w)}; }
                    const f32x4 v0 = r0 + acc[ai][bj][m][0], v1 = r1 + acc[ai][bj][m][1];
                    u32x4 w; w.x = cvtpk(v0.x, v0.y); w.y = cvtpk(v0.z, v0.w); w.z = cvtpk(v1.x, v1.y); w.w = cvtpk(v1.z, v1.w);
                    *(u32x4*)(out + off + bj * HALF) = w;
                }
                if (m & 1) asm volatile("" ::: "memory");
            }
    }
};
template <bool OUT8>
struct EpiSwiGLU {
    static constexpr bool PERM = true;
    void* O; float sc;
    __device__ __forceinline__ void operator()(const f32x4 (&acc)[2][2][4][2], const Unit& u, int wr, int wc, int fr, int fq) const {
#pragma unroll
        for (int ai = 0; ai < 2; ++ai)
#pragma unroll
            for (int mp = 0; mp < 2; ++mp) {
                u32x2 w8[2];
#pragma unroll
                for (int mi = 0; mi < 2; ++mi) { const int m = 2 * mp + mi;
                    const size_t eoff = (size_t)(u.pm * BM + ai * HALF + wr * 64 + m * 16 + fr) * DE + u.pn * HALF + wc * 32 + 8 * fq;
                    float h[8];
#pragma unroll
                    for (int n = 0; n < 2; ++n)
#pragma unroll
                        for (int e = 0; e < 4; ++e) { const float a = acc[ai][0][m][n][e] * sc, b = acc[ai][1][m][n][e] * sc;
                            h[n * 4 + e] = a * __builtin_amdgcn_rcpf(1.0f + __builtin_amdgcn_exp2f(-1.4426950408889634f * a)) * b; }
                    if constexpr (OUT8) { w8[mi].x = pack_fp8x4(h[0] * 16.f, h[1] * 16.f, h[2] * 16.f, h[3] * 16.f); w8[mi].y = pack_fp8x4(h[4] * 16.f, h[5] * 16.f, h[6] * 16.f, h[7] * 16.f); }
                    else { u32x4 w; w.x = cvtpk(h[0], h[1]); w.y = cvtpk(h[2], h[3]); w.z = cvtpk(h[4], h[5]); w.w = cvtpk(h[6], h[7]); *(u32x4*)((bf16*)O + eoff) = w; }
                }
                if constexpr (OUT8) { const u32x4 w16 = widen16(w8[0], w8[1]);
                    const int m = 2 * mp + (fq & 1);
                    *(u32x4*)((unsigned char*)O + (size_t)(u.pm * BM + ai * HALF + wr * 64 + m * 16 + fr) * DE + u.pn * HALF + wc * 32 + 8 * (fq & ~1)) = w16; }
            }
    }
};
struct EpiGate {
    static constexpr bool PERM = true;
    bf16* O; const LAS float* gtab;
    __device__ __forceinline__ void operator()(const f32x4 (&acc)[2][2][4][2], const Unit& u, int wr, int wc, int fr, int fq) const {
#pragma unroll
        for (int ai = 0; ai < 2; ++ai)
#pragma unroll
            for (int m = 0; m < 4; ++m) {
                const int rl = ai * HALF + wr * 64 + m * 16 + fr;
                const float gt = gtab[u.idx * 256 + rl];
                const size_t eoff = (size_t)(u.pm * BM + rl) * D + u.pn * BM + wc * 32 + 8 * fq;
                u32x2 w8[2];
#pragma unroll
                for (int bj = 0; bj < 2; ++bj) { const f32x4 v0 = acc[ai][bj][m][0] * gt, v1 = acc[ai][bj][m][1] * gt;
                    if (FP8_YS) { w8[bj].x = pack_fp8x4(v0.x, v0.y, v0.z, v0.w); w8[bj].y = pack_fp8x4(v1.x, v1.y, v1.z, v1.w); }
                    else { u32x4 w; w.x = cvtpk(v0.x, v0.y); w.y = cvtpk(v0.z, v0.w); w.z = cvtpk(v1.x, v1.y); w.w = cvtpk(v1.z, v1.w); *(u32x4*)(O + eoff + bj * HALF) = w; } }
                if (FP8_YS) { const u32x4 w16 = widen16(w8[0], w8[1]);
                    *(u32x4*)((unsigned char*)O + (size_t)(u.pm * BM + rl) * D + u.pn * BM + wc * 32 + 8 * (fq & ~1) + (fq & 1) * HALF) = w16; }
            }
    }
};

template <bool F8_>
struct MoeProb1T {
    static constexpr bool F8 = F8_;
    const void* A; const void* Bt; int K; const LAS int* tb; const LAS unsigned* aofs;
    __device__ __forceinline__ void a_offs(int i, const Unit&, const int (&R)[2], const int (&C)[2], unsigned (&o0)[2], unsigned (&o1)[2]) const {
#pragma unroll
        for (int k = 0; k < 2; ++k) { o0[k] = aofs[i * 256 + R[k]] + (unsigned)C[k] * 2u; o1[k] = aofs[i * 256 + 128 + R[k]] + (unsigned)C[k] * 2u; }
    }
    __device__ __forceinline__ unsigned b_off(const Unit& u) const {
        int e = 0;
#pragma unroll
        for (int k = 1; k < NE; ++k) e += (u.pm >= tb[k]) ? 1 : 0;
        return (unsigned)((e * 1024 + u.pn * 256) * 1024 * (F8 ? 1 : 2));
    }
};
template <bool F8_>
struct MoeProb2T {
    static constexpr bool F8 = F8_;
    const void* A; const void* Bt; int K; const LAS int* tb;
    __device__ __forceinline__ void a_offs(int, const Unit& u, const int (&R)[2], const int (&C)[2], unsigned (&o0)[2], unsigned (&o1)[2]) const {
        constexpr int esz = F8 ? 1 : 2;
#pragma unroll
        for (int k = 0; k < 2; ++k) { const unsigned b = (unsigned)((u.pm * BM + R[k]) * DE * esz + C[k] * 2); o0[k] = b; o1[k] = b + (unsigned)(HALF * DE * esz); }
    }
    __device__ __forceinline__ unsigned b_off(const Unit& u) const {
        int e = 0;
#pragma unroll
        for (int k = 1; k < NE; ++k) e += (u.pm >= tb[k]) ? 1 : 0;
        return (unsigned)((e * 1024 + u.pn * 256) * DE * (F8 ? 1 : 2));
    }
};
struct FoldOrder { int G, c; __device__ bool next(int i, Unit& u) const { const int L = i * G + c; if (L >= 16) return false; u.pm = L >> 2; u.pn = L & 3; return true; } };


#define XB_TMO      128
#define XB_XCNT(j)  (256  + 64 * (j))
#define XB_XSUB(j)  (1280 + 64 * (j))
#define XB_XGEN(j)  (2304 + 64 * (j))
#define XB_TOP      3328
#define XB_TOPGEN   3392
#define XCD_BAR_WORDS 3456
#define XB_SPIN_CAP (1u << 18)
__device__ __forceinline__ unsigned xb_ld(unsigned* p)              { return __hip_atomic_load(p, __ATOMIC_RELAXED, __HIP_MEMORY_SCOPE_AGENT); }
__device__ __forceinline__ unsigned xb_add(unsigned* p, unsigned v) { return __hip_atomic_fetch_add(p, v, __ATOMIC_RELAXED, __HIP_MEMORY_SCOPE_AGENT); }
__device__ __forceinline__ unsigned xb_xcc_id() { return (unsigned)__builtin_amdgcn_s_getreg((3 << 11) | 20) & 0xFu; }
#define XB_SPIN(cond, bar) do { unsigned _sp = 0; while (cond) { __builtin_amdgcn_s_sleep(1); \
    if ((++_sp & 255u) == 0u) { if (xb_ld(&(bar)[XB_TMO])) break; if (_sp > XB_SPIN_CAP) { atomicAdd(&(bar)[XB_TMO], 1u); break; } } } } while (0)
struct XcdBarrier { unsigned* bar; unsigned x; volatile LAS unsigned* st; };
__device__ __forceinline__ XcdBarrier xcd_barrier_post(unsigned* bar, volatile LAS unsigned* st) {
    XcdBarrier b; b.bar = bar; b.x = xb_xcc_id(); b.st = st;
    if (threadIdx.x == 0) (void)xb_add(&bar[XB_XCNT(b.x)], 1u);
    return b;
}
__device__ __forceinline__ void xcd_barrier_complete(unsigned* bar, unsigned x, unsigned& nloc, unsigned& nx) {
    const unsigned G = gridDim.x * gridDim.y * gridDim.z;
    unsigned sum, cnt, mine, sp = 0u;
    for (;;) {
        sum = 0u; cnt = 0u; mine = 0u;
#pragma unroll
        for (unsigned j = 0; j < 16; ++j) { const unsigned c = xb_ld(&bar[XB_XCNT(j)]); sum += c; cnt += (c > 0u) ? 1u : 0u; mine = (j == x) ? c : mine; }
        if (sum == G) break;
        __builtin_amdgcn_s_sleep(1);
        if ((++sp & 255u) == 0u) { if (xb_ld(&bar[XB_TMO])) break; if (sp > XB_SPIN_CAP) { atomicAdd(&bar[XB_TMO], 1u); break; } }
    }
    nloc = mine > 0u ? mine : 1u; nx = cnt > 0u ? cnt : 1u;
}
__device__ __forceinline__ void xcd_barrier(const XcdBarrier& b) {
    asm volatile("s_waitcnt vmcnt(0)" ::: "memory");
    __syncthreads();
    if (threadIdx.x == 0) {
        unsigned* bar = b.bar;
        __builtin_amdgcn_s_waitcnt(0);
        unsigned nloc = b.st[0], nx = b.st[1];
        if (nloc == 0u) { xcd_barrier_complete(bar, b.x, nloc, nx); b.st[0] = nloc; b.st[1] = nx; }
        const unsigned old = xb_add(&bar[XB_XSUB(b.x)], 1u);
        const unsigned gen = old / nloc;
        if (old + 1u == (gen + 1u) * nloc) {
            __builtin_amdgcn_fence(__ATOMIC_RELEASE, "agent");
            asm volatile("s_waitcnt vmcnt(0)" ::: "memory");
            const unsigned og = xb_add(&bar[XB_TOP], 1u);
            const unsigned tg = og / nx;
            if (og + 1u == (tg + 1u) * nx) xb_add(&bar[XB_TOPGEN], 1u);
            else XB_SPIN(xb_ld(&bar[XB_TOPGEN]) == tg, bar);
            __builtin_amdgcn_fence(__ATOMIC_ACQUIRE, "agent");
            xb_add(&bar[XB_XGEN(b.x)], 1u);
            asm volatile("s_waitcnt vmcnt(0)" ::: "memory");
        } else {
            XB_SPIN(xb_ld(&bar[XB_XGEN(b.x)]) == gen, bar);
            __builtin_amdgcn_fence(__ATOMIC_ACQUIRE, "agent");
            asm volatile("s_waitcnt vmcnt(0)" ::: "memory");
        }
    }
    __syncthreads();
}

constexpr int N_PHASES = 16;

typedef const __attribute__((address_space(4))) Params* KParamsPtr;
__device__ __forceinline__ KParamsPtr kparams() { KParamsPtr q = (KParamsPtr)__builtin_amdgcn_kernarg_segment_ptr(); asm volatile("" : "+s"(q)); return q; }
__global__ void __launch_bounds__(NTHREADS, 2) fwd_kernel(Params p) {
    extern __shared__ __attribute__((aligned(16))) unsigned char lds_raw[];
    LAS unsigned char* lds = (LAS unsigned char*)lds_raw;
    const int tid = threadIdx.x, lane = tid & 63, wave = __builtin_amdgcn_readfirstlane(tid >> 6);
    const int G = gridDim.x, bx = blockIdx.x;
    const int vcu = (G % 8 == 0) ? (bx % 8) * (G / 8) + bx / 8 : bx;
#define KP() kparams()
#define WSB() ((unsigned char*)KP()->ws)
#define G_ctl ((int*)(WSB() + WS_CTL))
#define G_cs ((float*)(WSB() + WS_CS))
#define G_lse ((float*)(WSB() + WS_LSE))
#define G_slotref ((int*)(WSB() + WS_SLOTREF))
#define Wgs ((bf16*)(WSB() + WS_WGS))
#define G_list ((int*)(WSB() + WS_LIST))
#define G_gatel ((float*)(WSB() + WS_GATEL))
#define Win_t ((bf16*)(WSB() + WS_WIN))
#define Wout_t ((bf16*)(WSB() + WS_WOUT))
#define Wpin_t ((bf16*)(WSB() + WS_WPIN))
#define Wc_t ((bf16*)(WSB() + WS_WC))
#define Wpo_t ((bf16*)(WSB() + WS_WPO))
#define W13 ((bf16*)(WSB() + WS_W13))
#define W2 ((bf16*)(WSB() + WS_W2))
#define Y ((bf16*)(WSB() + WS_Y))
#define QKV ((bf16*)(WSB() + WS_BIG))
#define OM ((bf16*)(WSB() + WS_OM))
#define HMID ((bf16*)(WSB() + WS_HMID))
#define YS ((bf16*)(WSB() + WS_YS))
#define U ((bf16*)(WSB() + WS_U))
#define POOLED ((bf16*)(WSB() + WS_POOLED))
#define OG ((bf16*)KP()->out)
#define H ((bf16*)(WSB() + WS_H))
    LAS int* tb = (LAS int*)(lds + MISC_OFF);
    LAS unsigned* aofs = (LAS unsigned*)(lds + AOFS_OFF);

    const int lo = p.ph_lo, hi = p.ph_hi;
#if MK_N_LAUNCHES == 1
    cg::grid_group grid = cg::this_grid();
    if (tid < 2) ((volatile LAS unsigned*)(lds + MISC_OFF))[64 + tid] = 0u;
    __syncthreads();
    const XcdBarrier xbar = xcd_barrier_post((unsigned*)(G_ctl + CW_BAR), (volatile LAS unsigned*)(lds + MISC_OFF) + 64);
#define GRID_BAR(k) do { if ((k) == CG_SEAM) grid.sync(); else xcd_barrier(xbar); } while (0)
#else
#define GRID_BAR(k) do { } while (0)
#endif
#ifndef PHASE_MASK
#define PHASE_MASK 0xffff
#endif
#ifndef REPEAT_MASK
#define REPEAT_MASK 0x0
#endif
#define REP(k) for (int rep_ = 0; rep_ <= ((REPEAT_MASK >> (k)) & 1); ++rep_)
#define IN(k) (((PHASE_MASK >> (k)) & 1) && lo <= (k) && (k) < hi)
#ifndef DOUBLE_BAR
#define DOUBLE_BAR 0
#endif
#ifndef PROBE_PHASE
#define PROBE_PHASE (-1)
#endif
#define PT0(k) if (PROBE_PHASE == (k)) pt0 = __builtin_amdgcn_s_memrealtime();
#define PT1(k) if (PROBE_PHASE == (k)) { const unsigned long long t1_ = __builtin_amdgcn_s_memrealtime(), d_ = t1_ - pt0; while (__builtin_amdgcn_s_memrealtime() - t1_ < d_) __builtin_amdgcn_s_sleep(8); }
#define SEAM(k) do { if (IN(k) && IN((k) + 1)) { _Pragma("unroll 1") for (int nb_ = 0; nb_ < 1 + (DOUBLE_BAR ? (hi > 0 ? 1 : 0) : 0); ++nb_) GRID_BAR(k); } } while (0)

    unsigned long long pt0 = 0;
    PT0(0)
    if (IN(0)) REP(0) {
        LAS float* scr = (LAS float*)(lds + wave * 16384);
        const int gw = vcu * NWAVES + wave, NGW = G * NWAVES;
        constexpr int I_IN = (D / 64) * (QKVW / 32);
        constexpr int I_OUT = (AW / 64) * (D / 32);
        constexpr int I_PIN = (D / 64) * (D / 32);
        constexpr int I_PO = I_PIN;
        constexpr int I_W1 = (D / 64) * (DE / 32);
        constexpr int I_W2 = (DE / 64) * (D / 32);
        constexpr int NITEMS = I_IN + I_OUT + I_PIN + I_PO + 32 * (2 * I_W1 + I_W2);
        for (int it = gw; it < NITEMS; it += NGW) {
            int r = it;
            if (r < I_IN) { const int nblk = QKVW / 32;
                if (FP8_QKV) transpose_item8(KP()->attn_w_in, QKVW, D, (unsigned char*)Win_t, MapQKV{}, 32.f, scr, 64 * (r / nblk), 32 * (r % nblk), lane);
                else transpose_item(KP()->attn_w_in, QKVW, D, Win_t, MapQKV{}, scr, 64 * (r / nblk), 32 * (r % nblk), lane);
                continue; } r -= I_IN;
            if (r < I_OUT) { const int nblk = D / 32; transpose_item(KP()->attn_w_out, D, AW, Wout_t, MapId{}, scr, 64 * (r / nblk), 32 * (r % nblk), lane); continue; } r -= I_OUT;
            if (r < I_PIN) { const int nblk = D / 32; transpose_item(KP()->pool_w_in, D, D, Wpin_t, MapId{}, scr, 64 * (r / nblk), 32 * (r % nblk), lane); continue; } r -= I_PIN;
            if (r < I_PO) { const int nblk = D / 32; transpose_item(KP()->pool_w_out, D, D, Wpo_t, MapId{}, scr, 64 * (r / nblk), 32 * (r % nblk), lane); continue; } r -= I_PO;
            const int le = r / (2 * I_W1 + I_W2); r -= le * (2 * I_W1 + I_W2);
            if (r < I_W1) { const int nblk = DE / 32;
                if (FP8_MOE1) transpose_item8(KP()->expert_w1 + (size_t)le * D * DE, DE, D, (unsigned char*)W13 + (size_t)le * 1024 * 1024, MapW13{0}, 32.f, scr, 64 * (r / nblk), 32 * (r % nblk), lane);
                else transpose_item(KP()->expert_w1 + (size_t)le * D * DE, DE, D, W13 + (size_t)le * 1024 * 1024, MapW13{0}, scr, 64 * (r / nblk), 32 * (r % nblk), lane);
                continue; } r -= I_W1;
            if (r < I_W1) { const int nblk = DE / 32;
                if (FP8_MOE1) transpose_item8(KP()->expert_w3 + (size_t)le * D * DE, DE, D, (unsigned char*)W13 + (size_t)le * 1024 * 1024, MapW13{128}, 32.f, scr, 64 * (r / nblk), 32 * (r % nblk), lane);
                else transpose_item(KP()->expert_w3 + (size_t)le * D * DE, DE, D, W13 + (size_t)le * 1024 * 1024, MapW13{128}, scr, 64 * (r / nblk), 32 * (r % nblk), lane);
                continue; } r -= I_W1;
            { const int nblk = D / 32;
                if (FP8_MOE2) transpose_item8(KP()->expert_w2 + (size_t)le * DE * D, D, DE, (unsigned char*)W2 + (size_t)le * 1024 * DE, MapId{}, 32.f, scr, 64 * (r / nblk), 32 * (r % nblk), lane);
                else transpose_item(KP()->expert_w2 + (size_t)le * DE * D, D, DE, W2 + (size_t)le * 1024 * DE, MapId{}, scr, 64 * (r / nblk), 32 * (r % nblk), lane); }
        }
        for (int i = vcu * NTHREADS + tid; i < 4 * 256 * 256 / 4; i += G * NTHREADS) {
            const int e4 = (i & 63) * 4, gidx = i >> 14;
            const f32x4 wv = *(const f32x4*)(KP()->pool_w_group + (size_t)i * 4); const f32x4 sc = *(const f32x4*)(KP()->pool_scale + gidx * 256 + e4);
            u32x2 o; o.x = cvtpk(wv.x * sc.x, wv.y * sc.y); o.y = cvtpk(wv.z * sc.z, wv.w * sc.w); *(u32x2*)(Wgs + (size_t)i * 4) = o;
        }
        for (int i = vcu * NTHREADS + tid; i < T * 8; i += G * NTHREADS) {
            const int tok = i >> 3, f = i & 7;
            const double invf = exp2(-(double)f * 0.125 * 18.931568569324174);
            const float ang = (float)KP()->positions[tok] * (float)invf;
            double sn, cn; sincos((double)ang, &sn, &cn);
            G_cs[(size_t)i * 2] = (float)cn; G_cs[(size_t)i * 2 + 1] = (float)sn;
        }
        RowPassCfg c{}; c.hin = KP()->x; c.gain = KP()->norm_mix; if (FP8_QKV) c.yout8 = (unsigned char*)Y; else c.yout = Y;
        row_pass<false, false, false>(lds, c, vcu, wave);
    }
    SEAM(0); PT1(0)
    PT0(1)
    if (IN(1)) REP(1) {
        pg8::DenseProbT<FP8_QKV != 0> P{Y, Win_t, D, D, 0, (size_t)256 * D};
        pg8::StaticOrder S; S.init(T / 256, QKVW / 256, G, bx);
        EpiQKV E{QKV, G_cs, FP8_QKV ? (1.0f / 32.0f) : 1.0f};
        pg8::gemm_phase<pg8::DenseProbT<FP8_QKV != 0>, EpiQKV, pg8::StaticOrder, true>(lds, P, S, E);
    }
    SEAM(1); PT1(1)
    PT0(2)
    if (IN(2)) REP(2) {
#ifndef ATT_PROBE_MODE
#define ATT_PROBE_MODE 0
#endif
        if (ATT_PROBE_MODE == 1) att::attn_phase<1>(lds, QKV, OG, G_lse, vcu, G);
        if (ATT_PROBE_MODE == 2) att::attn_phase<2>(lds, QKV, OG, G_lse, vcu, G);
        if (ATT_PROBE_MODE == 3) att::attn_phase<3>(lds, QKV, OG, G_lse, vcu, G);
        att::attn_phase<0>(lds, QKV, OG, G_lse, vcu, G);
    }
    SEAM(2); PT1(2)
    PT0(3)
    if (IN(3)) REP(3) {
        for (int row = vcu * NWAVES + wave; row < T; row += G * NWAVES) {
            const int h = lane >> 3;
            const float l0 = G_lse[(size_t)row * 24 + h], l1 = G_lse[(size_t)row * 24 + 8 + h], l2 = G_lse[(size_t)row * 24 + 16 + h];
            const float mx = fmaxf(l0, fmaxf(l1, l2));
            float w0 = __expf(l0 - mx), w1 = __expf(l1 - mx), w2 = __expf(l2 - mx); const float inv = 1.0f / (w0 + w1 + w2); w0 *= inv; w1 *= inv; w2 *= inv;
            u32x4 o;
            if (FP8_OG) {
                const unsigned char* src = (const unsigned char*)OG + (size_t)row * 1536 + lane * 8;
                const u32x2 a = *(const u32x2*)(src), b = *(const u32x2*)(src + 512), c = *(const u32x2*)(src + 1024);
                w0 *= (1.0f / 16.0f); w1 *= (1.0f / 16.0f); w2 *= (1.0f / 16.0f);
#define MRG_(WA, WB, WC, SEL) cvtpk(w0 * __builtin_amdgcn_cvt_pk_f32_fp8((int)(WA), SEL)[0] + w1 * __builtin_amdgcn_cvt_pk_f32_fp8((int)(WB), SEL)[0] + w2 * __builtin_amdgcn_cvt_pk_f32_fp8((int)(WC), SEL)[0], \
                                    w0 * __builtin_amdgcn_cvt_pk_f32_fp8((int)(WA), SEL)[1] + w1 * __builtin_amdgcn_cvt_pk_f32_fp8((int)(WB), SEL)[1] + w2 * __builtin_amdgcn_cvt_pk_f32_fp8((int)(WC), SEL)[1])
                o[0] = MRG_(a.x, b.x, c.x, false); o[1] = MRG_(a.x, b.x, c.x, true); o[2] = MRG_(a.y, b.y, c.y, false); o[3] = MRG_(a.y, b.y, c.y, true);
#undef MRG_
            } else {
            const bf16* src = OG + (size_t)row * 1536 + lane * 8;
            const u32x4 a = *(const u32x4*)(src), b = *(const u32x4*)(src + 512), c = *(const u32x4*)(src + 1024);
#pragma unroll
            for (int k = 0; k < 4; ++k) { const float lo_ = w0 * bf_lo(a[k]) + w1 * bf_lo(b[k]) + w2 * bf_lo(c[k]), hi_ = w0 * bf_hi(a[k]) + w1 * bf_hi(b[k]) + w2 * bf_hi(c[k]); o[k] = cvtpk(lo_, hi_); }
            }
            *(u32x4*)(OM + (size_t)row * AW + lane * 8) = o;
        }
    }
    SEAM(3); PT1(3)
    PT0(4)
    if (IN(4)) REP(4) {
        pg8::DenseProb P{OM, Wout_t, AW, AW, 0, (size_t)256 * AW};
        pg8::StaticOrder S; S.init(T / 256, D / 256, G, bx);
        EpiResBf16<true> E{KP()->x, H};
        pg8::gemm_phase<pg8::DenseProb, EpiResBf16<true>, pg8::StaticOrder, true>(lds, P, S, E);
    }
    SEAM(4); PT1(4)
#pragma unroll 1
    for (int L = 0; L < 2; ++L) {
        const int pb = (L == 0) ? 5 : 12;
        int* cnt = G_ctl + CW_CNT + L * NE;
        PT0(pb)
        if (IN(pb)) {
            RowPassCfg c{}; c.hin16 = H; c.gain = KP()->norm_ffn + L * D; if (FP8_MOE1) c.yout8 = (unsigned char*)Y; else c.yout = Y;
            c.rgw = KP()->router_group_w + (size_t)L * D * 4; c.rgb = KP()->router_group_b + L * 4; c.rew = KP()->router_expert_w + (size_t)L * 4 * D * 4; c.reb = KP()->router_expert_b + L * 16;
            c.cnt = cnt; c.list = G_list + (size_t)L * NE * T; c.gatel = G_gatel + (size_t)L * NE * T; c.slotref_out = G_slotref + (size_t)L * T * 2;
            if ((REPEAT_MASK >> pb) & 1) {
                RowPassCfg c2 = c; c2.cnt = G_ctl + 64 + L * NE; c2.list = (int*)(WSB() + WS_BIG + 200 * MiB); c2.gatel = (float*)(WSB() + WS_BIG + 204 * MiB); c2.slotref_out = (int*)(WSB() + WS_BIG + 208 * MiB);
                if (ROUTER_MFMA) router_pass(lds, c2, vcu, wave); else row_pass<false, true, true>(lds, c2, vcu, wave);
            }
            if (ROUTER_MFMA) router_pass(lds, c, vcu, wave); else row_pass<false, true, true>(lds, c, vcu, wave);
        }
        SEAM(pb); PT1(pb)
        PT0(pb + 1)
        if (IN(pb + 1) || IN(pb + 2)) {
            if (tid == 0) { int s = 0; for (int e = 0; e < NE; ++e) { tb[e] = s; tb[32 + e] = cnt[e]; s += (cnt[e] + 255) >> 8; } tb[NE] = s; }
            __syncthreads();
        }
        if (IN(pb + 1)) REP(pb + 1) {
            const int NT = tb[NE];
            pg8::StaticOrder S; S.init(NT, 4, G, bx);
            for (int i = 0; i < 8; ++i) { Unit u; if (!S.next(i, u)) break;
                int e = 0;
                for (int k = 1; k < NE; ++k) e += (u.pm >= tb[k]) ? 1 : 0;
                if (tid < 256) { const int li = (u.pm - tb[e]) * 256 + tid; const int tok = (li < tb[32 + e]) ? G_list[((size_t)L * NE + e) * T + li] : 0; aofs[i * 256 + tid] = (unsigned)tok * (unsigned)(D * (FP8_MOE1 ? 1 : 2)); } }
            __syncthreads();
            MoeProb1T<FP8_MOE1 != 0> P{Y, (const unsigned char*)W13 + (size_t)L * NE * 1024 * 1024 * (FP8_MOE1 ? 1 : 2), D, tb, aofs};
            EpiSwiGLU<FP8_MOE2 != 0> E{HMID, FP8_MOE1 ? (1.0f / 32.0f) : 1.0f};
            pg8::gemm_phase<MoeProb1T<FP8_MOE1 != 0>, EpiSwiGLU<FP8_MOE2 != 0>, pg8::StaticOrder, true>(lds, P, S, E);
            if (L == 0) {
                pg8::DenseProb Pf{Wpo_t, Wgs, 256, D, 256, (size_t)256 * 256};
                FoldOrder Sf{G, G - 1 - bx};
                EpiBf16 Ef{Wc_t, D};
                pg8::gemm_phase<pg8::DenseProb, EpiBf16, FoldOrder, true>(lds, Pf, Sf, Ef);
            }
        }
        SEAM(pb + 1); PT1(pb + 1)
        PT0(pb + 2)
        if (IN(pb + 2)) REP(pb + 2) {
            const int NT = tb[NE];
            pg8::StaticOrder S; S.init(NT, 4, G, bx);
            { const float gsc = (FP8_MOE2 ? (1.0f / 512.0f) : 1.0f) * (FP8_YS ? 64.0f : 1.0f);
              for (int i = 0; i < 8; ++i) { Unit u; if (!S.next(i, u)) break;
                int e = 0;
                for (int k = 1; k < NE; ++k) e += (u.pm >= tb[k]) ? 1 : 0;
                if (tid < 256) { const int li = (u.pm - tb[e]) * 256 + tid; ((LAS float*)aofs)[i * 256 + tid] = (li < tb[32 + e]) ? G_gatel[((size_t)L * NE + e) * T + li] * gsc : 0.f; } }
              __syncthreads(); }
            MoeProb2T<FP8_MOE2 != 0> P{HMID, (const unsigned char*)W2 + (size_t)L * NE * 1024 * DE * (FP8_MOE2 ? 1 : 2), DE, tb};
            EpiGate E{YS, (const LAS float*)aofs};
            pg8::gemm_phase<MoeProb2T<FP8_MOE2 != 0>, EpiGate, pg8::StaticOrder, true>(lds, P, S, E);
        }
        SEAM(pb + 2); PT1(pb + 2)
        if (L == 0) {
            PT0(8)
            if (IN(8)) {
                RowPassCfg c{}; c.hin16 = H; c.ys = YS; c.slotref = G_slotref; c.cnt_prev = cnt; c.hout = H; c.gain = KP()->norm_mix + D; c.yout = Y;
                if ((REPEAT_MASK >> 8) & 1) { RowPassCfg c2 = c; c2.hout = nullptr; row_pass<true, false, true>(lds, c2, vcu, wave); }
                row_pass<true, false, true>(lds, c, vcu, wave);
            }
            SEAM(8); PT1(8)
            PT0(9)
            if (IN(9)) REP(9) {
                pg8::DenseProb P{Y, Wpin_t, D, D, 0, (size_t)256 * D};
                pg8::StaticOrder S; S.init(T / 256, D / 256, G, bx);
                EpiBf16 E{U, D};
                pg8::gemm_phase<pg8::DenseProb, EpiBf16, pg8::StaticOrder, true>(lds, P, S, E);
            }
            SEAM(9); PT1(9)
            PT0(10)
            if (IN(10)) REP(10) {
                int tq10 = threadIdx.x; asm volatile("" : "+v"(tq10));
                for (int it = vcu * NTHREADS + tq10; it < (T / 32) * 128; it += G * NTHREADS) {
                    const int ch = (it & 127) * 8, run = it >> 7, t0 = run * 32, s0 = t0 & (SEQ - 1);
                    const int wdw = 2 << (ch >> 8);
                    float sum[8];
#pragma unroll
                    for (int k = 0; k < 8; ++k) sum[k] = 0.f;
                    for (int i = 1; i < wdw; ++i) { if (s0 - i < 0) break; const u32x4 a = *(const u32x4*)(U + (size_t)(t0 - i) * D + ch);
#pragma unroll
                        for (int k = 0; k < 4; ++k) { sum[2 * k] += bf_lo(a[k]); sum[2 * k + 1] += bf_hi(a[k]); } }
                    for (int i0 = 0; i0 < 32; i0 += 8) {
                        u32x4 a8[8], o8[8];
#pragma unroll
                        for (int i = 0; i < 8; ++i) { const int tk = t0 + i0 + i, sq = s0 + i0 + i;
                            a8[i] = *(const u32x4*)(U + (size_t)tk * D + ch);
                            const int tko = tk - wdw + 1; const unsigned msk = (sq - wdw + 1 >= 0) ? 0xffffffffu : 0u;
                            const u32x4 ov = *(const u32x4*)(U + (size_t)(tko < 0 ? 0 : tko) * D + ch); o8[i] = (u32x4){ov.x & msk, ov.y & msk, ov.z & msk, ov.w & msk}; }
#pragma unroll
                        for (int i = 0; i < 8; ++i) { const int tk = t0 + i0 + i, sq = s0 + i0 + i;
                            float cur[8];
#pragma unroll
                            for (int k = 0; k < 4; ++k) { cur[2 * k] = bf_lo(a8[i][k]); cur[2 * k + 1] = bf_hi(a8[i][k]); }
#pragma unroll
                            for (int k = 0; k < 8; ++k) sum[k] += cur[k];
                            const float invc = 1.0f / (float)((sq + 1) < wdw ? (sq + 1) : wdw);
                            u32x4 w;
#pragma unroll
                            for (int k = 0; k < 4; ++k) w[k] = cvtpk(sum[2 * k] * invc - cur[2 * k], sum[2 * k + 1] * invc - cur[2 * k + 1]);
                            *(u32x4*)(POOLED + (size_t)tk * D + ch) = w;
#pragma unroll
                            for (int k = 0; k < 4; ++k) { sum[2 * k] -= bf_lo(o8[i][k]); sum[2 * k + 1] -= bf_hi(o8[i][k]); }
                        }
                    }
                }
            }
            SEAM(10); PT1(10)
            PT0(11)
            if (IN(11)) REP(11) {
                pg8::DenseProb P{POOLED, Wc_t, D, D, 0, (size_t)256 * D};
                pg8::StaticOrder S; S.init(T / 256, D / 256, G, bx);
                EpiResBf16<false> E{H, (((REPEAT_MASK >> 11) & 1) && rep_ == 0) ? (bf16*)(WSB() + WS_BIG + 136 * MiB) : H};
                pg8::gemm_phase<pg8::DenseProb, EpiResBf16<false>, pg8::StaticOrder, true>(lds, P, S, E);
            }
            SEAM(11); PT1(11)
        }
    }
    PT0(15)
    if (IN(15)) {
        RowPassCfg c{}; c.hin16 = H; c.ys = YS; c.slotref = G_slotref + (size_t)T * 2; c.cnt_prev = G_ctl + CW_CNT + NE; c.gain = KP()->norm_final; c.fout = KP()->out;
        if ((REPEAT_MASK >> 15) & 1) { RowPassCfg c2 = c; c2.fout = nullptr; c2.yout = Y; row_pass<true, false, true>(lds, c2, vcu, wave); }
        row_pass<true, false, true>(lds, c, vcu, wave);
    }
    PT1(15)
#undef IN
#undef SEAM
#undef GRID_BAR
}

#undef KP
#undef WSB
#undef G_ctl
#undef G_cs
#undef G_lse
#undef G_slotref
#undef Wgs
#undef G_list
#undef G_gatel
#undef Win_t
#undef Wout_t
#undef Wpin_t
#undef Wc_t
#undef Wpo_t
#undef W13
#undef W2
#undef Y
#undef QKV
#undef OM
#undef HMID
#undef YS
#undef U
#undef POOLED
#undef OG
#undef H
extern "C" void kernel_launch(void* const* d_in, const int* in_sizes, int n_in, void* d_out, int out_size, void* d_ws, size_t ws_size, hipStream_t stream) {
    static int grid = 0;
    if (grid == 0) {
        if (n_in != 18 || in_sizes[0] != T * D || out_size != T * D || ws_size < WS_END) { fprintf(stderr, "kernel_launch: unexpected shapes (n_in %d, in0 %d, out %d, ws %zu)\n", n_in, n_in > 0 ? in_sizes[0] : -1, out_size, ws_size); grid = -1; return; }
        int dev = 0, cus = 0, per_cu = 0;
        if (hipGetDevice(&dev) != hipSuccess || hipDeviceGetAttribute(&cus, hipDeviceAttributeMultiprocessorCount, dev) != hipSuccess) { grid = -1; return; }
        if (hipFuncSetAttribute((const void*)fwd_kernel, hipFuncAttributeMaxDynamicSharedMemorySize, LDS_BYTES) != hipSuccess) { fprintf(stderr, "kernel_launch: hipFuncSetAttribute failed\n"); grid = -1; return; }
        if (hipOccupancyMaxActiveBlocksPerMultiprocessor(&per_cu, (const void*)fwd_kernel, NTHREADS, LDS_BYTES) != hipSuccess || per_cu < 1) { fprintf(stderr, "kernel_launch: occupancy query says %d\n", per_cu); per_cu = 1; }
        (void)hipGetLastError();
        grid = cus;
    }
    if (grid < 0) return;
    (void)hipMemsetAsync((char*)d_ws + WS_CTL, 0, CTL_ZERO_BYTES, stream);
    Params p{};
    p.x = (const float*)d_in[0]; p.positions = (const int*)d_in[1]; p.norm_mix = (const float*)d_in[2]; p.norm_ffn = (const float*)d_in[3]; p.norm_final = (const float*)d_in[4];
    p.attn_w_in = (const float*)d_in[5]; p.attn_w_out = (const float*)d_in[6]; p.pool_w_in = (const float*)d_in[7]; p.pool_w_group = (const float*)d_in[8]; p.pool_scale = (const float*)d_in[9]; p.pool_w_out = (const float*)d_in[10];
    p.router_group_w = (const float*)d_in[11]; p.router_group_b = (const float*)d_in[12]; p.router_expert_w = (const float*)d_in[13]; p.router_expert_b = (const float*)d_in[14];
    p.expert_w1 = (const float*)d_in[15]; p.expert_w3 = (const float*)d_in[16]; p.expert_w2 = (const float*)d_in[17];
    p.out = (float*)d_out; p.ws = (unsigned char*)d_ws;
#if MK_N_LAUNCHES == 1
    p.ph_lo = 0; p.ph_hi = N_PHASES;
    void* args[] = {&p};
    hipError_t e = hipLaunchCooperativeKernel((const void*)fwd_kernel, dim3(grid), dim3(NTHREADS), args, LDS_BYTES, stream);
    if (e != hipSuccess) fprintf(stderr, "cooperative launch failed: %s (grid %d)\n", hipGetErrorString(e), grid);
#else
    for (int ph = 0; ph < N_PHASES; ++ph) {
        p.ph_lo = ph; p.ph_hi = ph + 1;
        hipLaunchKernelGGL(fwd_kernel, dim3(grid), dim3(NTHREADS), LDS_BYTES, stream, p);
    }
#endif
}
```

```cpp
#include <hip/hip_runtime.h>
#include <hip/hip_cooperative_groups.h>
#include <cstdio>
#include <cstdint>
namespace cg = cooperative_groups;

#ifndef MK_N_LAUNCHES
#define MK_N_LAUNCHES 1
#endif

#ifndef FP8_MOE1
#define FP8_MOE1 1
#endif
#ifndef FP8_MOE2
#define FP8_MOE2 1
#endif
#ifndef FP8_QKVS
#define FP8_QKVS 1
#endif
#ifndef ROUTER_MFMA
#define ROUTER_MFMA 1
#endif
#ifndef FP8_OG
#define FP8_OG 1
#endif
#ifndef FP8_YS
#define FP8_YS 1
#endif
#ifndef FP8_QKV
#define FP8_QKV 1
#endif
#define LAS __attribute__((address_space(3)))
#define GAS __attribute__((address_space(1)))
typedef unsigned short bf16;
typedef short bf16x8 __attribute__((ext_vector_type(8)));
typedef float f32x4 __attribute__((ext_vector_type(4)));
typedef float f32x2 __attribute__((ext_vector_type(2)));
typedef float f32x16 __attribute__((ext_vector_type(16)));
typedef unsigned u32x4 __attribute__((ext_vector_type(4)));
typedef unsigned u32x2 __attribute__((ext_vector_type(2)));
typedef short s16x4 __attribute__((ext_vector_type(4)));
typedef __bf16 bf16x2_t __attribute__((ext_vector_type(2)));
typedef int i32x4 __attribute__((ext_vector_type(4)));
typedef int i32x8 __attribute__((ext_vector_type(8)));

constexpr int BATCH = 16, SEQ = 2048, D = 1024, T = BATCH * SEQ;
constexpr int NG = 3, HPG = 8, HD = 64, AW = 512, QKVW = NG * 3 * AW;
constexpr int NE = 16, DE = 512, SLOTS = 2 * T;
constexpr int MAXTILES = SLOTS / 256 + NE;
constexpr float RMS_EPS = 1e-6f;
constexpr int NWAVES = 8, NTHREADS = 512;

constexpr size_t MiB = 1u << 20;
constexpr size_t WS_CTL = 0, CTL_ZERO_BYTES = 64 * 1024;
constexpr size_t WS_CS = 1 * MiB;
constexpr size_t WS_LSE = 3 * MiB;
constexpr size_t WS_SLOTREF = 6 * MiB;
constexpr size_t WS_WGS = 7 * MiB;
constexpr size_t WS_LIST = 8 * MiB;
constexpr size_t WS_GATEL = 12 * MiB;
constexpr size_t WS_WIN = 16 * MiB;
constexpr size_t WS_WOUT = 25 * MiB;
constexpr size_t WS_WPIN = 26 * MiB;
constexpr size_t WS_WC = 28 * MiB;
constexpr size_t WS_WPO = 30 * MiB;
constexpr size_t WS_W13 = 32 * MiB;
constexpr size_t WS_W2 = 96 * MiB;
constexpr size_t WS_Y = 128 * MiB;
constexpr size_t WS_BIG = 192 * MiB;
constexpr size_t WS_OM = WS_BIG;
constexpr size_t WS_HMID = WS_BIG;
constexpr size_t WS_YS = WS_BIG + 72 * MiB;
constexpr size_t WS_U = WS_BIG;
constexpr size_t WS_POOLED = WS_BIG + 64 * MiB;
constexpr size_t WS_H = WS_BIG + 208 * MiB;
constexpr size_t WS_END = WS_BIG + 288 * MiB;
constexpr int CW_CNT = 0;
constexpr int CW_BAR = 1024;
#ifndef CG_SEAM
#define CG_SEAM (-1)
#endif

constexpr int RING_BYTES = 131072;
constexpr int AOFS_OFF = RING_BYTES;
constexpr int MISC_OFF = AOFS_OFF + 8192;
constexpr int LDS_BYTES = 147456;

__device__ __forceinline__ unsigned cvtpk(float lo, float hi) { f32x2 v = {lo, hi}; bf16x2_t b = __builtin_convertvector(v, bf16x2_t); return __builtin_bit_cast(unsigned, b); }
__device__ __forceinline__ float clamp8(float v) { return __builtin_amdgcn_fmed3f(v, -448.0f, 448.0f); }
__device__ __forceinline__ unsigned pack_fp8x4(float a, float b, float c, float d) {
    int r = __builtin_amdgcn_cvt_pk_fp8_f32(clamp8(a), clamp8(b), 0, false); r = __builtin_amdgcn_cvt_pk_fp8_f32(clamp8(c), clamp8(d), r, true); return (unsigned)r; }
__device__ __forceinline__ float bf_lo(unsigned u) { return __uint_as_float(u << 16); }
__device__ __forceinline__ float bf_hi(unsigned u) { return __uint_as_float(u & 0xffff0000u); }
#define DPP_ADD(v, ctrl) ((v) + __builtin_bit_cast(float, __builtin_amdgcn_update_dpp(0, __builtin_bit_cast(int, (v)), (ctrl), 0xF, 0xF, true)))
__device__ __forceinline__ float rows_sum(float v) {
    auto p = __builtin_amdgcn_permlane16_swap(__float_as_uint(v), __float_as_uint(v), false, false);
    const float t = __uint_as_float(p[0]) + __uint_as_float(p[1]);
    auto q = __builtin_amdgcn_permlane32_swap(__float_as_uint(t), __float_as_uint(t), false, false);
    return __uint_as_float(q[0]) + __uint_as_float(q[1]);
}
__device__ __forceinline__ float wave_sum(float v) {
    v = DPP_ADD(v, 0xB1);
    v = DPP_ADD(v, 0x4E);
    v = DPP_ADD(v, 0x141);
    v = DPP_ADD(v, 0x140);
    return rows_sum(v);
}

namespace pg8 {
constexpr int BM = 256, BK = 64, HALF = 128, HTB = HALF * BK * 2, STAGE_BYTES = 8 * HTB, NXCD = 8, WGM = 8;
__host__ __device__ __forceinline__ int lds_byte(int r, int c) { const int st = (r >> 4) * 2 + (c >> 5), rr = r & 15, cc = c & 31, ob = rr * 64 + cc * 2; return st * 1024 + (ob ^ (((ob >> 9) & 1) << 5)); }
__host__ __device__ __forceinline__ void stage_rc(int b, int& R, int& C) { const int st = b / 1024, sb = b % 1024, swz = sb ^ (((sb >> 9) & 1) << 5); R = (st >> 1) * 16 + swz / 64; C = (st & 1) * 32 + (swz % 64) / 2; }
__host__ __device__ __forceinline__ int perm32(int rho) { const int n = rho >> 4, i = rho & 15; return 8 * (i >> 2) + 4 * n + (i & 3); }

struct Unit { int pm, pn, idx; };

struct StaticOrder {
    int nM, nN, nwg, G, c;
    __device__ void init(int nM_, int nN_, int G_, int c_) { nM = nM_; nN = nN_; nwg = nM * nN; G = G_; c = c_; }
    __device__ bool next(int i, Unit& u) const {
        const long L = (long)i * G + c; if (L >= nwg) return false;
        int wgid = (int)L; { const int q = nwg / NXCD, r = nwg % NXCD, xcd = wgid % NXCD, off = wgid / NXCD; wgid = (xcd < r ? xcd * (q + 1) : r * (q + 1) + (xcd - r) * q) + off; }
        const int nig = WGM * nN, gid = wgid / nig, fm = gid * WGM, gsz = (nM - fm) < WGM ? (nM - fm) : WGM;
        u.pm = fm + ((wgid % nig) % gsz); u.pn = (wgid % nig) / gsz; return true;
    }
};

template <class Prob, class Epi, class Sched, bool ALIGN_EPI>
__device__ __forceinline__ void gemm_phase(LAS unsigned char* lds, const Prob& P, const Sched& S, const Epi& E) {
    int tid_ = threadIdx.x; asm volatile("" : "+v"(tid_));
    const int tid = tid_, wid = __builtin_amdgcn_readfirstlane(tid >> 6), lane = tid & 63, wr = wid >> 2, wc = wid & 3, fr = lane & 15, fq = lane >> 4;
    constexpr bool F8 = Prob::F8;
    const int Kb = P.K * (F8 ? 1 : 2), nt = Kb / (BK * 2);
    int Rr[2], Cc[2]; unsigned voffB[2];
#pragma unroll
    for (int i = 0; i < 2; ++i) { int R, C; stage_rc(tid * 16 + i * 8192, R, C); Rr[i] = R; Cc[i] = C; const int Rb = Epi::PERM ? ((R & ~31) + perm32(R & 31)) : R; voffB[i] = (unsigned)(Rb * Kb + C * 2); }
    const unsigned kstep = (unsigned)(BK * 2);
    const unsigned hstep = (unsigned)(HALF * Kb);
    const unsigned ldsw = (unsigned)wid * 1024u;
    const int aoff = lds_byte(wr * 64 + fr, fq * 8), boff = lds_byte(wc * 32 + fr, fq * 8);
    const __amdgpu_buffer_rsrc_t rsA = __builtin_amdgcn_make_buffer_rsrc((void*)P.A, 0, 0xFFFFFFFF, 0x00020000);
    const __amdgpu_buffer_rsrc_t rsB = __builtin_amdgcn_make_buffer_rsrc((void*)P.Bt, 0, 0xFFFFFFFF, 0x00020000);
#define PG8_SA(b, h) (((b) * 2 + (h)) * HTB)
#define PG8_SB(b, h) ((4 + (b) * 2 + (h)) * HTB)
#define PG8_STAGE_B(bufoff, sB) do { _Pragma("unroll") for (int _i = 0; _i < 2; ++_i) \
        __builtin_amdgcn_raw_ptr_buffer_load_lds(rsB, (LAS void*)(lds + (bufoff) + ldsw + _i * 8192), 16, (int)voffB[_i], (int)(sB), 0, 0); } while (0)
#define PG8_STAGE_A(bufoff, kb, o) do { _Pragma("unroll") for (int _i = 0; _i < 2; ++_i) \
        __builtin_amdgcn_raw_ptr_buffer_load_lds(rsA, (LAS void*)(lds + (bufoff) + ldsw + _i * 8192), 16, (int)(o)[_i], (int)(kb), 0, 0); } while (0)
#define PG8_LD2(p_) PG8_CAT(*(const LAS i32x4*)(p_), *(const LAS i32x4*)((p_) + 1024))
#define PG8_LDA(dst, b, h) do { if constexpr (F8) { _Pragma("unroll") for (int m = 0; m < 4; ++m) dst##8[m] = PG8_LD2(lds + PG8_SA(b, h) + aoff + m * 2048); } \
        else { _Pragma("unroll") for (int m = 0; m < 4; ++m) _Pragma("unroll") for (int k = 0; k < 2; ++k) dst[m][k] = *(const LAS bf16x8*)(lds + PG8_SA(b, h) + aoff + m * 2048 + k * 1024); } } while (0)
#define PG8_LDB(dst, b, h) do { if constexpr (F8) { _Pragma("unroll") for (int n = 0; n < 2; ++n) dst##8[n] = PG8_LD2(lds + PG8_SB(b, h) + boff + n * 2048); } \
        else { _Pragma("unroll") for (int n = 0; n < 2; ++n) _Pragma("unroll") for (int k = 0; k < 2; ++k) dst[n][k] = *(const LAS bf16x8*)(lds + PG8_SB(b, h) + boff + n * 2048 + k * 1024); } } while (0)
#define PG8_CAT(x0, x1) __builtin_shufflevector((x0), (x1), 0, 1, 2, 3, 4, 5, 6, 7)
#define PG8_MMA(ai, bj, At, Bt) do { __builtin_amdgcn_s_setprio(1); \
        if constexpr (F8) { _Pragma("unroll") for (int m = 0; m < 4; ++m) _Pragma("unroll") for (int n = 0; n < 2; ++n) \
            acc[ai][bj][m][n] = __builtin_amdgcn_mfma_scale_f32_16x16x128_f8f6f4(Bt##8[n], At##8[m], acc[ai][bj][m][n], 0, 0, 0, 0, 0, 0); } \
        else { _Pragma("unroll") for (int m = 0; m < 4; ++m) _Pragma("unroll") for (int n = 0; n < 2; ++n) _Pragma("unroll") for (int k = 0; k < 2; ++k) \
            acc[ai][bj][m][n] = __builtin_amdgcn_mfma_f32_16x16x32_bf16(Bt[n][k], At[m][k], acc[ai][bj][m][n], 0, 0, 0); } \
        __builtin_amdgcn_s_setprio(0); } while (0)
#define PG8_WAIT_V(n) asm volatile("s_waitcnt vmcnt(" #n ")" ::: "memory")
#define PG8_WAIT_L(n) asm volatile("s_waitcnt lgkmcnt(" #n ")" ::: "memory")
#define PG8_BAR __builtin_amdgcn_s_barrier()
#define PG8_SCHED __builtin_amdgcn_sched_barrier(0)
    Unit cur, nxt; int ui = 0;
    if (!S.next(0, cur)) return;
    cur.idx = 0;
    f32x4 acc[2][2][4][2];
#pragma unroll
    for (int a = 0; a < 2; ++a)
#pragma unroll
        for (int b = 0; b < 2; ++b)
#pragma unroll
            for (int m = 0; m < 4; ++m)
#pragma unroll
                for (int n = 0; n < 2; ++n) acc[a][b][m][n] = (f32x4){0.f, 0.f, 0.f, 0.f};
    bf16x8 At[4][2], B0[2][2], B1[2][2]; i32x8 At8[4], B08[2], B18[2];
    unsigned ca0[2], ca1[2];
    P.a_offs(0, cur, Rr, Cc, ca0, ca1);
    unsigned cB = P.b_off(cur);
    PG8_STAGE_B(PG8_SB(0, 0), cB); PG8_STAGE_B(PG8_SB(0, 1), cB + hstep); PG8_STAGE_A(PG8_SA(0, 0), 0, ca0); PG8_STAGE_A(PG8_SA(0, 1), 0, ca1);
    if (wr == 1) PG8_BAR;
    PG8_WAIT_V(2); PG8_BAR;
    PG8_STAGE_B(PG8_SB(1, 0), cB + kstep); PG8_STAGE_A(PG8_SA(1, 0), kstep, ca0); PG8_STAGE_B(PG8_SB(1, 1), cB + hstep + kstep);
    PG8_WAIT_V(6); PG8_BAR;
    for (;;) {
        const bool has_next = S.next(ui + 1, nxt); nxt.idx = ui + 1;
        unsigned nB = cB;
        if (has_next) nB = P.b_off(nxt);
#pragma unroll 1
        for (int t = 0; t < nt; t += 2) {
            const bool last = (t == nt - 2);
            const unsigned k1 = (unsigned)(t + 1) * kstep;
            const unsigned k2 = last ? 0u : (unsigned)(t + 2) * kstep, k3 = k2 + kstep;
            const unsigned b2 = last ? nB : cB + (unsigned)(t + 2) * kstep; const unsigned b3 = b2 + kstep;
            PG8_LDB(B0, 0, 0); PG8_LDB(B1, 0, 1); PG8_SCHED; PG8_LDA(At, 0, 0); PG8_STAGE_A(PG8_SA(1, 1), k1, ca1);
            if (last && has_next) {
                int tq = threadIdx.x; asm volatile("" : "+v"(tq)); int R2[2], C2[2];
#pragma unroll
                for (int i = 0; i < 2; ++i) stage_rc(tq * 16 + i * 8192, R2[i], C2[i]);
                P.a_offs(ui + 1, nxt, R2, C2, ca0, ca1);
            }
            PG8_WAIT_V(8); PG8_WAIT_L(0); PG8_BAR; PG8_MMA(0, 0, At, B0); PG8_MMA(0, 1, At, B1); PG8_BAR; PG8_SCHED;
            PG8_LDA(At, 0, 1); PG8_STAGE_B(PG8_SB(0, 0), b2); PG8_STAGE_B(PG8_SB(0, 1), b2 + hstep); PG8_STAGE_A(PG8_SA(0, 0), k2, ca0);
            PG8_WAIT_V(8); PG8_WAIT_L(0); PG8_BAR; PG8_MMA(1, 0, At, B0); PG8_MMA(1, 1, At, B1); PG8_BAR; PG8_SCHED;
            PG8_LDB(B0, 1, 0); PG8_LDB(B1, 1, 1); PG8_SCHED; PG8_LDA(At, 1, 0); PG8_STAGE_A(PG8_SA(0, 1), k2, ca1);
            PG8_WAIT_V(8); PG8_WAIT_L(0); PG8_BAR; PG8_MMA(0, 0, At, B0); PG8_MMA(0, 1, At, B1); PG8_BAR; PG8_SCHED;
            PG8_LDA(At, 1, 1); PG8_STAGE_B(PG8_SB(1, 0), b3); PG8_STAGE_B(PG8_SB(1, 1), b3 + hstep); PG8_STAGE_A(PG8_SA(1, 0), k3, ca0);
            PG8_WAIT_V(8); PG8_WAIT_L(0); PG8_BAR; PG8_MMA(1, 0, At, B0); PG8_MMA(1, 1, At, B1); PG8_BAR; PG8_SCHED;
        }
        if constexpr (ALIGN_EPI) { if (wr == 0) PG8_BAR; }
        { int te = threadIdx.x; asm volatile("" : "+v"(te));
          E(acc, cur, wr, wc, te & 15, (te >> 4) & 3); }
        if (!has_next) break;
#pragma unroll
        for (int a = 0; a < 2; ++a)
#pragma unroll
            for (int b = 0; b < 2; ++b)
#pragma unroll
                for (int m = 0; m < 4; ++m)
#pragma unroll
                    for (int n = 0; n < 2; ++n) acc[a][b][m][n] = (f32x4){0.f, 0.f, 0.f, 0.f};
        cur = nxt; cB = nB; ++ui;
        if constexpr (ALIGN_EPI) { if (wr == 1) PG8_BAR; }
    }
    PG8_WAIT_V(0);
    if constexpr (!ALIGN_EPI) { if (wr == 0) PG8_BAR; }
    PG8_BAR;
#undef PG8_SA
#undef PG8_SB
#undef PG8_STAGE_A
#undef PG8_STAGE_B
#undef PG8_LDA
#undef PG8_LD2
#undef PG8_LDB
#undef PG8_MMA
#undef PG8_CAT
#undef PG8_WAIT_V
#undef PG8_WAIT_L
#undef PG8_BAR
#undef PG8_SCHED
}

template <bool F8_>
struct DenseProbT {
    static constexpr bool F8 = F8_;
    const void* A; const void* Bt; int K, lda, acolstep; size_t bstep_pn;
    __device__ __forceinline__ void a_offs(int, const Unit& u, const int (&R)[2], const int (&C)[2], unsigned (&o0)[2], unsigned (&o1)[2]) const {
        constexpr int esz = F8 ? 1 : 2;
#pragma unroll
        for (int i = 0; i < 2; ++i) { const unsigned b = (unsigned)(((u.pm * BM + R[i]) * lda + u.pn * acolstep) * esz + C[i] * 2); o0[i] = b; o1[i] = b + (unsigned)(HALF * lda * esz); }
    }
    __device__ __forceinline__ unsigned b_off(const Unit& u) const { return (unsigned)((size_t)u.pn * bstep_pn * (F8 ? 1 : 2)); }
};
typedef DenseProbT<false> DenseProb;
}

struct Params {
    const float* x; const int* positions; const float* norm_mix; const float* norm_ffn; const float* norm_final;
    const float* attn_w_in; const float* attn_w_out; const float* pool_w_in; const float* pool_w_group; const float* pool_scale; const float* pool_w_out;
    const float* router_group_w; const float* router_group_b; const float* router_expert_w; const float* router_expert_b;
    const float* expert_w1; const float* expert_w3; const float* expert_w2;
    float* out; unsigned char* ws;
    int ph_lo, ph_hi;
};

template <class MapN>
__device__ __forceinline__ void transpose_item(const float* W, int ldw, int K, bf16* WT, MapN mapn, LAS float* scr, int k0, int n0, int lane) {
#pragma unroll 8
    for (int i = 0; i < 32; ++i) { const int kk = 2 * i + (lane >> 5); scr[kk * 33 + (lane & 31)] = W[(size_t)(k0 + kk) * ldw + n0 + (lane & 31)]; }
    asm volatile("s_waitcnt lgkmcnt(0)" ::: "memory");
    const int c = lane & 7;
#pragma unroll
    for (int j = 0; j < 4; ++j) { const int n = (lane >> 3) + 8 * j; const LAS float* s = scr + (8 * c) * 33 + n;
        u32x4 o; o.x = cvtpk(s[0 * 33], s[1 * 33]); o.y = cvtpk(s[2 * 33], s[3 * 33]); o.z = cvtpk(s[4 * 33], s[5 * 33]); o.w = cvtpk(s[6 * 33], s[7 * 33]);
        *(u32x4*)(WT + (size_t)mapn(n0 + n) * K + k0 + 8 * c) = o; }
    asm volatile("s_waitcnt lgkmcnt(0)" ::: "memory");
}
template <class MapN>
__device__ __forceinline__ void transpose_item8(const float* W, int ldw, int K, unsigned char* WT, MapN mapn, float sc, LAS float* scr, int k0, int n0, int lane) {
#pragma unroll 8
    for (int i = 0; i < 32; ++i) { const int kk = 2 * i + (lane >> 5); scr[kk * 33 + (lane & 31)] = W[(size_t)(k0 + kk) * ldw + n0 + (lane & 31)]; }
    asm volatile("s_waitcnt lgkmcnt(0)" ::: "memory");
    const int c = lane & 7;
#pragma unroll
    for (int j = 0; j < 4; ++j) { const int n = (lane >> 3) + 8 * j; const LAS float* s = scr + (8 * c) * 33 + n;
        u32x2 o; o.x = pack_fp8x4(s[0 * 33] * sc, s[1 * 33] * sc, s[2 * 33] * sc, s[3 * 33] * sc); o.y = pack_fp8x4(s[4 * 33] * sc, s[5 * 33] * sc, s[6 * 33] * sc, s[7 * 33] * sc);
        *(u32x2*)(WT + (size_t)mapn(n0 + n) * K + k0 + 8 * c) = o; }
    asm volatile("s_waitcnt lgkmcnt(0)" ::: "memory");
}
struct MapId { __device__ __forceinline__ int operator()(int n) const { return n; } };
struct MapQKV {
    __device__ __forceinline__ int operator()(int n) const { const int rem = n % 1536, kind = rem / 512, d = n & 63; if (kind < 2 && d < 16) return n - d + (d < 8 ? 2 * d : 2 * (d - 8) + 1); return n; }
};
struct MapW13 { int add; __device__ __forceinline__ int operator()(int n) const { return (n >> 7) * 256 + add + (n & 127); } };

struct RowPassCfg {
    const float* hin;
    const bf16* hin16;
    const bf16* ys; const int* slotref; const int* cnt_prev;
    bf16* hout;
    const float* gain;
    bf16* yout;
    unsigned char* yout8;
    float* fout;
    const float* rgw; const float* rgb; const float* rew; const float* reb;
    int* cnt; int* list; float* gatel; int* slotref_out;
};

__device__ __forceinline__ void route_decide(const float (&a)[20], const float* rgb, const float* reb, int& e0, int& e1, float& g0, float& g1) {
    float lg[4];
#pragma unroll
    for (int g = 0; g < 4; ++g) lg[g] = a[g] + rgb[g];
    int gs = 0; float gm = lg[0];
#pragma unroll
    for (int g = 1; g < 4; ++g) if (lg[g] > gm) { gm = lg[g]; gs = g; }
    float den = 0.f;
#pragma unroll
    for (int g = 0; g < 4; ++g) den += __expf(lg[g] - gm);
    const float gate1 = 1.0f / den;
    float le[4];
#pragma unroll
    for (int e = 0; e < 4; ++e) { const float sel = gs == 0 ? a[4 + e] : gs == 1 ? a[8 + e] : gs == 2 ? a[12 + e] : a[16 + e]; le[e] = sel + reb[gs * 4 + e]; }
    int i0 = 0; float v0 = le[0];
#pragma unroll
    for (int e = 1; e < 4; ++e) if (le[e] > v0) { v0 = le[e]; i0 = e; }
    int i1 = -1; float v1 = -INFINITY;
#pragma unroll
    for (int e = 0; e < 4; ++e) if (e != i0 && le[e] > v1) { v1 = le[e]; i1 = e; }
    const float ex = __expf(v1 - v0), p0 = 1.0f / (1.0f + ex), p1 = ex * p0;
    e0 = gs * 4 + i0; e1 = gs * 4 + i1; g0 = gate1 * p0; g1 = gate1 * p1;
}

template <bool COMBINE, bool ROUTER, bool HIN16>
__device__ __forceinline__ void row_pass(LAS unsigned char* lds, const RowPassCfg& c, int vcu, int wave) {
    int tid = threadIdx.x; asm volatile("" : "+v"(tid)); const int lane = tid & 63;
    LAS float* Wr = (LAS float*)lds;
    LAS int* selE = (LAS int*)(lds + 81920);
    LAS float* selG = (LAS float*)(lds + 81920 + 1024);
    LAS int* wcnt = (LAS int*)(lds + 81920 + 2048);
    LAS int* tb = (LAS int*)(lds + MISC_OFF);
    if (ROUTER) {
        for (int k = tid; k < 1024; k += NTHREADS) {
            const f32x4 g4 = *(const f32x4*)(c.rgw + (size_t)k * 4);
            Wr[0 * 1024 + k] = g4.x; Wr[1 * 1024 + k] = g4.y; Wr[2 * 1024 + k] = g4.z; Wr[3 * 1024 + k] = g4.w;
#pragma unroll
            for (int g = 0; g < 4; ++g) { const f32x4 e4 = *(const f32x4*)(c.rew + ((size_t)g * 1024 + k) * 4);
                Wr[(4 + g * 4 + 0) * 1024 + k] = e4.x; Wr[(4 + g * 4 + 1) * 1024 + k] = e4.y; Wr[(4 + g * 4 + 2) * 1024 + k] = e4.z; Wr[(4 + g * 4 + 3) * 1024 + k] = e4.w; }
        }
    }
    if (COMBINE) {
        if (tid == 0) { int sacc = 0; for (int e = 0; e < NE; ++e) { tb[e] = sacc; sacc += (c.cnt_prev[e] + 255) >> 8; } tb[NE] = sacc; }
    }
    __syncthreads();
    f32x4 gn[4];
#pragma unroll
    for (int j = 0; j < 4; ++j) gn[j] = *(const f32x4*)(c.gain + 4 * lane + 256 * j);
    for (int rb = vcu; rb < T / 128; rb += gridDim.x) {
        const int rbase = rb * 128 + wave * 16;
        int refs = 0;
        if (COMBINE) { if (lane < 32) refs = c.slotref[rbase * 2 + lane]; }
        f32x4 hv[2][2][4]; u32x2 hb[2][2][4]; u32x2 yv[2][2][2][4];
#define RP_ISSUE(buf, pr) do { _Pragma("unroll") for (int r = 0; r < 2; ++r) { const int row = rbase + 2 * (pr) + r; \
            if (HIN16) { _Pragma("unroll") for (int j = 0; j < 4; ++j) hb[buf][r][j] = *(const u32x2*)(c.hin16 + (size_t)row * D + 4 * lane + 256 * j); } \
            else { _Pragma("unroll") for (int j = 0; j < 4; ++j) hv[buf][r][j] = *(const f32x4*)(c.hin + (size_t)row * D + 4 * lane + 256 * j); } \
            if (COMBINE) { _Pragma("unroll") for (int sl = 0; sl < 2; ++sl) { const int ref = __builtin_amdgcn_readlane(refs, (2 * (pr) + r) * 2 + sl); const int e = ref >> 15, pos = ref & 32767; \
                if (FP8_YS) { const unsigned char* yr = (const unsigned char*)c.ys + ((size_t)tb[e] * 256 + pos) * D; \
                    _Pragma("unroll") for (int j = 0; j < 4; ++j) yv[buf][r][sl][j].x = *(const unsigned*)(yr + 4 * lane + 256 * j); } \
                else { const bf16* yr = c.ys + ((size_t)tb[e] * 256 + pos) * D; \
                    _Pragma("unroll") for (int j = 0; j < 4; ++j) yv[buf][r][sl][j] = *(const u32x2*)(yr + 4 * lane + 256 * j); } } } } } while (0)
#define RP_PROCESS(buf, pr) do { f32x4 v[2][4]; \
            _Pragma("unroll") for (int r = 0; r < 2; ++r) { const int row = rbase + 2 * (pr) + r; \
                _Pragma("unroll") for (int j = 0; j < 4; ++j) { if (HIN16) { const u32x2 w0 = hb[buf][r][j]; v[r][j] = (f32x4){bf_lo(w0.x), bf_hi(w0.x), bf_lo(w0.y), bf_hi(w0.y)}; } else v[r][j] = hv[buf][r][j]; \
                    if (COMBINE) { _Pragma("unroll") for (int sl = 0; sl < 2; ++sl) { const u32x2 w = yv[buf][r][sl][j]; \
                        if (FP8_YS) { const f32x2 lo2 = __builtin_amdgcn_cvt_pk_f32_fp8((int)w.x, false), hi2 = __builtin_amdgcn_cvt_pk_f32_fp8((int)w.x, true); \
                            v[r][j].x += lo2.x * (1.0f / 64.0f); v[r][j].y += lo2.y * (1.0f / 64.0f); v[r][j].z += hi2.x * (1.0f / 64.0f); v[r][j].w += hi2.y * (1.0f / 64.0f); } \
                        else { v[r][j].x += bf_lo(w.x); v[r][j].y += bf_hi(w.x); v[r][j].z += bf_lo(w.y); v[r][j].w += bf_hi(w.y); } } } } \
                if (c.hout) { _Pragma("unroll") for (int j = 0; j < 4; ++j) { u32x2 w; w.x = cvtpk(v[r][j].x, v[r][j].y); w.y = cvtpk(v[r][j].z, v[r][j].w); *(u32x2*)(c.hout + (size_t)row * D + 4 * lane + 256 * j) = w; \
                    v[r][j] = (f32x4){bf_lo(w.x), bf_hi(w.x), bf_lo(w.y), bf_hi(w.y)}; } } \
                float ss = 0.f; \
                _Pragma("unroll") for (int j = 0; j < 4; ++j) ss += (v[r][j].x * v[r][j].x + v[r][j].y * v[r][j].y) + (v[r][j].z * v[r][j].z + v[r][j].w * v[r][j].w); \
                const float rstd = 1.0f / sqrtf(wave_sum(ss) * (1.0f / D) + RMS_EPS); \
                _Pragma("unroll") for (int j = 0; j < 4; ++j) { v[r][j].x = v[r][j].x * rstd * gn[j].x; v[r][j].y = v[r][j].y * rstd * gn[j].y; v[r][j].z = v[r][j].z * rstd * gn[j].z; v[r][j].w = v[r][j].w * rstd * gn[j].w; } \
                if (c.yout) { _Pragma("unroll") for (int j = 0; j < 4; ++j) { u32x2 w; w.x = cvtpk(v[r][j].x, v[r][j].y); w.y = cvtpk(v[r][j].z, v[r][j].w); *(u32x2*)(c.yout + (size_t)row * D + 4 * lane + 256 * j) = w; } } \
                if (c.yout8) { _Pragma("unroll") for (int j = 0; j < 4; ++j) *(unsigned*)(c.yout8 + (size_t)row * D + 4 * lane + 256 * j) = pack_fp8x4(v[r][j].x, v[r][j].y, v[r][j].z, v[r][j].w); } \
                if (c.fout) { _Pragma("unroll") for (int j = 0; j < 4; ++j) *(f32x4*)(c.fout + (size_t)row * D + 4 * lane + 256 * j) = v[r][j]; } } \
            if (ROUTER) { float a0[20], a1[20]; f32x2 vv[4][4];        \
                _Pragma("unroll") for (int j = 0; j < 4; ++j) { vv[j][0] = (f32x2){v[0][j].x, v[1][j].x}; vv[j][1] = (f32x2){v[0][j].y, v[1][j].y}; vv[j][2] = (f32x2){v[0][j].z, v[1][j].z}; vv[j][3] = (f32x2){v[0][j].w, v[1][j].w}; } \
                _Pragma("unroll") for (int o = 0; o < 20; ++o) { f32x2 s2 = {0.f, 0.f}; \
                    _Pragma("unroll") for (int j = 0; j < 4; ++j) { const f32x4 w = *(const LAS f32x4*)(Wr + o * 1024 + 4 * lane + 256 * j); \
                        s2 = __builtin_elementwise_fma(vv[j][0], (f32x2){w.x, w.x}, s2); s2 = __builtin_elementwise_fma(vv[j][1], (f32x2){w.y, w.y}, s2); \
                        s2 = __builtin_elementwise_fma(vv[j][2], (f32x2){w.z, w.z}, s2); s2 = __builtin_elementwise_fma(vv[j][3], (f32x2){w.w, w.w}, s2); } \
                    a0[o] = s2.x; a1[o] = s2.y; if ((o & 3) == 3) __builtin_amdgcn_sched_barrier(0); } \
                _Pragma("unroll") for (int o = 0; o < 20; ++o) { a0[o] = DPP_ADD(a0[o], 0xB1); a1[o] = DPP_ADD(a1[o], 0xB1); } \
                _Pragma("unroll") for (int o = 0; o < 20; ++o) { a0[o] = DPP_ADD(a0[o], 0x4E); a1[o] = DPP_ADD(a1[o], 0x4E); } \
                _Pragma("unroll") for (int o = 0; o < 20; ++o) { a0[o] = DPP_ADD(a0[o], 0x141); a1[o] = DPP_ADD(a1[o], 0x141); } \
                _Pragma("unroll") for (int o = 0; o < 20; ++o) { a0[o] = DPP_ADD(a0[o], 0x140); a1[o] = DPP_ADD(a1[o], 0x140); } \
                _Pragma("unroll") for (int o = 0; o < 20; ++o) { a0[o] = rows_sum(a0[o]); a1[o] = rows_sum(a1[o]); if (o & 1) __builtin_amdgcn_sched_barrier(0); } \
                int e0, e1; float g0, g1; const int rl = wave * 16 + 2 * (pr); \
                route_decide(a0, c.rgb, c.reb, e0, e1, g0, g1); if (lane == 0) { selE[rl * 2] = e0; selE[rl * 2 + 1] = e1; selG[rl * 2] = g0; selG[rl * 2 + 1] = g1; } \
                route_decide(a1, c.rgb, c.reb, e0, e1, g0, g1); if (lane == 0) { selE[rl * 2 + 2] = e0; selE[rl * 2 + 3] = e1; selG[rl * 2 + 2] = g0; selG[rl * 2 + 3] = g1; } } } while (0)
        RP_ISSUE(0, 0);
#pragma unroll 1
        for (int it = 0; it < 4; ++it) {
            RP_ISSUE(1, 2 * it + 1);
            RP_PROCESS(0, 2 * it);
            if (it < 3) RP_ISSUE(0, 2 * it + 2);
            RP_PROCESS(1, 2 * it + 1);
        }
#undef RP_ISSUE
#undef RP_PROCESS
        if (ROUTER) {
            __syncthreads();
            int e = 0, rank = 0;
            if (tid < 256) {
                e = selE[tid]; int mycount = 0;
#pragma unroll
                for (int x = 0; x < NE; ++x) { const unsigned long long mask = __ballot(e == x); if (e == x) rank = __popcll(mask & ((1ull << lane) - 1ull)); if (lane == x) mycount = __popcll(mask); }
                if (lane < NE) wcnt[(tid >> 6) * 16 + lane] = mycount;
            }
            __syncthreads();
            if (tid < NE) { const int c0 = wcnt[tid], c1 = wcnt[16 + tid], c2 = wcnt[32 + tid], c3 = wcnt[48 + tid]; const int tot = c0 + c1 + c2 + c3;
                int base = 0; if (tot) base = atomicAdd(c.cnt + tid, tot);
                wcnt[tid] = base; wcnt[16 + tid] = base + c0; wcnt[32 + tid] = base + c0 + c1; wcnt[48 + tid] = base + c0 + c1 + c2; }
            __syncthreads();
            if (tid < 256) { const int pos = wcnt[(tid >> 6) * 16 + e] + rank; const int tok = rb * 128 + (tid >> 1);
                c.list[e * T + pos] = tok; c.gatel[e * T + pos] = selG[tid]; c.slotref_out[tok * 2 + (tid & 1)] = e * 32768 + pos; }
            __syncthreads();
        }
    }
    __syncthreads();
}

constexpr int RW_STRIDE = 2064;
__device__ __forceinline__ void router_pass(LAS unsigned char* lds, const RowPassCfg& c, int vcu, int wave) {
    int tid = threadIdx.x; asm volatile("" : "+v"(tid)); const int lane = tid & 63, r16 = lane & 15, kg = lane >> 4;
    LAS unsigned char* Wh = lds;
    LAS unsigned char* Wl = lds + 20 * RW_STRIDE;
    LAS float* gl = (LAS float*)(lds + 40 * RW_STRIDE);
    LAS int* selE = (LAS int*)(lds + 86656);
    LAS float* selG = (LAS float*)(lds + 86656 + 1024);
    LAS int* wcnt = (LAS int*)(lds + 86656 + 2048);
    LAS float* tr = (LAS float*)(lds + 90112) + wave * 512;
    for (int kp = tid; kp < 512; kp += NTHREADS) {
        const int k = 2 * kp;
#pragma unroll 1
        for (int v5 = 0; v5 < 5; ++v5) {
            const float* src = (v5 == 0) ? (c.rgw + (size_t)k * 4) : (c.rew + ((size_t)(v5 - 1) * 1024 + k) * 4);
            const f32x4 a = *(const f32x4*)src, b = *(const f32x4*)(src + 4);
#pragma unroll
            for (int q = 0; q < 4; ++q) { const int o = v5 * 4 + q; const unsigned hi = cvtpk(a[q], b[q]); const unsigned lo = cvtpk(a[q] - bf_lo(hi), b[q] - bf_hi(hi));
                *(LAS unsigned*)(Wh + o * RW_STRIDE + k * 2) = hi; *(LAS unsigned*)(Wl + o * RW_STRIDE + k * 2) = lo; }
        }
    }
    for (int k = tid; k < 1024; k += NTHREADS) gl[k] = c.gain[k];
    __syncthreads();
    typedef unsigned u32x2v __attribute__((ext_vector_type(2)));
    const __amdgpu_buffer_rsrc_t rsH = __builtin_amdgcn_make_buffer_rsrc((void*)c.hin16, 0, 0xFFFFFFFF, 0x00020000);
    const __amdgpu_buffer_rsrc_t rsY = __builtin_amdgcn_make_buffer_rsrc((void*)c.yout8, 0, 0xFFFFFFFF, 0x00020000);
    const int oc0 = r16, oc1 = (16 + r16) < 20 ? (16 + r16) : 19;
    for (int rb = vcu; rb < T / 128; rb += gridDim.x) {
        const int row = rb * 128 + wave * 16 + r16;
        u32x4 hreg[32];
        const unsigned voff = (unsigned)row * (unsigned)(D * 2) + (unsigned)kg * 16u;
#pragma unroll
        for (int s_ = 0; s_ < 32; ++s_) hreg[s_] = __builtin_bit_cast(u32x4, __builtin_amdgcn_raw_buffer_load_b128(rsH, (int)voff + s_ * 64, 0, 0));
        const unsigned yoff = (unsigned)row * (unsigned)D + (unsigned)kg * 8u;
        float ss = 0.f;
#pragma unroll
        for (int s_ = 0; s_ < 32; ++s_)
#pragma unroll
            for (int q = 0; q < 4; ++q) { unsigned hw = hreg[s_][q]; asm volatile("" : "+v"(hw));
                const float a = bf_lo(hw), b = bf_hi(hw); ss = __builtin_fmaf(a, a, ss); ss = __builtin_fmaf(b, b, ss); }
        const float rstd = 1.0f / sqrtf(rows_sum(ss) * (1.0f / D) + RMS_EPS);
        f32x4 acc0 = {0.f, 0.f, 0.f, 0.f}, acc1 = {0.f, 0.f, 0.f, 0.f};
#pragma unroll
        for (int s_ = 0; s_ < 32; ++s_) {
            const int kb = 32 * s_ + 8 * kg;
            const f32x4 g0 = *(const LAS f32x4*)(gl + kb), g1 = *(const LAS f32x4*)(gl + kb + 4);
            float y[8];
            y[0] = bf_lo(hreg[s_][0]) * rstd * g0.x; y[1] = bf_hi(hreg[s_][0]) * rstd * g0.y; y[2] = bf_lo(hreg[s_][1]) * rstd * g0.z; y[3] = bf_hi(hreg[s_][1]) * rstd * g0.w;
            y[4] = bf_lo(hreg[s_][2]) * rstd * g1.x; y[5] = bf_hi(hreg[s_][2]) * rstd * g1.y; y[6] = bf_lo(hreg[s_][3]) * rstd * g1.z; y[7] = bf_hi(hreg[s_][3]) * rstd * g1.w;
            u32x4 yh, yl;
#pragma unroll
            for (int q = 0; q < 4; ++q) { yh[q] = cvtpk(y[2 * q], y[2 * q + 1]); yl[q] = cvtpk(y[2 * q] - bf_lo(yh[q]), y[2 * q + 1] - bf_hi(yh[q])); }
            { u32x2 w8; w8.x = pack_fp8x4(y[0], y[1], y[2], y[3]); w8.y = pack_fp8x4(y[4], y[5], y[6], y[7]); __builtin_amdgcn_raw_buffer_store_b64(__builtin_bit_cast(u32x2v, w8), rsY, (int)yoff + s_ * 32, 0, 0); }
            const bf16x8 bh0 = *(const LAS bf16x8*)(Wh + oc0 * RW_STRIDE + kb * 2), bh1 = *(const LAS bf16x8*)(Wh + oc1 * RW_STRIDE + kb * 2);
            const bf16x8 bl0 = *(const LAS bf16x8*)(Wl + oc0 * RW_STRIDE + kb * 2), bl1 = *(const LAS bf16x8*)(Wl + oc1 * RW_STRIDE + kb * 2);
            const bf16x8 ah = __builtin_bit_cast(bf16x8, yh), al = __builtin_bit_cast(bf16x8, yl);
            acc0 = __builtin_amdgcn_mfma_f32_16x16x32_bf16(ah, bh0, acc0, 0, 0, 0); acc1 = __builtin_amdgcn_mfma_f32_16x16x32_bf16(ah, bh1, acc1, 0, 0, 0);
            acc0 = __builtin_amdgcn_mfma_f32_16x16x32_bf16(al, bh0, acc0, 0, 0, 0); acc1 = __builtin_amdgcn_mfma_f32_16x16x32_bf16(al, bh1, acc1, 0, 0, 0);
            acc0 = __builtin_amdgcn_mfma_f32_16x16x32_bf16(ah, bl0, acc0, 0, 0, 0); acc1 = __builtin_amdgcn_mfma_f32_16x16x32_bf16(ah, bl1, acc1, 0, 0, 0);
            __builtin_amdgcn_sched_barrier(0);
        }
#pragma unroll
        for (int e = 0; e < 4; ++e) { tr[(4 * kg + e) * 32 + r16] = acc0[e]; tr[(4 * kg + e) * 32 + 16 + r16] = acc1[e]; }
        asm volatile("s_waitcnt lgkmcnt(0)" ::: "memory");
        if (lane < 16) {
            float a[20];
#pragma unroll
            for (int o = 0; o < 20; ++o) a[o] = tr[lane * 32 + o];
            int e0, e1; float g0_, g1_; route_decide(a, c.rgb, c.reb, e0, e1, g0_, g1_);
            const int rl = wave * 16 + lane;
            selE[rl * 2] = e0; selE[rl * 2 + 1] = e1; selG[rl * 2] = g0_; selG[rl * 2 + 1] = g1_;
        }
        __syncthreads();
        int e = 0, rank = 0;
        if (tid < 256) {
            e = selE[tid]; int mycount = 0;
#pragma unroll
            for (int x = 0; x < NE; ++x) { const unsigned long long mask = __ballot(e == x); if (e == x) rank = __popcll(mask & ((1ull << lane) - 1ull)); if (lane == x) mycount = __popcll(mask); }
            if (lane < NE) wcnt[(tid >> 6) * 16 + lane] = mycount;
        }
        __syncthreads();
        if (tid < NE) { const int c0 = wcnt[tid], c1 = wcnt[16 + tid], c2 = wcnt[32 + tid], c3 = wcnt[48 + tid]; const int tot = c0 + c1 + c2 + c3;
            int base = 0; if (tot) base = atomicAdd(c.cnt + tid, tot);
            wcnt[tid] = base; wcnt[16 + tid] = base + c0; wcnt[32 + tid] = base + c0 + c1; wcnt[48 + tid] = base + c0 + c1 + c2; }
        __syncthreads();
        if (tid < 256) { const int pos = wcnt[(tid >> 6) * 16 + e] + rank; const int tok = rb * 128 + (tid >> 1);
            c.list[e * T + pos] = tok; c.gatel[e * T + pos] = selG[tid]; c.slotref_out[tok * 2 + (tid & 1)] = e * 32768 + pos; }
        __syncthreads();
    }
    __syncthreads();
}

namespace att {
constexpr float C2 = 0.125f * 1.4426950408889634f;
constexpr float LN2 = 0.6931471805599453f;
__device__ __forceinline__ int crow(int r, int hi) { return (r & 3) + 8 * (r >> 2) + 4 * hi; }
typedef short v4i16_t __attribute__((ext_vector_type(4)));
__device__ __forceinline__ s16x4 vtr(const LAS unsigned char* p) { return __builtin_bit_cast(s16x4, __builtin_amdgcn_ds_read_tr16_b64_v4i16((LAS v4i16_t*)p)); }

struct Item { int b, g, hh, dil, j, ph; };
__device__ __forceinline__ Item decode_item(int pp, int half) {
    Item it; it.hh = pp & 7; const int q8 = (pp >> 3) & 7; it.g = (pp >> 6) % 3; it.b = pp / 192;
    const int idx16 = q8 * 2 + half; it.dil = it.g == 0 ? 1 : (it.g == 1 ? 4 : 16); const int nb = 16 / it.dil; it.j = idx16 % nb; it.ph = idx16 / nb; return it;
}
__device__ __forceinline__ int kswz(int kv) { return (kv ^ (kv >> 3)) & 7; }
__device__ __forceinline__ u32x4 fp8x8_to_bf16(unsigned a, unsigned b) {
    const f32x2 a0 = __builtin_amdgcn_cvt_pk_f32_fp8((int)a, false), a1 = __builtin_amdgcn_cvt_pk_f32_fp8((int)a, true), b0 = __builtin_amdgcn_cvt_pk_f32_fp8((int)b, false), b1 = __builtin_amdgcn_cvt_pk_f32_fp8((int)b, true);
    return (u32x4){cvtpk(a0.x, a0.y), cvtpk(a1.x, a1.y), cvtpk(b0.x, b0.y), cvtpk(b1.x, b1.y)};
}

template <int MODE>
__device__ __forceinline__ void attn_phase(LAS unsigned char* lds, const bf16* qkv, bf16* og, float* lse, int vcu, int G) {
    int tid_ = threadIdx.x; asm volatile("" : "+v"(tid_));
    const int tid = tid_, lane = tid & 63, wid = __builtin_amdgcn_readfirstlane(tid >> 6);
    const int half = wid >> 2, w = wid & 3, r32 = lane & 31, hi = lane >> 5, th = tid & 255;
    LAS unsigned char* Kl = lds + half * 69632;
    LAS unsigned char* Vl = Kl + 36864;
    u32x4 kreg[4][2], vreg[4][2]; bf16x8 qbuf[2][4];
    u32x2 qraw[2][4];
    int skv[2], sc[2];
#pragma unroll
    for (int i = 0; i < 2; ++i) { const int P_ = th + 256 * i; skv[i] = P_ >> 3; sc[i] = P_ & 7; }
    const int skv8 = th >> 2, sc16 = th & 3;
    const __amdgpu_buffer_rsrc_t rsQ = __builtin_amdgcn_make_buffer_rsrc((void*)qkv, 0, 0xFFFFFFFF, 0x00020000);
    typedef unsigned u32x4v __attribute__((ext_vector_type(4)));
#if FP8_QKVS
#define ATT_ISSUE(IT, PAR) do { const unsigned rstrideB_ = (unsigned)(IT).dil * (unsigned)QKVW; \
        const unsigned baseB_ = (unsigned)(((IT).b * SEQ + (IT).ph) * QKVW + (IT).g * 1536 + (IT).hh * 64); const int l0_ = 128 * ((IT).j - 1); \
        const unsigned vo_ = (unsigned)skv8 * rstrideB_ + (unsigned)sc16 * 16u; \
        _Pragma("unroll") for (int tt = 0; tt < 4; ++tt) { if (tt >= 2 || (IT).j != 0) { const unsigned so_ = baseB_ + (unsigned)(l0_ + 64 * tt) * rstrideB_; \
            kreg[tt][0] = __builtin_bit_cast(u32x4, __builtin_amdgcn_raw_buffer_load_b128(rsQ, (int)vo_, (int)(so_ + 512u), 0)); vreg[tt][0] = __builtin_bit_cast(u32x4, __builtin_amdgcn_raw_buffer_load_b128(rsQ, (int)vo_, (int)(so_ + 1024u), 0)); } } \
        const unsigned qo_ = (unsigned)(32 * w + r32) * rstrideB_ + (unsigned)hi * 8u, qs_ = baseB_ + (unsigned)(128 * (IT).j) * rstrideB_; \
        _Pragma("unroll") for (int d0 = 0; d0 < 4; ++d0) qraw[PAR][d0] = __builtin_bit_cast(u32x2, __builtin_amdgcn_raw_buffer_load_b64(rsQ, (int)qo_, (int)(qs_ + (unsigned)d0 * 16u), 0)); } while (0)
#else
#define ATT_ISSUE(IT, PAR) do { const unsigned rstrideB_ = (unsigned)(IT).dil * (unsigned)(QKVW * 2); \
        const unsigned baseB_ = (unsigned)(((IT).b * SEQ + (IT).ph) * QKVW + (IT).g * 1536 + (IT).hh * 64) * 2u; const int l0_ = 128 * ((IT).j - 1); \
        const unsigned vo0_ = (unsigned)skv[0] * rstrideB_ + (unsigned)sc[0] * 16u, vo1_ = (unsigned)skv[1] * rstrideB_ + (unsigned)sc[1] * 16u; \
        _Pragma("unroll") for (int tt = 0; tt < 4; ++tt) { if (tt >= 2 || (IT).j != 0) { const unsigned so_ = baseB_ + (unsigned)(l0_ + 64 * tt) * rstrideB_; \
            kreg[tt][0] = __builtin_bit_cast(u32x4, __builtin_amdgcn_raw_buffer_load_b128(rsQ, (int)vo0_, (int)(so_ + 1024u), 0)); vreg[tt][0] = __builtin_bit_cast(u32x4, __builtin_amdgcn_raw_buffer_load_b128(rsQ, (int)vo0_, (int)(so_ + 2048u), 0)); \
            kreg[tt][1] = __builtin_bit_cast(u32x4, __builtin_amdgcn_raw_buffer_load_b128(rsQ, (int)vo1_, (int)(so_ + 1024u), 0)); vreg[tt][1] = __builtin_bit_cast(u32x4, __builtin_amdgcn_raw_buffer_load_b128(rsQ, (int)vo1_, (int)(so_ + 2048u), 0)); } } \
        const unsigned qo_ = (unsigned)(32 * w + r32) * rstrideB_ + (unsigned)hi * 16u, qs_ = baseB_ + (unsigned)(128 * (IT).j) * rstrideB_; \
        _Pragma("unroll") for (int d0 = 0; d0 < 4; ++d0) qbuf[PAR][d0] = __builtin_bit_cast(bf16x8, __builtin_amdgcn_raw_buffer_load_b128(rsQ, (int)qo_, (int)(qs_ + (unsigned)d0 * 32u), 0)); } while (0)
#endif
    int pp = vcu;
    Item cur = decode_item(pp < 3072 ? pp : 0, half);
    if (pp < 3072 && MODE != 2) ATT_ISSUE(cur, 0);
    const int koff = r32 * 144 + hi * 16;
    const int voff = ((lane >> 4) & 1) * 32 + (lane & 3) * 8 + (4 * hi + ((lane & 15) >> 2)) * 64;
    for (; pp < 3072; pp += 2 * G) {
#pragma unroll
    for (int par = 0; par < 2; ++par) {
        const int ppx = pp + par * G;
        if (ppx >= 3072) break;
        const int tt_lo = (cur.j == 0) ? 2 : 0;
#pragma unroll
        for (int tt = 0; tt < 4; ++tt) { if (MODE != 2 && (tt >= 2 || cur.j != 0)) {
            if (FP8_QKVS) {
                LAS unsigned char* kd = Kl + tt * 9216 + skv8 * 144 + sc16 * 32;
                *(LAS u32x4*)(kd) = fp8x8_to_bf16(kreg[tt][0].x, kreg[tt][0].y); *(LAS u32x4*)(kd + 16) = fp8x8_to_bf16(kreg[tt][0].z, kreg[tt][0].w);
                LAS unsigned char* vd = Vl + tt * 8192 + (sc16 >> 1) * 4096 + skv8 * 64 + (sc16 & 1) * 32;
                *(LAS u32x4*)(vd) = fp8x8_to_bf16(vreg[tt][0].x, vreg[tt][0].y); *(LAS u32x4*)(vd + 16) = fp8x8_to_bf16(vreg[tt][0].z, vreg[tt][0].w);
            } else {
#pragma unroll
            for (int i = 0; i < 2; ++i) {
                *(LAS u32x4*)(Kl + tt * 9216 + skv[i] * 144 + sc[i] * 16) = kreg[tt][i];
                *(LAS u32x4*)(Vl + tt * 8192 + (sc[i] >> 2) * 4096 + skv[i] * 64 + (sc[i] & 3) * 16) = vreg[tt][i]; } } } }
        bf16x8 qr[4];
        if (FP8_QKVS) {
            asm volatile("" : "+v"(qraw[par][0]), "+v"(qraw[par][1]), "+v"(qraw[par][2]), "+v"(qraw[par][3]));
#pragma unroll
            for (int d0 = 0; d0 < 4; ++d0) qr[d0] = __builtin_bit_cast(bf16x8, fp8x8_to_bf16(qraw[par][d0].x, qraw[par][d0].y));
        } else {
            asm volatile("" : "+v"(qbuf[par][0]), "+v"(qbuf[par][1]), "+v"(qbuf[par][2]), "+v"(qbuf[par][3]));
#pragma unroll
            for (int d0 = 0; d0 < 4; ++d0) qr[d0] = qbuf[par][d0];
        }
        __syncthreads();
        const Item me = cur;
        if (ppx + G < 3072) { cur = decode_item(ppx + G, half); if (MODE != 2) ATT_ISSUE(cur, par ^ 1); }
        if (MODE == 1) { __syncthreads(); continue; }
        float m = -1e30f, l = 0.f; f32x16 oT[2]; oT[0] = f32x16{}; oT[1] = f32x16{};
        const int t_lo = (w >= 2) ? (tt_lo > 1 ? tt_lo : 1) : tt_lo, t_hi = (w < 2) ? 2 : 3, t_mid = (w < 2) ? 1 : 2;
        for (int tt = t_lo; tt <= t_hi; ++tt) {
            const LAS unsigned char* kb = Kl + tt * 9216 + koff;
            f32x16 p0 = f32x16{}, p1 = f32x16{};
#pragma unroll
            for (int d0 = 0; d0 < 4; ++d0) {
                const bf16x8 k0 = *(const LAS bf16x8*)(kb + d0 * 32), k1 = *(const LAS bf16x8*)(kb + d0 * 32 + 32 * 144);
                p0 = __builtin_amdgcn_mfma_f32_32x32x16_bf16(k0, qr[d0], p0, 0, 0, 0);
                p1 = __builtin_amdgcn_mfma_f32_32x32x16_bf16(k1, qr[d0], p1, 0, 0, 0);
            }
            float mx = -INFINITY;
            if (tt != t_mid) {
                const int dbase = 128 + 32 * w + r32 - 64 * tt;
#pragma unroll
                for (int r = 0; r < 16; ++r) {
                    const int d0_ = dbase - crow(r, hi), d1_ = d0_ - 32;
                    p0[r] = (d0_ >= 0 && d0_ <= 128) ? p0[r] * C2 : -INFINITY;
                    p1[r] = (d1_ >= 0 && d1_ <= 128) ? p1[r] * C2 : -INFINITY;
                    mx = fmaxf(mx, fmaxf(p0[r], p1[r]));
                }
            } else {
#pragma unroll
                for (int r = 0; r < 16; ++r) { p0[r] *= C2; p1[r] *= C2; mx = fmaxf(mx, fmaxf(p0[r], p1[r])); }
            }
            { const auto rr = __builtin_amdgcn_permlane32_swap(__float_as_uint(mx), __float_as_uint(mx), false, false); mx = fmaxf(__uint_as_float(rr[0]), __uint_as_float(rr[1])); }
            const float mn = fmaxf(m, mx), alpha = __builtin_amdgcn_exp2f(m - mn);
            float rs = 0.f;
#pragma unroll
            for (int r = 0; r < 16; ++r) { p0[r] = __builtin_amdgcn_exp2f(p0[r] - mn); p1[r] = __builtin_amdgcn_exp2f(p1[r] - mn); rs += p0[r] + p1[r]; }
            l = l * alpha + rs; m = mn;
#pragma unroll
            for (int r = 0; r < 16; ++r) { oT[0][r] *= alpha; oT[1][r] *= alpha; }
            u32x4 pw[4];
            pw[0] = (u32x4){cvtpk(p0[0], p0[1]), cvtpk(p0[2], p0[3]), cvtpk(p0[4], p0[5]), cvtpk(p0[6], p0[7])};
            pw[1] = (u32x4){cvtpk(p0[8], p0[9]), cvtpk(p0[10], p0[11]), cvtpk(p0[12], p0[13]), cvtpk(p0[14], p0[15])};
            pw[2] = (u32x4){cvtpk(p1[0], p1[1]), cvtpk(p1[2], p1[3]), cvtpk(p1[4], p1[5]), cvtpk(p1[6], p1[7])};
            pw[3] = (u32x4){cvtpk(p1[8], p1[9]), cvtpk(p1[10], p1[11]), cvtpk(p1[12], p1[13]), cvtpk(p1[14], p1[15])};
            const LAS unsigned char* vp = Vl + tt * 8192 + voff;
#pragma unroll
            for (int d0 = 0; d0 < 2; ++d0)
#pragma unroll
                for (int ks = 0; ks < 4; ++ks) {
                    const s16x4 lo = vtr(vp + d0 * 4096 + ks * 1024), hh4 = vtr(vp + d0 * 4096 + ks * 1024 + 512);
                    const bf16x8 vf = (bf16x8){lo[0], lo[1], lo[2], lo[3], hh4[0], hh4[1], hh4[2], hh4[3]};
                    oT[d0] = __builtin_amdgcn_mfma_f32_32x32x16_bf16(vf, __builtin_bit_cast(bf16x8, pw[ks]), oT[d0], 0, 0, 0);
                }
        }
        float lt; { const auto rr = __builtin_amdgcn_permlane32_swap(__float_as_uint(l), __float_as_uint(l), false, false); lt = __uint_as_float(rr[0]) + __uint_as_float(rr[1]); }
        const float inv = 1.0f / lt;
        const int lq = 128 * me.j + 32 * w + r32;
        const size_t tok = (size_t)me.b * SEQ + (size_t)lq * me.dil + me.ph;
        if (MODE == 3) { asm volatile("" :: "v"(oT[0]), "v"(oT[1]), "v"(inv), "v"(m)); __syncthreads(); continue; }
        bf16* orow = og + tok * (NG * AW) + me.g * AW + me.hh * 64;
#pragma unroll
        for (int d0 = 0; d0 < 2; ++d0)
#pragma unroll
            for (int rp = 0; rp < 2; ++rp) {
                const int rg = 2 * rp;
                if (FP8_OG) {
                    const float i16 = inv * 16.0f;
                    const unsigned x = pack_fp8x4(oT[d0][4 * rg] * i16, oT[d0][4 * rg + 1] * i16, oT[d0][4 * rg + 2] * i16, oT[d0][4 * rg + 3] * i16);
                    const unsigned y = pack_fp8x4(oT[d0][4 * rg + 4] * i16, oT[d0][4 * rg + 5] * i16, oT[d0][4 * rg + 6] * i16, oT[d0][4 * rg + 7] * i16);
                    auto s0 = __builtin_amdgcn_permlane32_swap(x, y, false, false);
                    u32x2 wv; wv.x = s0[0]; wv.y = s0[1];
                    *(u32x2*)((unsigned char*)og + tok * (NG * AW) + me.g * AW + me.hh * 64 + 32 * d0 + 16 * rp + 8 * hi) = wv;
                } else {
                    unsigned x0 = cvtpk(oT[d0][4 * rg] * inv, oT[d0][4 * rg + 1] * inv), x1 = cvtpk(oT[d0][4 * rg + 2] * inv, oT[d0][4 * rg + 3] * inv);
                    unsigned y0 = cvtpk(oT[d0][4 * rg + 4] * inv, oT[d0][4 * rg + 5] * inv), y1 = cvtpk(oT[d0][4 * rg + 6] * inv, oT[d0][4 * rg + 7] * inv);
                    auto s0 = __builtin_amdgcn_permlane32_swap(x0, y0, false, false); auto s1 = __builtin_amdgcn_permlane32_swap(x1, y1, false, false);
                    u32x4 wv; wv.x = s0[0]; wv.y = s1[0]; wv.z = s0[1]; wv.w = s1[1];
                    *(u32x4*)(orow + 32 * d0 + 16 * rp + 8 * hi) = wv;
                }
            }
        if (hi == 0) lse[tok * 24 + me.g * 8 + me.hh] = (m + __builtin_amdgcn_logf(lt)) * LN2;
        __syncthreads();
    }
    }
#undef ATT_ISSUE
}
}

__device__ __forceinline__ u32x4 widen16(u32x2 x, u32x2 y) {
    auto s0 = __builtin_amdgcn_permlane16_swap(x.x, y.x, false, false); auto s1 = __builtin_amdgcn_permlane16_swap(x.y, y.y, false, false);
    return (u32x4){s0[0], s1[0], s0[1], s1[1]};
}
using pg8::Unit; using pg8::BM; using pg8::HALF;
struct EpiQKV {
    static constexpr bool PERM = true;
    bf16* O; const float* cs; float sc;
    __device__ __forceinline__ void operator()(const f32x4 (&acc)[2][2][4][2], const Unit& u, int wr, int wc, int fr, int fq) const {
        const int colt = u.pn * BM; const int kind = (colt % 1536) / 512;
        const bool rot = (kind < 2) && ((wc & 1) == 0) && (fq < 2);
        f32x4 cz[2][4][2];
#pragma unroll
        for (int ai = 0; ai < 2; ++ai)
#pragma unroll
            for (int m = 0; m < 4; ++m) { cz[ai][m][0] = (f32x4){1.f, 0.f, 1.f, 0.f}; cz[ai][m][1] = (f32x4){1.f, 0.f, 1.f, 0.f}; }
        if (rot) {
#pragma unroll
            for (int ai = 0; ai < 2; ++ai)
#pragma unroll
                for (int m = 0; m < 4; ++m) { const int row = u.pm * BM + ai * HALF + wr * 64 + m * 16 + fr;
                    cz[ai][m][0] = *(const f32x4*)(cs + (size_t)row * 16 + fq * 8); cz[ai][m][1] = *(const f32x4*)(cs + (size_t)row * 16 + fq * 8 + 4); }
        }
#pragma unroll
        for (int ai = 0; ai < 2; ++ai)
#pragma unroll
            for (int m = 0; m < 4; ++m) {
                const int row = u.pm * BM + ai * HALF + wr * 64 + m * 16 + fr;
                const f32x4 c0 = cz[ai][m][0], c1 = cz[ai][m][1];
                bf16* rowp = O + (size_t)row * QKVW + colt + wc * 32 + 8 * fq;
                u32x2 w8[2];
#pragma unroll
                for (int bj = 0; bj < 2; ++bj) {
                    f32x4 v0 = acc[ai][bj][m][0] * sc, v1 = acc[ai][bj][m][1] * sc;
                    f32x4 o0, o1;
                    o0.x = v0.x * c0.x - v0.y * c0.y; o0.y = v0.y * c0.x + v0.x * c0.y; o0.z = v0.z * c0.z - v0.w * c0.w; o0.w = v0.w * c0.z + v0.z * c0.w;
                    o1.x = v1.x * c1.x - v1.y * c1.y; o1.y = v1.y * c1.x + v1.x * c1.y; o1.z = v1.z * c1.z - v1.w * c1.w; o1.w = v1.w * c1.z + v1.z * c1.w;
                    if (FP8_QKVS) { w8[bj].x = pack_fp8x4(o0.x, o0.y, o0.z, o0.w); w8[bj].y = pack_fp8x4(o1.x, o1.y, o1.z, o1.w); }
                    else { u32x4 w; w.x = cvtpk(o0.x, o0.y); w.y = cvtpk(o0.z, o0.w); w.z = cvtpk(o1.x, o1.y); w.w = cvtpk(o1.z, o1.w);
                        *(u32x4*)(rowp + bj * HALF) = w; }
                }
                if (FP8_QKVS) {
                    const u32x4 w16 = widen16(w8[0], w8[1]);
                    *(u32x4*)((unsigned char*)O + (size_t)row * QKVW + colt + wc * 32 + 8 * (fq & ~1) + (fq & 1) * HALF) = w16; }
            }
    }
};
struct EpiBf16 {
    static constexpr bool PERM = true;
    bf16* O; int ldc;
    __device__ __forceinline__ void operator()(const f32x4 (&acc)[2][2][4][2], const Unit& u, int wr, int wc, int fr, int fq) const {
#pragma unroll
        for (int ai = 0; ai < 2; ++ai)
#pragma unroll
            for (int m = 0; m < 4; ++m) {
                bf16* rowp = O + (size_t)(u.pm * BM + ai * HALF + wr * 64 + m * 16 + fr) * ldc + u.pn * BM + wc * 32 + 8 * fq;
#pragma unroll
                for (int bj = 0; bj < 2; ++bj) { const f32x4 v0 = acc[ai][bj][m][0], v1 = acc[ai][bj][m][1];
                    u32x4 w; w.x = cvtpk(v0.x, v0.y); w.y = cvtpk(v0.z, v0.w); w.z = cvtpk(v1.x, v1.y); w.w = cvtpk(v1.z, v1.w);
                    *(u32x4*)(rowp + bj * HALF) = w; }
            }
    }
};
template <bool RES32>
struct EpiResBf16 {
    static constexpr bool PERM = true;
    const void* res; bf16* out;
    __device__ __forceinline__ void operator()(const f32x4 (&acc)[2][2][4][2], const Unit& u, int wr, int wc, int fr, int fq) const {
#pragma unroll
        for (int ai = 0; ai < 2; ++ai) {
            f32x4 r32[4][2][2]; u32x4 r16[4][2];
            if constexpr (RES32) {
#pragma unroll
                for (int m = 0; m < 4; ++m)
#pragma unroll
                    for (int bj = 0; bj < 2; ++bj) { const size_t off = (size_t)(u.pm * BM + ai * HALF + wr * 64 + m * 16 + fr) * D + u.pn * BM + wc * 32 + 8 * fq + bj * HALF;
                        r32[m][bj][0] = *(const f32x4*)((const float*)res + off); r32[m][bj][1] = *(const f32x4*)((const float*)res + off + 4); }
            } else {
#pragma unroll
                for (int m = 0; m < 4; ++m)
#pragma unroll
                    for (int bj = 0; bj < 2; ++bj) { const size_t off = (size_t)(u.pm * BM + ai * HALF + wr * 64 + m * 16 + fr) * D + u.pn * BM + wc * 32 + 8 * fq + bj * HALF;
                        r16[m][bj] = *(const u32x4*)((const bf16*)res + off); }
            }
#pragma unroll
            for (int m = 0; m < 4; ++m)
#pragma unroll
                for (int bj = 0; bj < 2; ++bj) {
                    const size_t off = (size_t)(u.pm * BM + ai * HALF + wr * 64 + m * 16 + fr) * D + u.pn * BM + wc * 32 + 8 * fq + bj * HALF;
                    f32x4 r0, r1;
                    if constexpr (RES32) { r0 = r32[m][bj][0]; r1 = r32[m][bj][1]; }
                    else { const u32x4 rw = r16[m][bj]; r0 = (f32x4){bf_lo(rw.x), bf_hi(rw.x), bf_lo(rw.y), bf_hi(rw.y)}; r1 = (f32x4){bf_lo(rw.z), bf_hi(rw.z), bf_lo(rw.w), bf_hi(rw.w)}; }
                    const f32x4 v0 = r0 + acc[ai][bj][m][0], v1 = r1 + acc[ai][bj][m][1];
                    u32x4 w; w.x = cvtpk(v0.x, v0.y); w.y = cvtpk(v0.z, v0.w); w.z = cvtpk(v1.x, v1.y); w.w = cvtpk(v1.z, v1.w);
                    *(u32x4*)(out + off) = w;
                }
            asm volatile("" ::: "memory");
        }
    }
};
template <bool OUT8>
struct EpiSwiGLU {
    static constexpr bool PERM = true;
    void* O; float sc;
    __device__ __forceinline__ void operator()(const f32x4 (&acc)[2][2][4][2], const Unit& u, int wr, int wc, int fr, int fq) const {
#pragma unroll
        for (int ai = 0; ai < 2; ++ai)
#pragma unroll
            for (int mp = 0; mp < 2; ++mp) {
                u32x2 w8[2];
#pragma unroll
                for (int mi = 0; mi < 2; ++mi) { const int m = 2 * mp + mi;
                    const size_t eoff = (size_t)(u.pm * BM + ai * HALF + wr * 64 + m * 16 + fr) * DE + u.pn * HALF + wc * 32 + 8 * fq;
                    float h[8];
#pragma unroll
                    for (int n = 0; n < 2; ++n)
#pragma unroll
                        for (int e = 0; e < 4; ++e) { const float a = acc[ai][0][m][n][e] * sc, b = acc[ai][1][m][n][e] * sc;
                            h[n * 4 + e] = a * __builtin_amdgcn_rcpf(1.0f + __builtin_amdgcn_exp2f(-1.4426950408889634f * a)) * b; }
                    if constexpr (OUT8) { w8[mi].x = pack_fp8x4(h[0] * 16.f, h[1] * 16.f, h[2] * 16.f, h[3] * 16.f); w8[mi].y = pack_fp8x4(h[4] * 16.f, h[5] * 16.f, h[6] * 16.f, h[7] * 16.f); }
                    else { u32x4 w; w.x = cvtpk(h[0], h[1]); w.y = cvtpk(h[2], h[3]); w.z = cvtpk(h[4], h[5]); w.w = cvtpk(h[6], h[7]); *(u32x4*)((bf16*)O + eoff) = w; }
                }
                if constexpr (OUT8) { const u32x4 w16 = widen16(w8[0], w8[1]);
                    const int m = 2 * mp + (fq & 1);
                    *(u32x4*)((unsigned char*)O + (size_t)(u.pm * BM + ai * HALF + wr * 64 + m * 16 + fr) * DE + u.pn * HALF + wc * 32 + 8 * (fq & ~1)) = w16; }
            }
    }
};
struct EpiGate {
    static constexpr bool PERM = true;
    bf16* O; const LAS float* gtab;
    __device__ __forceinline__ void operator()(const f32x4 (&acc)[2][2][4][2], const Unit& u, int wr, int wc, int fr, int fq) const {
#pragma unroll
        for (int ai = 0; ai < 2; ++ai)
#pragma unroll
            for (int m = 0; m < 4; ++m) {
                const int rl = ai * HALF + wr * 64 + m * 16 + fr;
                const float gt = gtab[u.idx * 256 + rl];
                const size_t eoff = (size_t)(u.pm * BM + rl) * D + u.pn * BM + wc * 32 + 8 * fq;
                u32x2 w8[2];
#pragma unroll
                for (int bj = 0; bj < 2; ++bj) { const f32x4 v0 = acc[ai][bj][m][0] * gt, v1 = acc[ai][bj][m][1] * gt;
                    if (FP8_YS) { w8[bj].x = pack_fp8x4(v0.x, v0.y, v0.z, v0.w); w8[bj].y = pack_fp8x4(v1.x, v1.y, v1.z, v1.w); }
                    else { u32x4 w; w.x = cvtpk(v0.x, v0.y); w.y = cvtpk(v0.z, v0.w); w.z = cvtpk(v1.x, v1.y); w.w = cvtpk(v1.z, v1.w); *(u32x4*)(O + eoff + bj * HALF) = w; } }
                if (FP8_YS) { const u32x4 w16 = widen16(w8[0], w8[1]);
                    *(u32x4*)((unsigned char*)O + (size_t)(u.pm * BM + rl) * D + u.pn * BM + wc * 32 + 8 * (fq & ~1) + (fq & 1) * HALF) = w16; }
            }
    }
};

template <bool F8_>
struct MoeProb1T {
    static constexpr bool F8 = F8_;
    const void* A; const void* Bt; int K; const LAS int* tb; const LAS unsigned* aofs;
    __device__ __forceinline__ void a_offs(int i, const Unit&, const int (&R)[2], const int (&C)[2], unsigned (&o0)[2], unsigned (&o1)[2]) const {
#pragma unroll
        for (int k = 0; k < 2; ++k) { o0[k] = aofs[i * 256 + R[k]] + (unsigned)C[k] * 2u; o1[k] = aofs[i * 256 + 128 + R[k]] + (unsigned)C[k] * 2u; }
    }
    __device__ __forceinline__ unsigned b_off(const Unit& u) const {
        int e = 0;
#pragma unroll
        for (int k = 1; k < NE; ++k) e += (u.pm >= tb[k]) ? 1 : 0;
        return (unsigned)((e * 1024 + u.pn * 256) * 1024 * (F8 ? 1 : 2));
    }
};
template <bool F8_>
struct MoeProb2T {
    static constexpr bool F8 = F8_;
    const void* A; const void* Bt; int K; const LAS int* tb;
    __device__ __forceinline__ void a_offs(int, const Unit& u, const int (&R)[2], const int (&C)[2], unsigned (&o0)[2], unsigned (&o1)[2]) const {
        constexpr int esz = F8 ? 1 : 2;
#pragma unroll
        for (int k = 0; k < 2; ++k) { const unsigned b = (unsigned)((u.pm * BM + R[k]) * DE * esz + C[k] * 2); o0[k] = b; o1[k] = b + (unsigned)(HALF * DE * esz); }
    }
    __device__ __forceinline__ unsigned b_off(const Unit& u) const {
        int e = 0;
#pragma unroll
        for (int k = 1; k < NE; ++k) e += (u.pm >= tb[k]) ? 1 : 0;
        return (unsigned)((e * 1024 + u.pn * 256) * DE * (F8 ? 1 : 2));
    }
};
struct FoldOrder { int G, c; __device__ bool next(int i, Unit& u) const { const int L = i * G + c; if (L >= 16) return false; u.pm = L >> 2; u.pn = L & 3; return true; } };


#define XB_TMO      128
#define XB_XCNT(j)  (256  + 64 * (j))
#define XB_XSUB(j)  (1280 + 64 * (j))
#define XB_XGEN(j)  (2304 + 64 * (j))
#define XB_TOP      3328
#define XB_TOPGEN   3392
#define XCD_BAR_WORDS 3456
#define XB_SPIN_CAP (1u << 18)
__device__ __forceinline__ unsigned xb_ld(unsigned* p)              { return __hip_atomic_load(p, __ATOMIC_RELAXED, __HIP_MEMORY_SCOPE_AGENT); }
__device__ __forceinline__ unsigned xb_add(unsigned* p, unsigned v) { return __hip_atomic_fetch_add(p, v, __ATOMIC_RELAXED, __HIP_MEMORY_SCOPE_AGENT); }
__device__ __forceinline__ unsigned xb_xcc_id() { return (unsigned)__builtin_amdgcn_s_getreg((3 << 11) | 20) & 0xFu; }
#define XB_SPIN(cond, bar) do { unsigned _sp = 0; while (cond) { __builtin_amdgcn_s_sleep(1); \
    if ((++_sp & 255u) == 0u) { if (xb_ld(&(bar)[XB_TMO])) break; if (_sp > XB_SPIN_CAP) { atomicAdd(&(bar)[XB_TMO], 1u); break; } } } } while (0)
struct XcdBarrier { unsigned* bar; unsigned x; volatile LAS unsigned* st; };
__device__ __forceinline__ XcdBarrier xcd_barrier_post(unsigned* bar, volatile LAS unsigned* st) {
    XcdBarrier b; b.bar = bar; b.x = xb_xcc_id(); b.st = st;
    if (threadIdx.x == 0) (void)xb_add(&bar[XB_XCNT(b.x)], 1u);
    return b;
}
__device__ __forceinline__ void xcd_barrier_complete(unsigned* bar, unsigned x, unsigned& nloc, unsigned& nx) {
    const unsigned G = gridDim.x * gridDim.y * gridDim.z;
    unsigned sum, cnt, mine, sp = 0u;
    for (;;) {
        sum = 0u; cnt = 0u; mine = 0u;
#pragma unroll
        for (unsigned j = 0; j < 16; ++j) { const unsigned c = xb_ld(&bar[XB_XCNT(j)]); sum += c; cnt += (c > 0u) ? 1u : 0u; mine = (j == x) ? c : mine; }
        if (sum == G) break;
        __builtin_amdgcn_s_sleep(1);
        if ((++sp & 255u) == 0u) { if (xb_ld(&bar[XB_TMO])) break; if (sp > XB_SPIN_CAP) { atomicAdd(&bar[XB_TMO], 1u); break; } }
    }
    nloc = mine > 0u ? mine : 1u; nx = cnt > 0u ? cnt : 1u;
}
__device__ __forceinline__ void xcd_barrier(const XcdBarrier& b) {
    asm volatile("s_waitcnt vmcnt(0)" ::: "memory");
    __syncthreads();
    if (threadIdx.x == 0) {
        unsigned* bar = b.bar;
        __builtin_amdgcn_s_waitcnt(0);
        unsigned nloc = b.st[0], nx = b.st[1];
        if (nloc == 0u) { xcd_barrier_complete(bar, b.x, nloc, nx); b.st[0] = nloc; b.st[1] = nx; }
        const unsigned old = xb_add(&bar[XB_XSUB(b.x)], 1u);
        const unsigned gen = old / nloc;
        if (old + 1u == (gen + 1u) * nloc) {
            __builtin_amdgcn_fence(__ATOMIC_RELEASE, "agent");
            asm volatile("s_waitcnt vmcnt(0)" ::: "memory");
            const unsigned og = xb_add(&bar[XB_TOP], 1u);
            const unsigned tg = og / nx;
            if (og + 1u == (tg + 1u) * nx) xb_add(&bar[XB_TOPGEN], 1u);
            else XB_SPIN(xb_ld(&bar[XB_TOPGEN]) == tg, bar);
            __builtin_amdgcn_fence(__ATOMIC_ACQUIRE, "agent");
            xb_add(&bar[XB_XGEN(b.x)], 1u);
            asm volatile("s_waitcnt vmcnt(0)" ::: "memory");
        } else {
            XB_SPIN(xb_ld(&bar[XB_XGEN(b.x)]) == gen, bar);
            __builtin_amdgcn_fence(__ATOMIC_ACQUIRE, "agent");
            asm volatile("s_waitcnt vmcnt(0)" ::: "memory");
        }
    }
    __syncthreads();
}

constexpr int N_PHASES = 16;

typedef const __attribute__((address_space(4))) Params* KParamsPtr;
__device__ __forceinline__ KParamsPtr kparams() { KParamsPtr q = (KParamsPtr)__builtin_amdgcn_kernarg_segment_ptr(); asm volatile("" : "+s"(q)); return q; }
__global__ void __launch_bounds__(NTHREADS, 2) fwd_kernel(Params p) {
    extern __shared__ __attribute__((aligned(16))) unsigned char lds_raw[];
    LAS unsigned char* lds = (LAS unsigned char*)lds_raw;
    const int tid = threadIdx.x, lane = tid & 63, wave = __builtin_amdgcn_readfirstlane(tid >> 6);
    const int G = gridDim.x, bx = blockIdx.x;
    const int vcu = (G % 8 == 0) ? (bx % 8) * (G / 8) + bx / 8 : bx;
#define KP() kparams()
#define WSB() ((unsigned char*)KP()->ws)
#define G_ctl ((int*)(WSB() + WS_CTL))
#define G_cs ((float*)(WSB() + WS_CS))
#define G_lse ((float*)(WSB() + WS_LSE))
#define G_slotref ((int*)(WSB() + WS_SLOTREF))
#define Wgs ((bf16*)(WSB() + WS_WGS))
#define G_list ((int*)(WSB() + WS_LIST))
#define G_gatel ((float*)(WSB() + WS_GATEL))
#define Win_t ((bf16*)(WSB() + WS_WIN))
#define Wout_t ((bf16*)(WSB() + WS_WOUT))
#define Wpin_t ((bf16*)(WSB() + WS_WPIN))
#define Wc_t ((bf16*)(WSB() + WS_WC))
#define Wpo_t ((bf16*)(WSB() + WS_WPO))
#define W13 ((bf16*)(WSB() + WS_W13))
#define W2 ((bf16*)(WSB() + WS_W2))
#define Y ((bf16*)(WSB() + WS_Y))
#define QKV ((bf16*)(WSB() + WS_BIG))
#define OM ((bf16*)(WSB() + WS_OM))
#define HMID ((bf16*)(WSB() + WS_HMID))
#define YS ((bf16*)(WSB() + WS_YS))
#define U ((bf16*)(WSB() + WS_U))
#define POOLED ((bf16*)(WSB() + WS_POOLED))
#define OG ((bf16*)KP()->out)
#define H ((bf16*)(WSB() + WS_H))
    LAS int* tb = (LAS int*)(lds + MISC_OFF);
    LAS unsigned* aofs = (LAS unsigned*)(lds + AOFS_OFF);

    const int lo = p.ph_lo, hi = p.ph_hi;
#if MK_N_LAUNCHES == 1
    cg::grid_group grid = cg::this_grid();
    if (tid < 2) ((volatile LAS unsigned*)(lds + MISC_OFF))[64 + tid] = 0u;
    __syncthreads();
    const XcdBarrier xbar = xcd_barrier_post((unsigned*)(G_ctl + CW_BAR), (volatile LAS unsigned*)(lds + MISC_OFF) + 64);
#define GRID_BAR(k) do { if ((k) == CG_SEAM) grid.sync(); else xcd_barrier(xbar); } while (0)
#else
#define GRID_BAR(k) do { } while (0)
#endif
#ifndef PHASE_MASK
#define PHASE_MASK 0xffff
#endif
#ifndef REPEAT_MASK
#define REPEAT_MASK 0x0
#endif
#define REP(k) for (int rep_ = 0; rep_ <= ((REPEAT_MASK >> (k)) & 1); ++rep_)
#define IN(k) (((PHASE_MASK >> (k)) & 1) && lo <= (k) && (k) < hi)
#ifndef DOUBLE_BAR
#define DOUBLE_BAR 0
#endif
#ifndef PROBE_PHASE
#define PROBE_PHASE (-1)
#endif
#define PT0(k) if (PROBE_PHASE == (k)) pt0 = __builtin_amdgcn_s_memrealtime();
#define PT1(k) if (PROBE_PHASE == (k)) { const unsigned long long t1_ = __builtin_amdgcn_s_memrealtime(), d_ = t1_ - pt0; while (__builtin_amdgcn_s_memrealtime() - t1_ < d_) __builtin_amdgcn_s_sleep(8); }
#define SEAM(k) do { if (IN(k) && IN((k) + 1)) { _Pragma("unroll 1") for (int nb_ = 0; nb_ < 1 + (DOUBLE_BAR ? (hi > 0 ? 1 : 0) : 0); ++nb_) GRID_BAR(k); } } while (0)

    unsigned long long pt0 = 0;
    PT0(0)
    if (IN(0)) REP(0) {
        LAS float* scr = (LAS float*)(lds + wave * 16384);
        const int gw = vcu * NWAVES + wave, NGW = G * NWAVES;
        constexpr int I_IN = (D / 64) * (QKVW / 32);
        constexpr int I_OUT = (AW / 64) * (D / 32);
        constexpr int I_PIN = (D / 64) * (D / 32);
        constexpr int I_PO = I_PIN;
        constexpr int I_W1 = (D / 64) * (DE / 32);
        constexpr int I_W2 = (DE / 64) * (D / 32);
        constexpr int NITEMS = I_IN + I_OUT + I_PIN + I_PO + 32 * (2 * I_W1 + I_W2);
        for (int it = gw; it < NITEMS; it += NGW) {
            int r = it;
            if (r < I_IN) { const int nblk = QKVW / 32;
                if (FP8_QKV) transpose_item8(KP()->attn_w_in, QKVW, D, (unsigned char*)Win_t, MapQKV{}, 32.f, scr, 64 * (r / nblk), 32 * (r % nblk), lane);
                else transpose_item(KP()->attn_w_in, QKVW, D, Win_t, MapQKV{}, scr, 64 * (r / nblk), 32 * (r % nblk), lane);
                continue; } r -= I_IN;
            if (r < I_OUT) { const int nblk = D / 32; transpose_item(KP()->attn_w_out, D, AW, Wout_t, MapId{}, scr, 64 * (r / nblk), 32 * (r % nblk), lane); continue; } r -= I_OUT;
            if (r < I_PIN) { const int nblk = D / 32; transpose_item(KP()->pool_w_in, D, D, Wpin_t, MapId{}, scr, 64 * (r / nblk), 32 * (r % nblk), lane); continue; } r -= I_PIN;
            if (r < I_PO) { const int nblk = D / 32; transpose_item(KP()->pool_w_out, D, D, Wpo_t, MapId{}, scr, 64 * (r / nblk), 32 * (r % nblk), lane); continue; } r -= I_PO;
            const int le = r / (2 * I_W1 + I_W2); r -= le * (2 * I_W1 + I_W2);
            if (r < I_W1) { const int nblk = DE / 32;
                if (FP8_MOE1) transpose_item8(KP()->expert_w1 + (size_t)le * D * DE, DE, D, (unsigned char*)W13 + (size_t)le * 1024 * 1024, MapW13{0}, 32.f, scr, 64 * (r / nblk), 32 * (r % nblk), lane);
                else transpose_item(KP()->expert_w1 + (size_t)le * D * DE, DE, D, W13 + (size_t)le * 1024 * 1024, MapW13{0}, scr, 64 * (r / nblk), 32 * (r % nblk), lane);
                continue; } r -= I_W1;
            if (r < I_W1) { const int nblk = DE / 32;
                if (FP8_MOE1) transpose_item8(KP()->expert_w3 + (size_t)le * D * DE, DE, D, (unsigned char*)W13 + (size_t)le * 1024 * 1024, MapW13{128}, 32.f, scr, 64 * (r / nblk), 32 * (r % nblk), lane);
                else transpose_item(KP()->expert_w3 + (size_t)le * D * DE, DE, D, W13 + (size_t)le * 1024 * 1024, MapW13{128}, scr, 64 * (r / nblk), 32 * (r % nblk), lane);
                continue; } r -= I_W1;
            { const int nblk = D / 32;
                if (FP8_MOE2) transpose_item8(KP()->expert_w2 + (size_t)le * DE * D, D, DE, (unsigned char*)W2 + (size_t)le * 1024 * DE, MapId{}, 32.f, scr, 64 * (r / nblk), 32 * (r % nblk), lane);
                else transpose_item(KP()->expert_w2 + (size_t)le * DE * D, D, DE, W2 + (size_t)le * 1024 * DE, MapId{}, scr, 64 * (r / nblk), 32 * (r % nblk), lane); }
        }
        for (int i = vcu * NTHREADS + tid; i < 4 * 256 * 256 / 4; i += G * NTHREADS) {
            const int e4 = (i & 63) * 4, gidx = i >> 14;
            const f32x4 wv = *(const f32x4*)(KP()->pool_w_group + (size_t)i * 4); const f32x4 sc = *(const f32x4*)(KP()->pool_scale + gidx * 256 + e4);
            u32x2 o; o.x = cvtpk(wv.x * sc.x, wv.y * sc.y); o.y = cvtpk(wv.z * sc.z, wv.w * sc.w); *(u32x2*)(Wgs + (size_t)i * 4) = o;
        }
        for (int i = vcu * NTHREADS + tid; i < T * 8; i += G * NTHREADS) {
            const int tok = i >> 3, f = i & 7;
            const double invf = exp2(-(double)f * 0.125 * 18.931568569324174);
            const float ang = (float)KP()->positions[tok] * (float)invf;
            double sn, cn; sincos((double)ang, &sn, &cn);
            G_cs[(size_t)i * 2] = (float)cn; G_cs[(size_t)i * 2 + 1] = (float)sn;
        }
        RowPassCfg c{}; c.hin = KP()->x; c.gain = KP()->norm_mix; if (FP8_QKV) c.yout8 = (unsigned char*)Y; else c.yout = Y;
        row_pass<false, false, false>(lds, c, vcu, wave);
    }
    SEAM(0); PT1(0)
    PT0(1)
    if (IN(1)) REP(1) {
        pg8::DenseProbT<FP8_QKV != 0> P{Y, Win_t, D, D, 0, (size_t)256 * D};
        pg8::StaticOrder S; S.init(T / 256, QKVW / 256, G, bx);
        EpiQKV E{QKV, G_cs, FP8_QKV ? (1.0f / 32.0f) : 1.0f};
        pg8::gemm_phase<pg8::DenseProbT<FP8_QKV != 0>, EpiQKV, pg8::StaticOrder, true>(lds, P, S, E);
    }
    SEAM(1); PT1(1)
    PT0(2)
    if (IN(2)) REP(2) {
#ifndef ATT_PROBE_MODE
#define ATT_PROBE_MODE 0
#endif
        if (ATT_PROBE_MODE == 1) att::attn_phase<1>(lds, QKV, OG, G_lse, vcu, G);
        if (ATT_PROBE_MODE == 2) att::attn_phase<2>(lds, QKV, OG, G_lse, vcu, G);
        if (ATT_PROBE_MODE == 3) att::attn_phase<3>(lds, QKV, OG, G_lse, vcu, G);
        att::attn_phase<0>(lds, QKV, OG, G_lse, vcu, G);
    }
    SEAM(2); PT1(2)
    PT0(3)
    if (IN(3)) REP(3) {
        for (int row = vcu * NWAVES + wave; row < T; row += G * NWAVES) {
            const int h = lane >> 3;
            const float l0 = G_lse[(size_t)row * 24 + h], l1 = G_lse[(size_t)row * 24 + 8 + h], l2 = G_lse[(size_t)row * 24 + 16 + h];
            const float mx = fmaxf(l0, fmaxf(l1, l2));
            float w0 = __expf(l0 - mx), w1 = __expf(l1 - mx), w2 = __expf(l2 - mx); const float inv = 1.0f / (w0 + w1 + w2); w0 *= inv; w1 *= inv; w2 *= inv;
            u32x4 o;
            if (FP8_OG) {
                const unsigned char* src = (const unsigned char*)OG + (size_t)row * 1536 + lane * 8;
                const u32x2 a = *(const u32x2*)(src), b = *(const u32x2*)(src + 512), c = *(const u32x2*)(src + 1024);
                w0 *= (1.0f / 16.0f); w1 *= (1.0f / 16.0f); w2 *= (1.0f / 16.0f);
#define MRG_(WA, WB, WC, SEL) cvtpk(w0 * __builtin_amdgcn_cvt_pk_f32_fp8((int)(WA), SEL)[0] + w1 * __builtin_amdgcn_cvt_pk_f32_fp8((int)(WB), SEL)[0] + w2 * __builtin_amdgcn_cvt_pk_f32_fp8((int)(WC), SEL)[0], \
                                    w0 * __builtin_amdgcn_cvt_pk_f32_fp8((int)(WA), SEL)[1] + w1 * __builtin_amdgcn_cvt_pk_f32_fp8((int)(WB), SEL)[1] + w2 * __builtin_amdgcn_cvt_pk_f32_fp8((int)(WC), SEL)[1])
                o[0] = MRG_(a.x, b.x, c.x, false); o[1] = MRG_(a.x, b.x, c.x, true); o[2] = MRG_(a.y, b.y, c.y, false); o[3] = MRG_(a.y, b.y, c.y, true);
#undef MRG_
            } else {
            const bf16* src = OG + (size_t)row * 1536 + lane * 8;
            const u32x4 a = *(const u32x4*)(src), b = *(const u32x4*)(src + 512), c = *(const u32x4*)(src + 1024);
#pragma unroll
            for (int k = 0; k < 4; ++k) { const float lo_ = w0 * bf_lo(a[k]) + w1 * bf_lo(b[k]) + w2 * bf_lo(c[k]), hi_ = w0 * bf_hi(a[k]) + w1 * bf_hi(b[k]) + w2 * bf_hi(c[k]); o[k] = cvtpk(lo_, hi_); }
            }
            *(u32x4*)(OM + (size_t)row * AW + lane * 8) = o;
        }
    }
    SEAM(3); PT1(3)
    PT0(4)
    if (IN(4)) REP(4) {
        pg8::DenseProb P{OM, Wout_t, AW, AW, 0, (size_t)256 * AW};
        pg8::StaticOrder S; S.init(T / 256, D / 256, G, bx);
        EpiResBf16<true> E{KP()->x, H};
        pg8::gemm_phase<pg8::DenseProb, EpiResBf16<true>, pg8::StaticOrder, true>(lds, P, S, E);
    }
    SEAM(4); PT1(4)
#pragma unroll 1
    for (int L = 0; L < 2; ++L) {
        const int pb = (L == 0) ? 5 : 12;
        int* cnt = G_ctl + CW_CNT + L * NE;
        PT0(pb)
        if (IN(pb)) {
            RowPassCfg c{}; c.hin16 = H; c.gain = KP()->norm_ffn + L * D; if (FP8_MOE1) c.yout8 = (unsigned char*)Y; else c.yout = Y;
            c.rgw = KP()->router_group_w + (size_t)L * D * 4; c.rgb = KP()->router_group_b + L * 4; c.rew = KP()->router_expert_w + (size_t)L * 4 * D * 4; c.reb = KP()->router_expert_b + L * 16;
            c.cnt = cnt; c.list = G_list + (size_t)L * NE * T; c.gatel = G_gatel + (size_t)L * NE * T; c.slotref_out = G_slotref + (size_t)L * T * 2;
            if ((REPEAT_MASK >> pb) & 1) {
                RowPassCfg c2 = c; c2.cnt = G_ctl + 64 + L * NE; c2.list = (int*)(WSB() + WS_BIG + 200 * MiB); c2.gatel = (float*)(WSB() + WS_BIG + 204 * MiB); c2.slotref_out = (int*)(WSB() + WS_BIG + 208 * MiB);
                if (ROUTER_MFMA) router_pass(lds, c2, vcu, wave); else row_pass<false, true, true>(lds, c2, vcu, wave);
            }
            if (ROUTER_MFMA) router_pass(lds, c, vcu, wave); else row_pass<false, true, true>(lds, c, vcu, wave);
        }
        SEAM(pb); PT1(pb)
        PT0(pb + 1)
        if (IN(pb + 1) || IN(pb + 2)) {
            if (tid == 0) { int s = 0; for (int e = 0; e < NE; ++e) { tb[e] = s; tb[32 + e] = cnt[e]; s += (cnt[e] + 255) >> 8; } tb[NE] = s; }
            __syncthreads();
        }
        if (IN(pb + 1)) REP(pb + 1) {
            const int NT = tb[NE];
            pg8::StaticOrder S; S.init(NT, 4, G, bx);
            for (int i = 0; i < 8; ++i) { Unit u; if (!S.next(i, u)) break;
                int e = 0;
                for (int k = 1; k < NE; ++k) e += (u.pm >= tb[k]) ? 1 : 0;
                if (tid < 256) { const int li = (u.pm - tb[e]) * 256 + tid; const int tok = (li < tb[32 + e]) ? G_list[((size_t)L * NE + e) * T + li] : 0; aofs[i * 256 + tid] = (unsigned)tok * (unsigned)(D * (FP8_MOE1 ? 1 : 2)); } }
            __syncthreads();
            MoeProb1T<FP8_MOE1 != 0> P{Y, (const unsigned char*)W13 + (size_t)L * NE * 1024 * 1024 * (FP8_MOE1 ? 1 : 2), D, tb, aofs};
            EpiSwiGLU<FP8_MOE2 != 0> E{HMID, FP8_MOE1 ? (1.0f / 32.0f) : 1.0f};
            pg8::gemm_phase<MoeProb1T<FP8_MOE1 != 0>, EpiSwiGLU<FP8_MOE2 != 0>, pg8::StaticOrder, true>(lds, P, S, E);
            if (L == 0) {
                pg8::DenseProb Pf{Wpo_t, Wgs, 256, D, 256, (size_t)256 * 256};
                FoldOrder Sf{G, G - 1 - bx};
                EpiBf16 Ef{Wc_t, D};
                pg8::gemm_phase<pg8::DenseProb, EpiBf16, FoldOrder, true>(lds, Pf, Sf, Ef);
            }
        }
        SEAM(pb + 1); PT1(pb + 1)
        PT0(pb + 2)
        if (IN(pb + 2)) REP(pb + 2) {
            const int NT = tb[NE];
            pg8::StaticOrder S; S.init(NT, 4, G, bx);
            { const float gsc = (FP8_MOE2 ? (1.0f / 512.0f) : 1.0f) * (FP8_YS ? 64.0f : 1.0f);
              for (int i = 0; i < 8; ++i) { Unit u; if (!S.next(i, u)) break;
                int e = 0;
                for (int k = 1; k < NE; ++k) e += (u.pm >= tb[k]) ? 1 : 0;
                if (tid < 256) { const int li = (u.pm - tb[e]) * 256 + tid; ((LAS float*)aofs)[i * 256 + tid] = (li < tb[32 + e]) ? G_gatel[((size_t)L * NE + e) * T + li] * gsc : 0.f; } }
              __syncthreads(); }
            MoeProb2T<FP8_MOE2 != 0> P{HMID, (const unsigned char*)W2 + (size_t)L * NE * 1024 * DE * (FP8_MOE2 ? 1 : 2), DE, tb};
            EpiGate E{YS, (const LAS float*)aofs};
            pg8::gemm_phase<MoeProb2T<FP8_MOE2 != 0>, EpiGate, pg8::StaticOrder, true>(lds, P, S, E);
        }
        SEAM(pb + 2); PT1(pb + 2)
        if (L == 0) {
            PT0(8)
            if (IN(8)) {
                RowPassCfg c{}; c.hin16 = H; c.ys = YS; c.slotref = G_slotref; c.cnt_prev = cnt; c.hout = H; c.gain = KP()->norm_mix + D; c.yout = Y;
                if ((REPEAT_MASK >> 8) & 1) { RowPassCfg c2 = c; c2.hout = nullptr; row_pass<true, false, true>(lds, c2, vcu, wave); }
                row_pass<true, false, true>(lds, c, vcu, wave);
            }
            SEAM(8); PT1(8)
            PT0(9)
            if (IN(9)) REP(9) {
                pg8::DenseProb P{Y, Wpin_t, D, D, 0, (size_t)256 * D};
                pg8::StaticOrder S; S.init(T / 256, D / 256, G, bx);
                EpiBf16 E{U, D};
                pg8::gemm_phase<pg8::DenseProb, EpiBf16, pg8::StaticOrder, true>(lds, P, S, E);
            }
            SEAM(9); PT1(9)
            PT0(10)
            if (IN(10)) REP(10) {
                int tq10 = threadIdx.x; asm volatile("" : "+v"(tq10));
                for (int it = vcu * NTHREADS + tq10; it < (T / 32) * 128; it += G * NTHREADS) {
                    const int ch = (it & 127) * 8, run = it >> 7, t0 = run * 32, s0 = t0 & (SEQ - 1);
                    const int wdw = 2 << (ch >> 8);
                    float sum[8];
#pragma unroll
                    for (int k = 0; k < 8; ++k) sum[k] = 0.f;
                    for (int i = 1; i < wdw; ++i) { if (s0 - i < 0) break; const u32x4 a = *(const u32x4*)(U + (size_t)(t0 - i) * D + ch);
#pragma unroll
                        for (int k = 0; k < 4; ++k) { sum[2 * k] += bf_lo(a[k]); sum[2 * k + 1] += bf_hi(a[k]); } }
                    for (int i0 = 0; i0 < 32; i0 += 8) {
                        u32x4 a8[8], o8[8];
#pragma unroll
                        for (int i = 0; i < 8; ++i) { const int tk = t0 + i0 + i, sq = s0 + i0 + i;
                            a8[i] = *(const u32x4*)(U + (size_t)tk * D + ch);
                            const int tko = tk - wdw + 1; const unsigned msk = (sq - wdw + 1 >= 0) ? 0xffffffffu : 0u;
                            const u32x4 ov = *(const u32x4*)(U + (size_t)(tko < 0 ? 0 : tko) * D + ch); o8[i] = (u32x4){ov.x & msk, ov.y & msk, ov.z & msk, ov.w & msk}; }
#pragma unroll
                        for (int i = 0; i < 8; ++i) { const int tk = t0 + i0 + i, sq = s0 + i0 + i;
                            float cur[8];
#pragma unroll
                            for (int k = 0; k < 4; ++k) { cur[2 * k] = bf_lo(a8[i][k]); cur[2 * k + 1] = bf_hi(a8[i][k]); }
#pragma unroll
                            for (int k = 0; k < 8; ++k) sum[k] += cur[k];
                            const float invc = 1.0f / (float)((sq + 1) < wdw ? (sq + 1) : wdw);
                            u32x4 w;
#pragma unroll
                            for (int k = 0; k < 4; ++k) w[k] = cvtpk(sum[2 * k] * invc - cur[2 * k], sum[2 * k + 1] * invc - cur[2 * k + 1]);
                            *(u32x4*)(POOLED + (size_t)tk * D + ch) = w;
#pragma unroll
                            for (int k = 0; k < 4; ++k) { sum[2 * k] -= bf_lo(o8[i][k]); sum[2 * k + 1] -= bf_hi(o8[i][k]); }
                        }
                    }
                }
            }
            SEAM(10); PT1(10)
            PT0(11)
            if (IN(11)) REP(11) {
                pg8::DenseProb P{POOLED, Wc_t, D, D, 0, (size_t)256 * D};
                pg8::StaticOrder S; S.init(T / 256, D / 256, G, bx);
                EpiResBf16<false> E{H, (((REPEAT_MASK >> 11) & 1) && rep_ == 0) ? (bf16*)(WSB() + WS_BIG + 136 * MiB) : H};
                pg8::gemm_phase<pg8::DenseProb, EpiResBf16<false>, pg8::StaticOrder, true>(lds, P, S, E);
            }
            SEAM(11); PT1(11)
        }
    }
    PT0(15)
    if (IN(15)) {
        RowPassCfg c{}; c.hin16 = H; c.ys = YS; c.slotref = G_slotref + (size_t)T * 2; c.cnt_prev = G_ctl + CW_CNT + NE; c.gain = KP()->norm_final; c.fout = KP()->out;
        if ((REPEAT_MASK >> 15) & 1) { RowPassCfg c2 = c; c2.fout = nullptr; c2.yout = Y; row_pass<true, false, true>(lds, c2, vcu, wave); }
        row_pass<true, false, true>(lds, c, vcu, wave);
    }
    PT1(15)
#undef IN
#undef SEAM
#undef GRID_BAR
}

#undef KP
#undef WSB
#undef G_ctl
#undef G_cs
#undef G_lse
#undef G_slotref
#undef Wgs
#undef G_list
#undef G_gatel
#undef Win_t
#undef Wout_t
#undef Wpin_t
#undef Wc_t
#undef Wpo_t
#undef W13
#undef W2
#undef Y
#undef QKV
#undef OM
#undef HMID
#undef YS
#undef U
#undef POOLED
#undef OG
#undef H
extern "C" void kernel_launch(void* const* d_in, const int* in_sizes, int n_in, void* d_out, int out_size, void* d_ws, size_t ws_size, hipStream_t stream) {
    static int grid = 0;
    if (grid == 0) {
        if (n_in != 18 || in_sizes[0] != T * D || out_size != T * D || ws_size < WS_END) { fprintf(stderr, "kernel_launch: unexpected shapes (n_in %d, in0 %d, out %d, ws %zu)\n", n_in, n_in > 0 ? in_sizes[0] : -1, out_size, ws_size); grid = -1; return; }
        int dev = 0, cus = 0, per_cu = 0;
        if (hipGetDevice(&dev) != hipSuccess || hipDeviceGetAttribute(&cus, hipDeviceAttributeMultiprocessorCount, dev) != hipSuccess) { grid = -1; return; }
        if (hipFuncSetAttribute((const void*)fwd_kernel, hipFuncAttributeMaxDynamicSharedMemorySize, LDS_BYTES) != hipSuccess) { fprintf(stderr, "kernel_launch: hipFuncSetAttribute failed\n"); grid = -1; return; }
        if (hipOccupancyMaxActiveBlocksPerMultiprocessor(&per_cu, (const void*)fwd_kernel, NTHREADS, LDS_BYTES) != hipSuccess || per_cu < 1) { fprintf(stderr, "kernel_launch: occupancy query says %d\n", per_cu); per_cu = 1; }
        (void)hipGetLastError();
        grid = cus;
    }
    if (grid < 0) return;
    (void)hipMemsetAsync((char*)d_ws + WS_CTL, 0, CTL_ZERO_BYTES, stream);
    Params p{};
    p.x = (const float*)d_in[0]; p.positions = (const int*)d_in[1]; p.norm_mix = (const float*)d_in[2]; p.norm_ffn = (const float*)d_in[3]; p.norm_final = (const float*)d_in[4];
    p.attn_w_in = (const float*)d_in[5]; p.attn_w_out = (const float*)d_in[6]; p.pool_w_in = (const float*)d_in[7]; p.pool_w_group = (const float*)d_in[8]; p.pool_scale = (const float*)d_in[9]; p.pool_w_out = (const float*)d_in[10];
    p.router_group_w = (const float*)d_in[11]; p.router_group_b = (const float*)d_in[12]; p.router_expert_w = (const float*)d_in[13]; p.router_expert_b = (const float*)d_in[14];
    p.expert_w1 = (const float*)d_in[15]; p.expert_w3 = (const float*)d_in[16]; p.expert_w2 = (const float*)d_in[17];
    p.out = (float*)d_out; p.ws = (unsigned char*)d_ws;
#if MK_N_LAUNCHES == 1
    p.ph_lo = 0; p.ph_hi = N_PHASES;
    void* args[] = {&p};
    hipError_t e = hipLaunchCooperativeKernel((const void*)fwd_kernel, dim3(grid), dim3(NTHREADS), args, LDS_BYTES, stream);
    if (e != hipSuccess) fprintf(stderr, "cooperative launch failed: %s (grid %d)\n", hipGetErrorString(e), grid);
#else
    for (int ph = 0; ph < N_PHASES; ++ph) {
        p.ph_lo = ph; p.ph_hi = ph + 1;
        hipLaunchKernelGGL(fwd_kernel, dim3(grid), dim3(NTHREADS), LDS_BYTES, stream, p);
    }
#endif
}
```

```cpp
#include <hip/hip_runtime.h>
#include <hip/hip_cooperative_groups.h>
#include <cstdio>
#include <cstdint>
namespace cg = cooperative_groups;

#ifndef MK_N_LAUNCHES
#define MK_N_LAUNCHES 1
#endif

#ifndef FP8_MOE1
#define FP8_MOE1 1
#endif
#ifndef FP8_MOE2
#define FP8_MOE2 1
#endif
#ifndef POOL_FUSED
#define POOL_FUSED 1
#endif
#ifndef FP8_QKVS
#define FP8_QKVS 1
#endif
#ifndef ROUTER_MFMA
#define ROUTER_MFMA 1
#endif
#ifndef FP8_OG
#define FP8_OG 1
#endif
#ifndef FP8_YS
#define FP8_YS 1
#endif
#ifndef FP8_QKV
#define FP8_QKV 1
#endif
#define LAS __attribute__((address_space(3)))
#define GAS __attribute__((address_space(1)))
typedef unsigned short bf16;
typedef short bf16x8 __attribute__((ext_vector_type(8)));
typedef float f32x4 __attribute__((ext_vector_type(4)));
typedef float f32x2 __attribute__((ext_vector_type(2)));
typedef float f32x16 __attribute__((ext_vector_type(16)));
typedef unsigned u32x4 __attribute__((ext_vector_type(4)));
typedef unsigned u32x2 __attribute__((ext_vector_type(2)));
typedef short s16x4 __attribute__((ext_vector_type(4)));
typedef __bf16 bf16x2_t __attribute__((ext_vector_type(2)));
typedef int i32x4 __attribute__((ext_vector_type(4)));
typedef int i32x8 __attribute__((ext_vector_type(8)));

constexpr int BATCH = 16, SEQ = 2048, D = 1024, T = BATCH * SEQ;
constexpr int NG = 3, HPG = 8, HD = 64, AW = 512, QKVW = NG * 3 * AW;
constexpr int NE = 16, DE = 512, SLOTS = 2 * T;
constexpr int MAXTILES = SLOTS / 256 + NE;
constexpr float RMS_EPS = 1e-6f;
constexpr int NWAVES = 8, NTHREADS = 512;

constexpr size_t MiB = 1u << 20;
constexpr size_t WS_CTL = 0, CTL_ZERO_BYTES = 64 * 1024;
constexpr size_t WS_CS = 1 * MiB;
constexpr size_t WS_LSE = 3 * MiB;
constexpr size_t WS_SLOTREF = 6 * MiB;
constexpr size_t WS_WGS = 7 * MiB;
constexpr size_t WS_LIST = 8 * MiB;
constexpr size_t WS_GATEL = 12 * MiB;
constexpr size_t WS_WIN = 16 * MiB;
constexpr size_t WS_WOUT = 25 * MiB;
constexpr size_t WS_WPIN = 26 * MiB;
constexpr size_t WS_WC = 28 * MiB;
constexpr size_t WS_WPO = 30 * MiB;
constexpr size_t WS_W13 = 32 * MiB;
constexpr size_t WS_W2 = 96 * MiB;
constexpr size_t WS_Y = 128 * MiB;
constexpr size_t WS_BIG = 192 * MiB;
constexpr size_t WS_OM = WS_BIG;
constexpr size_t WS_HMID = WS_BIG;
constexpr size_t WS_YS = WS_BIG + 72 * MiB;
constexpr size_t WS_U = WS_BIG;
constexpr size_t WS_POOLED = WS_BIG + 64 * MiB;
constexpr size_t WS_H = WS_BIG + 208 * MiB;
constexpr size_t WS_END = WS_BIG + 288 * MiB;
constexpr int CW_CNT = 0;
constexpr int CW_BAR = 1024;
#ifndef CG_SEAM
#define CG_SEAM (-1)
#endif

constexpr int RING_BYTES = 131072;
constexpr int AOFS_OFF = RING_BYTES;
constexpr int MISC_OFF = AOFS_OFF + 8192;
constexpr int LDS_BYTES = 147456;

__device__ __forceinline__ unsigned cvtpk(float lo, float hi) { f32x2 v = {lo, hi}; bf16x2_t b = __builtin_convertvector(v, bf16x2_t); return __builtin_bit_cast(unsigned, b); }
__device__ __forceinline__ float clamp8(float v) { return __builtin_amdgcn_fmed3f(v, -448.0f, 448.0f); }
__device__ __forceinline__ unsigned pack_fp8x4(float a, float b, float c, float d) {
    int r = __builtin_amdgcn_cvt_pk_fp8_f32(clamp8(a), clamp8(b), 0, false); r = __builtin_amdgcn_cvt_pk_fp8_f32(clamp8(c), clamp8(d), r, true); return (unsigned)r; }
__device__ __forceinline__ float bf_lo(unsigned u) { return __uint_as_float(u << 16); }
__device__ __forceinline__ float bf_hi(unsigned u) { return __uint_as_float(u & 0xffff0000u); }
#define DPP_ADD(v, ctrl) ((v) + __builtin_bit_cast(float, __builtin_amdgcn_update_dpp(0, __builtin_bit_cast(int, (v)), (ctrl), 0xF, 0xF, true)))
__device__ __forceinline__ float rows_sum(float v) {
    auto p = __builtin_amdgcn_permlane16_swap(__float_as_uint(v), __float_as_uint(v), false, false);
    const float t = __uint_as_float(p[0]) + __uint_as_float(p[1]);
    auto q = __builtin_amdgcn_permlane32_swap(__float_as_uint(t), __float_as_uint(t), false, false);
    return __uint_as_float(q[0]) + __uint_as_float(q[1]);
}
__device__ __forceinline__ float wave_sum(float v) {
    v = DPP_ADD(v, 0xB1);
    v = DPP_ADD(v, 0x4E);
    v = DPP_ADD(v, 0x141);
    v = DPP_ADD(v, 0x140);
    return rows_sum(v);
}

namespace pg8 {
constexpr int BM = 256, BK = 64, HALF = 128, HTB = HALF * BK * 2, STAGE_BYTES = 8 * HTB, NXCD = 8, WGM = 8;
__host__ __device__ __forceinline__ int lds_byte(int r, int c) { const int st = (r >> 4) * 2 + (c >> 5), rr = r & 15, cc = c & 31, ob = rr * 64 + cc * 2; return st * 1024 + (ob ^ (((ob >> 9) & 1) << 5)); }
__host__ __device__ __forceinline__ void stage_rc(int b, int& R, int& C) { const int st = b / 1024, sb = b % 1024, swz = sb ^ (((sb >> 9) & 1) << 5); R = (st >> 1) * 16 + swz / 64; C = (st & 1) * 32 + (swz % 64) / 2; }
__host__ __device__ __forceinline__ int perm32(int rho) { const int n = rho >> 4, i = rho & 15; return 8 * (i >> 2) + 4 * n + (i & 3); }

struct Unit { int pm, pn, idx; };

struct StaticOrder {
    int nM, nN, nwg, G, c;
    __device__ void init(int nM_, int nN_, int G_, int c_) { nM = nM_; nN = nN_; nwg = nM * nN; G = G_; c = c_; }
    __device__ bool next(int i, Unit& u) const {
        const long L = (long)i * G + c; if (L >= nwg) return false;
        int wgid = (int)L; { const int q = nwg / NXCD, r = nwg % NXCD, xcd = wgid % NXCD, off = wgid / NXCD; wgid = (xcd < r ? xcd * (q + 1) : r * (q + 1) + (xcd - r) * q) + off; }
        const int nig = WGM * nN, gid = wgid / nig, fm = gid * WGM, gsz = (nM - fm) < WGM ? (nM - fm) : WGM;
        u.pm = fm + ((wgid % nig) % gsz); u.pn = (wgid % nig) / gsz; return true;
    }
};

template <class Prob, class Epi, class Sched, bool ALIGN_EPI>
__device__ __forceinline__ void gemm_phase(LAS unsigned char* lds, const Prob& P, const Sched& S, const Epi& E) {
    int tid_ = threadIdx.x; asm volatile("" : "+v"(tid_));
    const int tid = tid_, wid = __builtin_amdgcn_readfirstlane(tid >> 6), lane = tid & 63, wr = wid >> 2, wc = wid & 3, fr = lane & 15, fq = lane >> 4;
    constexpr bool F8 = Prob::F8;
    const int Kb = P.K * (F8 ? 1 : 2), nt = Kb / (BK * 2);
    int Rr[2], Cc[2]; unsigned voffB[2];
#pragma unroll
    for (int i = 0; i < 2; ++i) { int R, C; stage_rc(tid * 16 + i * 8192, R, C); Rr[i] = R; Cc[i] = C; const int Rb = Epi::PERM ? ((R & ~31) + perm32(R & 31)) : R; voffB[i] = (unsigned)(Rb * Kb + C * 2); }
    const unsigned kstep = (unsigned)(BK * 2);
    const unsigned hstep = (unsigned)(HALF * Kb);
    const unsigned ldsw = (unsigned)wid * 1024u;
    const int aoff = lds_byte(wr * 64 + fr, fq * 8), boff = lds_byte(wc * 32 + fr, fq * 8);
    const __amdgpu_buffer_rsrc_t rsA = __builtin_amdgcn_make_buffer_rsrc((void*)P.A, 0, 0xFFFFFFFF, 0x00020000);
    const __amdgpu_buffer_rsrc_t rsB = __builtin_amdgcn_make_buffer_rsrc((void*)P.Bt, 0, 0xFFFFFFFF, 0x00020000);
#define PG8_SA(b, h) (((b) * 2 + (h)) * HTB)
#define PG8_SB(b, h) ((4 + (b) * 2 + (h)) * HTB)
#define PG8_STAGE_B(bufoff, sB) do { _Pragma("unroll") for (int _i = 0; _i < 2; ++_i) \
        __builtin_amdgcn_raw_ptr_buffer_load_lds(rsB, (LAS void*)(lds + (bufoff) + ldsw + _i * 8192), 16, (int)voffB[_i], (int)(sB), 0, 0); } while (0)
#define PG8_STAGE_A(bufoff, kb, o) do { _Pragma("unroll") for (int _i = 0; _i < 2; ++_i) \
        __builtin_amdgcn_raw_ptr_buffer_load_lds(rsA, (LAS void*)(lds + (bufoff) + ldsw + _i * 8192), 16, (int)(o)[_i], (int)(kb), 0, 0); } while (0)
#define PG8_LD2(p_) PG8_CAT(*(const LAS i32x4*)(p_), *(const LAS i32x4*)((p_) + 1024))
#define PG8_LDA(dst, b, h) do { if constexpr (F8) { _Pragma("unroll") for (int m = 0; m < 4; ++m) dst##8[m] = PG8_LD2(lds + PG8_SA(b, h) + aoff + m * 2048); } \
        else { _Pragma("unroll") for (int m = 0; m < 4; ++m) _Pragma("unroll") for (int k = 0; k < 2; ++k) dst[m][k] = *(const LAS bf16x8*)(lds + PG8_SA(b, h) + aoff + m * 2048 + k * 1024); } } while (0)
#define PG8_LDB(dst, b, h) do { if constexpr (F8) { _Pragma("unroll") for (int n = 0; n < 2; ++n) dst##8[n] = PG8_LD2(lds + PG8_SB(b, h) + boff + n * 2048); } \
        else { _Pragma("unroll") for (int n = 0; n < 2; ++n) _Pragma("unroll") for (int k = 0; k < 2; ++k) dst[n][k] = *(const LAS bf16x8*)(lds + PG8_SB(b, h) + boff + n * 2048 + k * 1024); } } while (0)
#define PG8_CAT(x0, x1) __builtin_shufflevector((x0), (x1), 0, 1, 2, 3, 4, 5, 6, 7)
#define PG8_MMA(ai, bj, At, Bt) do { __builtin_amdgcn_s_setprio(1); \
        if constexpr (F8) { _Pragma("unroll") for (int m = 0; m < 4; ++m) _Pragma("unroll") for (int n = 0; n < 2; ++n) \
            acc[ai][bj][m][n] = __builtin_amdgcn_mfma_scale_f32_16x16x128_f8f6f4(Bt##8[n], At##8[m], acc[ai][bj][m][n], 0, 0, 0, 0, 0, 0); } \
        else { _Pragma("unroll") for (int m = 0; m < 4; ++m) _Pragma("unroll") for (int n = 0; n < 2; ++n) _Pragma("unroll") for (int k = 0; k < 2; ++k) \
            acc[ai][bj][m][n] = __builtin_amdgcn_mfma_f32_16x16x32_bf16(Bt[n][k], At[m][k], acc[ai][bj][m][n], 0, 0, 0); } \
        __builtin_amdgcn_s_setprio(0); } while (0)
#define PG8_WAIT_V(n) asm volatile("s_waitcnt vmcnt(" #n ")" ::: "memory")
#define PG8_WAIT_L(n) asm volatile("s_waitcnt lgkmcnt(" #n ")" ::: "memory")
#define PG8_BAR __builtin_amdgcn_s_barrier()
#define PG8_SCHED __builtin_amdgcn_sched_barrier(0)
    Unit cur, nxt; int ui = 0;
    if (!S.next(0, cur)) return;
    cur.idx = 0;
    f32x4 acc[2][2][4][2];
#pragma unroll
    for (int a = 0; a < 2; ++a)
#pragma unroll
        for (int b = 0; b < 2; ++b)
#pragma unroll
            for (int m = 0; m < 4; ++m)
#pragma unroll
                for (int n = 0; n < 2; ++n) acc[a][b][m][n] = (f32x4){0.f, 0.f, 0.f, 0.f};
    bf16x8 At[4][2], B0[2][2], B1[2][2]; i32x8 At8[4], B08[2], B18[2];
    unsigned ca0[2], ca1[2];
    P.a_offs(0, cur, Rr, Cc, ca0, ca1);
    unsigned cB = P.b_off(cur);
    PG8_STAGE_B(PG8_SB(0, 0), cB); PG8_STAGE_B(PG8_SB(0, 1), cB + hstep); PG8_STAGE_A(PG8_SA(0, 0), 0, ca0); PG8_STAGE_A(PG8_SA(0, 1), 0, ca1);
    if (wr == 1) PG8_BAR;
    PG8_WAIT_V(2); PG8_BAR;
    PG8_STAGE_B(PG8_SB(1, 0), cB + kstep); PG8_STAGE_A(PG8_SA(1, 0), kstep, ca0); PG8_STAGE_B(PG8_SB(1, 1), cB + hstep + kstep);
    PG8_WAIT_V(6); PG8_BAR;
    for (;;) {
        const bool has_next = S.next(ui + 1, nxt); nxt.idx = ui + 1;
        unsigned nB = cB;
        if (has_next) nB = P.b_off(nxt);
#pragma unroll 1
        for (int t = 0; t < nt; t += 2) {
            const bool last = (t == nt - 2);
            const unsigned k1 = (unsigned)(t + 1) * kstep;
            const unsigned k2 = last ? 0u : (unsigned)(t + 2) * kstep, k3 = k2 + kstep;
            const unsigned b2 = last ? nB : cB + (unsigned)(t + 2) * kstep; const unsigned b3 = b2 + kstep;
            PG8_LDB(B0, 0, 0); PG8_LDB(B1, 0, 1); PG8_SCHED; PG8_LDA(At, 0, 0); PG8_STAGE_A(PG8_SA(1, 1), k1, ca1);
            if (last && has_next) {
                int tq = threadIdx.x; asm volatile("" : "+v"(tq)); int R2[2], C2[2];
#pragma unroll
                for (int i = 0; i < 2; ++i) stage_rc(tq * 16 + i * 8192, R2[i], C2[i]);
                P.a_offs(ui + 1, nxt, R2, C2, ca0, ca1);
            }
            PG8_WAIT_V(8); PG8_WAIT_L(0); PG8_BAR; PG8_MMA(0, 0, At, B0); PG8_MMA(0, 1, At, B1); PG8_BAR; PG8_SCHED;
            PG8_LDA(At, 0, 1); PG8_STAGE_B(PG8_SB(0, 0), b2); PG8_STAGE_B(PG8_SB(0, 1), b2 + hstep); PG8_STAGE_A(PG8_SA(0, 0), k2, ca0);
            PG8_WAIT_V(8); PG8_WAIT_L(0); PG8_BAR; PG8_MMA(1, 0, At, B0); PG8_MMA(1, 1, At, B1); PG8_BAR; PG8_SCHED;
            PG8_LDB(B0, 1, 0); PG8_LDB(B1, 1, 1); PG8_SCHED; PG8_LDA(At, 1, 0); PG8_STAGE_A(PG8_SA(0, 1), k2, ca1);
            PG8_WAIT_V(8); PG8_WAIT_L(0); PG8_BAR; PG8_MMA(0, 0, At, B0); PG8_MMA(0, 1, At, B1); PG8_BAR; PG8_SCHED;
            PG8_LDA(At, 1, 1); PG8_STAGE_B(PG8_SB(1, 0), b3); PG8_STAGE_B(PG8_SB(1, 1), b3 + hstep); PG8_STAGE_A(PG8_SA(1, 0), k3, ca0);
            PG8_WAIT_V(8); PG8_WAIT_L(0); PG8_BAR; PG8_MMA(1, 0, At, B0); PG8_MMA(1, 1, At, B1); PG8_BAR; PG8_SCHED;
        }
        if constexpr (ALIGN_EPI) { if (wr == 0) PG8_BAR; }
        { int te = threadIdx.x; asm volatile("" : "+v"(te));
          E(acc, cur, wr, wc, te & 15, (te >> 4) & 3); }
        if (!has_next) break;
#pragma unroll
        for (int a = 0; a < 2; ++a)
#pragma unroll
            for (int b = 0; b < 2; ++b)
#pragma unroll
                for (int m = 0; m < 4; ++m)
#pragma unroll
                    for (int n = 0; n < 2; ++n) acc[a][b][m][n] = (f32x4){0.f, 0.f, 0.f, 0.f};
        cur = nxt; cB = nB; ++ui;
        if constexpr (ALIGN_EPI) { if (wr == 1) PG8_BAR; }
    }
    PG8_WAIT_V(0);
    if constexpr (!ALIGN_EPI) { if (wr == 0) PG8_BAR; }
    PG8_BAR;
#undef PG8_SA
#undef PG8_SB
#undef PG8_STAGE_A
#undef PG8_STAGE_B
#undef PG8_LDA
#undef PG8_LD2
#undef PG8_LDB
#undef PG8_MMA
#undef PG8_CAT
#undef PG8_WAIT_V
#undef PG8_WAIT_L
#undef PG8_BAR
#undef PG8_SCHED
}

template <bool F8_>
struct DenseProbT {
    static constexpr bool F8 = F8_;
    const void* A; const void* Bt; int K, lda, acolstep; size_t bstep_pn;
    __device__ __forceinline__ void a_offs(int, const Unit& u, const int (&R)[2], const int (&C)[2], unsigned (&o0)[2], unsigned (&o1)[2]) const {
        constexpr int esz = F8 ? 1 : 2;
#pragma unroll
        for (int i = 0; i < 2; ++i) { const unsigned b = (unsigned)(((u.pm * BM + R[i]) * lda + u.pn * acolstep) * esz + C[i] * 2); o0[i] = b; o1[i] = b + (unsigned)(HALF * lda * esz); }
    }
    __device__ __forceinline__ unsigned b_off(const Unit& u) const { return (unsigned)((size_t)u.pn * bstep_pn * (F8 ? 1 : 2)); }
};
typedef DenseProbT<false> DenseProb;
}

struct Params {
    const float* x; const int* positions; const float* norm_mix; const float* norm_ffn; const float* norm_final;
    const float* attn_w_in; const float* attn_w_out; const float* pool_w_in; const float* pool_w_group; const float* pool_scale; const float* pool_w_out;
    const float* router_group_w; const float* router_group_b; const float* router_expert_w; const float* router_expert_b;
    const float* expert_w1; const float* expert_w3; const float* expert_w2;
    float* out; unsigned char* ws;
    int ph_lo, ph_hi;
};

template <class MapN>
__device__ __forceinline__ void transpose_item(const float* W, int ldw, int K, bf16* WT, MapN mapn, LAS float* scr, int k0, int n0, int lane) {
#pragma unroll 8
    for (int i = 0; i < 32; ++i) { const int kk = 2 * i + (lane >> 5); scr[kk * 33 + (lane & 31)] = W[(size_t)(k0 + kk) * ldw + n0 + (lane & 31)]; }
    asm volatile("s_waitcnt lgkmcnt(0)" ::: "memory");
    const int c = lane & 7;
#pragma unroll
    for (int j = 0; j < 4; ++j) { const int n = (lane >> 3) + 8 * j; const LAS float* s = scr + (8 * c) * 33 + n;
        u32x4 o; o.x = cvtpk(s[0 * 33], s[1 * 33]); o.y = cvtpk(s[2 * 33], s[3 * 33]); o.z = cvtpk(s[4 * 33], s[5 * 33]); o.w = cvtpk(s[6 * 33], s[7 * 33]);
        *(u32x4*)(WT + (size_t)mapn(n0 + n) * K + k0 + 8 * c) = o; }
    asm volatile("s_waitcnt lgkmcnt(0)" ::: "memory");
}
template <class MapN>
__device__ __forceinline__ void transpose_item8(const float* W, int ldw, int K, unsigned char* WT, MapN mapn, float sc, LAS float* scr, int k0, int n0, int lane) {
#pragma unroll 8
    for (int i = 0; i < 32; ++i) { const int kk = 2 * i + (lane >> 5); scr[kk * 33 + (lane & 31)] = W[(size_t)(k0 + kk) * ldw + n0 + (lane & 31)]; }
    asm volatile("s_waitcnt lgkmcnt(0)" ::: "memory");
    const int c = lane & 7;
#pragma unroll
    for (int j = 0; j < 4; ++j) { const int n = (lane >> 3) + 8 * j; const LAS float* s = scr + (8 * c) * 33 + n;
        u32x2 o; o.x = pack_fp8x4(s[0 * 33] * sc, s[1 * 33] * sc, s[2 * 33] * sc, s[3 * 33] * sc); o.y = pack_fp8x4(s[4 * 33] * sc, s[5 * 33] * sc, s[6 * 33] * sc, s[7 * 33] * sc);
        *(u32x2*)(WT + (size_t)mapn(n0 + n) * K + k0 + 8 * c) = o; }
    asm volatile("s_waitcnt lgkmcnt(0)" ::: "memory");
}
struct MapId { __device__ __forceinline__ int operator()(int n) const { return n; } };
struct MapQKV {
    __device__ __forceinline__ int operator()(int n) const { const int rem = n % 1536, kind = rem / 512, d = n & 63; if (kind < 2 && d < 16) return n - d + (d < 8 ? 2 * d : 2 * (d - 8) + 1); return n; }
};
struct MapW13 { int add; __device__ __forceinline__ int operator()(int n) const { return (n >> 7) * 256 + add + (n & 127); } };

struct RowPassCfg {
    const float* hin;
    const bf16* hin16;
    const bf16* ys; const int* slotref; const int* cnt_prev;
    bf16* hout;
    const float* gain;
    bf16* yout;
    unsigned char* yout8;
    float* fout;
    const float* rgw; const float* rgb; const float* rew; const float* reb;
    int* cnt; int* list; float* gatel; int* slotref_out;
};

__device__ __forceinline__ void route_decide(const float (&a)[20], const float* rgb, const float* reb, int& e0, int& e1, float& g0, float& g1) {
    float lg[4];
#pragma unroll
    for (int g = 0; g < 4; ++g) lg[g] = a[g] + rgb[g];
    int gs = 0; float gm = lg[0];
#pragma unroll
    for (int g = 1; g < 4; ++g) if (lg[g] > gm) { gm = lg[g]; gs = g; }
    float den = 0.f;
#pragma unroll
    for (int g = 0; g < 4; ++g) den += __expf(lg[g] - gm);
    const float gate1 = 1.0f / den;
    float le[4];
#pragma unroll
    for (int e = 0; e < 4; ++e) { const float sel = gs == 0 ? a[4 + e] : gs == 1 ? a[8 + e] : gs == 2 ? a[12 + e] : a[16 + e]; le[e] = sel + reb[gs * 4 + e]; }
    int i0 = 0; float v0 = le[0];
#pragma unroll
    for (int e = 1; e < 4; ++e) if (le[e] > v0) { v0 = le[e]; i0 = e; }
    int i1 = -1; float v1 = -INFINITY;
#pragma unroll
    for (int e = 0; e < 4; ++e) if (e != i0 && le[e] > v1) { v1 = le[e]; i1 = e; }
    const float ex = __expf(v1 - v0), p0 = 1.0f / (1.0f + ex), p1 = ex * p0;
    e0 = gs * 4 + i0; e1 = gs * 4 + i1; g0 = gate1 * p0; g1 = gate1 * p1;
}

template <bool COMBINE, bool ROUTER, bool HIN16>
__device__ __forceinline__ void row_pass(LAS unsigned char* lds, const RowPassCfg& c, int vcu, int wave) {
    int tid = threadIdx.x; asm volatile("" : "+v"(tid)); const int lane = tid & 63;
    LAS float* Wr = (LAS float*)lds;
    LAS int* selE = (LAS int*)(lds + 81920);
    LAS float* selG = (LAS float*)(lds + 81920 + 1024);
    LAS int* wcnt = (LAS int*)(lds + 81920 + 2048);
    LAS int* tb = (LAS int*)(lds + MISC_OFF);
    if (ROUTER) {
        for (int k = tid; k < 1024; k += NTHREADS) {
            const f32x4 g4 = *(const f32x4*)(c.rgw + (size_t)k * 4);
            Wr[0 * 1024 + k] = g4.x; Wr[1 * 1024 + k] = g4.y; Wr[2 * 1024 + k] = g4.z; Wr[3 * 1024 + k] = g4.w;
#pragma unroll
            for (int g = 0; g < 4; ++g) { const f32x4 e4 = *(const f32x4*)(c.rew + ((size_t)g * 1024 + k) * 4);
                Wr[(4 + g * 4 + 0) * 1024 + k] = e4.x; Wr[(4 + g * 4 + 1) * 1024 + k] = e4.y; Wr[(4 + g * 4 + 2) * 1024 + k] = e4.z; Wr[(4 + g * 4 + 3) * 1024 + k] = e4.w; }
        }
    }
    if (COMBINE) {
        if (tid == 0) { int sacc = 0; for (int e = 0; e < NE; ++e) { tb[e] = sacc; sacc += (c.cnt_prev[e] + 255) >> 8; } tb[NE] = sacc; }
    }
    __syncthreads();
    f32x4 gn[4];
#pragma unroll
    for (int j = 0; j < 4; ++j) gn[j] = *(const f32x4*)(c.gain + 4 * lane + 256 * j);
    for (int rb = vcu; rb < T / 128; rb += gridDim.x) {
        const int rbase = rb * 128 + wave * 16;
        int refs = 0;
        if (COMBINE) { if (lane < 32) refs = c.slotref[rbase * 2 + lane]; }
        f32x4 hv[2][2][4]; u32x2 hb[2][2][4]; u32x2 yv[2][2][2][4];
#define RP_ISSUE(buf, pr) do { _Pragma("unroll") for (int r = 0; r < 2; ++r) { const int row = rbase + 2 * (pr) + r; \
            if (HIN16) { _Pragma("unroll") for (int j = 0; j < 4; ++j) hb[buf][r][j] = *(const u32x2*)(c.hin16 + (size_t)row * D + 4 * lane + 256 * j); } \
            else { _Pragma("unroll") for (int j = 0; j < 4; ++j) hv[buf][r][j] = *(const f32x4*)(c.hin + (size_t)row * D + 4 * lane + 256 * j); } \
            if (COMBINE) { _Pragma("unroll") for (int sl = 0; sl < 2; ++sl) { const int ref = __builtin_amdgcn_readlane(refs, (2 * (pr) + r) * 2 + sl); const int e = ref >> 15, pos = ref & 32767; \
                if (FP8_YS) { const unsigned char* yr = (const unsigned char*)c.ys + ((size_t)tb[e] * 256 + pos) * D; \
                    _Pragma("unroll") for (int j = 0; j < 4; ++j) yv[buf][r][sl][j].x = *(const unsigned*)(yr + 4 * lane + 256 * j); } \
                else { const bf16* yr = c.ys + ((size_t)tb[e] * 256 + pos) * D; \
                    _Pragma("unroll") for (int j = 0; j < 4; ++j) yv[buf][r][sl][j] = *(const u32x2*)(yr + 4 * lane + 256 * j); } } } } } while (0)
#define RP_PROCESS(buf, pr) do { f32x4 v[2][4]; \
            _Pragma("unroll") for (int r = 0; r < 2; ++r) { const int row = rbase + 2 * (pr) + r; \
                _Pragma("unroll") for (int j = 0; j < 4; ++j) { if (HIN16) { const u32x2 w0 = hb[buf][r][j]; v[r][j] = (f32x4){bf_lo(w0.x), bf_hi(w0.x), bf_lo(w0.y), bf_hi(w0.y)}; } else v[r][j] = hv[buf][r][j]; \
                    if (COMBINE) { _Pragma("unroll") for (int sl = 0; sl < 2; ++sl) { const u32x2 w = yv[buf][r][sl][j]; \
                        if (FP8_YS) { const f32x2 lo2 = __builtin_amdgcn_cvt_pk_f32_fp8((int)w.x, false), hi2 = __builtin_amdgcn_cvt_pk_f32_fp8((int)w.x, true); \
                            v[r][j].x += lo2.x * (1.0f / 64.0f); v[r][j].y += lo2.y * (1.0f / 64.0f); v[r][j].z += hi2.x * (1.0f / 64.0f); v[r][j].w += hi2.y * (1.0f / 64.0f); } \
                        else { v[r][j].x += bf_lo(w.x); v[r][j].y += bf_hi(w.x); v[r][j].z += bf_lo(w.y); v[r][j].w += bf_hi(w.y); } } } } \
                if (c.hout) { _Pragma("unroll") for (int j = 0; j < 4; ++j) { u32x2 w; w.x = cvtpk(v[r][j].x, v[r][j].y); w.y = cvtpk(v[r][j].z, v[r][j].w); *(u32x2*)(c.hout + (size_t)row * D + 4 * lane + 256 * j) = w; \
                    v[r][j] = (f32x4){bf_lo(w.x), bf_hi(w.x), bf_lo(w.y), bf_hi(w.y)}; } } \
                float ss = 0.f; \
                _Pragma("unroll") for (int j = 0; j < 4; ++j) ss += (v[r][j].x * v[r][j].x + v[r][j].y * v[r][j].y) + (v[r][j].z * v[r][j].z + v[r][j].w * v[r][j].w); \
                const float rstd = 1.0f / sqrtf(wave_sum(ss) * (1.0f / D) + RMS_EPS); \
                _Pragma("unroll") for (int j = 0; j < 4; ++j) { v[r][j].x = v[r][j].x * rstd * gn[j].x; v[r][j].y = v[r][j].y * rstd * gn[j].y; v[r][j].z = v[r][j].z * rstd * gn[j].z; v[r][j].w = v[r][j].w * rstd * gn[j].w; } \
                if (c.yout) { _Pragma("unroll") for (int j = 0; j < 4; ++j) { u32x2 w; w.x = cvtpk(v[r][j].x, v[r][j].y); w.y = cvtpk(v[r][j].z, v[r][j].w); *(u32x2*)(c.yout + (size_t)row * D + 4 * lane + 256 * j) = w; } } \
                if (c.yout8) { _Pragma("unroll") for (int j = 0; j < 4; ++j) *(unsigned*)(c.yout8 + (size_t)row * D + 4 * lane + 256 * j) = pack_fp8x4(v[r][j].x, v[r][j].y, v[r][j].z, v[r][j].w); } \
                if (c.fout) { _Pragma("unroll") for (int j = 0; j < 4; ++j) *(f32x4*)(c.fout + (size_t)row * D + 4 * lane + 256 * j) = v[r][j]; } } \
            if (ROUTER) { float a0[20], a1[20]; f32x2 vv[4][4];        \
                _Pragma("unroll") for (int j = 0; j < 4; ++j) { vv[j][0] = (f32x2){v[0][j].x, v[1][j].x}; vv[j][1] = (f32x2){v[0][j].y, v[1][j].y}; vv[j][2] = (f32x2){v[0][j].z, v[1][j].z}; vv[j][3] = (f32x2){v[0][j].w, v[1][j].w}; } \
                _Pragma("unroll") for (int o = 0; o < 20; ++o) { f32x2 s2 = {0.f, 0.f}; \
                    _Pragma("unroll") for (int j = 0; j < 4; ++j) { const f32x4 w = *(const LAS f32x4*)(Wr + o * 1024 + 4 * lane + 256 * j); \
                        s2 = __builtin_elementwise_fma(vv[j][0], (f32x2){w.x, w.x}, s2); s2 = __builtin_elementwise_fma(vv[j][1], (f32x2){w.y, w.y}, s2); \
                        s2 = __builtin_elementwise_fma(vv[j][2], (f32x2){w.z, w.z}, s2); s2 = __builtin_elementwise_fma(vv[j][3], (f32x2){w.w, w.w}, s2); } \
                    a0[o] = s2.x; a1[o] = s2.y; if ((o & 3) == 3) __builtin_amdgcn_sched_barrier(0); } \
                _Pragma("unroll") for (int o = 0; o < 20; ++o) { a0[o] = DPP_ADD(a0[o], 0xB1); a1[o] = DPP_ADD(a1[o], 0xB1); } \
                _Pragma("unroll") for (int o = 0; o < 20; ++o) { a0[o] = DPP_ADD(a0[o], 0x4E); a1[o] = DPP_ADD(a1[o], 0x4E); } \
                _Pragma("unroll") for (int o = 0; o < 20; ++o) { a0[o] = DPP_ADD(a0[o], 0x141); a1[o] = DPP_ADD(a1[o], 0x141); } \
                _Pragma("unroll") for (int o = 0; o < 20; ++o) { a0[o] = DPP_ADD(a0[o], 0x140); a1[o] = DPP_ADD(a1[o], 0x140); } \
                _Pragma("unroll") for (int o = 0; o < 20; ++o) { a0[o] = rows_sum(a0[o]); a1[o] = rows_sum(a1[o]); if (o & 1) __builtin_amdgcn_sched_barrier(0); } \
                int e0, e1; float g0, g1; const int rl = wave * 16 + 2 * (pr); \
                route_decide(a0, c.rgb, c.reb, e0, e1, g0, g1); if (lane == 0) { selE[rl * 2] = e0; selE[rl * 2 + 1] = e1; selG[rl * 2] = g0; selG[rl * 2 + 1] = g1; } \
                route_decide(a1, c.rgb, c.reb, e0, e1, g0, g1); if (lane == 0) { selE[rl * 2 + 2] = e0; selE[rl * 2 + 3] = e1; selG[rl * 2 + 2] = g0; selG[rl * 2 + 3] = g1; } } } while (0)
        RP_ISSUE(0, 0);
#pragma unroll 1
        for (int it = 0; it < 4; ++it) {
            RP_ISSUE(1, 2 * it + 1);
            RP_PROCESS(0, 2 * it);
            if (it < 3) RP_ISSUE(0, 2 * it + 2);
            RP_PROCESS(1, 2 * it + 1);
        }
#undef RP_ISSUE
#undef RP_PROCESS
        if (ROUTER) {
            __syncthreads();
            int e = 0, rank = 0;
            if (tid < 256) {
                e = selE[tid]; int mycount = 0;
#pragma unroll
                for (int x = 0; x < NE; ++x) { const unsigned long long mask = __ballot(e == x); if (e == x) rank = __popcll(mask & ((1ull << lane) - 1ull)); if (lane == x) mycount = __popcll(mask); }
                if (lane < NE) wcnt[(tid >> 6) * 16 + lane] = mycount;
            }
            __syncthreads();
            if (tid < NE) { const int c0 = wcnt[tid], c1 = wcnt[16 + tid], c2 = wcnt[32 + tid], c3 = wcnt[48 + tid]; const int tot = c0 + c1 + c2 + c3;
                int base = 0; if (tot) base = atomicAdd(c.cnt + tid, tot);
                wcnt[tid] = base; wcnt[16 + tid] = base + c0; wcnt[32 + tid] = base + c0 + c1; wcnt[48 + tid] = base + c0 + c1 + c2; }
            __syncthreads();
            if (tid < 256) { const int pos = wcnt[(tid >> 6) * 16 + e] + rank; const int tok = rb * 128 + (tid >> 1);
                c.list[e * T + pos] = tok; c.gatel[e * T + pos] = selG[tid]; c.slotref_out[tok * 2 + (tid & 1)] = e * 32768 + pos; }
            __syncthreads();
        }
    }
    __syncthreads();
}

constexpr int RW_STRIDE = 2064;
__device__ __forceinline__ void router_pass(LAS unsigned char* lds, const RowPassCfg& c, int vcu, int wave) {
    int tid = threadIdx.x; asm volatile("" : "+v"(tid)); const int lane = tid & 63, r16 = lane & 15, kg = lane >> 4;
    LAS unsigned char* Wh = lds;
    LAS unsigned char* Wl = lds + 20 * RW_STRIDE;
    LAS float* gl = (LAS float*)(lds + 40 * RW_STRIDE);
    LAS int* selE = (LAS int*)(lds + 86656);
    LAS float* selG = (LAS float*)(lds + 86656 + 1024);
    LAS int* wcnt = (LAS int*)(lds + 86656 + 2048);
    LAS float* tr = (LAS float*)(lds + 90112) + wave * 512;
    for (int kp = tid; kp < 512; kp += NTHREADS) {
        const int k = 2 * kp;
#pragma unroll 1
        for (int v5 = 0; v5 < 5; ++v5) {
            const float* src = (v5 == 0) ? (c.rgw + (size_t)k * 4) : (c.rew + ((size_t)(v5 - 1) * 1024 + k) * 4);
            const f32x4 a = *(const f32x4*)src, b = *(const f32x4*)(src + 4);
#pragma unroll
            for (int q = 0; q < 4; ++q) { const int o = v5 * 4 + q; const unsigned hi = cvtpk(a[q], b[q]); const unsigned lo = cvtpk(a[q] - bf_lo(hi), b[q] - bf_hi(hi));
                *(LAS unsigned*)(Wh + o * RW_STRIDE + k * 2) = hi; *(LAS unsigned*)(Wl + o * RW_STRIDE + k * 2) = lo; }
        }
    }
    for (int k = tid; k < 1024; k += NTHREADS) gl[k] = c.gain[k];
    __syncthreads();
    typedef unsigned u32x2v __attribute__((ext_vector_type(2)));
    const __amdgpu_buffer_rsrc_t rsH = __builtin_amdgcn_make_buffer_rsrc((void*)c.hin16, 0, 0xFFFFFFFF, 0x00020000);
    const __amdgpu_buffer_rsrc_t rsY = __builtin_amdgcn_make_buffer_rsrc((void*)c.yout8, 0, 0xFFFFFFFF, 0x00020000);
    const int oc0 = r16, oc1 = (16 + r16) < 20 ? (16 + r16) : 19;
    for (int rb = vcu; rb < T / 128; rb += gridDim.x) {
        const int row = rb * 128 + wave * 16 + r16;
        u32x4 hreg[32];
        const unsigned voff = (unsigned)row * (unsigned)(D * 2) + (unsigned)kg * 16u;
#pragma unroll
        for (int s_ = 0; s_ < 32; ++s_) hreg[s_] = __builtin_bit_cast(u32x4, __builtin_amdgcn_raw_buffer_load_b128(rsH, (int)voff + s_ * 64, 0, 0));
        const unsigned yoff = (unsigned)row * (unsigned)D + (unsigned)kg * 8u;
        float ss = 0.f;
#pragma unroll
        for (int s_ = 0; s_ < 32; ++s_)
#pragma unroll
            for (int q = 0; q < 4; ++q) { unsigned hw = hreg[s_][q]; asm volatile("" : "+v"(hw));
                const float a = bf_lo(hw), b = bf_hi(hw); ss = __builtin_fmaf(a, a, ss); ss = __builtin_fmaf(b, b, ss); }
        const float rstd = 1.0f / sqrtf(rows_sum(ss) * (1.0f / D) + RMS_EPS);
        f32x4 acc0 = {0.f, 0.f, 0.f, 0.f}, acc1 = {0.f, 0.f, 0.f, 0.f};
#pragma unroll
        for (int s_ = 0; s_ < 32; ++s_) {
            const int kb = 32 * s_ + 8 * kg;
            const f32x4 g0 = *(const LAS f32x4*)(gl + kb), g1 = *(const LAS f32x4*)(gl + kb + 4);
            float y[8];
            y[0] = bf_lo(hreg[s_][0]) * rstd * g0.x; y[1] = bf_hi(hreg[s_][0]) * rstd * g0.y; y[2] = bf_lo(hreg[s_][1]) * rstd * g0.z; y[3] = bf_hi(hreg[s_][1]) * rstd * g0.w;
            y[4] = bf_lo(hreg[s_][2]) * rstd * g1.x; y[5] = bf_hi(hreg[s_][2]) * rstd * g1.y; y[6] = bf_lo(hreg[s_][3]) * rstd * g1.z; y[7] = bf_hi(hreg[s_][3]) * rstd * g1.w;
            u32x4 yh, yl;
#pragma unroll
            for (int q = 0; q < 4; ++q) { yh[q] = cvtpk(y[2 * q], y[2 * q + 1]); yl[q] = cvtpk(y[2 * q] - bf_lo(yh[q]), y[2 * q + 1] - bf_hi(yh[q])); }
            { u32x2 w8; w8.x = pack_fp8x4(y[0], y[1], y[2], y[3]); w8.y = pack_fp8x4(y[4], y[5], y[6], y[7]); __builtin_amdgcn_raw_buffer_store_b64(__builtin_bit_cast(u32x2v, w8), rsY, (int)yoff + s_ * 32, 0, 0); }
            const bf16x8 bh0 = *(const LAS bf16x8*)(Wh + oc0 * RW_STRIDE + kb * 2), bh1 = *(const LAS bf16x8*)(Wh + oc1 * RW_STRIDE + kb * 2);
            const bf16x8 bl0 = *(const LAS bf16x8*)(Wl + oc0 * RW_STRIDE + kb * 2), bl1 = *(const LAS bf16x8*)(Wl + oc1 * RW_STRIDE + kb * 2);
            const bf16x8 ah = __builtin_bit_cast(bf16x8, yh), al = __builtin_bit_cast(bf16x8, yl);
            acc0 = __builtin_amdgcn_mfma_f32_16x16x32_bf16(ah, bh0, acc0, 0, 0, 0); acc1 = __builtin_amdgcn_mfma_f32_16x16x32_bf16(ah, bh1, acc1, 0, 0, 0);
            acc0 = __builtin_amdgcn_mfma_f32_16x16x32_bf16(al, bh0, acc0, 0, 0, 0); acc1 = __builtin_amdgcn_mfma_f32_16x16x32_bf16(al, bh1, acc1, 0, 0, 0);
            acc0 = __builtin_amdgcn_mfma_f32_16x16x32_bf16(ah, bl0, acc0, 0, 0, 0); acc1 = __builtin_amdgcn_mfma_f32_16x16x32_bf16(ah, bl1, acc1, 0, 0, 0);
            __builtin_amdgcn_sched_barrier(0);
        }
#pragma unroll
        for (int e = 0; e < 4; ++e) { tr[(4 * kg + e) * 32 + r16] = acc0[e]; tr[(4 * kg + e) * 32 + 16 + r16] = acc1[e]; }
        asm volatile("s_waitcnt lgkmcnt(0)" ::: "memory");
        if (lane < 16) {
            float a[20];
#pragma unroll
            for (int o = 0; o < 20; ++o) a[o] = tr[lane * 32 + o];
            int e0, e1; float g0_, g1_; route_decide(a, c.rgb, c.reb, e0, e1, g0_, g1_);
            const int rl = wave * 16 + lane;
            selE[rl * 2] = e0; selE[rl * 2 + 1] = e1; selG[rl * 2] = g0_; selG[rl * 2 + 1] = g1_;
        }
        __syncthreads();
        int e = 0, rank = 0;
        if (tid < 256) {
            e = selE[tid]; int mycount = 0;
#pragma unroll
            for (int x = 0; x < NE; ++x) { const unsigned long long mask = __ballot(e == x); if (e == x) rank = __popcll(mask & ((1ull << lane) - 1ull)); if (lane == x) mycount = __popcll(mask); }
            if (lane < NE) wcnt[(tid >> 6) * 16 + lane] = mycount;
        }
        __syncthreads();
        if (tid < NE) { const int c0 = wcnt[tid], c1 = wcnt[16 + tid], c2 = wcnt[32 + tid], c3 = wcnt[48 + tid]; const int tot = c0 + c1 + c2 + c3;
            int base = 0; if (tot) base = atomicAdd(c.cnt + tid, tot);
            wcnt[tid] = base; wcnt[16 + tid] = base + c0; wcnt[32 + tid] = base + c0 + c1; wcnt[48 + tid] = base + c0 + c1 + c2; }
        __syncthreads();
        if (tid < 256) { const int pos = wcnt[(tid >> 6) * 16 + e] + rank; const int tok = rb * 128 + (tid >> 1);
            c.list[e * T + pos] = tok; c.gatel[e * T + pos] = selG[tid]; c.slotref_out[tok * 2 + (tid & 1)] = e * 32768 + pos; }
        __syncthreads();
    }
    __syncthreads();
}

namespace att {
constexpr float C2 = 0.125f * 1.4426950408889634f;
constexpr float LN2 = 0.6931471805599453f;
__device__ __forceinline__ int crow(int r, int hi) { return (r & 3) + 8 * (r >> 2) + 4 * hi; }
typedef short v4i16_t __attribute__((ext_vector_type(4)));
__device__ __forceinline__ s16x4 vtr(const LAS unsigned char* p) { return __builtin_bit_cast(s16x4, __builtin_amdgcn_ds_read_tr16_b64_v4i16((LAS v4i16_t*)p)); }

struct Item { int b, g, hh, dil, j, ph; };
__device__ __forceinline__ Item decode_item(int pp, int half) {
    Item it; it.hh = pp & 7; const int q8 = (pp >> 3) & 7; it.g = (pp >> 6) % 3; it.b = pp / 192;
    const int idx16 = q8 * 2 + half; it.dil = it.g == 0 ? 1 : (it.g == 1 ? 4 : 16); const int nb = 16 / it.dil; it.j = idx16 % nb; it.ph = idx16 / nb; return it;
}
__device__ __forceinline__ int kswz(int kv) { return (kv ^ (kv >> 3)) & 7; }
__device__ __forceinline__ u32x4 fp8x8_to_bf16(unsigned a, unsigned b) {
    const f32x2 a0 = __builtin_amdgcn_cvt_pk_f32_fp8((int)a, false), a1 = __builtin_amdgcn_cvt_pk_f32_fp8((int)a, true), b0 = __builtin_amdgcn_cvt_pk_f32_fp8((int)b, false), b1 = __builtin_amdgcn_cvt_pk_f32_fp8((int)b, true);
    return (u32x4){cvtpk(a0.x, a0.y), cvtpk(a1.x, a1.y), cvtpk(b0.x, b0.y), cvtpk(b1.x, b1.y)};
}

template <int MODE>
__device__ __forceinline__ void attn_phase(LAS unsigned char* lds, const bf16* qkv, bf16* og, float* lse, int vcu, int G) {
    int tid_ = threadIdx.x; asm volatile("" : "+v"(tid_));
    const int tid = tid_, lane = tid & 63, wid = __builtin_amdgcn_readfirstlane(tid >> 6);
    const int half = wid >> 2, w = wid & 3, r32 = lane & 31, hi = lane >> 5, th = tid & 255;
    LAS unsigned char* Kl = lds + half * 69632;
    LAS unsigned char* Vl = Kl + 36864;
    u32x4 kreg[4][2], vreg[4][2]; bf16x8 qbuf[2][4];
    u32x2 qraw[2][4];
    int skv[2], sc[2];
#pragma unroll
    for (int i = 0; i < 2; ++i) { const int P_ = th + 256 * i; skv[i] = P_ >> 3; sc[i] = P_ & 7; }
    const int skv8 = th >> 2, sc16 = th & 3;
    const __amdgpu_buffer_rsrc_t rsQ = __builtin_amdgcn_make_buffer_rsrc((void*)qkv, 0, 0xFFFFFFFF, 0x00020000);
    typedef unsigned u32x4v __attribute__((ext_vector_type(4)));
#if FP8_QKVS
#define ATT_ISSUE(IT, PAR) do { const unsigned rstrideB_ = (unsigned)(IT).dil * (unsigned)QKVW; \
        const unsigned baseB_ = (unsigned)(((IT).b * SEQ + (IT).ph) * QKVW + (IT).g * 1536 + (IT).hh * 64); const int l0_ = 128 * ((IT).j - 1); \
        const unsigned vo_ = (unsigned)skv8 * rstrideB_ + (unsigned)sc16 * 16u; \
        _Pragma("unroll") for (int tt = 0; tt < 4; ++tt) { if (tt >= 2 || (IT).j != 0) { const unsigned so_ = baseB_ + (unsigned)(l0_ + 64 * tt) * rstrideB_; \
            kreg[tt][0] = __builtin_bit_cast(u32x4, __builtin_amdgcn_raw_buffer_load_b128(rsQ, (int)vo_, (int)(so_ + 512u), 0)); vreg[tt][0] = __builtin_bit_cast(u32x4, __builtin_amdgcn_raw_buffer_load_b128(rsQ, (int)vo_, (int)(so_ + 1024u), 0)); } } \
        const unsigned qo_ = (unsigned)(32 * w + r32) * rstrideB_ + (unsigned)hi * 8u, qs_ = baseB_ + (unsigned)(128 * (IT).j) * rstrideB_; \
        _Pragma("unroll") for (int d0 = 0; d0 < 4; ++d0) qraw[PAR][d0] = __builtin_bit_cast(u32x2, __builtin_amdgcn_raw_buffer_load_b64(rsQ, (int)qo_, (int)(qs_ + (unsigned)d0 * 16u), 0)); } while (0)
#else
#define ATT_ISSUE(IT, PAR) do { const unsigned rstrideB_ = (unsigned)(IT).dil * (unsigned)(QKVW * 2); \
        const unsigned baseB_ = (unsigned)(((IT).b * SEQ + (IT).ph) * QKVW + (IT).g * 1536 + (IT).hh * 64) * 2u; const int l0_ = 128 * ((IT).j - 1); \
        const unsigned vo0_ = (unsigned)skv[0] * rstrideB_ + (unsigned)sc[0] * 16u, vo1_ = (unsigned)skv[1] * rstrideB_ + (unsigned)sc[1] * 16u; \
        _Pragma("unroll") for (int tt = 0; tt < 4; ++tt) { if (tt >= 2 || (IT).j != 0) { const unsigned so_ = baseB_ + (unsigned)(l0_ + 64 * tt) * rstrideB_; \
            kreg[tt][0] = __builtin_bit_cast(u32x4, __builtin_amdgcn_raw_buffer_load_b128(rsQ, (int)vo0_, (int)(so_ + 1024u), 0)); vreg[tt][0] = __builtin_bit_cast(u32x4, __builtin_amdgcn_raw_buffer_load_b128(rsQ, (int)vo0_, (int)(so_ + 2048u), 0)); \
            kreg[tt][1] = __builtin_bit_cast(u32x4, __builtin_amdgcn_raw_buffer_load_b128(rsQ, (int)vo1_, (int)(so_ + 1024u), 0)); vreg[tt][1] = __builtin_bit_cast(u32x4, __builtin_amdgcn_raw_buffer_load_b128(rsQ, (int)vo1_, (int)(so_ + 2048u), 0)); } } \
        const unsigned qo_ = (unsigned)(32 * w + r32) * rstrideB_ + (unsigned)hi * 16u, qs_ = baseB_ + (unsigned)(128 * (IT).j) * rstrideB_; \
        _Pragma("unroll") for (int d0 = 0; d0 < 4; ++d0) qbuf[PAR][d0] = __builtin_bit_cast(bf16x8, __builtin_amdgcn_raw_buffer_load_b128(rsQ, (int)qo_, (int)(qs_ + (unsigned)d0 * 32u), 0)); } while (0)
#endif
    int pp = vcu;
    Item cur = decode_item(pp < 3072 ? pp : 0, half);
    if (pp < 3072 && MODE != 2) ATT_ISSUE(cur, 0);
    const int koff = r32 * 144 + hi * 16;
    const int voff = ((lane >> 4) & 1) * 32 + (lane & 3) * 8 + (4 * hi + ((lane & 15) >> 2)) * 64;
    for (; pp < 3072; pp += 2 * G) {
#pragma unroll
    for (int par = 0; par < 2; ++par) {
        const int ppx = pp + par * G;
        if (ppx >= 3072) break;
        const int tt_lo = (cur.j == 0) ? 2 : 0;
#pragma unroll
        for (int tt = 0; tt < 4; ++tt) { if (MODE != 2 && (tt >= 2 || cur.j != 0)) {
            if (FP8_QKVS) {
                LAS unsigned char* kd = Kl + tt * 9216 + skv8 * 144 + sc16 * 32;
                *(LAS u32x4*)(kd) = fp8x8_to_bf16(kreg[tt][0].x, kreg[tt][0].y); *(LAS u32x4*)(kd + 16) = fp8x8_to_bf16(kreg[tt][0].z, kreg[tt][0].w);
                LAS unsigned char* vd = Vl + tt * 8192 + (sc16 >> 1) * 4096 + skv8 * 64 + (sc16 & 1) * 32;
                *(LAS u32x4*)(vd) = fp8x8_to_bf16(vreg[tt][0].x, vreg[tt][0].y); *(LAS u32x4*)(vd + 16) = fp8x8_to_bf16(vreg[tt][0].z, vreg[tt][0].w);
            } else {
#pragma unroll
            for (int i = 0; i < 2; ++i) {
                *(LAS u32x4*)(Kl + tt * 9216 + skv[i] * 144 + sc[i] * 16) = kreg[tt][i];
                *(LAS u32x4*)(Vl + tt * 8192 + (sc[i] >> 2) * 4096 + skv[i] * 64 + (sc[i] & 3) * 16) = vreg[tt][i]; } } } }
        bf16x8 qr[4];
        if (FP8_QKVS) {
            asm volatile("" : "+v"(qraw[par][0]), "+v"(qraw[par][1]), "+v"(qraw[par][2]), "+v"(qraw[par][3]));
#pragma unroll
            for (int d0 = 0; d0 < 4; ++d0) qr[d0] = __builtin_bit_cast(bf16x8, fp8x8_to_bf16(qraw[par][d0].x, qraw[par][d0].y));
        } else {
            asm volatile("" : "+v"(qbuf[par][0]), "+v"(qbuf[par][1]), "+v"(qbuf[par][2]), "+v"(qbuf[par][3]));
#pragma unroll
            for (int d0 = 0; d0 < 4; ++d0) qr[d0] = qbuf[par][d0];
        }
        __syncthreads();
        const Item me = cur;
        if (ppx + G < 3072) { cur = decode_item(ppx + G, half); if (MODE != 2) ATT_ISSUE(cur, par ^ 1); }
        if (MODE == 1) { __syncthreads(); continue; }
        float m = -1e30f, l = 0.f; f32x16 oT[2]; oT[0] = f32x16{}; oT[1] = f32x16{};
        const int t_lo = (w >= 2) ? (tt_lo > 1 ? tt_lo : 1) : tt_lo, t_hi = (w < 2) ? 2 : 3, t_mid = (w < 2) ? 1 : 2;
        for (int tt = t_lo; tt <= t_hi; ++tt) {
            const LAS unsigned char* kb = Kl + tt * 9216 + koff;
            f32x16 p0 = f32x16{}, p1 = f32x16{};
#pragma unroll
            for (int d0 = 0; d0 < 4; ++d0) {
                const bf16x8 k0 = *(const LAS bf16x8*)(kb + d0 * 32), k1 = *(const LAS bf16x8*)(kb + d0 * 32 + 32 * 144);
                p0 = __builtin_amdgcn_mfma_f32_32x32x16_bf16(k0, qr[d0], p0, 0, 0, 0);
                p1 = __builtin_amdgcn_mfma_f32_32x32x16_bf16(k1, qr[d0], p1, 0, 0, 0);
            }
            float mx = -INFINITY;
            if (tt != t_mid) {
                const int dbase = 128 + 32 * w + r32 - 64 * tt;
#pragma unroll
                for (int r = 0; r < 16; ++r) {
                    const int d0_ = dbase - crow(r, hi), d1_ = d0_ - 32;
                    p0[r] = (d0_ >= 0 && d0_ <= 128) ? p0[r] * C2 : -INFINITY;
                    p1[r] = (d1_ >= 0 && d1_ <= 128) ? p1[r] * C2 : -INFINITY;
                    mx = fmaxf(mx, fmaxf(p0[r], p1[r]));
                }
            } else {
#pragma unroll
                for (int r = 0; r < 16; ++r) { p0[r] *= C2; p1[r] *= C2; mx = fmaxf(mx, fmaxf(p0[r], p1[r])); }
            }
            { const auto rr = __builtin_amdgcn_permlane32_swap(__float_as_uint(mx), __float_as_uint(mx), false, false); mx = fmaxf(__uint_as_float(rr[0]), __uint_as_float(rr[1])); }
            const float mn = fmaxf(m, mx), alpha = __builtin_amdgcn_exp2f(m - mn);
            float rs = 0.f;
#pragma unroll
            for (int r = 0; r < 16; ++r) { p0[r] = __builtin_amdgcn_exp2f(p0[r] - mn); p1[r] = __builtin_amdgcn_exp2f(p1[r] - mn); rs += p0[r] + p1[r]; }
            l = l * alpha + rs; m = mn;
#pragma unroll
            for (int r = 0; r < 16; ++r) { oT[0][r] *= alpha; oT[1][r] *= alpha; }
            u32x4 pw[4];
            pw[0] = (u32x4){cvtpk(p0[0], p0[1]), cvtpk(p0[2], p0[3]), cvtpk(p0[4], p0[5]), cvtpk(p0[6], p0[7])};
            pw[1] = (u32x4){cvtpk(p0[8], p0[9]), cvtpk(p0[10], p0[11]), cvtpk(p0[12], p0[13]), cvtpk(p0[14], p0[15])};
            pw[2] = (u32x4){cvtpk(p1[0], p1[1]), cvtpk(p1[2], p1[3]), cvtpk(p1[4], p1[5]), cvtpk(p1[6], p1[7])};
            pw[3] = (u32x4){cvtpk(p1[8], p1[9]), cvtpk(p1[10], p1[11]), cvtpk(p1[12], p1[13]), cvtpk(p1[14], p1[15])};
            const LAS unsigned char* vp = Vl + tt * 8192 + voff;
#pragma unroll
            for (int d0 = 0; d0 < 2; ++d0)
#pragma unroll
                for (int ks = 0; ks < 4; ++ks) {
                    const s16x4 lo = vtr(vp + d0 * 4096 + ks * 1024), hh4 = vtr(vp + d0 * 4096 + ks * 1024 + 512);
                    const bf16x8 vf = (bf16x8){lo[0], lo[1], lo[2], lo[3], hh4[0], hh4[1], hh4[2], hh4[3]};
                    oT[d0] = __builtin_amdgcn_mfma_f32_32x32x16_bf16(vf, __builtin_bit_cast(bf16x8, pw[ks]), oT[d0], 0, 0, 0);
                }
        }
        float lt; { const auto rr = __builtin_amdgcn_permlane32_swap(__float_as_uint(l), __float_as_uint(l), false, false); lt = __uint_as_float(rr[0]) + __uint_as_float(rr[1]); }
        const float inv = 1.0f / lt;
        const int lq = 128 * me.j + 32 * w + r32;
        const size_t tok = (size_t)me.b * SEQ + (size_t)lq * me.dil + me.ph;
        if (MODE == 3) { asm volatile("" :: "v"(oT[0]), "v"(oT[1]), "v"(inv), "v"(m)); __syncthreads(); continue; }
        bf16* orow = og + tok * (NG * AW) + me.g * AW + me.hh * 64;
#pragma unroll
        for (int d0 = 0; d0 < 2; ++d0)
#pragma unroll
            for (int rp = 0; rp < 2; ++rp) {
                const int rg = 2 * rp;
                if (FP8_OG) {
                    const float i16 = inv * 16.0f;
                    const unsigned x = pack_fp8x4(oT[d0][4 * rg] * i16, oT[d0][4 * rg + 1] * i16, oT[d0][4 * rg + 2] * i16, oT[d0][4 * rg + 3] * i16);
                    const unsigned y = pack_fp8x4(oT[d0][4 * rg + 4] * i16, oT[d0][4 * rg + 5] * i16, oT[d0][4 * rg + 6] * i16, oT[d0][4 * rg + 7] * i16);
                    auto s0 = __builtin_amdgcn_permlane32_swap(x, y, false, false);
                    u32x2 wv; wv.x = s0[0]; wv.y = s0[1];
                    *(u32x2*)((unsigned char*)og + tok * (NG * AW) + me.g * AW + me.hh * 64 + 32 * d0 + 16 * rp + 8 * hi) = wv;
                } else {
                    unsigned x0 = cvtpk(oT[d0][4 * rg] * inv, oT[d0][4 * rg + 1] * inv), x1 = cvtpk(oT[d0][4 * rg + 2] * inv, oT[d0][4 * rg + 3] * inv);
                    unsigned y0 = cvtpk(oT[d0][4 * rg + 4] * inv, oT[d0][4 * rg + 5] * inv), y1 = cvtpk(oT[d0][4 * rg + 6] * inv, oT[d0][4 * rg + 7] * inv);
                    auto s0 = __builtin_amdgcn_permlane32_swap(x0, y0, false, false); auto s1 = __builtin_amdgcn_permlane32_swap(x1, y1, false, false);
                    u32x4 wv; wv.x = s0[0]; wv.y = s1[0]; wv.z = s0[1]; wv.w = s1[1];
                    *(u32x4*)(orow + 32 * d0 + 16 * rp + 8 * hi) = wv;
                }
            }
        if (hi == 0) lse[tok * 24 + me.g * 8 + me.hh] = (m + __builtin_amdgcn_logf(lt)) * LN2;
        __syncthreads();
    }
    }
#undef ATT_ISSUE
}
}

__device__ __forceinline__ u32x4 widen16(u32x2 x, u32x2 y) {
    auto s0 = __builtin_amdgcn_permlane16_swap(x.x, y.x, false, false); auto s1 = __builtin_amdgcn_permlane16_swap(x.y, y.y, false, false);
    return (u32x4){s0[0], s1[0], s0[1], s1[1]};
}
using pg8::Unit; using pg8::BM; using pg8::HALF;
struct EpiQKV {
    static constexpr bool PERM = true;
    bf16* O; const float* cs; float sc;
    __device__ __forceinline__ void operator()(const f32x4 (&acc)[2][2][4][2], const Unit& u, int wr, int wc, int fr, int fq) const {
        const int colt = u.pn * BM; const int kind = (colt % 1536) / 512;
        const bool rot = (kind < 2) && ((wc & 1) == 0) && (fq < 2);
        f32x4 cz[2][4][2];
#pragma unroll
        for (int ai = 0; ai < 2; ++ai)
#pragma unroll
            for (int m = 0; m < 4; ++m) { cz[ai][m][0] = (f32x4){1.f, 0.f, 1.f, 0.f}; cz[ai][m][1] = (f32x4){1.f, 0.f, 1.f, 0.f}; }
        if (rot) {
#pragma unroll
            for (int ai = 0; ai < 2; ++ai)
#pragma unroll
                for (int m = 0; m < 4; ++m) { const int row = u.pm * BM + ai * HALF + wr * 64 + m * 16 + fr;
                    cz[ai][m][0] = *(const f32x4*)(cs + (size_t)row * 16 + fq * 8); cz[ai][m][1] = *(const f32x4*)(cs + (size_t)row * 16 + fq * 8 + 4); }
        }
#pragma unroll
        for (int ai = 0; ai < 2; ++ai)
#pragma unroll
            for (int m = 0; m < 4; ++m) {
                const int row = u.pm * BM + ai * HALF + wr * 64 + m * 16 + fr;
                const f32x4 c0 = cz[ai][m][0], c1 = cz[ai][m][1];
                bf16* rowp = O + (size_t)row * QKVW + colt + wc * 32 + 8 * fq;
                u32x2 w8[2];
#pragma unroll
                for (int bj = 0; bj < 2; ++bj) {
                    f32x4 v0 = acc[ai][bj][m][0] * sc, v1 = acc[ai][bj][m][1] * sc;
                    f32x4 o0, o1;
                    o0.x = v0.x * c0.x - v0.y * c0.y; o0.y = v0.y * c0.x + v0.x * c0.y; o0.z = v0.z * c0.z - v0.w * c0.w; o0.w = v0.w * c0.z + v0.z * c0.w;
                    o1.x = v1.x * c1.x - v1.y * c1.y; o1.y = v1.y * c1.x + v1.x * c1.y; o1.z = v1.z * c1.z - v1.w * c1.w; o1.w = v1.w * c1.z + v1.z * c1.w;
                    if (FP8_QKVS) { w8[bj].x = pack_fp8x4(o0.x, o0.y, o0.z, o0.w); w8[bj].y = pack_fp8x4(o1.x, o1.y, o1.z, o1.w); }
                    else { u32x4 w; w.x = cvtpk(o0.x, o0.y); w.y = cvtpk(o0.z, o0.w); w.z = cvtpk(o1.x, o1.y); w.w = cvtpk(o1.z, o1.w);
                        *(u32x4*)(rowp + bj * HALF) = w; }
                }
                if (FP8_QKVS) {
                    const u32x4 w16 = widen16(w8[0], w8[1]);
                    *(u32x4*)((unsigned char*)O + (size_t)row * QKVW + colt + wc * 32 + 8 * (fq & ~1) + (fq & 1) * HALF) = w16; }
            }
    }
};
struct EpiBf16 {
    static constexpr bool PERM = true;
    bf16* O; int ldc;
    __device__ __forceinline__ void operator()(const f32x4 (&acc)[2][2][4][2], const Unit& u, int wr, int wc, int fr, int fq) const {
#pragma unroll
        for (int ai = 0; ai < 2; ++ai)
#pragma unroll
            for (int m = 0; m < 4; ++m) {
                bf16* rowp = O + (size_t)(u.pm * BM + ai * HALF + wr * 64 + m * 16 + fr) * ldc + u.pn * BM + wc * 32 + 8 * fq;
#pragma unroll
                for (int bj = 0; bj < 2; ++bj) { const f32x4 v0 = acc[ai][bj][m][0], v1 = acc[ai][bj][m][1];
                    u32x4 w; w.x = cvtpk(v0.x, v0.y); w.y = cvtpk(v0.z, v0.w); w.z = cvtpk(v1.x, v1.y); w.w = cvtpk(v1.z, v1.w);
                    *(u32x4*)(rowp + bj * HALF) = w; }
            }
    }
};
#define DPPF(v, ctrl) __builtin_bit_cast(float, __builtin_amdgcn_update_dpp(0, __builtin_bit_cast(int, (v)), (ctrl), 0xF, 0xF, true))
template <int W> __device__ __forceinline__ float pool_prefix(float x) {
    float t = x;
    t += DPPF(t, 0x111);
    if (W > 2) t += DPPF(t, 0x112);
    if (W > 4) t += DPPF(t, 0x114);
    if (W > 8) t += DPPF(t, 0x118);
    return t;
}
__device__ __forceinline__ float pool_suffix(float x) {
    float q = x;
    q += DPPF(q, 0x101); q += DPPF(q, 0x102); q += DPPF(q, 0x104); q += DPPF(q, 0x108);
    return q;
}
template <int W>
__device__ __forceinline__ void pool_epilogue(const f32x4 (&acc)[2][2][4][2], const pg8::Unit& u, int wr, int wc, int fr, int fq, bf16* POOLED_, bf16* HALO_) {
    const bool seq_start = ((u.pm & 7) == 0);
    const float invw = 1.0f / (float)W;
#pragma unroll
    for (int ai = 0; ai < 2; ++ai) {
        const bool first_blk = seq_start && ai == 0 && wr == 0;
        const float inv0 = first_blk ? 1.0f / (float)((fr + 1) < W ? (fr + 1) : W) : invw;
        const int blk = (u.pm * pg8::BM + ai * pg8::HALF + wr * 64) >> 6;
#pragma unroll
        for (int bj = 0; bj < 2; ++bj) {
            float po[4][8];
#pragma unroll
            for (int n = 0; n < 2; ++n)
#pragma unroll
                for (int e = 0; e < 4; ++e) {
                    float carry = 0.f;
#pragma unroll
                    for (int m = 0; m < 4; ++m) {
                        const float x = acc[ai][bj][m][n][e];
                        const float s = pool_prefix<W>(x) + carry;
                        po[m][n * 4 + e] = s * (m == 0 ? inv0 : invw) - x;
                        if (m < 3) { const float q = pool_suffix(x); carry = DPPF(q, 0x100 + (17 - W)); }
                    }
                }
            const size_t colo = (size_t)u.pn * pg8::BM + bj * pg8::HALF + wc * 32 + 8 * fq;
#pragma unroll
            for (int m = 0; m < 4; ++m) {
                u32x4 w; w.x = cvtpk(po[m][0], po[m][1]); w.y = cvtpk(po[m][2], po[m][3]); w.z = cvtpk(po[m][4], po[m][5]); w.w = cvtpk(po[m][6], po[m][7]);
                *(u32x4*)(POOLED_ + (size_t)(u.pm * pg8::BM + ai * pg8::HALF + wr * 64 + m * 16 + fr) * D + colo) = w;
            }
            if (fr >= 1) {
                u32x4 w; w.x = cvtpk(acc[ai][bj][3][0][0], acc[ai][bj][3][0][1]); w.y = cvtpk(acc[ai][bj][3][0][2], acc[ai][bj][3][0][3]); w.z = cvtpk(acc[ai][bj][3][1][0], acc[ai][bj][3][1][1]); w.w = cvtpk(acc[ai][bj][3][1][2], acc[ai][bj][3][1][3]);
                *(u32x4*)(HALO_ + ((size_t)blk * 15 + (fr - 1)) * D + colo) = w;
            }
        }
    }
}
struct EpiPool {
    static constexpr bool PERM = true;
    bf16* P_; bf16* H_;
    __device__ __forceinline__ void operator()(const f32x4 (&acc)[2][2][4][2], const pg8::Unit& u, int wr, int wc, int fr, int fq) const {
        switch (u.pn) {
            case 0: pool_epilogue<2>(acc, u, wr, wc, fr, fq, P_, H_); break;
            case 1: pool_epilogue<4>(acc, u, wr, wc, fr, fq, P_, H_); break;
            case 2: pool_epilogue<8>(acc, u, wr, wc, fr, fq, P_, H_); break;
            default: pool_epilogue<16>(acc, u, wr, wc, fr, fq, P_, H_); break;
        }
    }
};
template <bool RES32>
struct EpiResBf16 {
    static constexpr bool PERM = true;
    const void* res; bf16* out;
    __device__ __forceinline__ void operator()(const f32x4 (&acc)[2][2][4][2], const Unit& u, int wr, int wc, int fr, int fq) const {
#pragma unroll
        for (int ai = 0; ai < 2; ++ai) {
            f32x4 r32[4][2][2]; u32x4 r16[4][2];
            if constexpr (RES32) {
#pragma unroll
                for (int m = 0; m < 4; ++m)
#pragma unroll
                    for (int bj = 0; bj < 2; ++bj) { const size_t off = (size_t)(u.pm * BM + ai * HALF + wr * 64 + m * 16 + fr) * D + u.pn * BM + wc * 32 + 8 * fq + bj * HALF;
                        r32[m][bj][0] = *(const f32x4*)((const float*)res + off); r32[m][bj][1] = *(const f32x4*)((const float*)res + off + 4); }
            } else {
#pragma unroll
                for (int m = 0; m < 4; ++m)
#pragma unroll
                    for (int bj = 0; bj < 2; ++bj) { const size_t off = (size_t)(u.pm * BM + ai * HALF + wr * 64 + m * 16 + fr) * D + u.pn * BM + wc * 32 + 8 * fq + bj * HALF;
                        r16[m][bj] = *(const u32x4*)((const bf16*)res + off); }
            }
#pragma unroll
            for (int m = 0; m < 4; ++m)
#pragma unroll
                for (int bj = 0; bj < 2; ++bj) {
                    const size_t off = (size_t)(u.pm * BM + ai * HALF + wr * 64 + m * 16 + fr) * D + u.pn * BM + wc * 32 + 8 * fq + bj * HALF;
                    f32x4 r0, r1;
                    if constexpr (RES32) { r0 = r32[m][bj][0]; r1 = r32[m][bj][1]; }
                    else { const u32x4 rw = r16[m][bj]; r0 = (f32x4){bf_lo(rw.x), bf_hi(rw.x), bf_lo(rw.y), bf_hi(rw.y)}; r1 = (f32x4){bf_lo(rw.z), bf_hi(rw.z), bf_lo(rw.w), bf_hi(rw.w)}; }
                    const f32x4 v0 = r0 + acc[ai][bj][m][0], v1 = r1 + acc[ai][bj][m][1];
                    u32x4 w; w.x = cvtpk(v0.x, v0.y); w.y = cvtpk(v0.z, v0.w); w.z = cvtpk(v1.x, v1.y); w.w = cvtpk(v1.z, v1.w);
                    *(u32x4*)(out + off) = w;
                }
            asm volatile("" ::: "memory");
        }
    }
};
template <bool OUT8>
struct EpiSwiGLU {
    static constexpr bool PERM = true;
    void* O; float sc;
    __device__ __forceinline__ void operator()(const f32x4 (&acc)[2][2][4][2], const Unit& u, int wr, int wc, int fr, int fq) const {
#pragma unroll
        for (int ai = 0; ai < 2; ++ai)
#pragma unroll
            for (int mp = 0; mp < 2; ++mp) {
                u32x2 w8[2];
#pragma unroll
                for (int mi = 0; mi < 2; ++mi) { const int m = 2 * mp + mi;
                    const size_t eoff = (size_t)(u.pm * BM + ai * HALF + wr * 64 + m * 16 + fr) * DE + u.pn * HALF + wc * 32 + 8 * fq;
                    float h[8];
#pragma unroll
                    for (int n = 0; n < 2; ++n)
#pragma unroll
                        for (int e = 0; e < 4; ++e) { const float a = acc[ai][0][m][n][e] * sc, b = acc[ai][1][m][n][e] * sc;
                            h[n * 4 + e] = a * __builtin_amdgcn_rcpf(1.0f + __builtin_amdgcn_exp2f(-1.4426950408889634f * a)) * b; }
                    if constexpr (OUT8) { w8[mi].x = pack_fp8x4(h[0] * 16.f, h[1] * 16.f, h[2] * 16.f, h[3] * 16.f); w8[mi].y = pack_fp8x4(h[4] * 16.f, h[5] * 16.f, h[6] * 16.f, h[7] * 16.f); }
                    else { u32x4 w; w.x = cvtpk(h[0], h[1]); w.y = cvtpk(h[2], h[3]); w.z = cvtpk(h[4], h[5]); w.w = cvtpk(h[6], h[7]); *(u32x4*)((bf16*)O + eoff) = w; }
                }
                if constexpr (OUT8) { const u32x4 w16 = widen16(w8[0], w8[1]);
                    const int m = 2 * mp + (fq & 1);
                    *(u32x4*)((unsigned char*)O + (size_t)(u.pm * BM + ai * HALF + wr * 64 + m * 16 + fr) * DE + u.pn * HALF + wc * 32 + 8 * (fq & ~1)) = w16; }
            }
    }
};
struct EpiGate {
    static constexpr bool PERM = true;
    bf16* O; const LAS float* gtab;
    __device__ __forceinline__ void operator()(const f32x4 (&acc)[2][2][4][2], const Unit& u, int wr, int wc, int fr, int fq) const {
#pragma unroll
        for (int ai = 0; ai < 2; ++ai)
#pragma unroll
            for (int m = 0; m < 4; ++m) {
                const int rl = ai * HALF + wr * 64 + m * 16 + fr;
                const float gt = gtab[u.idx * 256 + rl];
                const size_t eoff = (size_t)(u.pm * BM + rl) * D + u.pn * BM + wc * 32 + 8 * fq;
                u32x2 w8[2];
#pragma unroll
                for (int bj = 0; bj < 2; ++bj) { const f32x4 v0 = acc[ai][bj][m][0] * gt, v1 = acc[ai][bj][m][1] * gt;
                    if (FP8_YS) { w8[bj].x = pack_fp8x4(v0.x, v0.y, v0.z, v0.w); w8[bj].y = pack_fp8x4(v1.x, v1.y, v1.z, v1.w); }
                    else { u32x4 w; w.x = cvtpk(v0.x, v0.y); w.y = cvtpk(v0.z, v0.w); w.z = cvtpk(v1.x, v1.y); w.w = cvtpk(v1.z, v1.w); *(u32x4*)(O + eoff + bj * HALF) = w; } }
                if (FP8_YS) { const u32x4 w16 = widen16(w8[0], w8[1]);
                    *(u32x4*)((unsigned char*)O + (size_t)(u.pm * BM + rl) * D + u.pn * BM + wc * 32 + 8 * (fq & ~1) + (fq & 1) * HALF) = w16; }
            }
    }
};

template <bool F8_>
struct MoeProb1T {
    static constexpr bool F8 = F8_;
    const void* A; const void* Bt; int K; const LAS int* tb; const LAS unsigned* aofs;
    __device__ __forceinline__ void a_offs(int i, const Unit&, const int (&R)[2], const int (&C)[2], unsigned (&o0)[2], unsigned (&o1)[2]) const {
#pragma unroll
        for (int k = 0; k < 2; ++k) { o0[k] = aofs[i * 256 + R[k]] + (unsigned)C[k] * 2u; o1[k] = aofs[i * 256 + 128 + R[k]] + (unsigned)C[k] * 2u; }
    }
    __device__ __forceinline__ unsigned b_off(const Unit& u) const {
        int e = 0;
#pragma unroll
        for (int k = 1; k < NE; ++k) e += (u.pm >= tb[k]) ? 1 : 0;
        return (unsigned)((e * 1024 + u.pn * 256) * 1024 * (F8 ? 1 : 2));
    }
};
template <bool F8_>
struct MoeProb2T {
    static constexpr bool F8 = F8_;
    const void* A; const void* Bt; int K; const LAS int* tb;
    __device__ __forceinline__ void a_offs(int, const Unit& u, const int (&R)[2], const int (&C)[2], unsigned (&o0)[2], unsigned (&o1)[2]) const {
        constexpr int esz = F8 ? 1 : 2;
#pragma unroll
        for (int k = 0; k < 2; ++k) { const unsigned b = (unsigned)((u.pm * BM + R[k]) * DE * esz + C[k] * 2); o0[k] = b; o1[k] = b + (unsigned)(HALF * DE * esz); }
    }
    __device__ __forceinline__ unsigned b_off(const Unit& u) const {
        int e = 0;
#pragma unroll
        for (int k = 1; k < NE; ++k) e += (u.pm >= tb[k]) ? 1 : 0;
        return (unsigned)((e * 1024 + u.pn * 256) * DE * (F8 ? 1 : 2));
    }
};
struct FoldOrder { int G, c; __device__ bool next(int i, Unit& u) const { const int L = i * G + c; if (L >= 16) return false; u.pm = L >> 2; u.pn = L & 3; return true; } };


#define XB_TMO      128
#define XB_XCNT(j)  (256  + 64 * (j))
#define XB_XSUB(j)  (1280 + 64 * (j))
#define XB_XGEN(j)  (2304 + 64 * (j))
#define XB_TOP      3328
#define XB_TOPGEN   3392
#define XCD_BAR_WORDS 3456
#define XB_SPIN_CAP (1u << 18)
__device__ __forceinline__ unsigned xb_ld(unsigned* p)              { return __hip_atomic_load(p, __ATOMIC_RELAXED, __HIP_MEMORY_SCOPE_AGENT); }
__device__ __forceinline__ unsigned xb_add(unsigned* p, unsigned v) { return __hip_atomic_fetch_add(p, v, __ATOMIC_RELAXED, __HIP_MEMORY_SCOPE_AGENT); }
__device__ __forceinline__ unsigned xb_xcc_id() { return (unsigned)__builtin_amdgcn_s_getreg((3 << 11) | 20) & 0xFu; }
#define XB_SPIN(cond, bar) do { unsigned _sp = 0; while (cond) { __builtin_amdgcn_s_sleep(1); \
    if ((++_sp & 255u) == 0u) { if (xb_ld(&(bar)[XB_TMO])) break; if (_sp > XB_SPIN_CAP) { atomicAdd(&(bar)[XB_TMO], 1u); break; } } } } while (0)
struct XcdBarrier { unsigned* bar; unsigned x; volatile LAS unsigned* st; };
__device__ __forceinline__ XcdBarrier xcd_barrier_post(unsigned* bar, volatile LAS unsigned* st) {
    XcdBarrier b; b.bar = bar; b.x = xb_xcc_id(); b.st = st;
    if (threadIdx.x == 0) (void)xb_add(&bar[XB_XCNT(b.x)], 1u);
    return b;
}
__device__ __forceinline__ void xcd_barrier_complete(unsigned* bar, unsigned x, unsigned& nloc, unsigned& nx) {
    const unsigned G = gridDim.x * gridDim.y * gridDim.z;
    unsigned sum, cnt, mine, sp = 0u;
    for (;;) {
        sum = 0u; cnt = 0u; mine = 0u;
#pragma unroll
        for (unsigned j = 0; j < 16; ++j) { const unsigned c = xb_ld(&bar[XB_XCNT(j)]); sum += c; cnt += (c > 0u) ? 1u : 0u; mine = (j == x) ? c : mine; }
        if (sum == G) break;
        __builtin_amdgcn_s_sleep(1);
        if ((++sp & 255u) == 0u) { if (xb_ld(&bar[XB_TMO])) break; if (sp > XB_SPIN_CAP) { atomicAdd(&bar[XB_TMO], 1u); break; } }
    }
    nloc = mine > 0u ? mine : 1u; nx = cnt > 0u ? cnt : 1u;
}
__device__ __forceinline__ void xcd_barrier(const XcdBarrier& b) {
    asm volatile("s_waitcnt vmcnt(0)" ::: "memory");
    __syncthreads();
    if (threadIdx.x == 0) {
        unsigned* bar = b.bar;
        __builtin_amdgcn_s_waitcnt(0);
        unsigned nloc = b.st[0], nx = b.st[1];
        if (nloc == 0u) { xcd_barrier_complete(bar, b.x, nloc, nx); b.st[0] = nloc; b.st[1] = nx; }
        const unsigned old = xb_add(&bar[XB_XSUB(b.x)], 1u);
        const unsigned gen = old / nloc;
        if (old + 1u == (gen + 1u) * nloc) {
            __builtin_amdgcn_fence(__ATOMIC_RELEASE, "agent");
            asm volatile("s_waitcnt vmcnt(0)" ::: "memory");
            const unsigned og = xb_add(&bar[XB_TOP], 1u);
            const unsigned tg = og / nx;
            if (og + 1u == (tg + 1u) * nx) xb_add(&bar[XB_TOPGEN], 1u);
            else XB_SPIN(xb_ld(&bar[XB_TOPGEN]) == tg, bar);
            __builtin_amdgcn_fence(__ATOMIC_ACQUIRE, "agent");
            xb_add(&bar[XB_XGEN(b.x)], 1u);
            asm volatile("s_waitcnt vmcnt(0)" ::: "memory");
        } else {
            XB_SPIN(xb_ld(&bar[XB_XGEN(b.x)]) == gen, bar);
            __builtin_amdgcn_fence(__ATOMIC_ACQUIRE, "agent");
            asm volatile("s_waitcnt vmcnt(0)" ::: "memory");
        }
    }
    __syncthreads();
}

constexpr int N_PHASES = 16;

template <int W>
__device__ __forceinline__ void seam_fix(const bf16* HALO_, bf16* POOLED_, int b, int ch) {
    u32x4 hrow[W - 1], prow[W - 1];
#pragma unroll
    for (int i = 0; i < W - 1; ++i) hrow[i] = *(const u32x4*)(HALO_ + ((size_t)(b - 1) * 15 + (16 - W + i)) * D + ch);
#pragma unroll
    for (int r = 0; r < W - 1; ++r) prow[r] = *(const u32x4*)(POOLED_ + (size_t)(b * 64 + r) * D + ch);
    const float invw = 1.0f / (float)W;
    float sum[8];
#pragma unroll
    for (int k = 0; k < 8; ++k) sum[k] = 0.f;
#pragma unroll
    for (int r = W - 2; r >= 0; --r) {
#pragma unroll
        for (int k = 0; k < 4; ++k) { sum[2 * k] += bf_lo(hrow[r][k]); sum[2 * k + 1] += bf_hi(hrow[r][k]); }
        u32x4 w;
#pragma unroll
        for (int k = 0; k < 4; ++k) w[k] = cvtpk(bf_lo(prow[r][k]) + sum[2 * k] * invw, bf_hi(prow[r][k]) + sum[2 * k + 1] * invw);
        *(u32x4*)(POOLED_ + (size_t)(b * 64 + r) * D + ch) = w;
    }
}
typedef const __attribute__((address_space(4))) Params* KParamsPtr;
__device__ __forceinline__ KParamsPtr kparams() { KParamsPtr q = (KParamsPtr)__builtin_amdgcn_kernarg_segment_ptr(); asm volatile("" : "+s"(q)); return q; }
__global__ void __launch_bounds__(NTHREADS, 2) fwd_kernel(Params p) {
    extern __shared__ __attribute__((aligned(16))) unsigned char lds_raw[];
    LAS unsigned char* lds = (LAS unsigned char*)lds_raw;
    const int tid = threadIdx.x, lane = tid & 63, wave = __builtin_amdgcn_readfirstlane(tid >> 6);
    const int G = gridDim.x, bx = blockIdx.x;
    const int vcu = (G % 8 == 0) ? (bx % 8) * (G / 8) + bx / 8 : bx;
#define KP() kparams()
#define WSB() ((unsigned char*)KP()->ws)
#define G_ctl ((int*)(WSB() + WS_CTL))
#define G_cs ((float*)(WSB() + WS_CS))
#define G_lse ((float*)(WSB() + WS_LSE))
#define G_slotref ((int*)(WSB() + WS_SLOTREF))
#define Wgs ((bf16*)(WSB() + WS_WGS))
#define G_list ((int*)(WSB() + WS_LIST))
#define G_gatel ((float*)(WSB() + WS_GATEL))
#define Win_t ((bf16*)(WSB() + WS_WIN))
#define Wout_t ((bf16*)(WSB() + WS_WOUT))
#define Wpin_t ((bf16*)(WSB() + WS_WPIN))
#define Wc_t ((bf16*)(WSB() + WS_WC))
#define Wpo_t ((bf16*)(WSB() + WS_WPO))
#define W13 ((bf16*)(WSB() + WS_W13))
#define W2 ((bf16*)(WSB() + WS_W2))
#define Y ((bf16*)(WSB() + WS_Y))
#define QKV ((bf16*)(WSB() + WS_BIG))
#define OM ((bf16*)(WSB() + WS_OM))
#define HMID ((bf16*)(WSB() + WS_HMID))
#define YS ((bf16*)(WSB() + WS_YS))
#define U ((bf16*)(WSB() + WS_U))
#define POOLED ((bf16*)(WSB() + WS_POOLED))
#define OG ((bf16*)KP()->out)
#define H ((bf16*)(WSB() + WS_H))
    LAS int* tb = (LAS int*)(lds + MISC_OFF);
    LAS unsigned* aofs = (LAS unsigned*)(lds + AOFS_OFF);

    const int lo = p.ph_lo, hi = p.ph_hi;
#if MK_N_LAUNCHES == 1
    cg::grid_group grid = cg::this_grid();
    if (tid < 2) ((volatile LAS unsigned*)(lds + MISC_OFF))[64 + tid] = 0u;
    __syncthreads();
    const XcdBarrier xbar = xcd_barrier_post((unsigned*)(G_ctl + CW_BAR), (volatile LAS unsigned*)(lds + MISC_OFF) + 64);
#define GRID_BAR(k) do { if ((k) == CG_SEAM) grid.sync(); else xcd_barrier(xbar); } while (0)
#else
#define GRID_BAR(k) do { } while (0)
#endif
#ifndef PHASE_MASK
#define PHASE_MASK 0xffff
#endif
#ifndef REPEAT_MASK
#define REPEAT_MASK 0x0
#endif
#define REP(k) for (int rep_ = 0; rep_ <= ((REPEAT_MASK >> (k)) & 1); ++rep_)
#define IN(k) (((PHASE_MASK >> (k)) & 1) && lo <= (k) && (k) < hi)
#ifndef DOUBLE_BAR
#define DOUBLE_BAR 0
#endif
#ifndef PROBE_PHASE
#define PROBE_PHASE (-1)
#endif
#define PT0(k) if (PROBE_PHASE == (k)) pt0 = __builtin_amdgcn_s_memrealtime();
#define PT1(k) if (PROBE_PHASE == (k)) { const unsigned long long t1_ = __builtin_amdgcn_s_memrealtime(), d_ = t1_ - pt0; while (__builtin_amdgcn_s_memrealtime() - t1_ < d_) __builtin_amdgcn_s_sleep(8); }
#define SEAM(k) do { if (IN(k) && IN((k) + 1)) { _Pragma("unroll 1") for (int nb_ = 0; nb_ < 1 + (DOUBLE_BAR ? (hi > 0 ? 1 : 0) : 0); ++nb_) GRID_BAR(k); } } while (0)

    unsigned long long pt0 = 0;
    PT0(0)
    if (IN(0)) REP(0) {
        LAS float* scr = (LAS float*)(lds + wave * 16384);
        const int gw = vcu * NWAVES + wave, NGW = G * NWAVES;
        constexpr int I_IN = (D / 64) * (QKVW / 32);
        constexpr int I_OUT = (AW / 64) * (D / 32);
        constexpr int I_PIN = (D / 64) * (D / 32);
        constexpr int I_PO = I_PIN;
        constexpr int I_W1 = (D / 64) * (DE / 32);
        constexpr int I_W2 = (DE / 64) * (D / 32);
        constexpr int NITEMS = I_IN + I_OUT + I_PIN + I_PO + 32 * (2 * I_W1 + I_W2);
        for (int it = gw; it < NITEMS; it += NGW) {
            int r = it;
            if (r < I_IN) { const int nblk = QKVW / 32;
                if (FP8_QKV) transpose_item8(KP()->attn_w_in, QKVW, D, (unsigned char*)Win_t, MapQKV{}, 32.f, scr, 64 * (r / nblk), 32 * (r % nblk), lane);
                else transpose_item(KP()->attn_w_in, QKVW, D, Win_t, MapQKV{}, scr, 64 * (r / nblk), 32 * (r % nblk), lane);
                continue; } r -= I_IN;
            if (r < I_OUT) { const int nblk = D / 32; transpose_item(KP()->attn_w_out, D, AW, Wout_t, MapId{}, scr, 64 * (r / nblk), 32 * (r % nblk), lane); continue; } r -= I_OUT;
            if (r < I_PIN) { const int nblk = D / 32; transpose_item(KP()->pool_w_in, D, D, Wpin_t, MapId{}, scr, 64 * (r / nblk), 32 * (r % nblk), lane); continue; } r -= I_PIN;
            if (r < I_PO) { const int nblk = D / 32; transpose_item(KP()->pool_w_out, D, D, Wpo_t, MapId{}, scr, 64 * (r / nblk), 32 * (r % nblk), lane); continue; } r -= I_PO;
            const int le = r / (2 * I_W1 + I_W2); r -= le * (2 * I_W1 + I_W2);
            if (r < I_W1) { const int nblk = DE / 32;
                if (FP8_MOE1) transpose_item8(KP()->expert_w1 + (size_t)le * D * DE, DE, D, (unsigned char*)W13 + (size_t)le * 1024 * 1024, MapW13{0}, 32.f, scr, 64 * (r / nblk), 32 * (r % nblk), lane);
                else transpose_item(KP()->expert_w1 + (size_t)le * D * DE, DE, D, W13 + (size_t)le * 1024 * 1024, MapW13{0}, scr, 64 * (r / nblk), 32 * (r % nblk), lane);
                continue; } r -= I_W1;
            if (r < I_W1) { const int nblk = DE / 32;
                if (FP8_MOE1) transpose_item8(KP()->expert_w3 + (size_t)le * D * DE, DE, D, (unsigned char*)W13 + (size_t)le * 1024 * 1024, MapW13{128}, 32.f, scr, 64 * (r / nblk), 32 * (r % nblk), lane);
                else transpose_item(KP()->expert_w3 + (size_t)le * D * DE, DE, D, W13 + (size_t)le * 1024 * 1024, MapW13{128}, scr, 64 * (r / nblk), 32 * (r % nblk), lane);
                continue; } r -= I_W1;
            { const int nblk = D / 32;
                if (FP8_MOE2) transpose_item8(KP()->expert_w2 + (size_t)le * DE * D, D, DE, (unsigned char*)W2 + (size_t)le * 1024 * DE, MapId{}, 32.f, scr, 64 * (r / nblk), 32 * (r % nblk), lane);
                else transpose_item(KP()->expert_w2 + (size_t)le * DE * D, D, DE, W2 + (size_t)le * 1024 * DE, MapId{}, scr, 64 * (r / nblk), 32 * (r % nblk), lane); }
        }
        for (int i = vcu * NTHREADS + tid; i < 4 * 256 * 256 / 4; i += G * NTHREADS) {
            const int e4 = (i & 63) * 4, gidx = i >> 14;
            const f32x4 wv = *(const f32x4*)(KP()->pool_w_group + (size_t)i * 4); const f32x4 sc = *(const f32x4*)(KP()->pool_scale + gidx * 256 + e4);
            u32x2 o; o.x = cvtpk(wv.x * sc.x, wv.y * sc.y); o.y = cvtpk(wv.z * sc.z, wv.w * sc.w); *(u32x2*)(Wgs + (size_t)i * 4) = o;
        }
        for (int i = vcu * NTHREADS + tid; i < T * 8; i += G * NTHREADS) {
            const int tok = i >> 3, f = i & 7;
            const double invf = exp2(-(double)f * 0.125 * 18.931568569324174);
            const float ang = (float)KP()->positions[tok] * (float)invf;
            double sn, cn; sincos((double)ang, &sn, &cn);
            G_cs[(size_t)i * 2] = (float)cn; G_cs[(size_t)i * 2 + 1] = (float)sn;
        }
        RowPassCfg c{}; c.hin = KP()->x; c.gain = KP()->norm_mix; if (FP8_QKV) c.yout8 = (unsigned char*)Y; else c.yout = Y;
        row_pass<false, false, false>(lds, c, vcu, wave);
    }
    SEAM(0); PT1(0)
    PT0(1)
    if (IN(1)) REP(1) {
        pg8::DenseProbT<FP8_QKV != 0> P{Y, Win_t, D, D, 0, (size_t)256 * D};
        pg8::StaticOrder S; S.init(T / 256, QKVW / 256, G, bx);
        EpiQKV E{QKV, G_cs, FP8_QKV ? (1.0f / 32.0f) : 1.0f};
        pg8::gemm_phase<pg8::DenseProbT<FP8_QKV != 0>, EpiQKV, pg8::StaticOrder, true>(lds, P, S, E);
    }
    SEAM(1); PT1(1)
    PT0(2)
    if (IN(2)) REP(2) {
#ifndef ATT_PROBE_MODE
#define ATT_PROBE_MODE 0
#endif
        if (ATT_PROBE_MODE == 1) att::attn_phase<1>(lds, QKV, OG, G_lse, vcu, G);
        if (ATT_PROBE_MODE == 2) att::attn_phase<2>(lds, QKV, OG, G_lse, vcu, G);
        if (ATT_PROBE_MODE == 3) att::attn_phase<3>(lds, QKV, OG, G_lse, vcu, G);
        att::attn_phase<0>(lds, QKV, OG, G_lse, vcu, G);
    }
    SEAM(2); PT1(2)
    PT0(3)
    if (IN(3)) REP(3) {
        for (int row = vcu * NWAVES + wave; row < T; row += G * NWAVES) {
            const int h = lane >> 3;
            const float l0 = G_lse[(size_t)row * 24 + h], l1 = G_lse[(size_t)row * 24 + 8 + h], l2 = G_lse[(size_t)row * 24 + 16 + h];
            const float mx = fmaxf(l0, fmaxf(l1, l2));
            float w0 = __expf(l0 - mx), w1 = __expf(l1 - mx), w2 = __expf(l2 - mx); const float inv = 1.0f / (w0 + w1 + w2); w0 *= inv; w1 *= inv; w2 *= inv;
            u32x4 o;
            if (FP8_OG) {
                const unsigned char* src = (const unsigned char*)OG + (size_t)row * 1536 + lane * 8;
                const u32x2 a = *(const u32x2*)(src), b = *(const u32x2*)(src + 512), c = *(const u32x2*)(src + 1024);
                w0 *= (1.0f / 16.0f); w1 *= (1.0f / 16.0f); w2 *= (1.0f / 16.0f);
#define MRG_(WA, WB, WC, SEL) cvtpk(w0 * __builtin_amdgcn_cvt_pk_f32_fp8((int)(WA), SEL)[0] + w1 * __builtin_amdgcn_cvt_pk_f32_fp8((int)(WB), SEL)[0] + w2 * __builtin_amdgcn_cvt_pk_f32_fp8((int)(WC), SEL)[0], \
                                    w0 * __builtin_amdgcn_cvt_pk_f32_fp8((int)(WA), SEL)[1] + w1 * __builtin_amdgcn_cvt_pk_f32_fp8((int)(WB), SEL)[1] + w2 * __builtin_amdgcn_cvt_pk_f32_fp8((int)(WC), SEL)[1])
                o[0] = MRG_(a.x, b.x, c.x, false); o[1] = MRG_(a.x, b.x, c.x, true); o[2] = MRG_(a.y, b.y, c.y, false); o[3] = MRG_(a.y, b.y, c.y, true);
#undef MRG_
            } else {
            const bf16* src = OG + (size_t)row * 1536 + lane * 8;
            const u32x4 a = *(const u32x4*)(src), b = *(const u32x4*)(src + 512), c = *(const u32x4*)(src + 1024);
#pragma unroll
            for (int k = 0; k < 4; ++k) { const float lo_ = w0 * bf_lo(a[k]) + w1 * bf_lo(b[k]) + w2 * bf_lo(c[k]), hi_ = w0 * bf_hi(a[k]) + w1 * bf_hi(b[k]) + w2 * bf_hi(c[k]); o[k] = cvtpk(lo_, hi_); }
            }
            *(u32x4*)(OM + (size_t)row * AW + lane * 8) = o;
        }
    }
    SEAM(3); PT1(3)
    PT0(4)
    if (IN(4)) REP(4) {
        pg8::DenseProb P{OM, Wout_t, AW, AW, 0, (size_t)256 * AW};
        pg8::StaticOrder S; S.init(T / 256, D / 256, G, bx);
        EpiResBf16<true> E{KP()->x, H};
        pg8::gemm_phase<pg8::DenseProb, EpiResBf16<true>, pg8::StaticOrder, true>(lds, P, S, E);
    }
    SEAM(4); PT1(4)
#pragma unroll 1
    for (int L = 0; L < 2; ++L) {
        const int pb = (L == 0) ? 5 : 12;
        int* cnt = G_ctl + CW_CNT + L * NE;
        PT0(pb)
        if (IN(pb)) {
            RowPassCfg c{}; c.hin16 = H; c.gain = KP()->norm_ffn + L * D; if (FP8_MOE1) c.yout8 = (unsigned char*)Y; else c.yout = Y;
            c.rgw = KP()->router_group_w + (size_t)L * D * 4; c.rgb = KP()->router_group_b + L * 4; c.rew = KP()->router_expert_w + (size_t)L * 4 * D * 4; c.reb = KP()->router_expert_b + L * 16;
            c.cnt = cnt; c.list = G_list + (size_t)L * NE * T; c.gatel = G_gatel + (size_t)L * NE * T; c.slotref_out = G_slotref + (size_t)L * T * 2;
            if ((REPEAT_MASK >> pb) & 1) {
                RowPassCfg c2 = c; c2.cnt = G_ctl + 64 + L * NE; c2.list = (int*)(WSB() + WS_BIG + 200 * MiB); c2.gatel = (float*)(WSB() + WS_BIG + 204 * MiB); c2.slotref_out = (int*)(WSB() + WS_BIG + 208 * MiB);
                if (ROUTER_MFMA) router_pass(lds, c2, vcu, wave); else row_pass<false, true, true>(lds, c2, vcu, wave);
            }
            if (ROUTER_MFMA) router_pass(lds, c, vcu, wave); else row_pass<false, true, true>(lds, c, vcu, wave);
        }
        SEAM(pb); PT1(pb)
        PT0(pb + 1)
        if (IN(pb + 1) || IN(pb + 2)) {
            if (tid == 0) { int s = 0; for (int e = 0; e < NE; ++e) { tb[e] = s; tb[32 + e] = cnt[e]; s += (cnt[e] + 255) >> 8; } tb[NE] = s; }
            __syncthreads();
        }
        if (IN(pb + 1)) REP(pb + 1) {
            const int NT = tb[NE];
            pg8::StaticOrder S; S.init(NT, 4, G, bx);
            for (int i = 0; i < 8; ++i) { Unit u; if (!S.next(i, u)) break;
                int e = 0;
                for (int k = 1; k < NE; ++k) e += (u.pm >= tb[k]) ? 1 : 0;
                if (tid < 256) { const int li = (u.pm - tb[e]) * 256 + tid; const int tok = (li < tb[32 + e]) ? G_list[((size_t)L * NE + e) * T + li] : 0; aofs[i * 256 + tid] = (unsigned)tok * (unsigned)(D * (FP8_MOE1 ? 1 : 2)); } }
            __syncthreads();
            MoeProb1T<FP8_MOE1 != 0> P{Y, (const unsigned char*)W13 + (size_t)L * NE * 1024 * 1024 * (FP8_MOE1 ? 1 : 2), D, tb, aofs};
            EpiSwiGLU<FP8_MOE2 != 0> E{HMID, FP8_MOE1 ? (1.0f / 32.0f) : 1.0f};
            pg8::gemm_phase<MoeProb1T<FP8_MOE1 != 0>, EpiSwiGLU<FP8_MOE2 != 0>, pg8::StaticOrder, true>(lds, P, S, E);
            if (L == 0) {
                pg8::DenseProb Pf{Wpo_t, Wgs, 256, D, 256, (size_t)256 * 256};
                FoldOrder Sf{G, G - 1 - bx};
                EpiBf16 Ef{Wc_t, D};
                pg8::gemm_phase<pg8::DenseProb, EpiBf16, FoldOrder, true>(lds, Pf, Sf, Ef);
            }
        }
        SEAM(pb + 1); PT1(pb + 1)
        PT0(pb + 2)
        if (IN(pb + 2)) REP(pb + 2) {
            const int NT = tb[NE];
            pg8::StaticOrder S; S.init(NT, 4, G, bx);
            { const float gsc = (FP8_MOE2 ? (1.0f / 512.0f) : 1.0f) * (FP8_YS ? 64.0f : 1.0f);
              for (int i = 0; i < 8; ++i) { Unit u; if (!S.next(i, u)) break;
                int e = 0;
                for (int k = 1; k < NE; ++k) e += (u.pm >= tb[k]) ? 1 : 0;
                if (tid < 256) { const int li = (u.pm - tb[e]) * 256 + tid; ((LAS float*)aofs)[i * 256 + tid] = (li < tb[32 + e]) ? G_gatel[((size_t)L * NE + e) * T + li] * gsc : 0.f; } }
              __syncthreads(); }
            MoeProb2T<FP8_MOE2 != 0> P{HMID, (const unsigned char*)W2 + (size_t)L * NE * 1024 * DE * (FP8_MOE2 ? 1 : 2), DE, tb};
            EpiGate E{YS, (const LAS float*)aofs};
            pg8::gemm_phase<MoeProb2T<FP8_MOE2 != 0>, EpiGate, pg8::StaticOrder, true>(lds, P, S, E);
        }
        SEAM(pb + 2); PT1(pb + 2)
        if (L == 0) {
            PT0(8)
            if (IN(8)) {
                RowPassCfg c{}; c.hin16 = H; c.ys = YS; c.slotref = G_slotref; c.cnt_prev = cnt; c.hout = H; c.gain = KP()->norm_mix + D; c.yout = Y;
                if ((REPEAT_MASK >> 8) & 1) { RowPassCfg c2 = c; c2.hout = nullptr; row_pass<true, false, true>(lds, c2, vcu, wave); }
                row_pass<true, false, true>(lds, c, vcu, wave);
            }
            SEAM(8); PT1(8)
            PT0(9)
            if (IN(9)) REP(9) {
                pg8::DenseProb P{Y, Wpin_t, D, D, 0, (size_t)256 * D};
                pg8::StaticOrder S; S.init(T / 256, D / 256, G, bx);
                if (POOL_FUSED) { EpiPool E{POOLED, U};
                    pg8::gemm_phase<pg8::DenseProb, EpiPool, pg8::StaticOrder, true>(lds, P, S, E); }
                else { EpiBf16 E{U, D};
                    pg8::gemm_phase<pg8::DenseProb, EpiBf16, pg8::StaticOrder, true>(lds, P, S, E); }
            }
            SEAM(9); PT1(9)
            PT0(10)
            if (IN(10) && POOL_FUSED) {
                int tq10 = threadIdx.x; asm volatile("" : "+v"(tq10));
                for (int it = vcu * NTHREADS + tq10; it < (T / 64) * 128; it += G * NTHREADS) {
                    const int ch = (it & 127) * 8, b = it >> 7;
                    if ((b & 31) == 0) continue;
                    switch (ch >> 8) { case 0: seam_fix<2>(U, POOLED, b, ch); break; case 1: seam_fix<4>(U, POOLED, b, ch); break; case 2: seam_fix<8>(U, POOLED, b, ch); break; default: seam_fix<16>(U, POOLED, b, ch); break; }
                }
            }
            if (IN(10) && !POOL_FUSED) REP(10) {
                int tq10 = threadIdx.x; asm volatile("" : "+v"(tq10));
                for (int it = vcu * NTHREADS + tq10; it < (T / 32) * 128; it += G * NTHREADS) {
                    const int ch = (it & 127) * 8, run = it >> 7, t0 = run * 32, s0 = t0 & (SEQ - 1);
                    const int wdw = 2 << (ch >> 8);
                    float sum[8];
#pragma unroll
                    for (int k = 0; k < 8; ++k) sum[k] = 0.f;
                    for (int i = 1; i < wdw; ++i) { if (s0 - i < 0) break; const u32x4 a = *(const u32x4*)(U + (size_t)(t0 - i) * D + ch);
#pragma unroll
                        for (int k = 0; k < 4; ++k) { sum[2 * k] += bf_lo(a[k]); sum[2 * k + 1] += bf_hi(a[k]); } }
                    for (int i0 = 0; i0 < 32; i0 += 8) {
                        u32x4 a8[8], o8[8];
#pragma unroll
                        for (int i = 0; i < 8; ++i) { const int tk = t0 + i0 + i, sq = s0 + i0 + i;
                            a8[i] = *(const u32x4*)(U + (size_t)tk * D + ch);
                            const int tko = tk - wdw + 1; const unsigned msk = (sq - wdw + 1 >= 0) ? 0xffffffffu : 0u;
                            const u32x4 ov = *(const u32x4*)(U + (size_t)(tko < 0 ? 0 : tko) * D + ch); o8[i] = (u32x4){ov.x & msk, ov.y & msk, ov.z & msk, ov.w & msk}; }
#pragma unroll
                        for (int i = 0; i < 8; ++i) { const int tk = t0 + i0 + i, sq = s0 + i0 + i;
                            float cur[8];
#pragma unroll
                            for (int k = 0; k < 4; ++k) { cur[2 * k] = bf_lo(a8[i][k]); cur[2 * k + 1] = bf_hi(a8[i][k]); }
#pragma unroll
                            for (int k = 0; k < 8; ++k) sum[k] += cur[k];
                            const float invc = 1.0f / (float)((sq + 1) < wdw ? (sq + 1) : wdw);
                            u32x4 w;
#pragma unroll
                            for (int k = 0; k < 4; ++k) w[k] = cvtpk(sum[2 * k] * invc - cur[2 * k], sum[2 * k + 1] * invc - cur[2 * k + 1]);
                            *(u32x4*)(POOLED + (size_t)tk * D + ch) = w;
#pragma unroll
                            for (int k = 0; k < 4; ++k) { sum[2 * k] -= bf_lo(o8[i][k]); sum[2 * k + 1] -= bf_hi(o8[i][k]); }
                        }
                    }
                }
            }
            SEAM(10); PT1(10)
            PT0(11)
            if (IN(11)) REP(11) {
                pg8::DenseProb P{POOLED, Wc_t, D, D, 0, (size_t)256 * D};
                pg8::StaticOrder S; S.init(T / 256, D / 256, G, bx);
                EpiResBf16<false> E{H, (((REPEAT_MASK >> 11) & 1) && rep_ == 0) ? (bf16*)(WSB() + WS_BIG + 136 * MiB) : H};
                pg8::gemm_phase<pg8::DenseProb, EpiResBf16<false>, pg8::StaticOrder, true>(lds, P, S, E);
            }
            SEAM(11); PT1(11)
        }
    }
    PT0(15)
    if (IN(15)) {
        RowPassCfg c{}; c.hin16 = H; c.ys = YS; c.slotref = G_slotref + (size_t)T * 2; c.cnt_prev = G_ctl + CW_CNT + NE; c.gain = KP()->norm_final; c.fout = KP()->out;
        if ((REPEAT_MASK >> 15) & 1) { RowPassCfg c2 = c; c2.fout = nullptr; c2.yout = Y; row_pass<true, false, true>(lds, c2, vcu, wave); }
        row_pass<true, false, true>(lds, c, vcu, wave);
    }
    PT1(15)
#undef IN
#undef SEAM
#undef GRID_BAR
}

#undef KP
#undef WSB
#undef G_ctl
#undef G_cs
#undef G_lse
#undef G_slotref
#undef Wgs
#undef G_list
#undef G_gatel
#undef Win_t
#undef Wout_t
#undef Wpin_t
#undef Wc_t
#undef Wpo_t
#undef W13
#undef W2
#undef Y
#undef QKV
#undef OM
#undef HMID
#undef YS
#undef U
#undef POOLED
#undef OG
#undef H
extern "C" void kernel_launch(void* const* d_in, const int* in_sizes, int n_in, void* d_out, int out_size, void* d_ws, size_t ws_size, hipStream_t stream) {
    static int grid = 0;
    if (grid == 0) {
        if (n_in != 18 || in_sizes[0] != T * D || out_size != T * D || ws_size < WS_END) { fprintf(stderr, "kernel_launch: unexpected shapes (n_in %d, in0 %d, out %d, ws %zu)\n", n_in, n_in > 0 ? in_sizes[0] : -1, out_size, ws_size); grid = -1; return; }
        int dev = 0, cus = 0, per_cu = 0;
        if (hipGetDevice(&dev) != hipSuccess || hipDeviceGetAttribute(&cus, hipDeviceAttributeMultiprocessorCount, dev) != hipSuccess) { grid = -1; return; }
        if (hipFuncSetAttribute((const void*)fwd_kernel, hipFuncAttributeMaxDynamicSharedMemorySize, LDS_BYTES) != hipSuccess) { fprintf(stderr, "kernel_launch: hipFuncSetAttribute failed\n"); grid = -1; return; }
        if (hipOccupancyMaxActiveBlocksPerMultiprocessor(&per_cu, (const void*)fwd_kernel, NTHREADS, LDS_BYTES) != hipSuccess || per_cu < 1) { fprintf(stderr, "kernel_launch: occupancy query says %d\n", per_cu); per_cu = 1; }
        (void)hipGetLastError();
        grid = cus;
    }
    if (grid < 0) return;
    (void)hipMemsetAsync((char*)d_ws + WS_CTL, 0, CTL_ZERO_BYTES, stream);
    Params p{};
    p.x = (const float*)d_in[0]; p.positions = (const int*)d_in[1]; p.norm_mix = (const float*)d_in[2]; p.norm_ffn = (const float*)d_in[3]; p.norm_final = (const float*)d_in[4];
    p.attn_w_in = (const float*)d_in[5]; p.attn_w_out = (const float*)d_in[6]; p.pool_w_in = (const float*)d_in[7]; p.pool_w_group = (const float*)d_in[8]; p.pool_scale = (const float*)d_in[9]; p.pool_w_out = (const float*)d_in[10];
    p.router_group_w = (const float*)d_in[11]; p.router_group_b = (const float*)d_in[12]; p.router_expert_w = (const float*)d_in[13]; p.router_expert_b = (const float*)d_in[14];
    p.expert_w1 = (const float*)d_in[15]; p.expert_w3 = (const float*)d_in[16]; p.expert_w2 = (const float*)d_in[17];
    p.out = (float*)d_out; p.ws = (unsigned char*)d_ws;
#if MK_N_LAUNCHES == 1
    p.ph_lo = 0; p.ph_hi = N_PHASES;
    void* args[] = {&p};
    hipError_t e = hipLaunchCooperativeKernel((const void*)fwd_kernel, dim3(grid), dim3(NTHREADS), args, LDS_BYTES, stream);
    if (e != hipSuccess) fprintf(stderr, "cooperative launch failed: %s (grid %d)\n", hipGetErrorString(e), grid);
#else
    for (int ph = 0; ph < N_PHASES; ++ph) {
        p.ph_lo = ph; p.ph_hi = ph + 1;
        hipLaunchKernelGGL(fwd_kernel, dim3(grid), dim3(NTHREADS), LDS_BYTES, stream, p);
    }
#endif
}
```

```cpp
#include <hip/hip_runtime.h>
#include <hip/hip_cooperative_groups.h>
#include <cstdio>
#include <cstdint>
namespace cg = cooperative_groups;

#ifndef MK_N_LAUNCHES
#define MK_N_LAUNCHES 1
#endif

#ifndef FP8_MOE1
#define FP8_MOE1 1
#endif
#ifndef FP8_MOE2
#define FP8_MOE2 1
#endif
#ifndef FP8_OUT
#define FP8_OUT 1
#endif
#ifndef POOL_FUSED
#define POOL_FUSED 1
#endif
#ifndef FP8_QKVS
#define FP8_QKVS 1
#endif
#ifndef ROUTER_MFMA
#define ROUTER_MFMA 1
#endif
#ifndef FP8_OG
#define FP8_OG 1
#endif
#ifndef FP8_YS
#define FP8_YS 1
#endif
#ifndef FP8_QKV
#define FP8_QKV 1
#endif
#define LAS __attribute__((address_space(3)))
#define GAS __attribute__((address_space(1)))
typedef unsigned short bf16;
typedef short bf16x8 __attribute__((ext_vector_type(8)));
typedef float f32x4 __attribute__((ext_vector_type(4)));
typedef float f32x2 __attribute__((ext_vector_type(2)));
typedef float f32x16 __attribute__((ext_vector_type(16)));
typedef unsigned u32x4 __attribute__((ext_vector_type(4)));
typedef unsigned u32x2 __attribute__((ext_vector_type(2)));
typedef short s16x4 __attribute__((ext_vector_type(4)));
typedef __bf16 bf16x2_t __attribute__((ext_vector_type(2)));
typedef int i32x4 __attribute__((ext_vector_type(4)));
typedef int i32x8 __attribute__((ext_vector_type(8)));

constexpr int BATCH = 16, SEQ = 2048, D = 1024, T = BATCH * SEQ;
constexpr int NG = 3, HPG = 8, HD = 64, AW = 512, QKVW = NG * 3 * AW;
constexpr int NE = 16, DE = 512, SLOTS = 2 * T;
constexpr int MAXTILES = SLOTS / 256 + NE;
constexpr float RMS_EPS = 1e-6f;
constexpr int NWAVES = 8, NTHREADS = 512;

constexpr size_t MiB = 1u << 20;
constexpr size_t WS_CTL = 0, CTL_ZERO_BYTES = 64 * 1024;
constexpr size_t WS_CS = 1 * MiB;
constexpr size_t WS_LSE = 3 * MiB;
constexpr size_t WS_SLOTREF = 6 * MiB;
constexpr size_t WS_WGS = 7 * MiB;
constexpr size_t WS_LIST = 8 * MiB;
constexpr size_t WS_GATEL = 12 * MiB;
constexpr size_t WS_WIN = 16 * MiB;
constexpr size_t WS_WOUT = 25 * MiB;
constexpr size_t WS_WPIN = 26 * MiB;
constexpr size_t WS_WC = 28 * MiB;
constexpr size_t WS_WPO = 30 * MiB;
constexpr size_t WS_W13 = 32 * MiB;
constexpr size_t WS_W2 = 96 * MiB;
constexpr size_t WS_Y = 128 * MiB;
constexpr size_t WS_BIG = 192 * MiB;
constexpr size_t WS_OM = WS_BIG;
constexpr size_t WS_HMID = WS_BIG;
constexpr size_t WS_YS = WS_BIG + 72 * MiB;
constexpr size_t WS_U = WS_BIG;
constexpr size_t WS_POOLED = WS_BIG + 64 * MiB;
constexpr size_t WS_H = WS_BIG + 208 * MiB;
constexpr size_t WS_END = WS_BIG + 288 * MiB;
constexpr int CW_CNT = 0;
constexpr int CW_BAR = 1024;
#ifndef CG_SEAM
#define CG_SEAM (-1)
#endif

constexpr int RING_BYTES = 131072;
constexpr int AOFS_OFF = RING_BYTES;
constexpr int MISC_OFF = AOFS_OFF + 8192;
constexpr int LDS_BYTES = 147456;

__device__ __forceinline__ unsigned cvtpk(float lo, float hi) { f32x2 v = {lo, hi}; bf16x2_t b = __builtin_convertvector(v, bf16x2_t); return __builtin_bit_cast(unsigned, b); }
__device__ __forceinline__ float clamp8(float v) { return __builtin_amdgcn_fmed3f(v, -448.0f, 448.0f); }
__device__ __forceinline__ unsigned pack_fp8x4(float a, float b, float c, float d) {
    int r = __builtin_amdgcn_cvt_pk_fp8_f32(clamp8(a), clamp8(b), 0, false); r = __builtin_amdgcn_cvt_pk_fp8_f32(clamp8(c), clamp8(d), r, true); return (unsigned)r; }
__device__ __forceinline__ float bf_lo(unsigned u) { return __uint_as_float(u << 16); }
__device__ __forceinline__ float bf_hi(unsigned u) { return __uint_as_float(u & 0xffff0000u); }
#define DPP_ADD(v, ctrl) ((v) + __builtin_bit_cast(float, __builtin_amdgcn_update_dpp(0, __builtin_bit_cast(int, (v)), (ctrl), 0xF, 0xF, true)))
__device__ __forceinline__ float rows_sum(float v) {
    auto p = __builtin_amdgcn_permlane16_swap(__float_as_uint(v), __float_as_uint(v), false, false);
    const float t = __uint_as_float(p[0]) + __uint_as_float(p[1]);
    auto q = __builtin_amdgcn_permlane32_swap(__float_as_uint(t), __float_as_uint(t), false, false);
    return __uint_as_float(q[0]) + __uint_as_float(q[1]);
}
__device__ __forceinline__ float wave_sum(float v) {
    v = DPP_ADD(v, 0xB1);
    v = DPP_ADD(v, 0x4E);
    v = DPP_ADD(v, 0x141);
    v = DPP_ADD(v, 0x140);
    return rows_sum(v);
}

namespace pg8 {
constexpr int BM = 256, BK = 64, HALF = 128, HTB = HALF * BK * 2, STAGE_BYTES = 8 * HTB, NXCD = 8, WGM = 8;
__host__ __device__ __forceinline__ int lds_byte(int r, int c) { const int st = (r >> 4) * 2 + (c >> 5), rr = r & 15, cc = c & 31, ob = rr * 64 + cc * 2; return st * 1024 + (ob ^ (((ob >> 9) & 1) << 5)); }
__host__ __device__ __forceinline__ void stage_rc(int b, int& R, int& C) { const int st = b / 1024, sb = b % 1024, swz = sb ^ (((sb >> 9) & 1) << 5); R = (st >> 1) * 16 + swz / 64; C = (st & 1) * 32 + (swz % 64) / 2; }
__host__ __device__ __forceinline__ int perm32(int rho) { const int n = rho >> 4, i = rho & 15; return 8 * (i >> 2) + 4 * n + (i & 3); }

struct Unit { int pm, pn, idx; };

struct StaticOrder {
    int nM, nN, nwg, G, c;
    __device__ void init(int nM_, int nN_, int G_, int c_) { nM = nM_; nN = nN_; nwg = nM * nN; G = G_; c = c_; }
    __device__ bool next(int i, Unit& u) const {
        const long L = (long)i * G + c; if (L >= nwg) return false;
        int wgid = (int)L; { const int q = nwg / NXCD, r = nwg % NXCD, xcd = wgid % NXCD, off = wgid / NXCD; wgid = (xcd < r ? xcd * (q + 1) : r * (q + 1) + (xcd - r) * q) + off; }
        const int nig = WGM * nN, gid = wgid / nig, fm = gid * WGM, gsz = (nM - fm) < WGM ? (nM - fm) : WGM;
        u.pm = fm + ((wgid % nig) % gsz); u.pn = (wgid % nig) / gsz; return true;
    }
};

template <class Prob, class Epi, class Sched, bool ALIGN_EPI>
__device__ __forceinline__ void gemm_phase(LAS unsigned char* lds, const Prob& P, const Sched& S, const Epi& E) {
    int tid_ = threadIdx.x; asm volatile("" : "+v"(tid_));
    const int tid = tid_, wid = __builtin_amdgcn_readfirstlane(tid >> 6), lane = tid & 63, wr = wid >> 2, wc = wid & 3, fr = lane & 15, fq = lane >> 4;
    constexpr bool F8 = Prob::F8;
    const int Kb = P.K * (F8 ? 1 : 2), nt = Kb / (BK * 2);
    int Rr[2], Cc[2]; unsigned voffB[2];
#pragma unroll
    for (int i = 0; i < 2; ++i) { int R, C; stage_rc(tid * 16 + i * 8192, R, C); Rr[i] = R; Cc[i] = C; const int Rb = Epi::PERM ? ((R & ~31) + perm32(R & 31)) : R; voffB[i] = (unsigned)(Rb * Kb + C * 2); }
    const unsigned kstep = (unsigned)(BK * 2);
    const unsigned hstep = (unsigned)(HALF * Kb);
    const unsigned ldsw = (unsigned)wid * 1024u;
    const int aoff = lds_byte(wr * 64 + fr, fq * 8), boff = lds_byte(wc * 32 + fr, fq * 8);
    const __amdgpu_buffer_rsrc_t rsA = __builtin_amdgcn_make_buffer_rsrc((void*)P.A, 0, 0xFFFFFFFF, 0x00020000);
    const __amdgpu_buffer_rsrc_t rsB = __builtin_amdgcn_make_buffer_rsrc((void*)P.Bt, 0, 0xFFFFFFFF, 0x00020000);
#define PG8_SA(b, h) (((b) * 2 + (h)) * HTB)
#define PG8_SB(b, h) ((4 + (b) * 2 + (h)) * HTB)
#define PG8_STAGE_B(bufoff, sB) do { _Pragma("unroll") for (int _i = 0; _i < 2; ++_i) \
        __builtin_amdgcn_raw_ptr_buffer_load_lds(rsB, (LAS void*)(lds + (bufoff) + ldsw + _i * 8192), 16, (int)voffB[_i], (int)(sB), 0, 0); } while (0)
#define PG8_STAGE_A(bufoff, kb, o) do { _Pragma("unroll") for (int _i = 0; _i < 2; ++_i) \
        __builtin_amdgcn_raw_ptr_buffer_load_lds(rsA, (LAS void*)(lds + (bufoff) + ldsw + _i * 8192), 16, (int)(o)[_i], (int)(kb), 0, 0); } while (0)
#define PG8_LD2(p_) PG8_CAT(*(const LAS i32x4*)(p_), *(const LAS i32x4*)((p_) + 1024))
#define PG8_LDA(dst, b, h) do { if constexpr (F8) { _Pragma("unroll") for (int m = 0; m < 4; ++m) dst##8[m] = PG8_LD2(lds + PG8_SA(b, h) + aoff + m * 2048); } \
        else { _Pragma("unroll") for (int m = 0; m < 4; ++m) _Pragma("unroll") for (int k = 0; k < 2; ++k) dst[m][k] = *(const LAS bf16x8*)(lds + PG8_SA(b, h) + aoff + m * 2048 + k * 1024); } } while (0)
#define PG8_LDB(dst, b, h) do { if constexpr (F8) { _Pragma("unroll") for (int n = 0; n < 2; ++n) dst##8[n] = PG8_LD2(lds + PG8_SB(b, h) + boff + n * 2048); } \
        else { _Pragma("unroll") for (int n = 0; n < 2; ++n) _Pragma("unroll") for (int k = 0; k < 2; ++k) dst[n][k] = *(const LAS bf16x8*)(lds + PG8_SB(b, h) + boff + n * 2048 + k * 1024); } } while (0)
#define PG8_CAT(x0, x1) __builtin_shufflevector((x0), (x1), 0, 1, 2, 3, 4, 5, 6, 7)
#define PG8_MMA(ai, bj, At, Bt) do { __builtin_amdgcn_s_setprio(1); \
        if constexpr (F8) { _Pragma("unroll") for (int m = 0; m < 4; ++m) _Pragma("unroll") for (int n = 0; n < 2; ++n) \
            acc[ai][bj][m][n] = __builtin_amdgcn_mfma_scale_f32_16x16x128_f8f6f4(Bt##8[n], At##8[m], acc[ai][bj][m][n], 0, 0, 0, 0, 0, 0); } \
        else { _Pragma("unroll") for (int m = 0; m < 4; ++m) _Pragma("unroll") for (int n = 0; n < 2; ++n) _Pragma("unroll") for (int k = 0; k < 2; ++k) \
            acc[ai][bj][m][n] = __builtin_amdgcn_mfma_f32_16x16x32_bf16(Bt[n][k], At[m][k], acc[ai][bj][m][n], 0, 0, 0); } \
        __builtin_amdgcn_s_setprio(0); } while (0)
#define PG8_WAIT_V(n) asm volatile("s_waitcnt vmcnt(" #n ")" ::: "memory")
#define PG8_WAIT_L(n) asm volatile("s_waitcnt lgkmcnt(" #n ")" ::: "memory")
#define PG8_BAR __builtin_amdgcn_s_barrier()
#define PG8_SCHED __builtin_amdgcn_sched_barrier(0)
    Unit cur, nxt; int ui = 0;
    if (!S.next(0, cur)) return;
    cur.idx = 0;
    f32x4 acc[2][2][4][2];
#pragma unroll
    for (int a = 0; a < 2; ++a)
#pragma unroll
        for (int b = 0; b < 2; ++b)
#pragma unroll
            for (int m = 0; m < 4; ++m)
#pragma unroll
                for (int n = 0; n < 2; ++n) acc[a][b][m][n] = (f32x4){0.f, 0.f, 0.f, 0.f};
    bf16x8 At[4][2], B0[2][2], B1[2][2]; i32x8 At8[4], B08[2], B18[2];
    unsigned ca0[2], ca1[2];
    P.a_offs(0, cur, Rr, Cc, ca0, ca1);
    unsigned cB = P.b_off(cur);
    PG8_STAGE_B(PG8_SB(0, 0), cB); PG8_STAGE_B(PG8_SB(0, 1), cB + hstep); PG8_STAGE_A(PG8_SA(0, 0), 0, ca0); PG8_STAGE_A(PG8_SA(0, 1), 0, ca1);
    if (wr == 1) PG8_BAR;
    PG8_WAIT_V(2); PG8_BAR;
    PG8_STAGE_B(PG8_SB(1, 0), cB + kstep); PG8_STAGE_A(PG8_SA(1, 0), kstep, ca0); PG8_STAGE_B(PG8_SB(1, 1), cB + hstep + kstep);
    PG8_WAIT_V(6); PG8_BAR;
    for (;;) {
        const bool has_next = S.next(ui + 1, nxt); nxt.idx = ui + 1;
        unsigned nB = cB;
        if (has_next) nB = P.b_off(nxt);
#pragma unroll 1
        for (int t = 0; t < nt; t += 2) {
            const bool last = (t == nt - 2);
            const unsigned k1 = (unsigned)(t + 1) * kstep;
            const unsigned k2 = last ? 0u : (unsigned)(t + 2) * kstep, k3 = k2 + kstep;
            const unsigned b2 = last ? nB : cB + (unsigned)(t + 2) * kstep; const unsigned b3 = b2 + kstep;
            PG8_LDB(B0, 0, 0); PG8_LDB(B1, 0, 1); PG8_SCHED; PG8_LDA(At, 0, 0); PG8_STAGE_A(PG8_SA(1, 1), k1, ca1);
            if (last && has_next) {
                int tq = threadIdx.x; asm volatile("" : "+v"(tq)); int R2[2], C2[2];
#pragma unroll
                for (int i = 0; i < 2; ++i) stage_rc(tq * 16 + i * 8192, R2[i], C2[i]);
                P.a_offs(ui + 1, nxt, R2, C2, ca0, ca1);
            }
            PG8_WAIT_V(8); PG8_WAIT_L(0); PG8_BAR; PG8_MMA(0, 0, At, B0); PG8_MMA(0, 1, At, B1); PG8_BAR; PG8_SCHED;
            PG8_LDA(At, 0, 1); PG8_STAGE_B(PG8_SB(0, 0), b2); PG8_STAGE_B(PG8_SB(0, 1), b2 + hstep); PG8_STAGE_A(PG8_SA(0, 0), k2, ca0);
            PG8_WAIT_V(8); PG8_WAIT_L(0); PG8_BAR; PG8_MMA(1, 0, At, B0); PG8_MMA(1, 1, At, B1); PG8_BAR; PG8_SCHED;
            PG8_LDB(B0, 1, 0); PG8_LDB(B1, 1, 1); PG8_SCHED; PG8_LDA(At, 1, 0); PG8_STAGE_A(PG8_SA(0, 1), k2, ca1);
            PG8_WAIT_V(8); PG8_WAIT_L(0); PG8_BAR; PG8_MMA(0, 0, At, B0); PG8_MMA(0, 1, At, B1); PG8_BAR; PG8_SCHED;
            PG8_LDA(At, 1, 1); PG8_STAGE_B(PG8_SB(1, 0), b3); PG8_STAGE_B(PG8_SB(1, 1), b3 + hstep); PG8_STAGE_A(PG8_SA(1, 0), k3, ca0);
            PG8_WAIT_V(8); PG8_WAIT_L(0); PG8_BAR; PG8_MMA(1, 0, At, B0); PG8_MMA(1, 1, At, B1); PG8_BAR; PG8_SCHED;
        }
        if constexpr (ALIGN_EPI) { if (wr == 0) PG8_BAR; }
        { int te = threadIdx.x; asm volatile("" : "+v"(te));
          E(acc, cur, wr, wc, te & 15, (te >> 4) & 3); }
        if (!has_next) break;
#pragma unroll
        for (int a = 0; a < 2; ++a)
#pragma unroll
            for (int b = 0; b < 2; ++b)
#pragma unroll
                for (int m = 0; m < 4; ++m)
#pragma unroll
                    for (int n = 0; n < 2; ++n) acc[a][b][m][n] = (f32x4){0.f, 0.f, 0.f, 0.f};
        cur = nxt; cB = nB; ++ui;
        if constexpr (ALIGN_EPI) { if (wr == 1) PG8_BAR; }
    }
    PG8_WAIT_V(0);
    if constexpr (!ALIGN_EPI) { if (wr == 0) PG8_BAR; }
    PG8_BAR;
#undef PG8_SA
#undef PG8_SB
#undef PG8_STAGE_A
#undef PG8_STAGE_B
#undef PG8_LDA
#undef PG8_LD2
#undef PG8_LDB
#undef PG8_MMA
#undef PG8_CAT
#undef PG8_WAIT_V
#undef PG8_WAIT_L
#undef PG8_BAR
#undef PG8_SCHED
}

template <bool F8_>
struct DenseProbT {
    static constexpr bool F8 = F8_;
    const void* A; const void* Bt; int K, lda, acolstep; size_t bstep_pn;
    __device__ __forceinline__ void a_offs(int, const Unit& u, const int (&R)[2], const int (&C)[2], unsigned (&o0)[2], unsigned (&o1)[2]) const {
        constexpr int esz = F8 ? 1 : 2;
#pragma unroll
        for (int i = 0; i < 2; ++i) { const unsigned b = (unsigned)(((u.pm * BM + R[i]) * lda + u.pn * acolstep) * esz + C[i] * 2); o0[i] = b; o1[i] = b + (unsigned)(HALF * lda * esz); }
    }
    __device__ __forceinline__ unsigned b_off(const Unit& u) const { return (unsigned)((size_t)u.pn * bstep_pn * (F8 ? 1 : 2)); }
};
typedef DenseProbT<false> DenseProb;
}

struct Params {
    const float* x; const int* positions; const float* norm_mix; const float* norm_ffn; const float* norm_final;
    const float* attn_w_in; const float* attn_w_out; const float* pool_w_in; const float* pool_w_group; const float* pool_scale; const float* pool_w_out;
    const float* router_group_w; const float* router_group_b; const float* router_expert_w; const float* router_expert_b;
    const float* expert_w1; const float* expert_w3; const float* expert_w2;
    float* out; unsigned char* ws;
    int ph_lo, ph_hi;
};

template <class MapN>
__device__ __forceinline__ void transpose_item(const float* W, int ldw, int K, bf16* WT, MapN mapn, LAS float* scr, int k0, int n0, int lane) {
#pragma unroll 8
    for (int i = 0; i < 32; ++i) { const int kk = 2 * i + (lane >> 5); scr[kk * 33 + (lane & 31)] = W[(size_t)(k0 + kk) * ldw + n0 + (lane & 31)]; }
    asm volatile("s_waitcnt lgkmcnt(0)" ::: "memory");
    const int c = lane & 7;
#pragma unroll
    for (int j = 0; j < 4; ++j) { const int n = (lane >> 3) + 8 * j; const LAS float* s = scr + (8 * c) * 33 + n;
        u32x4 o; o.x = cvtpk(s[0 * 33], s[1 * 33]); o.y = cvtpk(s[2 * 33], s[3 * 33]); o.z = cvtpk(s[4 * 33], s[5 * 33]); o.w = cvtpk(s[6 * 33], s[7 * 33]);
        *(u32x4*)(WT + (size_t)mapn(n0 + n) * K + k0 + 8 * c) = o; }
    asm volatile("s_waitcnt lgkmcnt(0)" ::: "memory");
}
template <class MapN>
__device__ __forceinline__ void transpose_item8(const float* W, int ldw, int K, unsigned char* WT, MapN mapn, float sc, LAS float* scr, int k0, int n0, int lane) {
#pragma unroll 8
    for (int i = 0; i < 32; ++i) { const int kk = 2 * i + (lane >> 5); scr[kk * 33 + (lane & 31)] = W[(size_t)(k0 + kk) * ldw + n0 + (lane & 31)]; }
    asm volatile("s_waitcnt lgkmcnt(0)" ::: "memory");
    const int c = lane & 7;
#pragma unroll
    for (int j = 0; j < 4; ++j) { const int n = (lane >> 3) + 8 * j; const LAS float* s = scr + (8 * c) * 33 + n;
        u32x2 o; o.x = pack_fp8x4(s[0 * 33] * sc, s[1 * 33] * sc, s[2 * 33] * sc, s[3 * 33] * sc); o.y = pack_fp8x4(s[4 * 33] * sc, s[5 * 33] * sc, s[6 * 33] * sc, s[7 * 33] * sc);
        *(u32x2*)(WT + (size_t)mapn(n0 + n) * K + k0 + 8 * c) = o; }
    asm volatile("s_waitcnt lgkmcnt(0)" ::: "memory");
}
struct MapId { __device__ __forceinline__ int operator()(int n) const { return n; } };
struct MapQKV {
    __device__ __forceinline__ int operator()(int n) const { const int rem = n % 1536, kind = rem / 512, d = n & 63; if (kind < 2 && d < 16) return n - d + (d < 8 ? 2 * d : 2 * (d - 8) + 1); return n; }
};
struct MapW13 { int add; __device__ __forceinline__ int operator()(int n) const { return (n >> 7) * 256 + add + (n & 127); } };

struct RowPassCfg {
    const float* hin;
    const bf16* hin16;
    const bf16* ys; const int* slotref; const int* cnt_prev;
    bf16* hout;
    const float* gain;
    bf16* yout;
    unsigned char* yout8;
    float* fout;
    const float* rgw; const float* rgb; const float* rew; const float* reb;
    int* cnt; int* list; float* gatel; int* slotref_out;
};

__device__ __forceinline__ void route_decide(const float (&a)[20], const float* rgb, const float* reb, int& e0, int& e1, float& g0, float& g1) {
    float lg[4];
#pragma unroll
    for (int g = 0; g < 4; ++g) lg[g] = a[g] + rgb[g];
    int gs = 0; float gm = lg[0];
#pragma unroll
    for (int g = 1; g < 4; ++g) if (lg[g] > gm) { gm = lg[g]; gs = g; }
    float den = 0.f;
#pragma unroll
    for (int g = 0; g < 4; ++g) den += __expf(lg[g] - gm);
    const float gate1 = 1.0f / den;
    float le[4];
#pragma unroll
    for (int e = 0; e < 4; ++e) { const float sel = gs == 0 ? a[4 + e] : gs == 1 ? a[8 + e] : gs == 2 ? a[12 + e] : a[16 + e]; le[e] = sel + reb[gs * 4 + e]; }
    int i0 = 0; float v0 = le[0];
#pragma unroll
    for (int e = 1; e < 4; ++e) if (le[e] > v0) { v0 = le[e]; i0 = e; }
    int i1 = -1; float v1 = -INFINITY;
#pragma unroll
    for (int e = 0; e < 4; ++e) if (e != i0 && le[e] > v1) { v1 = le[e]; i1 = e; }
    const float ex = __expf(v1 - v0), p0 = 1.0f / (1.0f + ex), p1 = ex * p0;
    e0 = gs * 4 + i0; e1 = gs * 4 + i1; g0 = gate1 * p0; g1 = gate1 * p1;
}

template <bool COMBINE, bool ROUTER, bool HIN16>
__device__ __forceinline__ void row_pass(LAS unsigned char* lds, const RowPassCfg& c, int vcu, int wave) {
    int tid = threadIdx.x; asm volatile("" : "+v"(tid)); const int lane = tid & 63;
    LAS float* Wr = (LAS float*)lds;
    LAS int* selE = (LAS int*)(lds + 81920);
    LAS float* selG = (LAS float*)(lds + 81920 + 1024);
    LAS int* wcnt = (LAS int*)(lds + 81920 + 2048);
    LAS int* tb = (LAS int*)(lds + MISC_OFF);
    if (ROUTER) {
        for (int k = tid; k < 1024; k += NTHREADS) {
            const f32x4 g4 = *(const f32x4*)(c.rgw + (size_t)k * 4);
            Wr[0 * 1024 + k] = g4.x; Wr[1 * 1024 + k] = g4.y; Wr[2 * 1024 + k] = g4.z; Wr[3 * 1024 + k] = g4.w;
#pragma unroll
            for (int g = 0; g < 4; ++g) { const f32x4 e4 = *(const f32x4*)(c.rew + ((size_t)g * 1024 + k) * 4);
                Wr[(4 + g * 4 + 0) * 1024 + k] = e4.x; Wr[(4 + g * 4 + 1) * 1024 + k] = e4.y; Wr[(4 + g * 4 + 2) * 1024 + k] = e4.z; Wr[(4 + g * 4 + 3) * 1024 + k] = e4.w; }
        }
    }
    if (COMBINE) {
        if (tid == 0) { int sacc = 0; for (int e = 0; e < NE; ++e) { tb[e] = sacc; sacc += (c.cnt_prev[e] + 255) >> 8; } tb[NE] = sacc; }
    }
    __syncthreads();
    f32x4 gn[4];
#pragma unroll
    for (int j = 0; j < 4; ++j) gn[j] = *(const f32x4*)(c.gain + 4 * lane + 256 * j);
    for (int rb = vcu; rb < T / 128; rb += gridDim.x) {
        const int rbase = rb * 128 + wave * 16;
        int refs = 0;
        if (COMBINE) { if (lane < 32) refs = c.slotref[rbase * 2 + lane]; }
        f32x4 hv[2][2][4]; u32x2 hb[2][2][4]; u32x2 yv[2][2][2][4];
#define RP_ISSUE(buf, pr) do { _Pragma("unroll") for (int r = 0; r < 2; ++r) { const int row = rbase + 2 * (pr) + r; \
            if (HIN16) { _Pragma("unroll") for (int j = 0; j < 4; ++j) hb[buf][r][j] = *(const u32x2*)(c.hin16 + (size_t)row * D + 4 * lane + 256 * j); } \
            else { _Pragma("unroll") for (int j = 0; j < 4; ++j) hv[buf][r][j] = *(const f32x4*)(c.hin + (size_t)row * D + 4 * lane + 256 * j); } \
            if (COMBINE) { _Pragma("unroll") for (int sl = 0; sl < 2; ++sl) { const int ref = __builtin_amdgcn_readlane(refs, (2 * (pr) + r) * 2 + sl); const int e = ref >> 15, pos = ref & 32767; \
                if (FP8_YS) { const unsigned char* yr = (const unsigned char*)c.ys + ((size_t)tb[e] * 256 + pos) * D; \
                    _Pragma("unroll") for (int j = 0; j < 4; ++j) yv[buf][r][sl][j].x = *(const unsigned*)(yr + 4 * lane + 256 * j); } \
                else { const bf16* yr = c.ys + ((size_t)tb[e] * 256 + pos) * D; \
                    _Pragma("unroll") for (int j = 0; j < 4; ++j) yv[buf][r][sl][j] = *(const u32x2*)(yr + 4 * lane + 256 * j); } } } } } while (0)
#define RP_PROCESS(buf, pr) do { f32x4 v[2][4]; \
            _Pragma("unroll") for (int r = 0; r < 2; ++r) { const int row = rbase + 2 * (pr) + r; \
                _Pragma("unroll") for (int j = 0; j < 4; ++j) { if (HIN16) { const u32x2 w0 = hb[buf][r][j]; v[r][j] = (f32x4){bf_lo(w0.x), bf_hi(w0.x), bf_lo(w0.y), bf_hi(w0.y)}; } else v[r][j] = hv[buf][r][j]; \
                    if (COMBINE) { _Pragma("unroll") for (int sl = 0; sl < 2; ++sl) { const u32x2 w = yv[buf][r][sl][j]; \
                        if (FP8_YS) { const f32x2 lo2 = __builtin_amdgcn_cvt_pk_f32_fp8((int)w.x, false), hi2 = __builtin_amdgcn_cvt_pk_f32_fp8((int)w.x, true); \
                            v[r][j].x += lo2.x * (1.0f / 64.0f); v[r][j].y += lo2.y * (1.0f / 64.0f); v[r][j].z += hi2.x * (1.0f / 64.0f); v[r][j].w += hi2.y * (1.0f / 64.0f); } \
                        else { v[r][j].x += bf_lo(w.x); v[r][j].y += bf_hi(w.x); v[r][j].z += bf_lo(w.y); v[r][j].w += bf_hi(w.y); } } } } \
                if (c.hout) { _Pragma("unroll") for (int j = 0; j < 4; ++j) { u32x2 w; w.x = cvtpk(v[r][j].x, v[r][j].y); w.y = cvtpk(v[r][j].z, v[r][j].w); *(u32x2*)(c.hout + (size_t)row * D + 4 * lane + 256 * j) = w; \
                    v[r][j] = (f32x4){bf_lo(w.x), bf_hi(w.x), bf_lo(w.y), bf_hi(w.y)}; } } \
                float ss = 0.f; \
                _Pragma("unroll") for (int j = 0; j < 4; ++j) ss += (v[r][j].x * v[r][j].x + v[r][j].y * v[r][j].y) + (v[r][j].z * v[r][j].z + v[r][j].w * v[r][j].w); \
                const float rstd = 1.0f / sqrtf(wave_sum(ss) * (1.0f / D) + RMS_EPS); \
                _Pragma("unroll") for (int j = 0; j < 4; ++j) { v[r][j].x = v[r][j].x * rstd * gn[j].x; v[r][j].y = v[r][j].y * rstd * gn[j].y; v[r][j].z = v[r][j].z * rstd * gn[j].z; v[r][j].w = v[r][j].w * rstd * gn[j].w; } \
                if (c.yout) { _Pragma("unroll") for (int j = 0; j < 4; ++j) { u32x2 w; w.x = cvtpk(v[r][j].x, v[r][j].y); w.y = cvtpk(v[r][j].z, v[r][j].w); *(u32x2*)(c.yout + (size_t)row * D + 4 * lane + 256 * j) = w; } } \
                if (c.yout8) { _Pragma("unroll") for (int j = 0; j < 4; ++j) *(unsigned*)(c.yout8 + (size_t)row * D + 4 * lane + 256 * j) = pack_fp8x4(v[r][j].x, v[r][j].y, v[r][j].z, v[r][j].w); } \
                if (c.fout) { _Pragma("unroll") for (int j = 0; j < 4; ++j) *(f32x4*)(c.fout + (size_t)row * D + 4 * lane + 256 * j) = v[r][j]; } } \
            if (ROUTER) { float a0[20], a1[20]; f32x2 vv[4][4];        \
                _Pragma("unroll") for (int j = 0; j < 4; ++j) { vv[j][0] = (f32x2){v[0][j].x, v[1][j].x}; vv[j][1] = (f32x2){v[0][j].y, v[1][j].y}; vv[j][2] = (f32x2){v[0][j].z, v[1][j].z}; vv[j][3] = (f32x2){v[0][j].w, v[1][j].w}; } \
                _Pragma("unroll") for (int o = 0; o < 20; ++o) { f32x2 s2 = {0.f, 0.f}; \
                    _Pragma("unroll") for (int j = 0; j < 4; ++j) { const f32x4 w = *(const LAS f32x4*)(Wr + o * 1024 + 4 * lane + 256 * j); \
                        s2 = __builtin_elementwise_fma(vv[j][0], (f32x2){w.x, w.x}, s2); s2 = __builtin_elementwise_fma(vv[j][1], (f32x2){w.y, w.y}, s2); \
                        s2 = __builtin_elementwise_fma(vv[j][2], (f32x2){w.z, w.z}, s2); s2 = __builtin_elementwise_fma(vv[j][3], (f32x2){w.w, w.w}, s2); } \
                    a0[o] = s2.x; a1[o] = s2.y; if ((o & 3) == 3) __builtin_amdgcn_sched_barrier(0); } \
                _Pragma("unroll") for (int o = 0; o < 20; ++o) { a0[o] = DPP_ADD(a0[o], 0xB1); a1[o] = DPP_ADD(a1[o], 0xB1); } \
                _Pragma("unroll") for (int o = 0; o < 20; ++o) { a0[o] = DPP_ADD(a0[o], 0x4E); a1[o] = DPP_ADD(a1[o], 0x4E); } \
                _Pragma("unroll") for (int o = 0; o < 20; ++o) { a0[o] = DPP_ADD(a0[o], 0x141); a1[o] = DPP_ADD(a1[o], 0x141); } \
                _Pragma("unroll") for (int o = 0; o < 20; ++o) { a0[o] = DPP_ADD(a0[o], 0x140); a1[o] = DPP_ADD(a1[o], 0x140); } \
                _Pragma("unroll") for (int o = 0; o < 20; ++o) { a0[o] = rows_sum(a0[o]); a1[o] = rows_sum(a1[o]); if (o & 1) __builtin_amdgcn_sched_barrier(0); } \
                int e0, e1; float g0, g1; const int rl = wave * 16 + 2 * (pr); \
                route_decide(a0, c.rgb, c.reb, e0, e1, g0, g1); if (lane == 0) { selE[rl * 2] = e0; selE[rl * 2 + 1] = e1; selG[rl * 2] = g0; selG[rl * 2 + 1] = g1; } \
                route_decide(a1, c.rgb, c.reb, e0, e1, g0, g1); if (lane == 0) { selE[rl * 2 + 2] = e0; selE[rl * 2 + 3] = e1; selG[rl * 2 + 2] = g0; selG[rl * 2 + 3] = g1; } } } while (0)
        RP_ISSUE(0, 0);
#pragma unroll 1
        for (int it = 0; it < 4; ++it) {
            RP_ISSUE(1, 2 * it + 1);
            RP_PROCESS(0, 2 * it);
            if (it < 3) RP_ISSUE(0, 2 * it + 2);
            RP_PROCESS(1, 2 * it + 1);
        }
#undef RP_ISSUE
#undef RP_PROCESS
        if (ROUTER) {
            __syncthreads();
            int e = 0, rank = 0;
            if (tid < 256) {
                e = selE[tid]; int mycount = 0;
#pragma unroll
                for (int x = 0; x < NE; ++x) { const unsigned long long mask = __ballot(e == x); if (e == x) rank = __popcll(mask & ((1ull << lane) - 1ull)); if (lane == x) mycount = __popcll(mask); }
                if (lane < NE) wcnt[(tid >> 6) * 16 + lane] = mycount;
            }
            __syncthreads();
            if (tid < NE) { const int c0 = wcnt[tid], c1 = wcnt[16 + tid], c2 = wcnt[32 + tid], c3 = wcnt[48 + tid]; const int tot = c0 + c1 + c2 + c3;
                int base = 0; if (tot) base = atomicAdd(c.cnt + tid, tot);
                wcnt[tid] = base; wcnt[16 + tid] = base + c0; wcnt[32 + tid] = base + c0 + c1; wcnt[48 + tid] = base + c0 + c1 + c2; }
            __syncthreads();
            if (tid < 256) { const int pos = wcnt[(tid >> 6) * 16 + e] + rank; const int tok = rb * 128 + (tid >> 1);
                c.list[e * T + pos] = tok; c.gatel[e * T + pos] = selG[tid]; c.slotref_out[tok * 2 + (tid & 1)] = e * 32768 + pos; }
            __syncthreads();
        }
    }
    __syncthreads();
}

constexpr int RW_STRIDE = 2064;
__device__ __forceinline__ void router_pass(LAS unsigned char* lds, const RowPassCfg& c, int vcu, int wave) {
    int tid = threadIdx.x; asm volatile("" : "+v"(tid)); const int lane = tid & 63, r16 = lane & 15, kg = lane >> 4;
    LAS unsigned char* Wh = lds;
    LAS unsigned char* Wl = lds + 20 * RW_STRIDE;
    LAS float* gl = (LAS float*)(lds + 40 * RW_STRIDE);
    LAS int* selE = (LAS int*)(lds + 86656);
    LAS float* selG = (LAS float*)(lds + 86656 + 1024);
    LAS int* wcnt = (LAS int*)(lds + 86656 + 2048);
    LAS float* tr = (LAS float*)(lds + 90112) + wave * 512;
    for (int kp = tid; kp < 512; kp += NTHREADS) {
        const int k = 2 * kp;
#pragma unroll 1
        for (int v5 = 0; v5 < 5; ++v5) {
            const float* src = (v5 == 0) ? (c.rgw + (size_t)k * 4) : (c.rew + ((size_t)(v5 - 1) * 1024 + k) * 4);
            const f32x4 a = *(const f32x4*)src, b = *(const f32x4*)(src + 4);
#pragma unroll
            for (int q = 0; q < 4; ++q) { const int o = v5 * 4 + q; const unsigned hi = cvtpk(a[q], b[q]); const unsigned lo = cvtpk(a[q] - bf_lo(hi), b[q] - bf_hi(hi));
                *(LAS unsigned*)(Wh + o * RW_STRIDE + k * 2) = hi; *(LAS unsigned*)(Wl + o * RW_STRIDE + k * 2) = lo; }
        }
    }
    for (int k = tid; k < 1024; k += NTHREADS) gl[k] = c.gain[k];
    __syncthreads();
    typedef unsigned u32x2v __attribute__((ext_vector_type(2)));
    const __amdgpu_buffer_rsrc_t rsH = __builtin_amdgcn_make_buffer_rsrc((void*)c.hin16, 0, 0xFFFFFFFF, 0x00020000);
    const __amdgpu_buffer_rsrc_t rsY = __builtin_amdgcn_make_buffer_rsrc((void*)c.yout8, 0, 0xFFFFFFFF, 0x00020000);
    const int oc0 = r16, oc1 = (16 + r16) < 20 ? (16 + r16) : 19;
    for (int rb = vcu; rb < T / 128; rb += gridDim.x) {
        const int row = rb * 128 + wave * 16 + r16;
        u32x4 hreg[32];
        const unsigned voff = (unsigned)row * (unsigned)(D * 2) + (unsigned)kg * 16u;
#pragma unroll
        for (int s_ = 0; s_ < 32; ++s_) hreg[s_] = __builtin_bit_cast(u32x4, __builtin_amdgcn_raw_buffer_load_b128(rsH, (int)voff + s_ * 64, 0, 0));
        const unsigned yoff = (unsigned)row * (unsigned)D + (unsigned)kg * 8u;
        float ss = 0.f;
#pragma unroll
        for (int s_ = 0; s_ < 32; ++s_)
#pragma unroll
            for (int q = 0; q < 4; ++q) { unsigned hw = hreg[s_][q]; asm volatile("" : "+v"(hw));
                const float a = bf_lo(hw), b = bf_hi(hw); ss = __builtin_fmaf(a, a, ss); ss = __builtin_fmaf(b, b, ss); }
        const float rstd = 1.0f / sqrtf(rows_sum(ss) * (1.0f / D) + RMS_EPS);
        f32x4 acc0 = {0.f, 0.f, 0.f, 0.f}, acc1 = {0.f, 0.f, 0.f, 0.f};
#pragma unroll
        for (int s_ = 0; s_ < 32; ++s_) {
            const int kb = 32 * s_ + 8 * kg;
            const f32x4 g0 = *(const LAS f32x4*)(gl + kb), g1 = *(const LAS f32x4*)(gl + kb + 4);
            float y[8];
            y[0] = bf_lo(hreg[s_][0]) * rstd * g0.x; y[1] = bf_hi(hreg[s_][0]) * rstd * g0.y; y[2] = bf_lo(hreg[s_][1]) * rstd * g0.z; y[3] = bf_hi(hreg[s_][1]) * rstd * g0.w;
            y[4] = bf_lo(hreg[s_][2]) * rstd * g1.x; y[5] = bf_hi(hreg[s_][2]) * rstd * g1.y; y[6] = bf_lo(hreg[s_][3]) * rstd * g1.z; y[7] = bf_hi(hreg[s_][3]) * rstd * g1.w;
            u32x4 yh, yl;
#pragma unroll
            for (int q = 0; q < 4; ++q) { yh[q] = cvtpk(y[2 * q], y[2 * q + 1]); yl[q] = cvtpk(y[2 * q] - bf_lo(yh[q]), y[2 * q + 1] - bf_hi(yh[q])); }
            { u32x2 w8; w8.x = pack_fp8x4(y[0], y[1], y[2], y[3]); w8.y = pack_fp8x4(y[4], y[5], y[6], y[7]); __builtin_amdgcn_raw_buffer_store_b64(__builtin_bit_cast(u32x2v, w8), rsY, (int)yoff + s_ * 32, 0, 0); }
            const bf16x8 bh0 = *(const LAS bf16x8*)(Wh + oc0 * RW_STRIDE + kb * 2), bh1 = *(const LAS bf16x8*)(Wh + oc1 * RW_STRIDE + kb * 2);
            const bf16x8 bl0 = *(const LAS bf16x8*)(Wl + oc0 * RW_STRIDE + kb * 2), bl1 = *(const LAS bf16x8*)(Wl + oc1 * RW_STRIDE + kb * 2);
            const bf16x8 ah = __builtin_bit_cast(bf16x8, yh), al = __builtin_bit_cast(bf16x8, yl);
            acc0 = __builtin_amdgcn_mfma_f32_16x16x32_bf16(ah, bh0, acc0, 0, 0, 0); acc1 = __builtin_amdgcn_mfma_f32_16x16x32_bf16(ah, bh1, acc1, 0, 0, 0);
            acc0 = __builtin_amdgcn_mfma_f32_16x16x32_bf16(al, bh0, acc0, 0, 0, 0); acc1 = __builtin_amdgcn_mfma_f32_16x16x32_bf16(al, bh1, acc1, 0, 0, 0);
            acc0 = __builtin_amdgcn_mfma_f32_16x16x32_bf16(ah, bl0, acc0, 0, 0, 0); acc1 = __builtin_amdgcn_mfma_f32_16x16x32_bf16(ah, bl1, acc1, 0, 0, 0);
            __builtin_amdgcn_sched_barrier(0);
        }
#pragma unroll
        for (int e = 0; e < 4; ++e) { tr[(4 * kg + e) * 32 + r16] = acc0[e]; tr[(4 * kg + e) * 32 + 16 + r16] = acc1[e]; }
        asm volatile("s_waitcnt lgkmcnt(0)" ::: "memory");
        if (lane < 16) {
            float a[20];
#pragma unroll
            for (int o = 0; o < 20; ++o) a[o] = tr[lane * 32 + o];
            int e0, e1; float g0_, g1_; route_decide(a, c.rgb, c.reb, e0, e1, g0_, g1_);
            const int rl = wave * 16 + lane;
            selE[rl * 2] = e0; selE[rl * 2 + 1] = e1; selG[rl * 2] = g0_; selG[rl * 2 + 1] = g1_;
        }
        __syncthreads();
        int e = 0, rank = 0;
        if (tid < 256) {
            e = selE[tid]; int mycount = 0;
#pragma unroll
            for (int x = 0; x < NE; ++x) { const unsigned long long mask = __ballot(e == x); if (e == x) rank = __popcll(mask & ((1ull << lane) - 1ull)); if (lane == x) mycount = __popcll(mask); }
            if (lane < NE) wcnt[(tid >> 6) * 16 + lane] = mycount;
        }
        __syncthreads();
        if (tid < NE) { const int c0 = wcnt[tid], c1 = wcnt[16 + tid], c2 = wcnt[32 + tid], c3 = wcnt[48 + tid]; const int tot = c0 + c1 + c2 + c3;
            int base = 0; if (tot) base = atomicAdd(c.cnt + tid, tot);
            wcnt[tid] = base; wcnt[16 + tid] = base + c0; wcnt[32 + tid] = base + c0 + c1; wcnt[48 + tid] = base + c0 + c1 + c2; }
        __syncthreads();
        if (tid < 256) { const int pos = wcnt[(tid >> 6) * 16 + e] + rank; const int tok = rb * 128 + (tid >> 1);
            c.list[e * T + pos] = tok; c.gatel[e * T + pos] = selG[tid]; c.slotref_out[tok * 2 + (tid & 1)] = e * 32768 + pos; }
        __syncthreads();
    }
    __syncthreads();
}

namespace att {
constexpr float C2 = 0.125f * 1.4426950408889634f;
constexpr float LN2 = 0.6931471805599453f;
__device__ __forceinline__ int crow(int r, int hi) { return (r & 3) + 8 * (r >> 2) + 4 * hi; }
typedef short v4i16_t __attribute__((ext_vector_type(4)));
__device__ __forceinline__ s16x4 vtr(const LAS unsigned char* p) { return __builtin_bit_cast(s16x4, __builtin_amdgcn_ds_read_tr16_b64_v4i16((LAS v4i16_t*)p)); }

struct Item { int b, g, hh, dil, j, ph; };
__device__ __forceinline__ Item decode_item(int pp, int half) {
    Item it; it.hh = pp & 7; const int q8 = (pp >> 3) & 7; it.g = (pp >> 6) % 3; it.b = pp / 192;
    const int idx16 = q8 * 2 + half; it.dil = it.g == 0 ? 1 : (it.g == 1 ? 4 : 16); const int nb = 16 / it.dil; it.j = idx16 % nb; it.ph = idx16 / nb; return it;
}
__device__ __forceinline__ int kswz(int kv) { return (kv ^ (kv >> 3)) & 7; }
__device__ __forceinline__ u32x4 fp8x8_to_bf16(unsigned a, unsigned b) {
    const f32x2 a0 = __builtin_amdgcn_cvt_pk_f32_fp8((int)a, false), a1 = __builtin_amdgcn_cvt_pk_f32_fp8((int)a, true), b0 = __builtin_amdgcn_cvt_pk_f32_fp8((int)b, false), b1 = __builtin_amdgcn_cvt_pk_f32_fp8((int)b, true);
    return (u32x4){cvtpk(a0.x, a0.y), cvtpk(a1.x, a1.y), cvtpk(b0.x, b0.y), cvtpk(b1.x, b1.y)};
}

template <int MODE>
__device__ __forceinline__ void attn_phase(LAS unsigned char* lds, const bf16* qkv, bf16* og, float* lse, int vcu, int G) {
    int tid_ = threadIdx.x; asm volatile("" : "+v"(tid_));
    const int tid = tid_, lane = tid & 63, wid = __builtin_amdgcn_readfirstlane(tid >> 6);
    const int half = wid >> 2, w = wid & 3, r32 = lane & 31, hi = lane >> 5, th = tid & 255;
    LAS unsigned char* Kl = lds + half * 69632;
    LAS unsigned char* Vl = Kl + 36864;
    u32x4 kreg[4][2], vreg[4][2]; bf16x8 qbuf[2][4];
    u32x2 qraw[2][4];
    int skv[2], sc[2];
#pragma unroll
    for (int i = 0; i < 2; ++i) { const int P_ = th + 256 * i; skv[i] = P_ >> 3; sc[i] = P_ & 7; }
    const int skv8 = th >> 2, sc16 = th & 3;
    const __amdgpu_buffer_rsrc_t rsQ = __builtin_amdgcn_make_buffer_rsrc((void*)qkv, 0, 0xFFFFFFFF, 0x00020000);
    typedef unsigned u32x4v __attribute__((ext_vector_type(4)));
#if FP8_QKVS
#define ATT_ISSUE(IT, PAR) do { const unsigned rstrideB_ = (unsigned)(IT).dil * (unsigned)QKVW; \
        const unsigned baseB_ = (unsigned)(((IT).b * SEQ + (IT).ph) * QKVW + (IT).g * 1536 + (IT).hh * 64); const int l0_ = 128 * ((IT).j - 1); \
        const unsigned vo_ = (unsigned)skv8 * rstrideB_ + (unsigned)sc16 * 16u; \
        _Pragma("unroll") for (int tt = 0; tt < 4; ++tt) { if (tt >= 2 || (IT).j != 0) { const unsigned so_ = baseB_ + (unsigned)(l0_ + 64 * tt) * rstrideB_; \
            kreg[tt][0] = __builtin_bit_cast(u32x4, __builtin_amdgcn_raw_buffer_load_b128(rsQ, (int)vo_, (int)(so_ + 512u), 0)); vreg[tt][0] = __builtin_bit_cast(u32x4, __builtin_amdgcn_raw_buffer_load_b128(rsQ, (int)vo_, (int)(so_ + 1024u), 0)); } } \
        const unsigned qo_ = (unsigned)(32 * w + r32) * rstrideB_ + (unsigned)hi * 8u, qs_ = baseB_ + (unsigned)(128 * (IT).j) * rstrideB_; \
        _Pragma("unroll") for (int d0 = 0; d0 < 4; ++d0) qraw[PAR][d0] = __builtin_bit_cast(u32x2, __builtin_amdgcn_raw_buffer_load_b64(rsQ, (int)qo_, (int)(qs_ + (unsigned)d0 * 16u), 0)); } while (0)
#else
#define ATT_ISSUE(IT, PAR) do { const unsigned rstrideB_ = (unsigned)(IT).dil * (unsigned)(QKVW * 2); \
        const unsigned baseB_ = (unsigned)(((IT).b * SEQ + (IT).ph) * QKVW + (IT).g * 1536 + (IT).hh * 64) * 2u; const int l0_ = 128 * ((IT).j - 1); \
        const unsigned vo0_ = (unsigned)skv[0] * rstrideB_ + (unsigned)sc[0] * 16u, vo1_ = (unsigned)skv[1] * rstrideB_ + (unsigned)sc[1] * 16u; \
        _Pragma("unroll") for (int tt = 0; tt < 4; ++tt) { if (tt >= 2 || (IT).j != 0) { const unsigned so_ = baseB_ + (unsigned)(l0_ + 64 * tt) * rstrideB_; \
            kreg[tt][0] = __builtin_bit_cast(u32x4, __builtin_amdgcn_raw_buffer_load_b128(rsQ, (int)vo0_, (int)(so_ + 1024u), 0)); vreg[tt][0] = __builtin_bit_cast(u32x4, __builtin_amdgcn_raw_buffer_load_b128(rsQ, (int)vo0_, (int)(so_ + 2048u), 0)); \
            kreg[tt][1] = __builtin_bit_cast(u32x4, __builtin_amdgcn_raw_buffer_load_b128(rsQ, (int)vo1_, (int)(so_ + 1024u), 0)); vreg[tt][1] = __builtin_bit_cast(u32x4, __builtin_amdgcn_raw_buffer_load_b128(rsQ, (int)vo1_, (int)(so_ + 2048u), 0)); } } \
        const unsigned qo_ = (unsigned)(32 * w + r32) * rstrideB_ + (unsigned)hi * 16u, qs_ = baseB_ + (unsigned)(128 * (IT).j) * rstrideB_; \
        _Pragma("unroll") for (int d0 = 0; d0 < 4; ++d0) qbuf[PAR][d0] = __builtin_bit_cast(bf16x8, __builtin_amdgcn_raw_buffer_load_b128(rsQ, (int)qo_, (int)(qs_ + (unsigned)d0 * 32u), 0)); } while (0)
#endif
    int pp = vcu;
    Item cur = decode_item(pp < 3072 ? pp : 0, half);
    if (pp < 3072 && MODE != 2) ATT_ISSUE(cur, 0);
    const int koff = r32 * 144 + hi * 16;
    const int voff = ((lane >> 4) & 1) * 32 + (lane & 3) * 8 + (4 * hi + ((lane & 15) >> 2)) * 64;
    for (; pp < 3072; pp += 2 * G) {
#pragma unroll
    for (int par = 0; par < 2; ++par) {
        const int ppx = pp + par * G;
        if (ppx >= 3072) break;
        const int tt_lo = (cur.j == 0) ? 2 : 0;
#pragma unroll
        for (int tt = 0; tt < 4; ++tt) { if (MODE != 2 && (tt >= 2 || cur.j != 0)) {
            if (FP8_QKVS) {
                LAS unsigned char* kd = Kl + tt * 9216 + skv8 * 144 + sc16 * 32;
                *(LAS u32x4*)(kd) = fp8x8_to_bf16(kreg[tt][0].x, kreg[tt][0].y); *(LAS u32x4*)(kd + 16) = fp8x8_to_bf16(kreg[tt][0].z, kreg[tt][0].w);
                LAS unsigned char* vd = Vl + tt * 8192 + (sc16 >> 1) * 4096 + skv8 * 64 + (sc16 & 1) * 32;
                *(LAS u32x4*)(vd) = fp8x8_to_bf16(vreg[tt][0].x, vreg[tt][0].y); *(LAS u32x4*)(vd + 16) = fp8x8_to_bf16(vreg[tt][0].z, vreg[tt][0].w);
            } else {
#pragma unroll
            for (int i = 0; i < 2; ++i) {
                *(LAS u32x4*)(Kl + tt * 9216 + skv[i] * 144 + sc[i] * 16) = kreg[tt][i];
                *(LAS u32x4*)(Vl + tt * 8192 + (sc[i] >> 2) * 4096 + skv[i] * 64 + (sc[i] & 3) * 16) = vreg[tt][i]; } } } }
        bf16x8 qr[4];
        if (FP8_QKVS) {
            asm volatile("" : "+v"(qraw[par][0]), "+v"(qraw[par][1]), "+v"(qraw[par][2]), "+v"(qraw[par][3]));
#pragma unroll
            for (int d0 = 0; d0 < 4; ++d0) qr[d0] = __builtin_bit_cast(bf16x8, fp8x8_to_bf16(qraw[par][d0].x, qraw[par][d0].y));
        } else {
            asm volatile("" : "+v"(qbuf[par][0]), "+v"(qbuf[par][1]), "+v"(qbuf[par][2]), "+v"(qbuf[par][3]));
#pragma unroll
            for (int d0 = 0; d0 < 4; ++d0) qr[d0] = qbuf[par][d0];
        }
        __syncthreads();
        const Item me = cur;
        if (ppx + G < 3072) { cur = decode_item(ppx + G, half); if (MODE != 2) ATT_ISSUE(cur, par ^ 1); }
        if (MODE == 1) { __syncthreads(); continue; }
        float m = -1e30f, l = 0.f; f32x16 oT[2]; oT[0] = f32x16{}; oT[1] = f32x16{};
        const int t_lo = (w >= 2) ? (tt_lo > 1 ? tt_lo : 1) : tt_lo, t_hi = (w < 2) ? 2 : 3, t_mid = (w < 2) ? 1 : 2;
        for (int tt = t_lo; tt <= t_hi; ++tt) {
            const LAS unsigned char* kb = Kl + tt * 9216 + koff;
            f32x16 p0 = f32x16{}, p1 = f32x16{};
#pragma unroll
            for (int d0 = 0; d0 < 4; ++d0) {
                const bf16x8 k0 = *(const LAS bf16x8*)(kb + d0 * 32), k1 = *(const LAS bf16x8*)(kb + d0 * 32 + 32 * 144);
                p0 = __builtin_amdgcn_mfma_f32_32x32x16_bf16(k0, qr[d0], p0, 0, 0, 0);
                p1 = __builtin_amdgcn_mfma_f32_32x32x16_bf16(k1, qr[d0], p1, 0, 0, 0);
            }
            float mx = -INFINITY;
            if (tt != t_mid) {
                const int dbase = 128 + 32 * w + r32 - 64 * tt;
#pragma unroll
                for (int r = 0; r < 16; ++r) {
                    const int d0_ = dbase - crow(r, hi), d1_ = d0_ - 32;
                    p0[r] = (d0_ >= 0 && d0_ <= 128) ? p0[r] * C2 : -INFINITY;
                    p1[r] = (d1_ >= 0 && d1_ <= 128) ? p1[r] * C2 : -INFINITY;
                    mx = fmaxf(mx, fmaxf(p0[r], p1[r]));
                }
            } else {
#pragma unroll
                for (int r = 0; r < 16; ++r) { p0[r] *= C2; p1[r] *= C2; mx = fmaxf(mx, fmaxf(p0[r], p1[r])); }
            }
            { const auto rr = __builtin_amdgcn_permlane32_swap(__float_as_uint(mx), __float_as_uint(mx), false, false); mx = fmaxf(__uint_as_float(rr[0]), __uint_as_float(rr[1])); }
            const float mn = fmaxf(m, mx), alpha = __builtin_amdgcn_exp2f(m - mn);
            float rs = 0.f;
#pragma unroll
            for (int r = 0; r < 16; ++r) { p0[r] = __builtin_amdgcn_exp2f(p0[r] - mn); p1[r] = __builtin_amdgcn_exp2f(p1[r] - mn); rs += p0[r] + p1[r]; }
            l = l * alpha + rs; m = mn;
#pragma unroll
            for (int r = 0; r < 16; ++r) { oT[0][r] *= alpha; oT[1][r] *= alpha; }
            u32x4 pw[4];
            pw[0] = (u32x4){cvtpk(p0[0], p0[1]), cvtpk(p0[2], p0[3]), cvtpk(p0[4], p0[5]), cvtpk(p0[6], p0[7])};
            pw[1] = (u32x4){cvtpk(p0[8], p0[9]), cvtpk(p0[10], p0[11]), cvtpk(p0[12], p0[13]), cvtpk(p0[14], p0[15])};
            pw[2] = (u32x4){cvtpk(p1[0], p1[1]), cvtpk(p1[2], p1[3]), cvtpk(p1[4], p1[5]), cvtpk(p1[6], p1[7])};
            pw[3] = (u32x4){cvtpk(p1[8], p1[9]), cvtpk(p1[10], p1[11]), cvtpk(p1[12], p1[13]), cvtpk(p1[14], p1[15])};
            const LAS unsigned char* vp = Vl + tt * 8192 + voff;
#pragma unroll
            for (int d0 = 0; d0 < 2; ++d0)
#pragma unroll
                for (int ks = 0; ks < 4; ++ks) {
                    const s16x4 lo = vtr(vp + d0 * 4096 + ks * 1024), hh4 = vtr(vp + d0 * 4096 + ks * 1024 + 512);
                    const bf16x8 vf = (bf16x8){lo[0], lo[1], lo[2], lo[3], hh4[0], hh4[1], hh4[2], hh4[3]};
                    oT[d0] = __builtin_amdgcn_mfma_f32_32x32x16_bf16(vf, __builtin_bit_cast(bf16x8, pw[ks]), oT[d0], 0, 0, 0);
                }
        }
        float lt; { const auto rr = __builtin_amdgcn_permlane32_swap(__float_as_uint(l), __float_as_uint(l), false, false); lt = __uint_as_float(rr[0]) + __uint_as_float(rr[1]); }
        const float inv = 1.0f / lt;
        const int lq = 128 * me.j + 32 * w + r32;
        const size_t tok = (size_t)me.b * SEQ + (size_t)lq * me.dil + me.ph;
        if (MODE == 3) { asm volatile("" :: "v"(oT[0]), "v"(oT[1]), "v"(inv), "v"(m)); __syncthreads(); continue; }
        bf16* orow = og + tok * (NG * AW) + me.g * AW + me.hh * 64;
#pragma unroll
        for (int d0 = 0; d0 < 2; ++d0)
#pragma unroll
            for (int rp = 0; rp < 2; ++rp) {
                const int rg = 2 * rp;
                if (FP8_OG) {
                    const float i16 = inv * 16.0f;
                    const unsigned x = pack_fp8x4(oT[d0][4 * rg] * i16, oT[d0][4 * rg + 1] * i16, oT[d0][4 * rg + 2] * i16, oT[d0][4 * rg + 3] * i16);
                    const unsigned y = pack_fp8x4(oT[d0][4 * rg + 4] * i16, oT[d0][4 * rg + 5] * i16, oT[d0][4 * rg + 6] * i16, oT[d0][4 * rg + 7] * i16);
                    auto s0 = __builtin_amdgcn_permlane32_swap(x, y, false, false);
                    u32x2 wv; wv.x = s0[0]; wv.y = s0[1];
                    *(u32x2*)((unsigned char*)og + tok * (NG * AW) + me.g * AW + me.hh * 64 + 32 * d0 + 16 * rp + 8 * hi) = wv;
                } else {
                    unsigned x0 = cvtpk(oT[d0][4 * rg] * inv, oT[d0][4 * rg + 1] * inv), x1 = cvtpk(oT[d0][4 * rg + 2] * inv, oT[d0][4 * rg + 3] * inv);
                    unsigned y0 = cvtpk(oT[d0][4 * rg + 4] * inv, oT[d0][4 * rg + 5] * inv), y1 = cvtpk(oT[d0][4 * rg + 6] * inv, oT[d0][4 * rg + 7] * inv);
                    auto s0 = __builtin_amdgcn_permlane32_swap(x0, y0, false, false); auto s1 = __builtin_amdgcn_permlane32_swap(x1, y1, false, false);
                    u32x4 wv; wv.x = s0[0]; wv.y = s1[0]; wv.z = s0[1]; wv.w = s1[1];
                    *(u32x4*)(orow + 32 * d0 + 16 * rp + 8 * hi) = wv;
                }
            }
        if (hi == 0) lse[tok * 24 + me.g * 8 + me.hh] = (m + __builtin_amdgcn_logf(lt)) * LN2;
        __syncthreads();
    }
    }
#undef ATT_ISSUE
}
}

__device__ __forceinline__ u32x4 widen16(u32x2 x, u32x2 y) {
    auto s0 = __builtin_amdgcn_permlane16_swap(x.x, y.x, false, false); auto s1 = __builtin_amdgcn_permlane16_swap(x.y, y.y, false, false);
    return (u32x4){s0[0], s1[0], s0[1], s1[1]};
}
using pg8::Unit; using pg8::BM; using pg8::HALF;
struct EpiQKV {
    static constexpr bool PERM = true;
    bf16* O; const float* cs; float sc;
    __device__ __forceinline__ void operator()(const f32x4 (&acc)[2][2][4][2], const Unit& u, int wr, int wc, int fr, int fq) const {
        const int colt = u.pn * BM; const int kind = (colt % 1536) / 512;
        const bool rot = (kind < 2) && ((wc & 1) == 0) && (fq < 2);
        f32x4 cz[2][4][2];
#pragma unroll
        for (int ai = 0; ai < 2; ++ai)
#pragma unroll
            for (int m = 0; m < 4; ++m) { cz[ai][m][0] = (f32x4){1.f, 0.f, 1.f, 0.f}; cz[ai][m][1] = (f32x4){1.f, 0.f, 1.f, 0.f}; }
        if (rot) {
#pragma unroll
            for (int ai = 0; ai < 2; ++ai)
#pragma unroll
                for (int m = 0; m < 4; ++m) { const int row = u.pm * BM + ai * HALF + wr * 64 + m * 16 + fr;
                    cz[ai][m][0] = *(const f32x4*)(cs + (size_t)row * 16 + fq * 8); cz[ai][m][1] = *(const f32x4*)(cs + (size_t)row * 16 + fq * 8 + 4); }
        }
#pragma unroll
        for (int ai = 0; ai < 2; ++ai)
#pragma unroll
            for (int m = 0; m < 4; ++m) {
                const int row = u.pm * BM + ai * HALF + wr * 64 + m * 16 + fr;
                const f32x4 c0 = cz[ai][m][0], c1 = cz[ai][m][1];
                bf16* rowp = O + (size_t)row * QKVW + colt + wc * 32 + 8 * fq;
                u32x2 w8[2];
#pragma unroll
                for (int bj = 0; bj < 2; ++bj) {
                    f32x4 v0 = acc[ai][bj][m][0] * sc, v1 = acc[ai][bj][m][1] * sc;
                    f32x4 o0, o1;
                    o0.x = v0.x * c0.x - v0.y * c0.y; o0.y = v0.y * c0.x + v0.x * c0.y; o0.z = v0.z * c0.z - v0.w * c0.w; o0.w = v0.w * c0.z + v0.z * c0.w;
                    o1.x = v1.x * c1.x - v1.y * c1.y; o1.y = v1.y * c1.x + v1.x * c1.y; o1.z = v1.z * c1.z - v1.w * c1.w; o1.w = v1.w * c1.z + v1.z * c1.w;
                    if (FP8_QKVS) { w8[bj].x = pack_fp8x4(o0.x, o0.y, o0.z, o0.w); w8[bj].y = pack_fp8x4(o1.x, o1.y, o1.z, o1.w); }
                    else { u32x4 w; w.x = cvtpk(o0.x, o0.y); w.y = cvtpk(o0.z, o0.w); w.z = cvtpk(o1.x, o1.y); w.w = cvtpk(o1.z, o1.w);
                        *(u32x4*)(rowp + bj * HALF) = w; }
                }
                if (FP8_QKVS) {
                    const u32x4 w16 = widen16(w8[0], w8[1]);
                    *(u32x4*)((unsigned char*)O + (size_t)row * QKVW + colt + wc * 32 + 8 * (fq & ~1) + (fq & 1) * HALF) = w16; }
            }
    }
};
struct EpiBf16 {
    static constexpr bool PERM = true;
    bf16* O; int ldc;
    __device__ __forceinline__ void operator()(const f32x4 (&acc)[2][2][4][2], const Unit& u, int wr, int wc, int fr, int fq) const {
#pragma unroll
        for (int ai = 0; ai < 2; ++ai)
#pragma unroll
            for (int m = 0; m < 4; ++m) {
                bf16* rowp = O + (size_t)(u.pm * BM + ai * HALF + wr * 64 + m * 16 + fr) * ldc + u.pn * BM + wc * 32 + 8 * fq;
#pragma unroll
                for (int bj = 0; bj < 2; ++bj) { const f32x4 v0 = acc[ai][bj][m][0], v1 = acc[ai][bj][m][1];
                    u32x4 w; w.x = cvtpk(v0.x, v0.y); w.y = cvtpk(v0.z, v0.w); w.z = cvtpk(v1.x, v1.y); w.w = cvtpk(v1.z, v1.w);
                    *(u32x4*)(rowp + bj * HALF) = w; }
            }
    }
};
#define DPPF(v, ctrl) __builtin_bit_cast(float, __builtin_amdgcn_update_dpp(0, __builtin_bit_cast(int, (v)), (ctrl), 0xF, 0xF, true))
template <int W> __device__ __forceinline__ float pool_prefix(float x) {
    float t = x;
    t += DPPF(t, 0x111);
    if (W > 2) t += DPPF(t, 0x112);
    if (W > 4) t += DPPF(t, 0x114);
    if (W > 8) t += DPPF(t, 0x118);
    return t;
}
__device__ __forceinline__ float pool_suffix(float x) {
    float q = x;
    q += DPPF(q, 0x101); q += DPPF(q, 0x102); q += DPPF(q, 0x104); q += DPPF(q, 0x108);
    return q;
}
template <int W>
__device__ __forceinline__ void pool_epilogue(const f32x4 (&acc)[2][2][4][2], const pg8::Unit& u, int wr, int wc, int fr, int fq, bf16* POOLED_, bf16* HALO_) {
    const bool seq_start = ((u.pm & 7) == 0);
    const float invw = 1.0f / (float)W;
#pragma unroll
    for (int ai = 0; ai < 2; ++ai) {
        const bool first_blk = seq_start && ai == 0 && wr == 0;
        const float inv0 = first_blk ? 1.0f / (float)((fr + 1) < W ? (fr + 1) : W) : invw;
        const int blk = (u.pm * pg8::BM + ai * pg8::HALF + wr * 64) >> 6;
#pragma unroll
        for (int bj = 0; bj < 2; ++bj) {
            float po[4][8];
#pragma unroll
            for (int n = 0; n < 2; ++n)
#pragma unroll
                for (int e = 0; e < 4; ++e) {
                    float carry = 0.f;
#pragma unroll
                    for (int m = 0; m < 4; ++m) {
                        const float x = acc[ai][bj][m][n][e];
                        const float s = pool_prefix<W>(x) + carry;
                        po[m][n * 4 + e] = s * (m == 0 ? inv0 : invw) - x;
                        if (m < 3) { const float q = pool_suffix(x); carry = DPPF(q, 0x100 + (17 - W)); }
                    }
                }
            const size_t colo = (size_t)u.pn * pg8::BM + bj * pg8::HALF + wc * 32 + 8 * fq;
#pragma unroll
            for (int m = 0; m < 4; ++m) {
                u32x4 w; w.x = cvtpk(po[m][0], po[m][1]); w.y = cvtpk(po[m][2], po[m][3]); w.z = cvtpk(po[m][4], po[m][5]); w.w = cvtpk(po[m][6], po[m][7]);
                *(u32x4*)(POOLED_ + (size_t)(u.pm * pg8::BM + ai * pg8::HALF + wr * 64 + m * 16 + fr) * D + colo) = w;
            }
            if (fr >= 1) {
                u32x4 w; w.x = cvtpk(acc[ai][bj][3][0][0], acc[ai][bj][3][0][1]); w.y = cvtpk(acc[ai][bj][3][0][2], acc[ai][bj][3][0][3]); w.z = cvtpk(acc[ai][bj][3][1][0], acc[ai][bj][3][1][1]); w.w = cvtpk(acc[ai][bj][3][1][2], acc[ai][bj][3][1][3]);
                *(u32x4*)(HALO_ + ((size_t)blk * 15 + (fr - 1)) * D + colo) = w;
            }
        }
    }
}
struct EpiPool {
    static constexpr bool PERM = true;
    bf16* P_; bf16* H_;
    __device__ __forceinline__ void operator()(const f32x4 (&acc)[2][2][4][2], const pg8::Unit& u, int wr, int wc, int fr, int fq) const {
        switch (u.pn) {
            case 0: pool_epilogue<2>(acc, u, wr, wc, fr, fq, P_, H_); break;
            case 1: pool_epilogue<4>(acc, u, wr, wc, fr, fq, P_, H_); break;
            case 2: pool_epilogue<8>(acc, u, wr, wc, fr, fq, P_, H_); break;
            default: pool_epilogue<16>(acc, u, wr, wc, fr, fq, P_, H_); break;
        }
    }
};
template <bool RES32>
struct EpiResBf16 {
    static constexpr bool PERM = true;
    const void* res; bf16* out; float sc = 1.0f;
    __device__ __forceinline__ void operator()(const f32x4 (&acc)[2][2][4][2], const Unit& u, int wr, int wc, int fr, int fq) const {
#pragma unroll
        for (int ai = 0; ai < 2; ++ai) {
            f32x4 r32[4][2][2]; u32x4 r16[4][2];
            if constexpr (RES32) {
#pragma unroll
                for (int m = 0; m < 4; ++m)
#pragma unroll
                    for (int bj = 0; bj < 2; ++bj) { const size_t off = (size_t)(u.pm * BM + ai * HALF + wr * 64 + m * 16 + fr) * D + u.pn * BM + wc * 32 + 8 * fq + bj * HALF;
                        r32[m][bj][0] = *(const f32x4*)((const float*)res + off); r32[m][bj][1] = *(const f32x4*)((const float*)res + off + 4); }
            } else {
#pragma unroll
                for (int m = 0; m < 4; ++m)
#pragma unroll
                    for (int bj = 0; bj < 2; ++bj) { const size_t off = (size_t)(u.pm * BM + ai * HALF + wr * 64 + m * 16 + fr) * D + u.pn * BM + wc * 32 + 8 * fq + bj * HALF;
                        r16[m][bj] = *(const u32x4*)((const bf16*)res + off); }
            }
#pragma unroll
            for (int m = 0; m < 4; ++m)
#pragma unroll
                for (int bj = 0; bj < 2; ++bj) {
                    const size_t off = (size_t)(u.pm * BM + ai * HALF + wr * 64 + m * 16 + fr) * D + u.pn * BM + wc * 32 + 8 * fq + bj * HALF;
                    f32x4 r0, r1;
                    if constexpr (RES32) { r0 = r32[m][bj][0]; r1 = r32[m][bj][1]; }
                    else { const u32x4 rw = r16[m][bj]; r0 = (f32x4){bf_lo(rw.x), bf_hi(rw.x), bf_lo(rw.y), bf_hi(rw.y)}; r1 = (f32x4){bf_lo(rw.z), bf_hi(rw.z), bf_lo(rw.w), bf_hi(rw.w)}; }
                    const f32x4 v0 = r0 + acc[ai][bj][m][0] * sc, v1 = r1 + acc[ai][bj][m][1] * sc;
                    u32x4 w; w.x = cvtpk(v0.x, v0.y); w.y = cvtpk(v0.z, v0.w); w.z = cvtpk(v1.x, v1.y); w.w = cvtpk(v1.z, v1.w);
                    *(u32x4*)(out + off) = w;
                }
            asm volatile("" ::: "memory");
        }
    }
};
template <bool OUT8>
struct EpiSwiGLU {
    static constexpr bool PERM = true;
    void* O; float sc;
    __device__ __forceinline__ void operator()(const f32x4 (&acc)[2][2][4][2], const Unit& u, int wr, int wc, int fr, int fq) const {
#pragma unroll
        for (int ai = 0; ai < 2; ++ai)
#pragma unroll
            for (int mp = 0; mp < 2; ++mp) {
                u32x2 w8[2];
#pragma unroll
                for (int mi = 0; mi < 2; ++mi) { const int m = 2 * mp + mi;
                    const size_t eoff = (size_t)(u.pm * BM + ai * HALF + wr * 64 + m * 16 + fr) * DE + u.pn * HALF + wc * 32 + 8 * fq;
                    float h[8];
#pragma unroll
                    for (int n = 0; n < 2; ++n)
#pragma unroll
                        for (int e = 0; e < 4; ++e) { const float a = acc[ai][0][m][n][e] * sc, b = acc[ai][1][m][n][e] * sc;
                            h[n * 4 + e] = a * __builtin_amdgcn_rcpf(1.0f + __builtin_amdgcn_exp2f(-1.4426950408889634f * a)) * b; }
                    if constexpr (OUT8) { w8[mi].x = pack_fp8x4(h[0] * 16.f, h[1] * 16.f, h[2] * 16.f, h[3] * 16.f); w8[mi].y = pack_fp8x4(h[4] * 16.f, h[5] * 16.f, h[6] * 16.f, h[7] * 16.f); }
                    else { u32x4 w; w.x = cvtpk(h[0], h[1]); w.y = cvtpk(h[2], h[3]); w.z = cvtpk(h[4], h[5]); w.w = cvtpk(h[6], h[7]); *(u32x4*)((bf16*)O + eoff) = w; }
                }
                if constexpr (OUT8) { const u32x4 w16 = widen16(w8[0], w8[1]);
                    const int m = 2 * mp + (fq & 1);
                    *(u32x4*)((unsigned char*)O + (size_t)(u.pm * BM + ai * HALF + wr * 64 + m * 16 + fr) * DE + u.pn * HALF + wc * 32 + 8 * (fq & ~1)) = w16; }
            }
    }
};
struct EpiGate {
    static constexpr bool PERM = true;
    bf16* O; const LAS float* gtab;
    __device__ __forceinline__ void operator()(const f32x4 (&acc)[2][2][4][2], const Unit& u, int wr, int wc, int fr, int fq) const {
#pragma unroll
        for (int ai = 0; ai < 2; ++ai)
#pragma unroll
            for (int m = 0; m < 4; ++m) {
                const int rl = ai * HALF + wr * 64 + m * 16 + fr;
                const float gt = gtab[u.idx * 256 + rl];
                const size_t eoff = (size_t)(u.pm * BM + rl) * D + u.pn * BM + wc * 32 + 8 * fq;
                u32x2 w8[2];
#pragma unroll
                for (int bj = 0; bj < 2; ++bj) { const f32x4 v0 = acc[ai][bj][m][0] * gt, v1 = acc[ai][bj][m][1] * gt;
                    if (FP8_YS) { w8[bj].x = pack_fp8x4(v0.x, v0.y, v0.z, v0.w); w8[bj].y = pack_fp8x4(v1.x, v1.y, v1.z, v1.w); }
                    else { u32x4 w; w.x = cvtpk(v0.x, v0.y); w.y = cvtpk(v0.z, v0.w); w.z = cvtpk(v1.x, v1.y); w.w = cvtpk(v1.z, v1.w); *(u32x4*)(O + eoff + bj * HALF) = w; } }
                if (FP8_YS) { const u32x4 w16 = widen16(w8[0], w8[1]);
                    *(u32x4*)((unsigned char*)O + (size_t)(u.pm * BM + rl) * D + u.pn * BM + wc * 32 + 8 * (fq & ~1) + (fq & 1) * HALF) = w16; }
            }
    }
};

template <bool F8_>
struct MoeProb1T {
    static constexpr bool F8 = F8_;
    const void* A; const void* Bt; int K; const LAS int* tb; const LAS unsigned* aofs;
    __device__ __forceinline__ void a_offs(int i, const Unit&, const int (&R)[2], const int (&C)[2], unsigned (&o0)[2], unsigned (&o1)[2]) const {
#pragma unroll
        for (int k = 0; k < 2; ++k) { o0[k] = aofs[i * 256 + R[k]] + (unsigned)C[k] * 2u; o1[k] = aofs[i * 256 + 128 + R[k]] + (unsigned)C[k] * 2u; }
    }
    __device__ __forceinline__ unsigned b_off(const Unit& u) const {
        int e = 0;
#pragma unroll
        for (int k = 1; k < NE; ++k) e += (u.pm >= tb[k]) ? 1 : 0;
        return (unsigned)((e * 1024 + u.pn * 256) * 1024 * (F8 ? 1 : 2));
    }
};
template <bool F8_>
struct MoeProb2T {
    static constexpr bool F8 = F8_;
    const void* A; const void* Bt; int K; const LAS int* tb;
    __device__ __forceinline__ void a_offs(int, const Unit& u, const int (&R)[2], const int (&C)[2], unsigned (&o0)[2], unsigned (&o1)[2]) const {
        constexpr int esz = F8 ? 1 : 2;
#pragma unroll
        for (int k = 0; k < 2; ++k) { const unsigned b = (unsigned)((u.pm * BM + R[k]) * DE * esz + C[k] * 2); o0[k] = b; o1[k] = b + (unsigned)(HALF * DE * esz); }
    }
    __device__ __forceinline__ unsigned b_off(const Unit& u) const {
        int e = 0;
#pragma unroll
        for (int k = 1; k < NE; ++k) e += (u.pm >= tb[k]) ? 1 : 0;
        return (unsigned)((e * 1024 + u.pn * 256) * DE * (F8 ? 1 : 2));
    }
};
struct FoldOrder { int G, c; __device__ bool next(int i, Unit& u) const { const int L = i * G + c; if (L >= 16) return false; u.pm = L >> 2; u.pn = L & 3; return true; } };


#define XB_TMO      128
#define XB_XCNT(j)  (256  + 64 * (j))
#define XB_XSUB(j)  (1280 + 64 * (j))
#define XB_XGEN(j)  (2304 + 64 * (j))
#define XB_TOP      3328
#define XB_TOPGEN   3392
#define XCD_BAR_WORDS 3456
#define XB_SPIN_CAP (1u << 18)
__device__ __forceinline__ unsigned xb_ld(unsigned* p)              { return __hip_atomic_load(p, __ATOMIC_RELAXED, __HIP_MEMORY_SCOPE_AGENT); }
__device__ __forceinline__ unsigned xb_add(unsigned* p, unsigned v) { return __hip_atomic_fetch_add(p, v, __ATOMIC_RELAXED, __HIP_MEMORY_SCOPE_AGENT); }
__device__ __forceinline__ unsigned xb_xcc_id() { return (unsigned)__builtin_amdgcn_s_getreg((3 << 11) | 20) & 0xFu; }
#define XB_SPIN(cond, bar) do { unsigned _sp = 0; while (cond) { __builtin_amdgcn_s_sleep(1); \
    if ((++_sp & 255u) == 0u) { if (xb_ld(&(bar)[XB_TMO])) break; if (_sp > XB_SPIN_CAP) { atomicAdd(&(bar)[XB_TMO], 1u); break; } } } } while (0)
struct XcdBarrier { unsigned* bar; unsigned x; volatile LAS unsigned* st; };
__device__ __forceinline__ XcdBarrier xcd_barrier_post(unsigned* bar, volatile LAS unsigned* st) {
    XcdBarrier b; b.bar = bar; b.x = xb_xcc_id(); b.st = st;
    if (threadIdx.x == 0) (void)xb_add(&bar[XB_XCNT(b.x)], 1u);
    return b;
}
__device__ __forceinline__ void xcd_barrier_complete(unsigned* bar, unsigned x, unsigned& nloc, unsigned& nx) {
    const unsigned G = gridDim.x * gridDim.y * gridDim.z;
    unsigned sum, cnt, mine, sp = 0u;
    for (;;) {
        sum = 0u; cnt = 0u; mine = 0u;
#pragma unroll
        for (unsigned j = 0; j < 16; ++j) { const unsigned c = xb_ld(&bar[XB_XCNT(j)]); sum += c; cnt += (c > 0u) ? 1u : 0u; mine = (j == x) ? c : mine; }
        if (sum == G) break;
        __builtin_amdgcn_s_sleep(1);
        if ((++sp & 255u) == 0u) { if (xb_ld(&bar[XB_TMO])) break; if (sp > XB_SPIN_CAP) { atomicAdd(&bar[XB_TMO], 1u); break; } }
    }
    nloc = mine > 0u ? mine : 1u; nx = cnt > 0u ? cnt : 1u;
}
__device__ __forceinline__ void xcd_barrier(const XcdBarrier& b) {
    asm volatile("s_waitcnt vmcnt(0)" ::: "memory");
    __syncthreads();
    if (threadIdx.x == 0) {
        unsigned* bar = b.bar;
        __builtin_amdgcn_s_waitcnt(0);
        unsigned nloc = b.st[0], nx = b.st[1];
        if (nloc == 0u) { xcd_barrier_complete(bar, b.x, nloc, nx); b.st[0] = nloc; b.st[1] = nx; }
        const unsigned old = xb_add(&bar[XB_XSUB(b.x)], 1u);
        const unsigned gen = old / nloc;
        if (old + 1u == (gen + 1u) * nloc) {
            __builtin_amdgcn_fence(__ATOMIC_RELEASE, "agent");
            asm volatile("s_waitcnt vmcnt(0)" ::: "memory");
            const unsigned og = xb_add(&bar[XB_TOP], 1u);
            const unsigned tg = og / nx;
            if (og + 1u == (tg + 1u) * nx) xb_add(&bar[XB_TOPGEN], 1u);
            else XB_SPIN(xb_ld(&bar[XB_TOPGEN]) == tg, bar);
            __builtin_amdgcn_fence(__ATOMIC_ACQUIRE, "agent");
            xb_add(&bar[XB_XGEN(b.x)], 1u);
            asm volatile("s_waitcnt vmcnt(0)" ::: "memory");
        } else {
            XB_SPIN(xb_ld(&bar[XB_XGEN(b.x)]) == gen, bar);
            __builtin_amdgcn_fence(__ATOMIC_ACQUIRE, "agent");
            asm volatile("s_waitcnt vmcnt(0)" ::: "memory");
        }
    }
    __syncthreads();
}

constexpr int N_PHASES = 16;

template <int W>
__device__ __forceinline__ void seam_fix(const bf16* HALO_, bf16* POOLED_, int b, int ch) {
    u32x4 hrow[W - 1], prow[W - 1];
#pragma unroll
    for (int i = 0; i < W - 1; ++i) hrow[i] = *(const u32x4*)(HALO_ + ((size_t)(b - 1) * 15 + (16 - W + i)) * D + ch);
#pragma unroll
    for (int r = 0; r < W - 1; ++r) prow[r] = *(const u32x4*)(POOLED_ + (size_t)(b * 64 + r) * D + ch);
    const float invw = 1.0f / (float)W;
    float sum[8];
#pragma unroll
    for (int k = 0; k < 8; ++k) sum[k] = 0.f;
#pragma unroll
    for (int r = W - 2; r >= 0; --r) {
#pragma unroll
        for (int k = 0; k < 4; ++k) { sum[2 * k] += bf_lo(hrow[r][k]); sum[2 * k + 1] += bf_hi(hrow[r][k]); }
        u32x4 w;
#pragma unroll
        for (int k = 0; k < 4; ++k) w[k] = cvtpk(bf_lo(prow[r][k]) + sum[2 * k] * invw, bf_hi(prow[r][k]) + sum[2 * k + 1] * invw);
        *(u32x4*)(POOLED_ + (size_t)(b * 64 + r) * D + ch) = w;
    }
}
typedef const __attribute__((address_space(4))) Params* KParamsPtr;
__device__ __forceinline__ KParamsPtr kparams() { KParamsPtr q = (KParamsPtr)__builtin_amdgcn_kernarg_segment_ptr(); asm volatile("" : "+s"(q)); return q; }
__global__ void __launch_bounds__(NTHREADS, 2) fwd_kernel(Params p) {
    extern __shared__ __attribute__((aligned(16))) unsigned char lds_raw[];
    LAS unsigned char* lds = (LAS unsigned char*)lds_raw;
    const int tid = threadIdx.x, lane = tid & 63, wave = __builtin_amdgcn_readfirstlane(tid >> 6);
    const int G = gridDim.x, bx = blockIdx.x;
    const int vcu = (G % 8 == 0) ? (bx % 8) * (G / 8) + bx / 8 : bx;
#define KP() kparams()
#define WSB() ((unsigned char*)KP()->ws)
#define G_ctl ((int*)(WSB() + WS_CTL))
#define G_cs ((float*)(WSB() + WS_CS))
#define G_lse ((float*)(WSB() + WS_LSE))
#define G_slotref ((int*)(WSB() + WS_SLOTREF))
#define Wgs ((bf16*)(WSB() + WS_WGS))
#define G_list ((int*)(WSB() + WS_LIST))
#define G_gatel ((float*)(WSB() + WS_GATEL))
#define Win_t ((bf16*)(WSB() + WS_WIN))
#define Wout_t ((bf16*)(WSB() + WS_WOUT))
#define Wpin_t ((bf16*)(WSB() + WS_WPIN))
#define Wc_t ((bf16*)(WSB() + WS_WC))
#define Wpo_t ((bf16*)(WSB() + WS_WPO))
#define W13 ((bf16*)(WSB() + WS_W13))
#define W2 ((bf16*)(WSB() + WS_W2))
#define Y ((bf16*)(WSB() + WS_Y))
#define QKV ((bf16*)(WSB() + WS_BIG))
#define OM ((bf16*)(WSB() + WS_OM))
#define HMID ((bf16*)(WSB() + WS_HMID))
#define YS ((bf16*)(WSB() + WS_YS))
#define U ((bf16*)(WSB() + WS_U))
#define POOLED ((bf16*)(WSB() + WS_POOLED))
#define OG ((bf16*)KP()->out)
#define H ((bf16*)(WSB() + WS_H))
    LAS int* tb = (LAS int*)(lds + MISC_OFF);
    LAS unsigned* aofs = (LAS unsigned*)(lds + AOFS_OFF);

    const int lo = p.ph_lo, hi = p.ph_hi;
#if MK_N_LAUNCHES == 1
    cg::grid_group grid = cg::this_grid();
    if (tid < 2) ((volatile LAS unsigned*)(lds + MISC_OFF))[64 + tid] = 0u;
    __syncthreads();
    const XcdBarrier xbar = xcd_barrier_post((unsigned*)(G_ctl + CW_BAR), (volatile LAS unsigned*)(lds + MISC_OFF) + 64);
#define GRID_BAR(k) do { if ((k) == CG_SEAM) grid.sync(); else xcd_barrier(xbar); } while (0)
#else
#define GRID_BAR(k) do { } while (0)
#endif
#ifndef PHASE_MASK
#define PHASE_MASK 0xffff
#endif
#ifndef REPEAT_MASK
#define REPEAT_MASK 0x0
#endif
#define REP(k) for (int rep_ = 0; rep_ <= ((REPEAT_MASK >> (k)) & 1); ++rep_)
#define IN(k) (((PHASE_MASK >> (k)) & 1) && lo <= (k) && (k) < hi)
#ifndef DOUBLE_BAR
#define DOUBLE_BAR 0
#endif
#ifndef PROBE_PHASE
#define PROBE_PHASE (-1)
#endif
#define PT0(k) if (PROBE_PHASE == (k)) pt0 = __builtin_amdgcn_s_memrealtime();
#define PT1(k) if (PROBE_PHASE == (k)) { const unsigned long long t1_ = __builtin_amdgcn_s_memrealtime(), d_ = t1_ - pt0; while (__builtin_amdgcn_s_memrealtime() - t1_ < d_) __builtin_amdgcn_s_sleep(8); }
#define SEAM(k) do { if (IN(k) && IN((k) + 1)) { _Pragma("unroll 1") for (int nb_ = 0; nb_ < 1 + (DOUBLE_BAR ? (hi > 0 ? 1 : 0) : 0); ++nb_) GRID_BAR(k); } } while (0)

    unsigned long long pt0 = 0;
    PT0(0)
    if (IN(0)) REP(0) {
        LAS float* scr = (LAS float*)(lds + wave * 16384);
        const int gw = vcu * NWAVES + wave, NGW = G * NWAVES;
        constexpr int I_IN = (D / 64) * (QKVW / 32);
        constexpr int I_OUT = (AW / 64) * (D / 32);
        constexpr int I_PIN = (D / 64) * (D / 32);
        constexpr int I_PO = I_PIN;
        constexpr int I_W1 = (D / 64) * (DE / 32);
        constexpr int I_W2 = (DE / 64) * (D / 32);
        constexpr int NITEMS = I_IN + I_OUT + I_PIN + I_PO + 32 * (2 * I_W1 + I_W2);
        for (int it = gw; it < NITEMS; it += NGW) {
            int r = it;
            if (r < I_IN) { const int nblk = QKVW / 32;
                if (FP8_QKV) transpose_item8(KP()->attn_w_in, QKVW, D, (unsigned char*)Win_t, MapQKV{}, 32.f, scr, 64 * (r / nblk), 32 * (r % nblk), lane);
                else transpose_item(KP()->attn_w_in, QKVW, D, Win_t, MapQKV{}, scr, 64 * (r / nblk), 32 * (r % nblk), lane);
                continue; } r -= I_IN;
            if (r < I_OUT) { const int nblk = D / 32;
                if (FP8_OUT) transpose_item8(KP()->attn_w_out, D, AW, (unsigned char*)Wout_t, MapId{}, 32.f, scr, 64 * (r / nblk), 32 * (r % nblk), lane);
                else transpose_item(KP()->attn_w_out, D, AW, Wout_t, MapId{}, scr, 64 * (r / nblk), 32 * (r % nblk), lane);
                continue; } r -= I_OUT;
            if (r < I_PIN) { const int nblk = D / 32; transpose_item(KP()->pool_w_in, D, D, Wpin_t, MapId{}, scr, 64 * (r / nblk), 32 * (r % nblk), lane); continue; } r -= I_PIN;
            if (r < I_PO) { const int nblk = D / 32; transpose_item(KP()->pool_w_out, D, D, Wpo_t, MapId{}, scr, 64 * (r / nblk), 32 * (r % nblk), lane); continue; } r -= I_PO;
            const int le = r / (2 * I_W1 + I_W2); r -= le * (2 * I_W1 + I_W2);
            if (r < I_W1) { const int nblk = DE / 32;
                if (FP8_MOE1) transpose_item8(KP()->expert_w1 + (size_t)le * D * DE, DE, D, (unsigned char*)W13 + (size_t)le * 1024 * 1024, MapW13{0}, 32.f, scr, 64 * (r / nblk), 32 * (r % nblk), lane);
                else transpose_item(KP()->expert_w1 + (size_t)le * D * DE, DE, D, W13 + (size_t)le * 1024 * 1024, MapW13{0}, scr, 64 * (r / nblk), 32 * (r % nblk), lane);
                continue; } r -= I_W1;
            if (r < I_W1) { const int nblk = DE / 32;
                if (FP8_MOE1) transpose_item8(KP()->expert_w3 + (size_t)le * D * DE, DE, D, (unsigned char*)W13 + (size_t)le * 1024 * 1024, MapW13{128}, 32.f, scr, 64 * (r / nblk), 32 * (r % nblk), lane);
                else transpose_item(KP()->expert_w3 + (size_t)le * D * DE, DE, D, W13 + (size_t)le * 1024 * 1024, MapW13{128}, scr, 64 * (r / nblk), 32 * (r % nblk), lane);
                continue; } r -= I_W1;
            { const int nblk = D / 32;
                if (FP8_MOE2) transpose_item8(KP()->expert_w2 + (size_t)le * DE * D, D, DE, (unsigned char*)W2 + (size_t)le * 1024 * DE, MapId{}, 32.f, scr, 64 * (r / nblk), 32 * (r % nblk), lane);
                else transpose_item(KP()->expert_w2 + (size_t)le * DE * D, D, DE, W2 + (size_t)le * 1024 * DE, MapId{}, scr, 64 * (r / nblk), 32 * (r % nblk), lane); }
        }
        for (int i = vcu * NTHREADS + tid; i < 4 * 256 * 256 / 4; i += G * NTHREADS) {
            const int e4 = (i & 63) * 4, gidx = i >> 14;
            const f32x4 wv = *(const f32x4*)(KP()->pool_w_group + (size_t)i * 4); const f32x4 sc = *(const f32x4*)(KP()->pool_scale + gidx * 256 + e4);
            u32x2 o; o.x = cvtpk(wv.x * sc.x, wv.y * sc.y); o.y = cvtpk(wv.z * sc.z, wv.w * sc.w); *(u32x2*)(Wgs + (size_t)i * 4) = o;
        }
        for (int i = vcu * NTHREADS + tid; i < T * 8; i += G * NTHREADS) {
            const int tok = i >> 3, f = i & 7;
            const double invf = exp2(-(double)f * 0.125 * 18.931568569324174);
            const float ang = (float)KP()->positions[tok] * (float)invf;
            double sn, cn; sincos((double)ang, &sn, &cn);
            G_cs[(size_t)i * 2] = (float)cn; G_cs[(size_t)i * 2 + 1] = (float)sn;
        }
        RowPassCfg c{}; c.hin = KP()->x; c.gain = KP()->norm_mix; if (FP8_QKV) c.yout8 = (unsigned char*)Y; else c.yout = Y;
        row_pass<false, false, false>(lds, c, vcu, wave);
    }
    SEAM(0); PT1(0)
    PT0(1)
    if (IN(1)) REP(1) {
        pg8::DenseProbT<FP8_QKV != 0> P{Y, Win_t, D, D, 0, (size_t)256 * D};
        pg8::StaticOrder S; S.init(T / 256, QKVW / 256, G, bx);
        EpiQKV E{QKV, G_cs, FP8_QKV ? (1.0f / 32.0f) : 1.0f};
        pg8::gemm_phase<pg8::DenseProbT<FP8_QKV != 0>, EpiQKV, pg8::StaticOrder, true>(lds, P, S, E);
    }
    SEAM(1); PT1(1)
    PT0(2)
    if (IN(2)) REP(2) {
#ifndef ATT_PROBE_MODE
#define ATT_PROBE_MODE 0
#endif
        if (ATT_PROBE_MODE == 1) att::attn_phase<1>(lds, QKV, OG, G_lse, vcu, G);
        if (ATT_PROBE_MODE == 2) att::attn_phase<2>(lds, QKV, OG, G_lse, vcu, G);
        if (ATT_PROBE_MODE == 3) att::attn_phase<3>(lds, QKV, OG, G_lse, vcu, G);
        att::attn_phase<0>(lds, QKV, OG, G_lse, vcu, G);
    }
    SEAM(2); PT1(2)
    PT0(3)
    if (IN(3)) REP(3) {
        for (int row = vcu * NWAVES + wave; row < T; row += G * NWAVES) {
            const int h = lane >> 3;
            const float l0 = G_lse[(size_t)row * 24 + h], l1 = G_lse[(size_t)row * 24 + 8 + h], l2 = G_lse[(size_t)row * 24 + 16 + h];
            const float mx = fmaxf(l0, fmaxf(l1, l2));
            float w0 = __expf(l0 - mx), w1 = __expf(l1 - mx), w2 = __expf(l2 - mx); const float inv = 1.0f / (w0 + w1 + w2); w0 *= inv; w1 *= inv; w2 *= inv;
            u32x4 o;
            if (FP8_OG) {
                const unsigned char* src = (const unsigned char*)OG + (size_t)row * 1536 + lane * 8;
                const u32x2 a = *(const u32x2*)(src), b = *(const u32x2*)(src + 512), c = *(const u32x2*)(src + 1024);
                if (!FP8_OUT) { w0 *= (1.0f / 16.0f); w1 *= (1.0f / 16.0f); w2 *= (1.0f / 16.0f); }
#define MRGF_(WA, WB, WC, SEL, I) (w0 * __builtin_amdgcn_cvt_pk_f32_fp8((int)(WA), SEL)[I] + w1 * __builtin_amdgcn_cvt_pk_f32_fp8((int)(WB), SEL)[I] + w2 * __builtin_amdgcn_cvt_pk_f32_fp8((int)(WC), SEL)[I])
                if (FP8_OUT) {
                    u32x2 o8; o8.x = pack_fp8x4(MRGF_(a.x, b.x, c.x, false, 0), MRGF_(a.x, b.x, c.x, false, 1), MRGF_(a.x, b.x, c.x, true, 0), MRGF_(a.x, b.x, c.x, true, 1));
                    o8.y = pack_fp8x4(MRGF_(a.y, b.y, c.y, false, 0), MRGF_(a.y, b.y, c.y, false, 1), MRGF_(a.y, b.y, c.y, true, 0), MRGF_(a.y, b.y, c.y, true, 1));
                    *(u32x2*)((unsigned char*)OM + (size_t)row * AW + lane * 8) = o8; continue;
                }
#define MRG_(WA, WB, WC, SEL) cvtpk(w0 * __builtin_amdgcn_cvt_pk_f32_fp8((int)(WA), SEL)[0] + w1 * __builtin_amdgcn_cvt_pk_f32_fp8((int)(WB), SEL)[0] + w2 * __builtin_amdgcn_cvt_pk_f32_fp8((int)(WC), SEL)[0], \
                                    w0 * __builtin_amdgcn_cvt_pk_f32_fp8((int)(WA), SEL)[1] + w1 * __builtin_amdgcn_cvt_pk_f32_fp8((int)(WB), SEL)[1] + w2 * __builtin_amdgcn_cvt_pk_f32_fp8((int)(WC), SEL)[1])
                o[0] = MRG_(a.x, b.x, c.x, false); o[1] = MRG_(a.x, b.x, c.x, true); o[2] = MRG_(a.y, b.y, c.y, false); o[3] = MRG_(a.y, b.y, c.y, true);
#undef MRG_
#undef MRGF_
            } else {
            const bf16* src = OG + (size_t)row * 1536 + lane * 8;
            const u32x4 a = *(const u32x4*)(src), b = *(const u32x4*)(src + 512), c = *(const u32x4*)(src + 1024);
#pragma unroll
            for (int k = 0; k < 4; ++k) { const float lo_ = w0 * bf_lo(a[k]) + w1 * bf_lo(b[k]) + w2 * bf_lo(c[k]), hi_ = w0 * bf_hi(a[k]) + w1 * bf_hi(b[k]) + w2 * bf_hi(c[k]); o[k] = cvtpk(lo_, hi_); }
            }
            *(u32x4*)(OM + (size_t)row * AW + lane * 8) = o;
        }
    }
    SEAM(3); PT1(3)
    PT0(4)
    if (IN(4)) REP(4) {
        pg8::DenseProbT<FP8_OUT != 0> P{OM, Wout_t, AW, AW, 0, (size_t)256 * AW};
        pg8::StaticOrder S; S.init(T / 256, D / 256, G, bx);
        EpiResBf16<true> E{KP()->x, H, FP8_OUT ? (1.0f / 512.0f) : 1.0f};
        pg8::gemm_phase<pg8::DenseProbT<FP8_OUT != 0>, EpiResBf16<true>, pg8::StaticOrder, true>(lds, P, S, E);
    }
    SEAM(4); PT1(4)
#pragma unroll 1
    for (int L = 0; L < 2; ++L) {
        const int pb = (L == 0) ? 5 : 12;
        int* cnt = G_ctl + CW_CNT + L * NE;
        PT0(pb)
        if (IN(pb)) {
            RowPassCfg c{}; c.hin16 = H; c.gain = KP()->norm_ffn + L * D; if (FP8_MOE1) c.yout8 = (unsigned char*)Y; else c.yout = Y;
            c.rgw = KP()->router_group_w + (size_t)L * D * 4; c.rgb = KP()->router_group_b + L * 4; c.rew = KP()->router_expert_w + (size_t)L * 4 * D * 4; c.reb = KP()->router_expert_b + L * 16;
            c.cnt = cnt; c.list = G_list + (size_t)L * NE * T; c.gatel = G_gatel + (size_t)L * NE * T; c.slotref_out = G_slotref + (size_t)L * T * 2;
            if ((REPEAT_MASK >> pb) & 1) {
                RowPassCfg c2 = c; c2.cnt = G_ctl + 64 + L * NE; c2.list = (int*)(WSB() + WS_BIG + 200 * MiB); c2.gatel = (float*)(WSB() + WS_BIG + 204 * MiB); c2.slotref_out = (int*)(WSB() + WS_BIG + 208 * MiB);
                if (ROUTER_MFMA) router_pass(lds, c2, vcu, wave); else row_pass<false, true, true>(lds, c2, vcu, wave);
            }
            if (ROUTER_MFMA) router_pass(lds, c, vcu, wave); else row_pass<false, true, true>(lds, c, vcu, wave);
        }
        SEAM(pb); PT1(pb)
        PT0(pb + 1)
        if (IN(pb + 1) || IN(pb + 2)) {
            if (tid == 0) { int s = 0; for (int e = 0; e < NE; ++e) { tb[e] = s; tb[32 + e] = cnt[e]; s += (cnt[e] + 255) >> 8; } tb[NE] = s; }
            __syncthreads();
        }
        if (IN(pb + 1)) REP(pb + 1) {
            const int NT = tb[NE];
            pg8::StaticOrder S; S.init(NT, 4, G, bx);
            for (int i = 0; i < 8; ++i) { Unit u; if (!S.next(i, u)) break;
                int e = 0;
                for (int k = 1; k < NE; ++k) e += (u.pm >= tb[k]) ? 1 : 0;
                if (tid < 256) { const int li = (u.pm - tb[e]) * 256 + tid; const int tok = (li < tb[32 + e]) ? G_list[((size_t)L * NE + e) * T + li] : 0; aofs[i * 256 + tid] = (unsigned)tok * (unsigned)(D * (FP8_MOE1 ? 1 : 2)); } }
            __syncthreads();
            MoeProb1T<FP8_MOE1 != 0> P{Y, (const unsigned char*)W13 + (size_t)L * NE * 1024 * 1024 * (FP8_MOE1 ? 1 : 2), D, tb, aofs};
            EpiSwiGLU<FP8_MOE2 != 0> E{HMID, FP8_MOE1 ? (1.0f / 32.0f) : 1.0f};
            pg8::gemm_phase<MoeProb1T<FP8_MOE1 != 0>, EpiSwiGLU<FP8_MOE2 != 0>, pg8::StaticOrder, true>(lds, P, S, E);
            if (L == 0) {
                pg8::DenseProb Pf{Wpo_t, Wgs, 256, D, 256, (size_t)256 * 256};
                FoldOrder Sf{G, G - 1 - bx};
                EpiBf16 Ef{Wc_t, D};
                pg8::gemm_phase<pg8::DenseProb, EpiBf16, FoldOrder, true>(lds, Pf, Sf, Ef);
            }
        }
        SEAM(pb + 1); PT1(pb + 1)
        PT0(pb + 2)
        if (IN(pb + 2)) REP(pb + 2) {
            const int NT = tb[NE];
            pg8::StaticOrder S; S.init(NT, 4, G, bx);
            { const float gsc = (FP8_MOE2 ? (1.0f / 512.0f) : 1.0f) * (FP8_YS ? 64.0f : 1.0f);
              for (int i = 0; i < 8; ++i) { Unit u; if (!S.next(i, u)) break;
                int e = 0;
                for (int k = 1; k < NE; ++k) e += (u.pm >= tb[k]) ? 1 : 0;
                if (tid < 256) { const int li = (u.pm - tb[e]) * 256 + tid; ((LAS float*)aofs)[i * 256 + tid] = (li < tb[32 + e]) ? G_gatel[((size_t)L * NE + e) * T + li] * gsc : 0.f; } }
              __syncthreads(); }
            MoeProb2T<FP8_MOE2 != 0> P{HMID, (const unsigned char*)W2 + (size_t)L * NE * 1024 * DE * (FP8_MOE2 ? 1 : 2), DE, tb};
            EpiGate E{YS, (const LAS float*)aofs};
            pg8::gemm_phase<MoeProb2T<FP8_MOE2 != 0>, EpiGate, pg8::StaticOrder, true>(lds, P, S, E);
        }
        SEAM(pb + 2); PT1(pb + 2)
        if (L == 0) {
            PT0(8)
            if (IN(8)) {
                RowPassCfg c{}; c.hin16 = H; c.ys = YS; c.slotref = G_slotref; c.cnt_prev = cnt; c.hout = H; c.gain = KP()->norm_mix + D; c.yout = Y;
                if ((REPEAT_MASK >> 8) & 1) { RowPassCfg c2 = c; c2.hout = nullptr; row_pass<true, false, true>(lds, c2, vcu, wave); }
                row_pass<true, false, true>(lds, c, vcu, wave);
            }
            SEAM(8); PT1(8)
            PT0(9)
            if (IN(9)) REP(9) {
                pg8::DenseProb P{Y, Wpin_t, D, D, 0, (size_t)256 * D};
                pg8::StaticOrder S; S.init(T / 256, D / 256, G, bx);
                if (POOL_FUSED) { EpiPool E{POOLED, U};
                    pg8::gemm_phase<pg8::DenseProb, EpiPool, pg8::StaticOrder, true>(lds, P, S, E); }
                else { EpiBf16 E{U, D};
                    pg8::gemm_phase<pg8::DenseProb, EpiBf16, pg8::StaticOrder, true>(lds, P, S, E); }
            }
            SEAM(9); PT1(9)
            PT0(10)
            if (IN(10) && POOL_FUSED) {
                int tq10 = threadIdx.x; asm volatile("" : "+v"(tq10));
                for (int it = vcu * NTHREADS + tq10; it < (T / 64) * 128; it += G * NTHREADS) {
                    const int ch = (it & 127) * 8, b = it >> 7;
                    if ((b & 31) == 0) continue;
                    switch (ch >> 8) { case 0: seam_fix<2>(U, POOLED, b, ch); break; case 1: seam_fix<4>(U, POOLED, b, ch); break; case 2: seam_fix<8>(U, POOLED, b, ch); break; default: seam_fix<16>(U, POOLED, b, ch); break; }
                }
            }
            if (IN(10) && !POOL_FUSED) REP(10) {
                int tq10 = threadIdx.x; asm volatile("" : "+v"(tq10));
                for (int it = vcu * NTHREADS + tq10; it < (T / 32) * 128; it += G * NTHREADS) {
                    const int ch = (it & 127) * 8, run = it >> 7, t0 = run * 32, s0 = t0 & (SEQ - 1);
                    const int wdw = 2 << (ch >> 8);
                    float sum[8];
#pragma unroll
                    for (int k = 0; k < 8; ++k) sum[k] = 0.f;
                    for (int i = 1; i < wdw; ++i) { if (s0 - i < 0) break; const u32x4 a = *(const u32x4*)(U + (size_t)(t0 - i) * D + ch);
#pragma unroll
                        for (int k = 0; k < 4; ++k) { sum[2 * k] += bf_lo(a[k]); sum[2 * k + 1] += bf_hi(a[k]); } }
                    for (int i0 = 0; i0 < 32; i0 += 8) {
                        u32x4 a8[8], o8[8];
#pragma unroll
                        for (int i = 0; i < 8; ++i) { const int tk = t0 + i0 + i, sq = s0 + i0 + i;
                            a8[i] = *(const u32x4*)(U + (size_t)tk * D + ch);
                            const int tko = tk - wdw + 1; const unsigned msk = (sq - wdw + 1 >= 0) ? 0xffffffffu : 0u;
                            const u32x4 ov = *(const u32x4*)(U + (size_t)(tko < 0 ? 0 : tko) * D + ch); o8[i] = (u32x4){ov.x & msk, ov.y & msk, ov.z & msk, ov.w & msk}; }
#pragma unroll
                        for (int i = 0; i < 8; ++i) { const int tk = t0 + i0 + i, sq = s0 + i0 + i;
                            float cur[8];
#pragma unroll
                            for (int k = 0; k < 4; ++k) { cur[2 * k] = bf_lo(a8[i][k]); cur[2 * k + 1] = bf_hi(a8[i][k]); }
#pragma unroll
                            for (int k = 0; k < 8; ++k) sum[k] += cur[k];
                            const float invc = 1.0f / (float)((sq + 1) < wdw ? (sq + 1) : wdw);
                            u32x4 w;
#pragma unroll
                            for (int k = 0; k < 4; ++k) w[k] = cvtpk(sum[2 * k] * invc - cur[2 * k], sum[2 * k + 1] * invc - cur[2 * k + 1]);
                            *(u32x4*)(POOLED + (size_t)tk * D + ch) = w;
#pragma unroll
                            for (int k = 0; k < 4; ++k) { sum[2 * k] -= bf_lo(o8[i][k]); sum[2 * k + 1] -= bf_hi(o8[i][k]); }
                        }
                    }
                }
            }
            SEAM(10); PT1(10)
            PT0(11)
            if (IN(11)) REP(11) {
                pg8::DenseProb P{POOLED, Wc_t, D, D, 0, (size_t)256 * D};
                pg8::StaticOrder S; S.init(T / 256, D / 256, G, bx);
                EpiResBf16<false> E{H, (((REPEAT_MASK >> 11) & 1) && rep_ == 0) ? (bf16*)(WSB() + WS_BIG + 136 * MiB) : H};
                pg8::gemm_phase<pg8::DenseProb, EpiResBf16<false>, pg8::StaticOrder, true>(lds, P, S, E);
            }
            SEAM(11); PT1(11)
        }
    }
    PT0(15)
    if (IN(15)) {
        RowPassCfg c{}; c.hin16 = H; c.ys = YS; c.slotref = G_slotref + (size_t)T * 2; c.cnt_prev = G_ctl + CW_CNT + NE; c.gain = KP()->norm_final; c.fout = KP()->out;
        if ((REPEAT_MASK >> 15) & 1) { RowPassCfg c2 = c; c2.fout = nullptr; c2.yout = Y; row_pass<true, false, true>(lds, c2, vcu, wave); }
        row_pass<true, false, true>(lds, c, vcu, wave);
    }
    PT1(15)
#undef IN
#undef SEAM
#undef GRID_BAR
}

#undef KP
#undef WSB
#undef G_ctl
#undef G_cs
#undef G_lse
#undef G_slotref
#undef Wgs
#undef G_list
#undef G_gatel
#undef Win_t
#undef Wout_t
#undef Wpin_t
#undef Wc_t
#undef Wpo_t
#undef W13
#undef W2
#undef Y
#undef QKV
#undef OM
#undef HMID
#undef YS
#undef U
#undef POOLED
#undef OG
#undef H
extern "C" void kernel_launch(void* const* d_in, const int* in_sizes, int n_in, void* d_out, int out_size, void* d_ws, size_t ws_size, hipStream_t stream) {
    static int grid = 0;
    if (grid == 0) {
        if (n_in != 18 || in_sizes[0] != T * D || out_size != T * D || ws_size < WS_END) { fprintf(stderr, "kernel_launch: unexpected shapes (n_in %d, in0 %d, out %d, ws %zu)\n", n_in, n_in > 0 ? in_sizes[0] : -1, out_size, ws_size); grid = -1; return; }
        int dev = 0, cus = 0, per_cu = 0;
        if (hipGetDevice(&dev) != hipSuccess || hipDeviceGetAttribute(&cus, hipDeviceAttributeMultiprocessorCount, dev) != hipSuccess) { grid = -1; return; }
        if (hipFuncSetAttribute((const void*)fwd_kernel, hipFuncAttributeMaxDynamicSharedMemorySize, LDS_BYTES) != hipSuccess) { fprintf(stderr, "kernel_launch: hipFuncSetAttribute failed\n"); grid = -1; return; }
        if (hipOccupancyMaxActiveBlocksPerMultiprocessor(&per_cu, (const void*)fwd_kernel, NTHREADS, LDS_BYTES) != hipSuccess || per_cu < 1) { fprintf(stderr, "kernel_launch: occupancy query says %d\n", per_cu); per_cu = 1; }
        (void)hipGetLastError();
        grid = cus;
    }
    if (grid < 0) return;
    (void)hipMemsetAsync((char*)d_ws + WS_CTL, 0, CTL_ZERO_BYTES, stream);
    Params p{};
    p.x = (const float*)d_in[0]; p.positions = (const int*)d_in[1]; p.norm_mix = (const float*)d_in[2]; p.norm_ffn = (const float*)d_in[3]; p.norm_final = (const float*)d_in[4];
    p.attn_w_in = (const float*)d_in[5]; p.attn_w_out = (const float*)d_in[6]; p.pool_w_in = (const float*)d_in[7]; p.pool_w_group = (const float*)d_in[8]; p.pool_scale = (const float*)d_in[9]; p.pool_w_out = (const float*)d_in[10];
    p.router_group_w = (const float*)d_in[11]; p.router_group_b = (const float*)d_in[12]; p.router_expert_w = (const float*)d_in[13]; p.router_expert_b = (const float*)d_in[14];
    p.expert_w1 = (const float*)d_in[15]; p.expert_w3 = (const float*)d_in[16]; p.expert_w2 = (const float*)d_in[17];
    p.out = (float*)d_out; p.ws = (unsigned char*)d_ws;
#if MK_N_LAUNCHES == 1
    p.ph_lo = 0; p.ph_hi = N_PHASES;
    void* args[] = {&p};
    hipError_t e = hipLaunchCooperativeKernel((const void*)fwd_kernel, dim3(grid), dim3(NTHREADS), args, LDS_BYTES, stream);
    if (e != hipSuccess) fprintf(stderr, "cooperative launch failed: %s (grid %d)\n", hipGetErrorString(e), grid);
#else
    for (int ph = 0; ph < N_PHASES; ++ph) {
        p.ph_lo = ph; p.ph_hi = ph + 1;
        hipLaunchKernelGGL(fwd_kernel, dim3(grid), dim3(NTHREADS), LDS_BYTES, stream, p);
    }
#endif
}
```

```cpp
#include <hip/hip_runtime.h>
#include <hip/hip_cooperative_groups.h>
#include <cstdio>
#include <cstdint>
namespace cg = cooperative_groups;

#ifndef MK_N_LAUNCHES
#define MK_N_LAUNCHES 1
#endif

#ifndef FP8_MOE1
#define FP8_MOE1 1
#endif
#ifndef FP8_MOE2
#define FP8_MOE2 1
#endif
#ifndef FP8_OUT
#define FP8_OUT 1
#endif
#ifndef GATE_FOLD
#define GATE_FOLD 1
#endif
#ifndef FP8_POOL2
#define FP8_POOL2 1
#endif
#ifndef POOL_FUSED
#define POOL_FUSED 1
#endif
#ifndef FP8_QKVS
#define FP8_QKVS 1
#endif
#ifndef ROUTER_MFMA
#define ROUTER_MFMA 1
#endif
#ifndef FP8_OG
#define FP8_OG 1
#endif
#ifndef FP8_YS
#define FP8_YS 1
#endif
#ifndef FP8_QKV
#define FP8_QKV 1
#endif
#define LAS __attribute__((address_space(3)))
#define GAS __attribute__((address_space(1)))
typedef unsigned short bf16;
typedef short bf16x8 __attribute__((ext_vector_type(8)));
typedef float f32x4 __attribute__((ext_vector_type(4)));
typedef float f32x2 __attribute__((ext_vector_type(2)));
typedef float f32x16 __attribute__((ext_vector_type(16)));
typedef unsigned u32x4 __attribute__((ext_vector_type(4)));
typedef unsigned u32x2 __attribute__((ext_vector_type(2)));
typedef short s16x4 __attribute__((ext_vector_type(4)));
typedef __bf16 bf16x2_t __attribute__((ext_vector_type(2)));
typedef int i32x4 __attribute__((ext_vector_type(4)));
typedef int i32x8 __attribute__((ext_vector_type(8)));

constexpr int BATCH = 16, SEQ = 2048, D = 1024, T = BATCH * SEQ;
constexpr int NG = 3, HPG = 8, HD = 64, AW = 512, QKVW = NG * 3 * AW;
constexpr int NE = 16, DE = 512, SLOTS = 2 * T;
constexpr int MAXTILES = SLOTS / 256 + NE;
constexpr float RMS_EPS = 1e-6f;
constexpr int NWAVES = 8, NTHREADS = 512;

constexpr size_t MiB = 1u << 20;
constexpr size_t WS_CTL = 0, CTL_ZERO_BYTES = 20 * 1024;
constexpr size_t WS_CS = 1 * MiB;
constexpr size_t WS_LSE = 3 * MiB;
constexpr size_t WS_SLOTREF = 6 * MiB;
constexpr size_t WS_WGS = 7 * MiB;
constexpr size_t WS_LIST = 8 * MiB;
constexpr size_t WS_GATEL = 12 * MiB;
constexpr size_t WS_WIN = 16 * MiB;
constexpr size_t WS_WOUT = 25 * MiB;
constexpr size_t WS_WPIN = 26 * MiB;
constexpr size_t WS_WC = 28 * MiB;
constexpr size_t WS_WPO = 30 * MiB;
constexpr size_t WS_W13 = 32 * MiB;
constexpr size_t WS_W2 = 96 * MiB;
constexpr size_t WS_Y = 128 * MiB;
constexpr size_t WS_BIG = 192 * MiB;
constexpr size_t WS_OM = WS_BIG;
constexpr size_t WS_HMID = WS_BIG;
constexpr size_t WS_YS = WS_BIG + 72 * MiB;
constexpr size_t WS_U = WS_BIG;
constexpr size_t WS_POOLED = WS_BIG + 64 * MiB;
constexpr size_t WS_H = WS_BIG + 208 * MiB;
constexpr size_t WS_END = WS_BIG + 288 * MiB;
constexpr int CW_CNT = 0;
constexpr int CW_BAR = 1024;
#ifndef CG_SEAM
#define CG_SEAM (-1)
#endif

constexpr int RING_BYTES = 131072;
constexpr int AOFS_OFF = RING_BYTES;
constexpr int MISC_OFF = AOFS_OFF + 8192;
constexpr int LDS_BYTES = 147456;

__device__ __forceinline__ unsigned cvtpk(float lo, float hi) { f32x2 v = {lo, hi}; bf16x2_t b = __builtin_convertvector(v, bf16x2_t); return __builtin_bit_cast(unsigned, b); }
__device__ __forceinline__ float clamp8(float v) { return __builtin_amdgcn_fmed3f(v, -448.0f, 448.0f); }
__device__ __forceinline__ unsigned pack_fp8x4(float a, float b, float c, float d) {
    int r = __builtin_amdgcn_cvt_pk_fp8_f32(clamp8(a), clamp8(b), 0, false); r = __builtin_amdgcn_cvt_pk_fp8_f32(clamp8(c), clamp8(d), r, true); return (unsigned)r; }
__device__ __forceinline__ float bf_lo(unsigned u) { return __uint_as_float(u << 16); }
__device__ __forceinline__ float bf_hi(unsigned u) { return __uint_as_float(u & 0xffff0000u); }
#define DPP_ADD(v, ctrl) ((v) + __builtin_bit_cast(float, __builtin_amdgcn_update_dpp(0, __builtin_bit_cast(int, (v)), (ctrl), 0xF, 0xF, true)))
__device__ __forceinline__ float rows_sum(float v) {
    auto p = __builtin_amdgcn_permlane16_swap(__float_as_uint(v), __float_as_uint(v), false, false);
    const float t = __uint_as_float(p[0]) + __uint_as_float(p[1]);
    auto q = __builtin_amdgcn_permlane32_swap(__float_as_uint(t), __float_as_uint(t), false, false);
    return __uint_as_float(q[0]) + __uint_as_float(q[1]);
}
__device__ __forceinline__ float wave_sum(float v) {
    v = DPP_ADD(v, 0xB1);
    v = DPP_ADD(v, 0x4E);
    v = DPP_ADD(v, 0x141);
    v = DPP_ADD(v, 0x140);
    return rows_sum(v);
}

namespace pg8 {
constexpr int BM = 256, BK = 64, HALF = 128, HTB = HALF * BK * 2, STAGE_BYTES = 8 * HTB, NXCD = 8, WGM = 8;
__host__ __device__ __forceinline__ int lds_byte(int r, int c) { const int st = (r >> 4) * 2 + (c >> 5), rr = r & 15, cc = c & 31, ob = rr * 64 + cc * 2; return st * 1024 + (ob ^ (((ob >> 9) & 1) << 5)); }
__host__ __device__ __forceinline__ void stage_rc(int b, int& R, int& C) { const int st = b / 1024, sb = b % 1024, swz = sb ^ (((sb >> 9) & 1) << 5); R = (st >> 1) * 16 + swz / 64; C = (st & 1) * 32 + (swz % 64) / 2; }
__host__ __device__ __forceinline__ int perm32(int rho) { const int n = rho >> 4, i = rho & 15; return 8 * (i >> 2) + 4 * n + (i & 3); }

struct Unit { int pm, pn, idx; };

struct StaticOrder {
    int nM, nN, nwg, G, c;
    __device__ __forceinline__ void init(int nM_, int nN_, int G_, int c_) { nM = nM_; nN = nN_; nwg = nM * nN; G = G_; c = c_; }
    __device__ __forceinline__ bool next(int i, Unit& u) const {
        const long L = (long)i * G + c; if (L >= nwg) return false;
        int wgid = (int)L; { const int q = nwg / NXCD, r = nwg % NXCD, xcd = wgid % NXCD, off = wgid / NXCD; wgid = (xcd < r ? xcd * (q + 1) : r * (q + 1) + (xcd - r) * q) + off; }
        const int nig = WGM * nN, gid = wgid / nig, fm = gid * WGM, gsz = (nM - fm) < WGM ? (nM - fm) : WGM;
        u.pm = fm + ((wgid % nig) % gsz); u.pn = (wgid % nig) / gsz; return true;
    }
};

template <class Prob, class Epi, class Sched, bool ALIGN_EPI>
__device__ __forceinline__ void gemm_phase(LAS unsigned char* lds, const Prob& P, const Sched& S, const Epi& E) {
    int tid_ = threadIdx.x; asm volatile("" : "+v"(tid_));
    const int tid = tid_, wid = __builtin_amdgcn_readfirstlane(tid >> 6), lane = tid & 63, wr = wid >> 2, wc = wid & 3, fr = lane & 15, fq = lane >> 4;
    constexpr bool F8 = Prob::F8;
    const int Kb = P.K * (F8 ? 1 : 2), nt = Kb / (BK * 2);
    int Rr[2], Cc[2]; unsigned voffB[2];
#pragma unroll
    for (int i = 0; i < 2; ++i) { int R, C; stage_rc(tid * 16 + i * 8192, R, C); Rr[i] = R; Cc[i] = C; const int Rb = Epi::PERM ? ((R & ~31) + perm32(R & 31)) : R; voffB[i] = (unsigned)(Rb * Kb + C * 2); }
    const unsigned kstep = (unsigned)(BK * 2);
    const unsigned hstep = (unsigned)(HALF * Kb);
    const unsigned ldsw = (unsigned)wid * 1024u;
    const int aoff = lds_byte(wr * 64 + fr, fq * 8), boff = lds_byte(wc * 32 + fr, fq * 8);
    const __amdgpu_buffer_rsrc_t rsA = __builtin_amdgcn_make_buffer_rsrc((void*)P.A, 0, 0xFFFFFFFF, 0x00020000);
    const __amdgpu_buffer_rsrc_t rsB = __builtin_amdgcn_make_buffer_rsrc((void*)P.Bt, 0, 0xFFFFFFFF, 0x00020000);
#define PG8_SA(b, h) (((b) * 2 + (h)) * HTB)
#define PG8_SB(b, h) ((4 + (b) * 2 + (h)) * HTB)
#define PG8_STAGE_B(bufoff, sB) do { _Pragma("unroll") for (int _i = 0; _i < 2; ++_i) \
        __builtin_amdgcn_raw_ptr_buffer_load_lds(rsB, (LAS void*)(lds + (bufoff) + ldsw + _i * 8192), 16, (int)voffB[_i], (int)(sB), 0, 0); } while (0)
#define PG8_STAGE_A(bufoff, kb, o) do { _Pragma("unroll") for (int _i = 0; _i < 2; ++_i) \
        __builtin_amdgcn_raw_ptr_buffer_load_lds(rsA, (LAS void*)(lds + (bufoff) + ldsw + _i * 8192), 16, (int)(o)[_i], (int)(kb), 0, 0); } while (0)
#define PG8_LD2(p_) PG8_CAT(*(const LAS i32x4*)(p_), *(const LAS i32x4*)((p_) + 1024))
#define PG8_LDA(dst, b, h) do { if constexpr (F8) { _Pragma("unroll") for (int m = 0; m < 4; ++m) dst##8[m] = PG8_LD2(lds + PG8_SA(b, h) + aoff + m * 2048); } \
        else { _Pragma("unroll") for (int m = 0; m < 4; ++m) _Pragma("unroll") for (int k = 0; k < 2; ++k) dst[m][k] = *(const LAS bf16x8*)(lds + PG8_SA(b, h) + aoff + m * 2048 + k * 1024); } } while (0)
#define PG8_LDB(dst, b, h) do { if constexpr (F8) { _Pragma("unroll") for (int n = 0; n < 2; ++n) dst##8[n] = PG8_LD2(lds + PG8_SB(b, h) + boff + n * 2048); } \
        else { _Pragma("unroll") for (int n = 0; n < 2; ++n) _Pragma("unroll") for (int k = 0; k < 2; ++k) dst[n][k] = *(const LAS bf16x8*)(lds + PG8_SB(b, h) + boff + n * 2048 + k * 1024); } } while (0)
#define PG8_CAT(x0, x1) __builtin_shufflevector((x0), (x1), 0, 1, 2, 3, 4, 5, 6, 7)
#define PG8_MMA(ai, bj, At, Bt) do { __builtin_amdgcn_s_setprio(1); \
        if constexpr (F8) { _Pragma("unroll") for (int m = 0; m < 4; ++m) _Pragma("unroll") for (int n = 0; n < 2; ++n) \
            acc[ai][bj][m][n] = __builtin_amdgcn_mfma_scale_f32_16x16x128_f8f6f4(Bt##8[n], At##8[m], acc[ai][bj][m][n], 0, 0, 0, 0, 0, 0); } \
        else { _Pragma("unroll") for (int m = 0; m < 4; ++m) _Pragma("unroll") for (int n = 0; n < 2; ++n) _Pragma("unroll") for (int k = 0; k < 2; ++k) \
            acc[ai][bj][m][n] = __builtin_amdgcn_mfma_f32_16x16x32_bf16(Bt[n][k], At[m][k], acc[ai][bj][m][n], 0, 0, 0); } \
        __builtin_amdgcn_s_setprio(0); } while (0)
#define PG8_WAIT_V(n) asm volatile("s_waitcnt vmcnt(" #n ")" ::: "memory")
#define PG8_WAIT_L(n) asm volatile("s_waitcnt lgkmcnt(" #n ")" ::: "memory")
#define PG8_BAR __builtin_amdgcn_s_barrier()
#define PG8_SCHED __builtin_amdgcn_sched_barrier(0)
    Unit cur, nxt; int ui = 0;
    if (!S.next(0, cur)) return;
    cur.idx = 0;
    f32x4 acc[2][2][4][2];
#pragma unroll
    for (int a = 0; a < 2; ++a)
#pragma unroll
        for (int b = 0; b < 2; ++b)
#pragma unroll
            for (int m = 0; m < 4; ++m)
#pragma unroll
                for (int n = 0; n < 2; ++n) acc[a][b][m][n] = (f32x4){0.f, 0.f, 0.f, 0.f};
    bf16x8 At[4][2], B0[2][2], B1[2][2]; i32x8 At8[4], B08[2], B18[2];
    unsigned ca0[2], ca1[2];
    P.a_offs(0, cur, Rr, Cc, ca0, ca1);
    unsigned cB = P.b_off(cur);
    PG8_STAGE_B(PG8_SB(0, 0), cB); PG8_STAGE_B(PG8_SB(0, 1), cB + hstep); PG8_STAGE_A(PG8_SA(0, 0), 0, ca0); PG8_STAGE_A(PG8_SA(0, 1), 0, ca1);
    if (wr == 1) PG8_BAR;
    PG8_WAIT_V(2); PG8_BAR;
    PG8_STAGE_B(PG8_SB(1, 0), cB + kstep); PG8_STAGE_A(PG8_SA(1, 0), kstep, ca0); PG8_STAGE_B(PG8_SB(1, 1), cB + hstep + kstep);
    PG8_WAIT_V(6); PG8_BAR;
    for (;;) {
        const bool has_next = S.next(ui + 1, nxt); nxt.idx = ui + 1;
        unsigned nB = cB;
        if (has_next) nB = P.b_off(nxt);
#pragma unroll 1
        for (int t = 0; t < nt; t += 2) {
            const bool last = (t == nt - 2);
            const unsigned k1 = (unsigned)(t + 1) * kstep;
            const unsigned k2 = last ? 0u : (unsigned)(t + 2) * kstep, k3 = k2 + kstep;
            const unsigned b2 = last ? nB : cB + (unsigned)(t + 2) * kstep; const unsigned b3 = b2 + kstep;
            PG8_LDB(B0, 0, 0); PG8_LDB(B1, 0, 1); PG8_SCHED; PG8_LDA(At, 0, 0); PG8_STAGE_A(PG8_SA(1, 1), k1, ca1);
            if (last && has_next) {
                int tq = threadIdx.x; asm volatile("" : "+v"(tq)); int R2[2], C2[2];
#pragma unroll
                for (int i = 0; i < 2; ++i) stage_rc(tq * 16 + i * 8192, R2[i], C2[i]);
                P.a_offs(ui + 1, nxt, R2, C2, ca0, ca1);
            }
            PG8_WAIT_V(8); PG8_WAIT_L(0); PG8_BAR; PG8_MMA(0, 0, At, B0); PG8_MMA(0, 1, At, B1); PG8_BAR; PG8_SCHED;
            PG8_LDA(At, 0, 1); PG8_STAGE_B(PG8_SB(0, 0), b2); PG8_STAGE_B(PG8_SB(0, 1), b2 + hstep); PG8_STAGE_A(PG8_SA(0, 0), k2, ca0);
            PG8_WAIT_V(8); PG8_WAIT_L(0); PG8_BAR; PG8_MMA(1, 0, At, B0); PG8_MMA(1, 1, At, B1); PG8_BAR; PG8_SCHED;
            PG8_LDB(B0, 1, 0); PG8_LDB(B1, 1, 1); PG8_SCHED; PG8_LDA(At, 1, 0); PG8_STAGE_A(PG8_SA(0, 1), k2, ca1);
            PG8_WAIT_V(8); PG8_WAIT_L(0); PG8_BAR; PG8_MMA(0, 0, At, B0); PG8_MMA(0, 1, At, B1); PG8_BAR; PG8_SCHED;
            PG8_LDA(At, 1, 1); PG8_STAGE_B(PG8_SB(1, 0), b3); PG8_STAGE_B(PG8_SB(1, 1), b3 + hstep); PG8_STAGE_A(PG8_SA(1, 0), k3, ca0);
            PG8_WAIT_V(8); PG8_WAIT_L(0); PG8_BAR; PG8_MMA(1, 0, At, B0); PG8_MMA(1, 1, At, B1); PG8_BAR; PG8_SCHED;
        }
        if constexpr (ALIGN_EPI) { if (wr == 0) PG8_BAR; }
        { int te = threadIdx.x; asm volatile("" : "+v"(te));
          E(acc, cur, wr, wc, te & 15, (te >> 4) & 3); }
        if (!has_next) break;
#pragma unroll
        for (int a = 0; a < 2; ++a)
#pragma unroll
            for (int b = 0; b < 2; ++b)
#pragma unroll
                for (int m = 0; m < 4; ++m)
#pragma unroll
                    for (int n = 0; n < 2; ++n) acc[a][b][m][n] = (f32x4){0.f, 0.f, 0.f, 0.f};
        cur = nxt; cB = nB; ++ui;
        if constexpr (ALIGN_EPI) { if (wr == 1) PG8_BAR; }
    }
    PG8_WAIT_V(0);
    if constexpr (!ALIGN_EPI) { if (wr == 0) PG8_BAR; }
    PG8_BAR;
#undef PG8_SA
#undef PG8_SB
#undef PG8_STAGE_A
#undef PG8_STAGE_B
#undef PG8_LDA
#undef PG8_LD2
#undef PG8_LDB
#undef PG8_MMA
#undef PG8_CAT
#undef PG8_WAIT_V
#undef PG8_WAIT_L
#undef PG8_BAR
#undef PG8_SCHED
}

template <bool F8_>
struct DenseProbT {
    static constexpr bool F8 = F8_;
    const void* A; const void* Bt; int K, lda, acolstep; size_t bstep_pn;
    __device__ __forceinline__ void a_offs(int, const Unit& u, const int (&R)[2], const int (&C)[2], unsigned (&o0)[2], unsigned (&o1)[2]) const {
        constexpr int esz = F8 ? 1 : 2;
#pragma unroll
        for (int i = 0; i < 2; ++i) { const unsigned b = (unsigned)(((u.pm * BM + R[i]) * lda + u.pn * acolstep) * esz + C[i] * 2); o0[i] = b; o1[i] = b + (unsigned)(HALF * lda * esz); }
    }
    __device__ __forceinline__ unsigned b_off(const Unit& u) const { return (unsigned)((size_t)u.pn * bstep_pn * (F8 ? 1 : 2)); }
};
typedef DenseProbT<false> DenseProb;
}

struct Params {
    const float* x; const int* positions; const float* norm_mix; const float* norm_ffn; const float* norm_final;
    const float* attn_w_in; const float* attn_w_out; const float* pool_w_in; const float* pool_w_group; const float* pool_scale; const float* pool_w_out;
    const float* router_group_w; const float* router_group_b; const float* router_expert_w; const float* router_expert_b;
    const float* expert_w1; const float* expert_w3; const float* expert_w2;
    float* out; unsigned char* ws;
    int ph_lo, ph_hi;
};

template <class MapN>
__device__ __forceinline__ void transpose_item(const float* W, int ldw, int K, bf16* WT, MapN mapn, LAS float* scr, int k0, int n0, int lane) {
#pragma unroll 32
    for (int i = 0; i < 32; ++i) { const int kk = 2 * i + (lane >> 5); scr[kk * 33 + (lane & 31)] = __builtin_nontemporal_load(W + (size_t)(k0 + kk) * ldw + n0 + (lane & 31)); }
    asm volatile("s_waitcnt lgkmcnt(0)" ::: "memory");
    const int c = lane & 7;
#pragma unroll
    for (int j = 0; j < 4; ++j) { const int n = (lane >> 3) + 8 * j; const LAS float* s = scr + (8 * c) * 33 + n;
        u32x4 o; o.x = cvtpk(s[0 * 33], s[1 * 33]); o.y = cvtpk(s[2 * 33], s[3 * 33]); o.z = cvtpk(s[4 * 33], s[5 * 33]); o.w = cvtpk(s[6 * 33], s[7 * 33]);
        *(u32x4*)(WT + (size_t)mapn(n0 + n) * K + k0 + 8 * c) = o; }
    asm volatile("s_waitcnt lgkmcnt(0)" ::: "memory");
}
template <class MapN>
__device__ __forceinline__ void transpose_item8(const float* W, int ldw, int K, unsigned char* WT, MapN mapn, float sc, LAS float* scr, int k0, int n0, int lane) {
#pragma unroll 32
    for (int i = 0; i < 32; ++i) { const int kk = 2 * i + (lane >> 5); scr[kk * 33 + (lane & 31)] = __builtin_nontemporal_load(W + (size_t)(k0 + kk) * ldw + n0 + (lane & 31)); }
    asm volatile("s_waitcnt lgkmcnt(0)" ::: "memory");
    const int c = lane & 7;
#pragma unroll
    for (int j = 0; j < 4; ++j) { const int n = (lane >> 3) + 8 * j; const LAS float* s = scr + (8 * c) * 33 + n;
        u32x2 o; o.x = pack_fp8x4(s[0 * 33] * sc, s[1 * 33] * sc, s[2 * 33] * sc, s[3 * 33] * sc); o.y = pack_fp8x4(s[4 * 33] * sc, s[5 * 33] * sc, s[6 * 33] * sc, s[7 * 33] * sc);
        *(u32x2*)(WT + (size_t)mapn(n0 + n) * K + k0 + 8 * c) = o; }
    asm volatile("s_waitcnt lgkmcnt(0)" ::: "memory");
}
struct MapId { __device__ __forceinline__ int operator()(int n) const { return n; } };
struct MapQKV {
    __device__ __forceinline__ int operator()(int n) const { const int rem = n % 1536, kind = rem / 512, d = n & 63; if (kind < 2 && d < 16) return n - d + (d < 8 ? 2 * d : 2 * (d - 8) + 1); return n; }
};
struct MapW13 { int add; __device__ __forceinline__ int operator()(int n) const { return (n >> 7) * 256 + add + (n & 127); } };

struct RowPassCfg {
    const float* hin;
    const bf16* hin16;
    const bf16* ys; const int* slotref; const int* cnt_prev;
    bf16* hout;
    const float* gain;
    bf16* yout;
    unsigned char* yout8;
    float* fout;
    const float* rgw; const float* rgb; const float* rew; const float* reb;
    int* cnt; int* list; float* gatel; int* slotref_out;
    float* rms_out;
};

__device__ __forceinline__ void build_tile_base(LAS int* tb, const int* cnt, int) {
    int tid = threadIdx.x; asm volatile("" : "+v"(tid));
    if (tid < 64) {
        const int c = (tid < NE) ? cnt[tid] : 0;
        int v = (c + 255) >> 8;
        int incl = v;
        { int t_; t_ = __builtin_amdgcn_update_dpp(0, incl, 0x111, 0xF, 0xF, true); incl += t_; t_ = __builtin_amdgcn_update_dpp(0, incl, 0x112, 0xF, 0xF, true); incl += t_;
          t_ = __builtin_amdgcn_update_dpp(0, incl, 0x114, 0xF, 0xF, true); incl += t_; t_ = __builtin_amdgcn_update_dpp(0, incl, 0x118, 0xF, 0xF, true); incl += t_; }
        if (tid < NE) { tb[tid] = incl - v; tb[32 + tid] = c; if (tid == NE - 1) tb[NE] = incl; }
    }
}
__device__ __forceinline__ void route_decide(const float (&a)[20], const float* rgb, const float* reb, int& e0, int& e1, float& g0, float& g1) {
    float lg[4];
#pragma unroll
    for (int g = 0; g < 4; ++g) lg[g] = a[g] + rgb[g];
    int gs = 0; float gm = lg[0];
#pragma unroll
    for (int g = 1; g < 4; ++g) if (lg[g] > gm) { gm = lg[g]; gs = g; }
    float den = 0.f;
#pragma unroll
    for (int g = 0; g < 4; ++g) den += __expf(lg[g] - gm);
    const float gate1 = 1.0f / den;
    float le[4];
#pragma unroll
    for (int e = 0; e < 4; ++e) { const float sel = gs == 0 ? a[4 + e] : gs == 1 ? a[8 + e] : gs == 2 ? a[12 + e] : a[16 + e]; le[e] = sel + reb[gs * 4 + e]; }
    int i0 = 0; float v0 = le[0];
#pragma unroll
    for (int e = 1; e < 4; ++e) if (le[e] > v0) { v0 = le[e]; i0 = e; }
    int i1 = -1; float v1 = -INFINITY;
#pragma unroll
    for (int e = 0; e < 4; ++e) if (e != i0 && le[e] > v1) { v1 = le[e]; i1 = e; }
    const float ex = __expf(v1 - v0), p0 = 1.0f / (1.0f + ex), p1 = ex * p0;
    e0 = gs * 4 + i0; e1 = gs * 4 + i1; g0 = gate1 * p0; g1 = gate1 * p1;
}

template <bool COMBINE, bool ROUTER, bool HIN16>
__device__ __forceinline__ void row_pass(LAS unsigned char* lds, const RowPassCfg& c, int vcu, int wave) {
    int tid = threadIdx.x; asm volatile("" : "+v"(tid)); const int lane = tid & 63;
    LAS float* Wr = (LAS float*)lds;
    LAS int* selE = (LAS int*)(lds + 81920);
    LAS float* selG = (LAS float*)(lds + 81920 + 1024);
    LAS int* wcnt = (LAS int*)(lds + 81920 + 2048);
    LAS int* tb = (LAS int*)(lds + MISC_OFF);
    if (ROUTER) {
        for (int k = tid; k < 1024; k += NTHREADS) {
            const f32x4 g4 = *(const f32x4*)(c.rgw + (size_t)k * 4);
            Wr[0 * 1024 + k] = g4.x; Wr[1 * 1024 + k] = g4.y; Wr[2 * 1024 + k] = g4.z; Wr[3 * 1024 + k] = g4.w;
#pragma unroll
            for (int g = 0; g < 4; ++g) { const f32x4 e4 = *(const f32x4*)(c.rew + ((size_t)g * 1024 + k) * 4);
                Wr[(4 + g * 4 + 0) * 1024 + k] = e4.x; Wr[(4 + g * 4 + 1) * 1024 + k] = e4.y; Wr[(4 + g * 4 + 2) * 1024 + k] = e4.z; Wr[(4 + g * 4 + 3) * 1024 + k] = e4.w; }
        }
    }
    if (COMBINE && MK_N_LAUNCHES != 1) {
        build_tile_base(tb, c.cnt_prev, tid);
    }
    __syncthreads();
    f32x4 gn[4];
#pragma unroll
    for (int j = 0; j < 4; ++j) gn[j] = c.gain ? *(const f32x4*)(c.gain + 4 * lane + 256 * j) : (f32x4){1.f, 1.f, 1.f, 1.f};
    for (int rb = vcu; rb < T / 128; rb += gridDim.x) {
        const int rbase = rb * 128 + wave * 16;
        int refs = 0;
        if (COMBINE) { if (lane < 32) refs = c.slotref[rbase * 2 + lane]; }
        f32x4 hv[2][2][4]; u32x2 hb[2][2][4]; u32x2 yv[2][2][2][4];
#define RP_ISSUE(buf, pr) do { _Pragma("unroll") for (int r = 0; r < 2; ++r) { const int row = rbase + 2 * (pr) + r; \
            if (HIN16) { _Pragma("unroll") for (int j = 0; j < 4; ++j) hb[buf][r][j] = *(const u32x2*)(c.hin16 + (size_t)row * D + 4 * lane + 256 * j); } \
            else { _Pragma("unroll") for (int j = 0; j < 4; ++j) hv[buf][r][j] = __builtin_nontemporal_load((const f32x4*)(c.hin + (size_t)row * D + 4 * lane + 256 * j)); } \
            if (COMBINE) { _Pragma("unroll") for (int sl = 0; sl < 2; ++sl) { const int ref = __builtin_amdgcn_readlane(refs, (2 * (pr) + r) * 2 + sl); const int e = ref >> 15, pos = ref & 32767; \
                if (FP8_YS) { const unsigned char* yr = (const unsigned char*)c.ys + ((size_t)tb[e] * 256 + pos) * D; \
                    _Pragma("unroll") for (int j = 0; j < 4; ++j) yv[buf][r][sl][j].x = *(const unsigned*)(yr + 4 * lane + 256 * j); } \
                else { const bf16* yr = c.ys + ((size_t)tb[e] * 256 + pos) * D; \
                    _Pragma("unroll") for (int j = 0; j < 4; ++j) yv[buf][r][sl][j] = *(const u32x2*)(yr + 4 * lane + 256 * j); } } } } } while (0)
#define RP_PROCESS(buf, pr) do { f32x4 v[2][4]; \
            _Pragma("unroll") for (int r = 0; r < 2; ++r) { const int row = rbase + 2 * (pr) + r; \
                _Pragma("unroll") for (int j = 0; j < 4; ++j) { if (HIN16) { const u32x2 w0 = hb[buf][r][j]; v[r][j] = (f32x4){bf_lo(w0.x), bf_hi(w0.x), bf_lo(w0.y), bf_hi(w0.y)}; } else v[r][j] = hv[buf][r][j]; \
                    if (COMBINE) { _Pragma("unroll") for (int sl = 0; sl < 2; ++sl) { const u32x2 w = yv[buf][r][sl][j]; \
                        if (FP8_YS) { const f32x2 lo2 = __builtin_amdgcn_cvt_pk_f32_fp8((int)w.x, false), hi2 = __builtin_amdgcn_cvt_pk_f32_fp8((int)w.x, true); \
                            v[r][j].x += lo2.x * (1.0f / 64.0f); v[r][j].y += lo2.y * (1.0f / 64.0f); v[r][j].z += hi2.x * (1.0f / 64.0f); v[r][j].w += hi2.y * (1.0f / 64.0f); } \
                        else { v[r][j].x += bf_lo(w.x); v[r][j].y += bf_hi(w.x); v[r][j].z += bf_lo(w.y); v[r][j].w += bf_hi(w.y); } } } } \
                if (c.hout) { _Pragma("unroll") for (int j = 0; j < 4; ++j) { u32x2 w; w.x = cvtpk(v[r][j].x, v[r][j].y); w.y = cvtpk(v[r][j].z, v[r][j].w); *(u32x2*)(c.hout + (size_t)row * D + 4 * lane + 256 * j) = w; \
                    v[r][j] = (f32x4){bf_lo(w.x), bf_hi(w.x), bf_lo(w.y), bf_hi(w.y)}; } } \
                float ss = 0.f; \
                _Pragma("unroll") for (int j = 0; j < 4; ++j) ss += (v[r][j].x * v[r][j].x + v[r][j].y * v[r][j].y) + (v[r][j].z * v[r][j].z + v[r][j].w * v[r][j].w); \
                const float rms_ = sqrtf(wave_sum(ss) * (1.0f / D) + RMS_EPS); const float rstd = 1.0f / rms_; \
                if (c.rms_out) { if (lane == 0) c.rms_out[row] = rms_; } \
                _Pragma("unroll") for (int j = 0; j < 4; ++j) { v[r][j].x = v[r][j].x * rstd * gn[j].x; v[r][j].y = v[r][j].y * rstd * gn[j].y; v[r][j].z = v[r][j].z * rstd * gn[j].z; v[r][j].w = v[r][j].w * rstd * gn[j].w; } \
                if (c.yout) { _Pragma("unroll") for (int j = 0; j < 4; ++j) { u32x2 w; w.x = cvtpk(v[r][j].x, v[r][j].y); w.y = cvtpk(v[r][j].z, v[r][j].w); *(u32x2*)(c.yout + (size_t)row * D + 4 * lane + 256 * j) = w; } } \
                if (c.yout8) { _Pragma("unroll") for (int j = 0; j < 4; ++j) *(unsigned*)(c.yout8 + (size_t)row * D + 4 * lane + 256 * j) = pack_fp8x4(v[r][j].x, v[r][j].y, v[r][j].z, v[r][j].w); } \
                if (c.fout) { _Pragma("unroll") for (int j = 0; j < 4; ++j) *(f32x4*)(c.fout + (size_t)row * D + 4 * lane + 256 * j) = v[r][j]; } } \
            if (ROUTER) { float a0[20], a1[20]; f32x2 vv[4][4];        \
                _Pragma("unroll") for (int j = 0; j < 4; ++j) { vv[j][0] = (f32x2){v[0][j].x, v[1][j].x}; vv[j][1] = (f32x2){v[0][j].y, v[1][j].y}; vv[j][2] = (f32x2){v[0][j].z, v[1][j].z}; vv[j][3] = (f32x2){v[0][j].w, v[1][j].w}; } \
                _Pragma("unroll") for (int o = 0; o < 20; ++o) { f32x2 s2 = {0.f, 0.f}; \
                    _Pragma("unroll") for (int j = 0; j < 4; ++j) { const f32x4 w = *(const LAS f32x4*)(Wr + o * 1024 + 4 * lane + 256 * j); \
                        s2 = __builtin_elementwise_fma(vv[j][0], (f32x2){w.x, w.x}, s2); s2 = __builtin_elementwise_fma(vv[j][1], (f32x2){w.y, w.y}, s2); \
                        s2 = __builtin_elementwise_fma(vv[j][2], (f32x2){w.z, w.z}, s2); s2 = __builtin_elementwise_fma(vv[j][3], (f32x2){w.w, w.w}, s2); } \
                    a0[o] = s2.x; a1[o] = s2.y; if ((o & 3) == 3) __builtin_amdgcn_sched_barrier(0); } \
                _Pragma("unroll") for (int o = 0; o < 20; ++o) { a0[o] = DPP_ADD(a0[o], 0xB1); a1[o] = DPP_ADD(a1[o], 0xB1); } \
                _Pragma("unroll") for (int o = 0; o < 20; ++o) { a0[o] = DPP_ADD(a0[o], 0x4E); a1[o] = DPP_ADD(a1[o], 0x4E); } \
                _Pragma("unroll") for (int o = 0; o < 20; ++o) { a0[o] = DPP_ADD(a0[o], 0x141); a1[o] = DPP_ADD(a1[o], 0x141); } \
                _Pragma("unroll") for (int o = 0; o < 20; ++o) { a0[o] = DPP_ADD(a0[o], 0x140); a1[o] = DPP_ADD(a1[o], 0x140); } \
                _Pragma("unroll") for (int o = 0; o < 20; ++o) { a0[o] = rows_sum(a0[o]); a1[o] = rows_sum(a1[o]); if (o & 1) __builtin_amdgcn_sched_barrier(0); } \
                int e0, e1; float g0, g1; const int rl = wave * 16 + 2 * (pr); \
                route_decide(a0, c.rgb, c.reb, e0, e1, g0, g1); if (lane == 0) { selE[rl * 2] = e0; selE[rl * 2 + 1] = e1; selG[rl * 2] = g0; selG[rl * 2 + 1] = g1; } \
                route_decide(a1, c.rgb, c.reb, e0, e1, g0, g1); if (lane == 0) { selE[rl * 2 + 2] = e0; selE[rl * 2 + 3] = e1; selG[rl * 2 + 2] = g0; selG[rl * 2 + 3] = g1; } } } while (0)
        RP_ISSUE(0, 0);
#pragma unroll 1
        for (int it = 0; it < 4; ++it) {
            RP_ISSUE(1, 2 * it + 1);
            RP_PROCESS(0, 2 * it);
            if (it < 3) RP_ISSUE(0, 2 * it + 2);
            RP_PROCESS(1, 2 * it + 1);
        }
#undef RP_ISSUE
#undef RP_PROCESS
        if (ROUTER) {
            __syncthreads();
            int e = 0, rank = 0;
            if (tid < 256) {
                e = selE[tid]; int mycount = 0;
#pragma unroll
                for (int x = 0; x < NE; ++x) { const unsigned long long mask = __ballot(e == x); if (e == x) rank = __popcll(mask & ((1ull << lane) - 1ull)); if (lane == x) mycount = __popcll(mask); }
                if (lane < NE) wcnt[(tid >> 6) * 16 + lane] = mycount;
            }
            __syncthreads();
            if (tid < NE) { const int c0 = wcnt[tid], c1 = wcnt[16 + tid], c2 = wcnt[32 + tid], c3 = wcnt[48 + tid]; const int tot = c0 + c1 + c2 + c3;
                int base = 0; if (tot) base = atomicAdd(c.cnt + tid, tot);
                wcnt[tid] = base; wcnt[16 + tid] = base + c0; wcnt[32 + tid] = base + c0 + c1; wcnt[48 + tid] = base + c0 + c1 + c2; }
            __syncthreads();
            if (tid < 256) { const int pos = wcnt[(tid >> 6) * 16 + e] + rank; const int tok = rb * 128 + (tid >> 1);
                c.list[e * T + pos] = tok; c.gatel[e * T + pos] = selG[tid]; c.slotref_out[tok * 2 + (tid & 1)] = e * 32768 + pos; }
            __syncthreads();
        }
    }
    __syncthreads();
}

constexpr int RW_STRIDE = 2064;
__device__ __forceinline__ void router_pass(LAS unsigned char* lds, const RowPassCfg& c, int vcu, int wave) {
    int tid = threadIdx.x; asm volatile("" : "+v"(tid)); const int lane = tid & 63, r16 = lane & 15, kg = lane >> 4;
    LAS unsigned char* Wh = lds;
    LAS unsigned char* Wl = lds + 20 * RW_STRIDE;
    LAS float* gl = (LAS float*)(lds + 40 * RW_STRIDE);
    LAS int* selE = (LAS int*)(lds + 86656);
    LAS float* selG = (LAS float*)(lds + 86656 + 1024);
    LAS int* wcnt = (LAS int*)(lds + 86656 + 2048);
    LAS float* tr = (LAS float*)(lds + 90112) + wave * 512;
    for (int kp = tid; kp < 512; kp += NTHREADS) {
        const int k = 2 * kp;
#pragma unroll 1
        for (int v5 = 0; v5 < 5; ++v5) {
            const float* src = (v5 == 0) ? (c.rgw + (size_t)k * 4) : (c.rew + ((size_t)(v5 - 1) * 1024 + k) * 4);
            const f32x4 a = *(const f32x4*)src, b = *(const f32x4*)(src + 4);
#pragma unroll
            for (int q = 0; q < 4; ++q) { const int o = v5 * 4 + q; const unsigned hi = cvtpk(a[q], b[q]); const unsigned lo = cvtpk(a[q] - bf_lo(hi), b[q] - bf_hi(hi));
                *(LAS unsigned*)(Wh + o * RW_STRIDE + k * 2) = hi; *(LAS unsigned*)(Wl + o * RW_STRIDE + k * 2) = lo; }
        }
    }
    for (int k = tid; k < 1024; k += NTHREADS) gl[k] = c.gain[k];
    __syncthreads();
    typedef unsigned u32x2v __attribute__((ext_vector_type(2)));
    const __amdgpu_buffer_rsrc_t rsH = __builtin_amdgcn_make_buffer_rsrc((void*)c.hin16, 0, 0xFFFFFFFF, 0x00020000);
    const __amdgpu_buffer_rsrc_t rsY = __builtin_amdgcn_make_buffer_rsrc((void*)c.yout8, 0, 0xFFFFFFFF, 0x00020000);
    const int oc0 = r16, oc1 = (16 + r16) < 20 ? (16 + r16) : 19;
    for (int rb = vcu; rb < T / 128; rb += gridDim.x) {
        const int row = rb * 128 + wave * 16 + r16;
        u32x4 hreg[32];
        const unsigned voff = (unsigned)row * (unsigned)(D * 2) + (unsigned)kg * 32u;
#pragma unroll
        for (int s_ = 0; s_ < 32; ++s_) hreg[s_] = __builtin_bit_cast(u32x4, __builtin_amdgcn_raw_buffer_load_b128(rsH, (int)voff + (s_ >> 1) * 128 + (s_ & 1) * 16, 0, 0));
        const unsigned yoff = (unsigned)row * (unsigned)D + (unsigned)kg * 16u;
        u32x2 w8prev = {0u, 0u};
        float ss = 0.f;
#pragma unroll
        for (int s_ = 0; s_ < 32; ++s_)
#pragma unroll
            for (int q = 0; q < 4; ++q) { unsigned hw = hreg[s_][q]; asm volatile("" : "+v"(hw));
                const float a = bf_lo(hw), b = bf_hi(hw); ss = __builtin_fmaf(a, a, ss); ss = __builtin_fmaf(b, b, ss); }
        const float rstd = 1.0f / sqrtf(rows_sum(ss) * (1.0f / D) + RMS_EPS);
        f32x4 acc0 = {0.f, 0.f, 0.f, 0.f}, acc1 = {0.f, 0.f, 0.f, 0.f};
#pragma unroll
        for (int s_ = 0; s_ < 32; ++s_) {
            const int kb = 64 * (s_ >> 1) + 16 * kg + 8 * (s_ & 1);
            const f32x4 g0 = *(const LAS f32x4*)(gl + kb), g1 = *(const LAS f32x4*)(gl + kb + 4);
            float y[8];
            y[0] = bf_lo(hreg[s_][0]) * rstd * g0.x; y[1] = bf_hi(hreg[s_][0]) * rstd * g0.y; y[2] = bf_lo(hreg[s_][1]) * rstd * g0.z; y[3] = bf_hi(hreg[s_][1]) * rstd * g0.w;
            y[4] = bf_lo(hreg[s_][2]) * rstd * g1.x; y[5] = bf_hi(hreg[s_][2]) * rstd * g1.y; y[6] = bf_lo(hreg[s_][3]) * rstd * g1.z; y[7] = bf_hi(hreg[s_][3]) * rstd * g1.w;
            u32x4 yh, yl;
#pragma unroll
            for (int q = 0; q < 4; ++q) { yh[q] = cvtpk(y[2 * q], y[2 * q + 1]); yl[q] = cvtpk(y[2 * q] - bf_lo(yh[q]), y[2 * q + 1] - bf_hi(yh[q])); }
            { u32x2 w8; w8.x = pack_fp8x4(y[0], y[1], y[2], y[3]); w8.y = pack_fp8x4(y[4], y[5], y[6], y[7]);
              if (s_ & 1) { typedef unsigned u32x4v_ __attribute__((ext_vector_type(4))); const u32x4v_ w16 = {w8prev.x, w8prev.y, w8.x, w8.y}; __builtin_amdgcn_raw_buffer_store_b128(w16, rsY, (int)yoff + (s_ >> 1) * 64, 0, 0); } else w8prev = w8; }
            const bf16x8 bh0 = *(const LAS bf16x8*)(Wh + oc0 * RW_STRIDE + kb * 2), bh1 = *(const LAS bf16x8*)(Wh + oc1 * RW_STRIDE + kb * 2);
            const bf16x8 bl0 = *(const LAS bf16x8*)(Wl + oc0 * RW_STRIDE + kb * 2), bl1 = *(const LAS bf16x8*)(Wl + oc1 * RW_STRIDE + kb * 2);
            const bf16x8 ah = __builtin_bit_cast(bf16x8, yh), al = __builtin_bit_cast(bf16x8, yl);
            acc0 = __builtin_amdgcn_mfma_f32_16x16x32_bf16(ah, bh0, acc0, 0, 0, 0); acc1 = __builtin_amdgcn_mfma_f32_16x16x32_bf16(ah, bh1, acc1, 0, 0, 0);
            acc0 = __builtin_amdgcn_mfma_f32_16x16x32_bf16(al, bh0, acc0, 0, 0, 0); acc1 = __builtin_amdgcn_mfma_f32_16x16x32_bf16(al, bh1, acc1, 0, 0, 0);
            acc0 = __builtin_amdgcn_mfma_f32_16x16x32_bf16(ah, bl0, acc0, 0, 0, 0); acc1 = __builtin_amdgcn_mfma_f32_16x16x32_bf16(ah, bl1, acc1, 0, 0, 0);
            __builtin_amdgcn_sched_barrier(0);
        }
#pragma unroll
        for (int e = 0; e < 4; ++e) { tr[(4 * kg + e) * 32 + r16] = acc0[e]; tr[(4 * kg + e) * 32 + 16 + r16] = acc1[e]; }
        asm volatile("s_waitcnt lgkmcnt(0)" ::: "memory");
        if (lane < 16) {
            float a[20];
#pragma unroll
            for (int o = 0; o < 20; ++o) a[o] = tr[lane * 32 + o];
            int e0, e1; float g0_, g1_; route_decide(a, c.rgb, c.reb, e0, e1, g0_, g1_);
            const int rl = wave * 16 + lane;
            selE[rl * 2] = e0; selE[rl * 2 + 1] = e1; selG[rl * 2] = g0_; selG[rl * 2 + 1] = g1_;
        }
        __syncthreads();
        int e = 0, rank = 0;
        if (tid < 256) {
            e = selE[tid]; int mycount = 0;
#pragma unroll
            for (int x = 0; x < NE; ++x) { const unsigned long long mask = __ballot(e == x); if (e == x) rank = __popcll(mask & ((1ull << lane) - 1ull)); if (lane == x) mycount = __popcll(mask); }
            if (lane < NE) wcnt[(tid >> 6) * 16 + lane] = mycount;
        }
        __syncthreads();
        if (tid < NE) { const int c0 = wcnt[tid], c1 = wcnt[16 + tid], c2 = wcnt[32 + tid], c3 = wcnt[48 + tid]; const int tot = c0 + c1 + c2 + c3;
            int base = 0; if (tot) base = atomicAdd(c.cnt + tid, tot);
            wcnt[tid] = base; wcnt[16 + tid] = base + c0; wcnt[32 + tid] = base + c0 + c1; wcnt[48 + tid] = base + c0 + c1 + c2; }
        __syncthreads();
        if (tid < 256) { const int pos = wcnt[(tid >> 6) * 16 + e] + rank; const int tok = rb * 128 + (tid >> 1);
            c.list[e * T + pos] = tok; c.gatel[e * T + pos] = selG[tid]; c.slotref_out[tok * 2 + (tid & 1)] = e * 32768 + pos; }
        __syncthreads();
    }
    __syncthreads();
}

#ifndef ATT_OGLDS
#define ATT_OGLDS 1
#endif
#ifndef ATT_THR
#define ATT_THR 8
#endif
#ifndef ATT_PV8
#define ATT_PV8 1
#endif
#ifndef ATT_QK8
#define ATT_QK8 1
#endif
namespace att {
constexpr float C2 = 0.125f * 1.4426950408889634f;
constexpr float LN2 = 0.6931471805599453f;
__device__ __forceinline__ int crow(int r, int hi) { return (r & 3) + 8 * (r >> 2) + 4 * hi; }
typedef short v4i16_t __attribute__((ext_vector_type(4)));
__device__ __forceinline__ s16x4 vtr(const LAS unsigned char* p) { return __builtin_bit_cast(s16x4, __builtin_amdgcn_ds_read_tr16_b64_v4i16((LAS v4i16_t*)p)); }

struct Item { int b, g, hh, dil, j, ph, ld4, rot; };
__device__ __forceinline__ Item decode_item(int vv, int half, int idx) {
    Item it; it.hh = vv & 7; const int r = (vv >> 3) * 2 + half, qtr = r & 3; it.b = r >> 2;
    int step = idx + 4 * ((vv >> 3) % 3); step = step >= 12 ? step - 12 : step;
    const int k = step & 3; it.g = step >> 2; it.dil = it.g == 0 ? 1 : (it.g == 1 ? 4 : 16);
    it.j = it.g == 0 ? 4 * qtr + k : (it.g == 1 ? k : 0); it.ph = it.g == 0 ? 0 : (it.g == 1 ? qtr : 4 * qtr + k);
    it.ld4 = (it.g == 0 && k == 0 && qtr != 0) ? 1 : 0; it.rot = (it.g != 2 && (k & 1)) ? 2 : 0; return it;
}
typedef int v2i32_t __attribute__((ext_vector_type(2)));
__device__ __forceinline__ v2i32_t vtr8(const LAS unsigned char* p) { return __builtin_amdgcn_ds_read_tr8_b64_v2i32((LAS v2i32_t*)p); }
__device__ __forceinline__ int pk8(float a_, float b_, float c_, float d_) { int r = __builtin_amdgcn_cvt_pk_fp8_f32(a_, b_, 0, false); return __builtin_amdgcn_cvt_pk_fp8_f32(c_, d_, r, true); }
__device__ __forceinline__ int kswz(int kv) { return (kv ^ (kv >> 3)) & 7; }
__device__ __forceinline__ u32x4 fp8x8_to_bf16(unsigned a, unsigned b) {
    const f32x2 a0 = __builtin_amdgcn_cvt_pk_f32_fp8((int)a, false), a1 = __builtin_amdgcn_cvt_pk_f32_fp8((int)a, true), b0 = __builtin_amdgcn_cvt_pk_f32_fp8((int)b, false), b1 = __builtin_amdgcn_cvt_pk_f32_fp8((int)b, true);
    return (u32x4){cvtpk(a0.x, a0.y), cvtpk(a1.x, a1.y), cvtpk(b0.x, b0.y), cvtpk(b1.x, b1.y)};
}

template <int MODE>
__device__ __forceinline__ void attn_phase(LAS unsigned char* lds, const bf16* qkv, bf16* og, float* lse, int vcu, int G) {
    int tid_ = threadIdx.x; asm volatile("" : "+v"(tid_));
    const int tid = tid_, lane = tid & 63, wid = __builtin_amdgcn_readfirstlane(tid >> 6);
    const int half = wid >> 2, w = wid & 3, r32 = lane & 31, hi = lane >> 5, th = tid & 255;
    LAS unsigned char* Kl = lds + half * 69632;
    LAS unsigned char* Vl = Kl + 36864;
    u32x4 kreg[4][2], vreg[4][2]; bf16x8 qbuf[2][4];
    u32x2 qraw[2][4];
    u32x4 qraw8[2][2];
    int skv[2], sc[2];
#pragma unroll
    for (int i = 0; i < 2; ++i) { const int P_ = th + 256 * i; skv[i] = P_ >> 3; sc[i] = P_ & 7; }
    const int skv8 = th >> 2, sc16 = th & 3;
    const __amdgpu_buffer_rsrc_t rsQ = __builtin_amdgcn_make_buffer_rsrc((void*)qkv, 0, 0xFFFFFFFF, 0x00020000);
    typedef unsigned u32x4v __attribute__((ext_vector_type(4)));
#if FP8_QKVS
#define ATT_ISSUE(IT, PAR) do { const unsigned rstrideB_ = (unsigned)(IT).dil * (unsigned)QKVW; \
        const unsigned baseB_ = (unsigned)(((IT).b * SEQ + (IT).ph) * QKVW + (IT).g * 1536 + (IT).hh * 64); const int l0_ = 128 * ((IT).j - 1); \
        const unsigned vo_ = (unsigned)skv8 * rstrideB_ + (unsigned)sc16 * 16u; \
        _Pragma("unroll") for (int tt = 0; tt < 4; ++tt) { if (tt >= 2 || (IT).ld4) { const unsigned so_ = baseB_ + (unsigned)(l0_ + 64 * tt) * rstrideB_; \
            kreg[tt][0] = __builtin_bit_cast(u32x4, __builtin_amdgcn_raw_buffer_load_b128(rsQ, (int)vo_, (int)(so_ + 512u), 0)); vreg[tt][0] = __builtin_bit_cast(u32x4, __builtin_amdgcn_raw_buffer_load_b128(rsQ, (int)vo_, (int)(so_ + 1024u), 0)); } } \
        const unsigned qs_ = baseB_ + (unsigned)(128 * (IT).j) * rstrideB_; \
        if (ATT_QK8) { const unsigned qo_ = (unsigned)(32 * w + r32) * rstrideB_ + (unsigned)hi * 32u; \
            _Pragma("unroll") for (int d0 = 0; d0 < 2; ++d0) qraw8[PAR][d0] = __builtin_bit_cast(u32x4, __builtin_amdgcn_raw_buffer_load_b128(rsQ, (int)qo_, (int)(qs_ + (unsigned)d0 * 16u), 0)); } \
        else { const unsigned qo_ = (unsigned)(32 * w + r32) * rstrideB_ + (unsigned)hi * 8u; \
            _Pragma("unroll") for (int d0 = 0; d0 < 4; ++d0) qraw[PAR][d0] = __builtin_bit_cast(u32x2, __builtin_amdgcn_raw_buffer_load_b64(rsQ, (int)qo_, (int)(qs_ + (unsigned)d0 * 16u), 0)); } } while (0)
#else
#define ATT_ISSUE(IT, PAR) do { const unsigned rstrideB_ = (unsigned)(IT).dil * (unsigned)(QKVW * 2); \
        const unsigned baseB_ = (unsigned)(((IT).b * SEQ + (IT).ph) * QKVW + (IT).g * 1536 + (IT).hh * 64) * 2u; const int l0_ = 128 * ((IT).j - 1); \
        const unsigned vo0_ = (unsigned)skv[0] * rstrideB_ + (unsigned)sc[0] * 16u, vo1_ = (unsigned)skv[1] * rstrideB_ + (unsigned)sc[1] * 16u; \
        _Pragma("unroll") for (int tt = 0; tt < 4; ++tt) { if (tt >= 2 || (IT).ld4) { const unsigned so_ = baseB_ + (unsigned)(l0_ + 64 * tt) * rstrideB_; \
            kreg[tt][0] = __builtin_bit_cast(u32x4, __builtin_amdgcn_raw_buffer_load_b128(rsQ, (int)vo0_, (int)(so_ + 1024u), 0)); vreg[tt][0] = __builtin_bit_cast(u32x4, __builtin_amdgcn_raw_buffer_load_b128(rsQ, (int)vo0_, (int)(so_ + 2048u), 0)); \
            kreg[tt][1] = __builtin_bit_cast(u32x4, __builtin_amdgcn_raw_buffer_load_b128(rsQ, (int)vo1_, (int)(so_ + 1024u), 0)); vreg[tt][1] = __builtin_bit_cast(u32x4, __builtin_amdgcn_raw_buffer_load_b128(rsQ, (int)vo1_, (int)(so_ + 2048u), 0)); } } \
        const unsigned qo_ = (unsigned)(32 * w + r32) * rstrideB_ + (unsigned)hi * 16u, qs_ = baseB_ + (unsigned)(128 * (IT).j) * rstrideB_; \
        _Pragma("unroll") for (int d0 = 0; d0 < 4; ++d0) qbuf[PAR][d0] = __builtin_bit_cast(bf16x8, __builtin_amdgcn_raw_buffer_load_b128(rsQ, (int)qo_, (int)(qs_ + (unsigned)d0 * 32u), 0)); } while (0)
#endif
    const int NIT = (vcu < 256) ? 12 * ((255 - vcu) / G + 1) : 0;
    Item cur = decode_item(vcu < 256 ? vcu : 0, half, 0);
    if (NIT > 0 && MODE != 2) ATT_ISSUE(cur, 0);
    const int koff = r32 * 144 + hi * 16;
    const int vq_ = (lane & 15) >> 1, voff8 = (8 * (vq_ >> 2) + 4 * hi + (vq_ & 3)) * 80 + 16 * ((lane >> 4) & 1) + 8 * (lane & 1);
    const int koff8 = r32 * 80 + hi * 32;
    const int voff = ((lane >> 4) & 1) * 32 + (lane & 3) * 8 + (4 * hi + ((lane & 15) >> 2)) * 64;
    for (int n0 = 0; n0 < NIT; n0 += 2) {
#pragma unroll
    for (int par = 0; par < 2; ++par) {
        const int nx = n0 + par;
        if (nx >= NIT) break;
        const int tt_lo = (cur.j == 0) ? 2 : 0;
#pragma unroll
        for (int tt = 0; tt < 4; ++tt) { if (MODE != 2 && (tt >= 2 || cur.ld4)) { const int pt = (tt + cur.rot) & 3;
            if (FP8_QKVS) {
                if (ATT_QK8) *(LAS u32x4*)(Kl + pt * 9216 + skv8 * 80 + sc16 * 16) = kreg[tt][0];
                else { LAS unsigned char* kd = Kl + pt * 9216 + skv8 * 144 + sc16 * 32;
                *(LAS u32x4*)(kd) = fp8x8_to_bf16(kreg[tt][0].x, kreg[tt][0].y); *(LAS u32x4*)(kd + 16) = fp8x8_to_bf16(kreg[tt][0].z, kreg[tt][0].w); }
                if (ATT_QK8 && ATT_PV8) *(LAS u32x4*)(Vl + pt * 8192 + skv8 * 80 + sc16 * 16) = vreg[tt][0];
                else { LAS unsigned char* vd = Vl + pt * 8192 + (sc16 >> 1) * 4096 + skv8 * 64 + (sc16 & 1) * 32;
                *(LAS u32x4*)(vd) = fp8x8_to_bf16(vreg[tt][0].x, vreg[tt][0].y); *(LAS u32x4*)(vd + 16) = fp8x8_to_bf16(vreg[tt][0].z, vreg[tt][0].w); }
            } else {
#pragma unroll
            for (int i = 0; i < 2; ++i) {
                *(LAS u32x4*)(Kl + pt * 9216 + skv[i] * 144 + sc[i] * 16) = kreg[tt][i];
                *(LAS u32x4*)(Vl + pt * 8192 + (sc[i] >> 2) * 4096 + skv[i] * 64 + (sc[i] & 3) * 16) = vreg[tt][i]; } } } }
        bf16x8 qr[4]; i32x8 qf8 = {0, 0, 0, 0, 0, 0, 0, 0};
        if (FP8_QKVS && ATT_QK8) {
            asm volatile("" : "+v"(qraw8[par][0]), "+v"(qraw8[par][1]));
            qf8 = (i32x8){(int)qraw8[par][0].x, (int)qraw8[par][0].y, (int)qraw8[par][0].z, (int)qraw8[par][0].w, (int)qraw8[par][1].x, (int)qraw8[par][1].y, (int)qraw8[par][1].z, (int)qraw8[par][1].w};
#pragma unroll
            for (int d0 = 0; d0 < 4; ++d0) qr[d0] = bf16x8{};
        } else if (FP8_QKVS) {
            asm volatile("" : "+v"(qraw[par][0]), "+v"(qraw[par][1]), "+v"(qraw[par][2]), "+v"(qraw[par][3]));
#pragma unroll
            for (int d0 = 0; d0 < 4; ++d0) qr[d0] = __builtin_bit_cast(bf16x8, fp8x8_to_bf16(qraw[par][d0].x, qraw[par][d0].y));
        } else {
            asm volatile("" : "+v"(qbuf[par][0]), "+v"(qbuf[par][1]), "+v"(qbuf[par][2]), "+v"(qbuf[par][3]));
#pragma unroll
            for (int d0 = 0; d0 < 4; ++d0) qr[d0] = qbuf[par][d0];
        }
        __syncthreads();
        const Item me = cur;
        if (nx + 1 < NIT) { cur = decode_item(vcu + ((nx + 1) / 12) * G, half, (nx + 1) % 12); if (MODE != 2) ATT_ISSUE(cur, par ^ 1); }
        if (MODE == 1) { __syncthreads(); continue; }
        float m = -1e30f, l = 0.f; f32x16 oT[2]; oT[0] = f32x16{}; oT[1] = f32x16{}; bool fresh_ = true;
#define ATT_TILE(TT, MASKED, USE0, USE1, EDGE_HI) do { const int tt = (TT);        \
            const int pt_ = (tt + me.rot) & 3; const LAS unsigned char* kb = Kl + pt_ * 9216 + koff; \
            f32x16 p0 = f32x16{}, p1 = f32x16{}; \
            if (FP8_QKVS && ATT_QK8) { const LAS unsigned char* kb8 = Kl + pt_ * 9216 + koff8; \
                if (USE0) { const i32x4 ka = *(const LAS i32x4*)(kb8), kc = *(const LAS i32x4*)(kb8 + 16); const i32x8 kf = {ka.x, ka.y, ka.z, ka.w, kc.x, kc.y, kc.z, kc.w}; p0 = __builtin_amdgcn_mfma_scale_f32_32x32x64_f8f6f4(kf, qf8, p0, 0, 0, 0, 0, 0, 0); } \
                if (USE1) { const i32x4 ka = *(const LAS i32x4*)(kb8 + 32 * 80), kc = *(const LAS i32x4*)(kb8 + 32 * 80 + 16); const i32x8 kf = {ka.x, ka.y, ka.z, ka.w, kc.x, kc.y, kc.z, kc.w}; p1 = __builtin_amdgcn_mfma_scale_f32_32x32x64_f8f6f4(kf, qf8, p1, 0, 0, 0, 0, 0, 0); } \
            } else { \
            _Pragma("unroll") for (int d0 = 0; d0 < 4; ++d0) { \
                if (USE0) { const bf16x8 k0 = *(const LAS bf16x8*)(kb + d0 * 32); p0 = __builtin_amdgcn_mfma_f32_32x32x16_bf16(k0, qr[d0], p0, 0, 0, 0); } \
                if (USE1) { const bf16x8 k1 = *(const LAS bf16x8*)(kb + d0 * 32 + 32 * 144); p1 = __builtin_amdgcn_mfma_f32_32x32x16_bf16(k1, qr[d0], p1, 0, 0, 0); } } } \
            float mx = -INFINITY; \
            if (MASKED) { int dbase = 128 + 32 * w + r32 - 64 * tt - 4 * hi; asm volatile("" : "+v"(dbase));        \
                _Pragma("unroll") for (int r = 0; r < 16; ++r) { const int d0_ = dbase - crow(r, 0), d1_ = d0_ - 32; \
                    if (USE0) { p0[r] = ((EDGE_HI) ? (d0_ <= 128) : (d0_ >= 0)) ? p0[r] : -INFINITY; mx = fmaxf(mx, p0[r]); } \
                    if (USE1) { p1[r] = ((EDGE_HI) ? (d1_ <= 128) : (d1_ >= 0)) ? p1[r] : -INFINITY; mx = fmaxf(mx, p1[r]); } } \
            } else { _Pragma("unroll") for (int r = 0; r < 16; ++r) { mx = fmaxf(mx, fmaxf(p0[r], p1[r])); } } \
            mx *= C2;                                                 \
            { const auto rr = __builtin_amdgcn_permlane32_swap(__float_as_uint(mx), __float_as_uint(mx), false, false); mx = fmaxf(__uint_as_float(rr[0]), __uint_as_float(rr[1])); } \
            float mn = m;                                            \
            if (fresh_) { mn = fmaxf(m, mx); fresh_ = false; }        \
            else if (__builtin_amdgcn_ballot_w64(mx > m + (float)ATT_THR) != 0ull) { mn = fmaxf(m, mx); const float alpha = __builtin_amdgcn_exp2f(m - mn); l *= alpha; \
                _Pragma("unroll") for (int r = 0; r < 16; ++r) { oT[0][r] *= alpha; oT[1][r] *= alpha; } } \
            float rs = 0.f; \
            _Pragma("unroll") for (int r = 0; r < 16; ++r) { if (USE0) { p0[r] = __builtin_amdgcn_exp2f(__builtin_fmaf(p0[r], C2, -mn)); rs += p0[r]; } if (USE1) { p1[r] = __builtin_amdgcn_exp2f(__builtin_fmaf(p1[r], C2, -mn)); rs += p1[r]; } } \
            l += rs; m = mn; \
            if (FP8_QKVS && ATT_QK8 && ATT_PV8) { \
                i32x8 pf; \
                _Pragma("unroll") for (int j = 0; j < 4; ++j) { pf[j] = (USE0) ? pk8(p0[4 * j], p0[4 * j + 1], p0[4 * j + 2], p0[4 * j + 3]) : 0; pf[4 + j] = (USE1) ? pk8(p1[4 * j], p1[4 * j + 1], p1[4 * j + 2], p1[4 * j + 3]) : 0; } \
                const LAS unsigned char* vp8 = Vl + pt_ * 8192 + voff8; \
                _Pragma("unroll") for (int d0 = 0; d0 < 2; ++d0) { i32x8 vf8; \
                    _Pragma("unroll") for (int t = 0; t < 4; ++t) { if ((t < 2) ? (USE0) : (USE1)) { const v2i32_t x2 = vtr8(vp8 + t * 1280 + d0 * 32); vf8[2 * t] = x2.x; vf8[2 * t + 1] = x2.y; } else { vf8[2 * t] = 0; vf8[2 * t + 1] = 0; } } \
                    oT[d0] = __builtin_amdgcn_mfma_scale_f32_32x32x64_f8f6f4(vf8, pf, oT[d0], 0, 0, 0, 0, 0, 0); } \
            } else { \
            u32x4 pw[4]; \
            if (USE0) { pw[0] = (u32x4){cvtpk(p0[0], p0[1]), cvtpk(p0[2], p0[3]), cvtpk(p0[4], p0[5]), cvtpk(p0[6], p0[7])}; pw[1] = (u32x4){cvtpk(p0[8], p0[9]), cvtpk(p0[10], p0[11]), cvtpk(p0[12], p0[13]), cvtpk(p0[14], p0[15])}; } \
            if (USE1) { pw[2] = (u32x4){cvtpk(p1[0], p1[1]), cvtpk(p1[2], p1[3]), cvtpk(p1[4], p1[5]), cvtpk(p1[6], p1[7])}; pw[3] = (u32x4){cvtpk(p1[8], p1[9]), cvtpk(p1[10], p1[11]), cvtpk(p1[12], p1[13]), cvtpk(p1[14], p1[15])}; } \
            const LAS unsigned char* vp = Vl + pt_ * 8192 + voff; \
            _Pragma("unroll") for (int d0 = 0; d0 < 2; ++d0) \
                _Pragma("unroll") for (int ks = 0; ks < 4; ++ks) { if ((ks < 2) ? (USE0) : (USE1)) { \
                    const s16x4 lo = vtr(vp + d0 * 4096 + ks * 1024), hh4 = vtr(vp + d0 * 4096 + ks * 1024 + 512); \
                    const bf16x8 vf = (bf16x8){lo[0], lo[1], lo[2], lo[3], hh4[0], hh4[1], hh4[2], hh4[3]}; \
                    oT[d0] = __builtin_amdgcn_mfma_f32_32x32x16_bf16(vf, __builtin_bit_cast(bf16x8, pw[ks]), oT[d0], 0, 0, 0); } } } } while (0)
        const int t_first = (w < 2) ? 0 : 1;
        if (w & 1) {
            if (t_first >= tt_lo) ATT_TILE(t_first, true, false, true, true);
            if (t_first + 1 >= tt_lo) ATT_TILE(t_first + 1, false, true, true, false);
            ATT_TILE(t_first + 2, true, true, true, false);
        } else {
            if (t_first >= tt_lo) ATT_TILE(t_first, true, true, true, true);
            if (t_first + 1 >= tt_lo) ATT_TILE(t_first + 1, false, true, true, false);
            ATT_TILE(t_first + 2, true, true, false, false);
        }
#undef ATT_TILE
        float lt; { const auto rr = __builtin_amdgcn_permlane32_swap(__float_as_uint(l), __float_as_uint(l), false, false); lt = __uint_as_float(rr[0]) + __uint_as_float(rr[1]); }
        const float inv = 1.0f / lt;
        const int lq = 128 * me.j + 32 * w + r32;
        const size_t tok = (size_t)me.b * SEQ + (size_t)lq * me.dil + me.ph;
        if (MODE == 3) { asm volatile("" :: "v"(oT[0]), "v"(oT[1]), "v"(inv), "v"(m)); __syncthreads(); continue; }
        bf16* orow = og + tok * (NG * AW) + me.g * AW + me.hh * 64;
        if (FP8_OG && ATT_QK8 && ATT_OGLDS && MODE == 0) {
            LAS unsigned char* st = Kl + w * 9216 + 5120;
            const float i16 = inv * 16.0f;
#pragma unroll
            for (int d0 = 0; d0 < 2; ++d0)
#pragma unroll
                for (int rp = 0; rp < 2; ++rp) { const int rg = 2 * rp;
                    u32x2 wv; wv.x = pack_fp8x4(oT[d0][4 * rg] * i16, oT[d0][4 * rg + 1] * i16, oT[d0][4 * rg + 2] * i16, oT[d0][4 * rg + 3] * i16);
                    wv.y = pack_fp8x4(oT[d0][4 * rg + 4] * i16, oT[d0][4 * rg + 5] * i16, oT[d0][4 * rg + 6] * i16, oT[d0][4 * rg + 7] * i16);
                    *(LAS unsigned*)(st + r32 * 80 + 32 * d0 + 16 * rp + 4 * hi) = wv.x; *(LAS unsigned*)(st + r32 * 80 + 32 * d0 + 16 * rp + 8 + 4 * hi) = wv.y; }
#pragma unroll
            for (int q = 0; q < 2; ++q) { const int row = 16 * q + (lane >> 2), ch = lane & 3;
                const u32x4 v16 = *(const LAS u32x4*)(st + row * 80 + ch * 16);
                const size_t tk = (size_t)me.b * SEQ + (size_t)(128 * me.j + 32 * w + row) * me.dil + me.ph;
                *(u32x4*)((unsigned char*)og + tk * (NG * AW) + me.g * AW + me.hh * 64 + ch * 16) = v16; }
        } else
#pragma unroll
        for (int d0 = 0; d0 < 2; ++d0)
#pragma unroll
            for (int rp = 0; rp < 2; ++rp) {
                const int rg = 2 * rp;
                if (FP8_OG) {
                    const float i16 = inv * 16.0f;
                    const unsigned x = pack_fp8x4(oT[d0][4 * rg] * i16, oT[d0][4 * rg + 1] * i16, oT[d0][4 * rg + 2] * i16, oT[d0][4 * rg + 3] * i16);
                    const unsigned y = pack_fp8x4(oT[d0][4 * rg + 4] * i16, oT[d0][4 * rg + 5] * i16, oT[d0][4 * rg + 6] * i16, oT[d0][4 * rg + 7] * i16);
                    auto s0 = __builtin_amdgcn_permlane32_swap(x, y, false, false);
                    u32x2 wv; wv.x = s0[0]; wv.y = s0[1];
                    *(u32x2*)((unsigned char*)og + tok * (NG * AW) + me.g * AW + me.hh * 64 + 32 * d0 + 16 * rp + 8 * hi) = wv;
                } else {
                    unsigned x0 = cvtpk(oT[d0][4 * rg] * inv, oT[d0][4 * rg + 1] * inv), x1 = cvtpk(oT[d0][4 * rg + 2] * inv, oT[d0][4 * rg + 3] * inv);
                    unsigned y0 = cvtpk(oT[d0][4 * rg + 4] * inv, oT[d0][4 * rg + 5] * inv), y1 = cvtpk(oT[d0][4 * rg + 6] * inv, oT[d0][4 * rg + 7] * inv);
                    auto s0 = __builtin_amdgcn_permlane32_swap(x0, y0, false, false); auto s1 = __builtin_amdgcn_permlane32_swap(x1, y1, false, false);
                    u32x4 wv; wv.x = s0[0]; wv.y = s1[0]; wv.z = s0[1]; wv.w = s1[1];
                    *(u32x4*)(orow + 32 * d0 + 16 * rp + 8 * hi) = wv;
                }
            }
        if (hi == 0) lse[tok * 24 + me.g * 8 + me.hh] = (m + __builtin_amdgcn_logf(lt)) * LN2;
        __syncthreads();
    }
    }
#undef ATT_ISSUE
}
}

__device__ __forceinline__ u32x4 widen16(u32x2 x, u32x2 y) {
    auto s0 = __builtin_amdgcn_permlane16_swap(x.x, y.x, false, false); auto s1 = __builtin_amdgcn_permlane16_swap(x.y, y.y, false, false);
    return (u32x4){s0[0], s1[0], s0[1], s1[1]};
}
using pg8::Unit; using pg8::BM; using pg8::HALF;
struct EpiQKV {
    static constexpr bool PERM = true;
    bf16* O; const float* cs; float sc;
    __device__ __forceinline__ void operator()(const f32x4 (&acc)[2][2][4][2], const Unit& u, int wr, int wc, int fr, int fq) const {
        const int colt = u.pn * BM; const int kind = (colt % 1536) / 512;
        const bool rot = (kind < 2) && ((wc & 1) == 0) && (fq < 2);
        f32x4 cz[2][4][2];
#pragma unroll
        for (int ai = 0; ai < 2; ++ai)
#pragma unroll
            for (int m = 0; m < 4; ++m) { cz[ai][m][0] = (f32x4){1.f, 0.f, 1.f, 0.f}; cz[ai][m][1] = (f32x4){1.f, 0.f, 1.f, 0.f}; }
        if (rot) {
#pragma unroll
            for (int ai = 0; ai < 2; ++ai)
#pragma unroll
                for (int m = 0; m < 4; ++m) { const int row = u.pm * BM + ai * HALF + wr * 64 + m * 16 + fr;
                    cz[ai][m][0] = *(const f32x4*)(cs + (size_t)row * 16 + fq * 8); cz[ai][m][1] = *(const f32x4*)(cs + (size_t)row * 16 + fq * 8 + 4); }
        }
        if (FP8_QKVS) {
#pragma unroll
            for (int ai = 0; ai < 2; ++ai)
#pragma unroll
                for (int mp = 0; mp < 2; ++mp)
#pragma unroll
                    for (int bj = 0; bj < 2; ++bj) { u32x2 w8[2];
#pragma unroll
                        for (int mi = 0; mi < 2; ++mi) { const int m = 2 * mp + mi;
                            const f32x4 c0 = cz[ai][m][0], c1 = cz[ai][m][1];
                            const f32x4 v0 = acc[ai][bj][m][0] * sc, v1 = acc[ai][bj][m][1] * sc;
                            f32x4 o0, o1;
                            o0.x = v0.x * c0.x - v0.y * c0.y; o0.y = v0.y * c0.x + v0.x * c0.y; o0.z = v0.z * c0.z - v0.w * c0.w; o0.w = v0.w * c0.z + v0.z * c0.w;
                            o1.x = v1.x * c1.x - v1.y * c1.y; o1.y = v1.y * c1.x + v1.x * c1.y; o1.z = v1.z * c1.z - v1.w * c1.w; o1.w = v1.w * c1.z + v1.z * c1.w;
                            w8[mi].x = pack_fp8x4(o0.x, o0.y, o0.z, o0.w); w8[mi].y = pack_fp8x4(o1.x, o1.y, o1.z, o1.w); }
                        const u32x4 w16 = widen16(w8[0], w8[1]); const int m = 2 * mp + (fq & 1);
                        *(u32x4*)((unsigned char*)O + (size_t)(u.pm * BM + ai * HALF + wr * 64 + m * 16 + fr) * QKVW + colt + bj * HALF + wc * 32 + 8 * (fq & ~1)) = w16; }
            return;
        }
#pragma unroll
        for (int ai = 0; ai < 2; ++ai)
#pragma unroll
            for (int m = 0; m < 4; ++m) {
                const int row = u.pm * BM + ai * HALF + wr * 64 + m * 16 + fr;
                const f32x4 c0 = cz[ai][m][0], c1 = cz[ai][m][1];
                bf16* rowp = O + (size_t)row * QKVW + colt + wc * 32 + 8 * fq;
                u32x2 w8[2];
#pragma unroll
                for (int bj = 0; bj < 2; ++bj) {
                    f32x4 v0 = acc[ai][bj][m][0] * sc, v1 = acc[ai][bj][m][1] * sc;
                    f32x4 o0, o1;
                    o0.x = v0.x * c0.x - v0.y * c0.y; o0.y = v0.y * c0.x + v0.x * c0.y; o0.z = v0.z * c0.z - v0.w * c0.w; o0.w = v0.w * c0.z + v0.z * c0.w;
                    o1.x = v1.x * c1.x - v1.y * c1.y; o1.y = v1.y * c1.x + v1.x * c1.y; o1.z = v1.z * c1.z - v1.w * c1.w; o1.w = v1.w * c1.z + v1.z * c1.w;
                    if (FP8_QKVS) { w8[bj].x = pack_fp8x4(o0.x, o0.y, o0.z, o0.w); w8[bj].y = pack_fp8x4(o1.x, o1.y, o1.z, o1.w); }
                    else { u32x4 w; w.x = cvtpk(o0.x, o0.y); w.y = cvtpk(o0.z, o0.w); w.z = cvtpk(o1.x, o1.y); w.w = cvtpk(o1.z, o1.w);
                        *(u32x4*)(rowp + bj * HALF) = w; }
                }
                if (FP8_QKVS) {
                    const u32x4 w16 = widen16(w8[0], w8[1]);
                    *(u32x4*)((unsigned char*)O + (size_t)row * QKVW + colt + wc * 32 + 8 * (fq & ~1) + (fq & 1) * HALF) = w16; }
            }
    }
};
struct EpiBf16 {
    static constexpr bool PERM = true;
    bf16* O; int ldc;
    __device__ __forceinline__ void operator()(const f32x4 (&acc)[2][2][4][2], const Unit& u, int wr, int wc, int fr, int fq) const {
#pragma unroll
        for (int ai = 0; ai < 2; ++ai)
#pragma unroll
            for (int m = 0; m < 4; ++m) {
                bf16* rowp = O + (size_t)(u.pm * BM + ai * HALF + wr * 64 + m * 16 + fr) * ldc + u.pn * BM + wc * 32 + 8 * fq;
#pragma unroll
                for (int bj = 0; bj < 2; ++bj) { const f32x4 v0 = acc[ai][bj][m][0], v1 = acc[ai][bj][m][1];
                    u32x4 w; w.x = cvtpk(v0.x, v0.y); w.y = cvtpk(v0.z, v0.w); w.z = cvtpk(v1.x, v1.y); w.w = cvtpk(v1.z, v1.w);
                    *(u32x4*)(rowp + bj * HALF) = w; }
            }
    }
};
struct EpiFp8 {
    static constexpr bool PERM = true;
    unsigned char* O; int ldc; float sc;
    __device__ __forceinline__ void operator()(const f32x4 (&acc)[2][2][4][2], const Unit& u, int wr, int wc, int fr, int fq) const {
#pragma unroll
        for (int ai = 0; ai < 2; ++ai)
#pragma unroll
            for (int bj = 0; bj < 2; ++bj)
#pragma unroll
                for (int mp = 0; mp < 2; ++mp) { u32x2 w8[2];
#pragma unroll
                    for (int mi = 0; mi < 2; ++mi) { const f32x4 v0 = acc[ai][bj][2 * mp + mi][0] * sc, v1 = acc[ai][bj][2 * mp + mi][1] * sc; w8[mi].x = pack_fp8x4(v0.x, v0.y, v0.z, v0.w); w8[mi].y = pack_fp8x4(v1.x, v1.y, v1.z, v1.w); }
                    const u32x4 w16 = widen16(w8[0], w8[1]); const int m = 2 * mp + (fq & 1);
                    *(u32x4*)(O + (size_t)(u.pm * BM + ai * HALF + wr * 64 + m * 16 + fr) * ldc + u.pn * BM + bj * HALF + wc * 32 + 8 * (fq & ~1)) = w16; }
    }
};
#define DPPF(v, ctrl) __builtin_bit_cast(float, __builtin_amdgcn_update_dpp(0, __builtin_bit_cast(int, (v)), (ctrl), 0xF, 0xF, true))
template <int W> __device__ __forceinline__ float pool_prefix(float x) {
    float t = x;
    t += DPPF(t, 0x111);
    if (W > 2) t += DPPF(t, 0x112);
    if (W > 4) t += DPPF(t, 0x114);
    if (W > 8) t += DPPF(t, 0x118);
    return t;
}
__device__ __forceinline__ float pool_suffix(float x) {
    float q = x;
    q += DPPF(q, 0x101); q += DPPF(q, 0x102); q += DPPF(q, 0x104); q += DPPF(q, 0x108);
    return q;
}
template <int W>
__device__ __forceinline__ void pool_epilogue(const f32x4 (&acc)[2][2][4][2], const pg8::Unit& u, int wr, int wc, int fr, int fq, bf16* POOLED_, bf16* HALO_) {
    const bool seq_start = ((u.pm & 7) == 0);
    const float invw = 1.0f / (float)W;
#pragma unroll
    for (int ai = 0; ai < 2; ++ai) {
        const bool first_blk = seq_start && ai == 0 && wr == 0;
        const float inv0 = first_blk ? 1.0f / (float)((fr + 1) < W ? (fr + 1) : W) : invw;
        const int blk = (u.pm * pg8::BM + ai * pg8::HALF + wr * 64) >> 6;
#pragma unroll
        for (int bj = 0; bj < 2; ++bj) {
            float po[4][8];
#pragma unroll
            for (int n = 0; n < 2; ++n)
#pragma unroll
                for (int e = 0; e < 4; ++e) {
                    float carry = 0.f;
#pragma unroll
                    for (int m = 0; m < 4; ++m) {
                        const float x = acc[ai][bj][m][n][e];
                        const float s = pool_prefix<W>(x) + carry;
                        po[m][n * 4 + e] = s * (m == 0 ? inv0 : invw) - x;
                        if (m < 3) { const float q = pool_suffix(x); carry = DPPF(q, 0x100 + (17 - W)); }
                    }
                }
            const size_t colo = (size_t)u.pn * pg8::BM + bj * pg8::HALF + wc * 32 + 8 * fq;
            if (FP8_POOL2) {
#pragma unroll
                for (int mp = 0; mp < 2; ++mp) { u32x2 w8[2];
#pragma unroll
                    for (int mi = 0; mi < 2; ++mi) { const int m = 2 * mp + mi; w8[mi].x = pack_fp8x4(po[m][0] * 16.f, po[m][1] * 16.f, po[m][2] * 16.f, po[m][3] * 16.f); w8[mi].y = pack_fp8x4(po[m][4] * 16.f, po[m][5] * 16.f, po[m][6] * 16.f, po[m][7] * 16.f); }
                    const u32x4 w16 = widen16(w8[0], w8[1]); const int m = 2 * mp + (fq & 1);
                    *(u32x4*)((unsigned char*)POOLED_ + (size_t)(u.pm * pg8::BM + ai * pg8::HALF + wr * 64 + m * 16 + fr) * D + (size_t)u.pn * pg8::BM + bj * pg8::HALF + wc * 32 + 8 * (fq & ~1)) = w16; }
                if (fr < W - 1) {
                    u32x4 w; w.x = cvtpk(po[0][0], po[0][1]); w.y = cvtpk(po[0][2], po[0][3]); w.z = cvtpk(po[0][4], po[0][5]); w.w = cvtpk(po[0][6], po[0][7]);
                    *(u32x4*)(HALO_ + (size_t)8 * 1024 * 1024 + ((size_t)blk * 15 + fr) * D + colo) = w; }
            } else {
#pragma unroll
            for (int m = 0; m < 4; ++m) {
                u32x4 w; w.x = cvtpk(po[m][0], po[m][1]); w.y = cvtpk(po[m][2], po[m][3]); w.z = cvtpk(po[m][4], po[m][5]); w.w = cvtpk(po[m][6], po[m][7]);
                *(u32x4*)(POOLED_ + (size_t)(u.pm * pg8::BM + ai * pg8::HALF + wr * 64 + m * 16 + fr) * D + colo) = w;
            } }
            if (fr >= 17 - W) {
                u32x4 w; w.x = cvtpk(acc[ai][bj][3][0][0], acc[ai][bj][3][0][1]); w.y = cvtpk(acc[ai][bj][3][0][2], acc[ai][bj][3][0][3]); w.z = cvtpk(acc[ai][bj][3][1][0], acc[ai][bj][3][1][1]); w.w = cvtpk(acc[ai][bj][3][1][2], acc[ai][bj][3][1][3]);
                *(u32x4*)(HALO_ + ((size_t)blk * 15 + (fr - 1)) * D + colo) = w;
            }
        }
    }
}
struct EpiPool {
    static constexpr bool PERM = true;
    bf16* P_; bf16* H_;
    __device__ __forceinline__ void operator()(const f32x4 (&acc)[2][2][4][2], const pg8::Unit& u, int wr, int wc, int fr, int fq) const {
        switch (u.pn) {
            case 0: pool_epilogue<2>(acc, u, wr, wc, fr, fq, P_, H_); break;
            case 1: pool_epilogue<4>(acc, u, wr, wc, fr, fq, P_, H_); break;
            case 2: pool_epilogue<8>(acc, u, wr, wc, fr, fq, P_, H_); break;
            default: pool_epilogue<16>(acc, u, wr, wc, fr, fq, P_, H_); break;
        }
    }
};
template <bool RES32>
struct EpiResBf16 {
    static constexpr bool PERM = true;
    const void* res; bf16* out; float sc = 1.0f;
    const float* rrms = nullptr;
    __device__ __forceinline__ void operator()(const f32x4 (&acc)[2][2][4][2], const Unit& u, int wr, int wc, int fr, int fq) const {
        if constexpr (!RES32) {
            u32x4 q16[2][4][2]; float qrms[2][4];
#pragma unroll
            for (int ai = 0; ai < 2; ++ai)
#pragma unroll
                for (int m = 0; m < 4; ++m) { qrms[ai][m] = rrms ? rrms[u.pm * BM + ai * HALF + wr * 64 + m * 16 + fr] : 1.f;
#pragma unroll
                    for (int bj = 0; bj < 2; ++bj) { const size_t off = (size_t)(u.pm * BM + ai * HALF + wr * 64 + m * 16 + fr) * D + u.pn * BM + wc * 32 + 8 * fq + bj * HALF;
                        q16[ai][m][bj] = *(const u32x4*)((const bf16*)res + off); } }
#pragma unroll
            for (int ai = 0; ai < 2; ++ai)
#pragma unroll
                for (int m = 0; m < 4; ++m)
#pragma unroll
                    for (int bj = 0; bj < 2; ++bj) { const size_t off = (size_t)(u.pm * BM + ai * HALF + wr * 64 + m * 16 + fr) * D + u.pn * BM + wc * 32 + 8 * fq + bj * HALF;
                        const u32x4 rw = q16[ai][m][bj]; const float rm = qrms[ai][m];
                        const f32x4 r0 = (f32x4){bf_lo(rw.x), bf_hi(rw.x), bf_lo(rw.y), bf_hi(rw.y)} * rm, r1 = (f32x4){bf_lo(rw.z), bf_hi(rw.z), bf_lo(rw.w), bf_hi(rw.w)} * rm;
                        const f32x4 v0 = r0 + acc[ai][bj][m][0] * sc, v1 = r1 + acc[ai][bj][m][1] * sc;
                        u32x4 w; w.x = cvtpk(v0.x, v0.y); w.y = cvtpk(v0.z, v0.w); w.z = cvtpk(v1.x, v1.y); w.w = cvtpk(v1.z, v1.w);
                        *(u32x4*)(out + off) = w; }
            return;
        }
#pragma unroll
        for (int ai = 0; ai < 2; ++ai) {
            f32x4 r32[4][2][2]; u32x4 r16[4][2]; float rmsr[4] = {1.f, 1.f, 1.f, 1.f};
            if (!RES32 && rrms) {
#pragma unroll
                for (int m = 0; m < 4; ++m) rmsr[m] = rrms[u.pm * BM + ai * HALF + wr * 64 + m * 16 + fr];
            }
            if constexpr (RES32) {
#pragma unroll
                for (int m = 0; m < 4; ++m)
#pragma unroll
                    for (int bj = 0; bj < 2; ++bj) { const size_t off = (size_t)(u.pm * BM + ai * HALF + wr * 64 + m * 16 + fr) * D + u.pn * BM + wc * 32 + 8 * fq + bj * HALF;
                        r32[m][bj][0] = __builtin_nontemporal_load((const f32x4*)((const float*)res + off)); r32[m][bj][1] = __builtin_nontemporal_load((const f32x4*)((const float*)res + off + 4)); }
            } else {
#pragma unroll
                for (int m = 0; m < 4; ++m)
#pragma unroll
                    for (int bj = 0; bj < 2; ++bj) { const size_t off = (size_t)(u.pm * BM + ai * HALF + wr * 64 + m * 16 + fr) * D + u.pn * BM + wc * 32 + 8 * fq + bj * HALF;
                        r16[m][bj] = *(const u32x4*)((const bf16*)res + off); }
            }
#pragma unroll
            for (int m = 0; m < 4; ++m)
#pragma unroll
                for (int bj = 0; bj < 2; ++bj) {
                    const size_t off = (size_t)(u.pm * BM + ai * HALF + wr * 64 + m * 16 + fr) * D + u.pn * BM + wc * 32 + 8 * fq + bj * HALF;
                    f32x4 r0, r1;
                    if constexpr (RES32) { r0 = r32[m][bj][0]; r1 = r32[m][bj][1]; }
                    else { const u32x4 rw = r16[m][bj]; r0 = (f32x4){bf_lo(rw.x), bf_hi(rw.x), bf_lo(rw.y), bf_hi(rw.y)}; r1 = (f32x4){bf_lo(rw.z), bf_hi(rw.z), bf_lo(rw.w), bf_hi(rw.w)};
                        if (rrms) { const float rm = rmsr[m]; r0 = r0 * rm; r1 = r1 * rm; } }
                    const f32x4 v0 = r0 + acc[ai][bj][m][0] * sc, v1 = r1 + acc[ai][bj][m][1] * sc;
                    u32x4 w; w.x = cvtpk(v0.x, v0.y); w.y = cvtpk(v0.z, v0.w); w.z = cvtpk(v1.x, v1.y); w.w = cvtpk(v1.z, v1.w);
                    *(u32x4*)(out + off) = w;
                }
            asm volatile("" ::: "memory");
        }
    }
};
template <bool OUT8>
struct EpiSwiGLU {
    static constexpr bool PERM = true;
    void* O; float sc;
    const LAS float* gtab = nullptr;
    __device__ __forceinline__ void operator()(const f32x4 (&acc)[2][2][4][2], const Unit& u, int wr, int wc, int fr, int fq) const {
#pragma unroll
        for (int ai = 0; ai < 2; ++ai)
#pragma unroll
            for (int mp = 0; mp < 2; ++mp) {
                u32x2 w8[2];
#pragma unroll
                for (int mi = 0; mi < 2; ++mi) { const int m = 2 * mp + mi;
                    const size_t eoff = (size_t)(u.pm * BM + ai * HALF + wr * 64 + m * 16 + fr) * DE + u.pn * HALF + wc * 32 + 8 * fq;
                    const float g16 = gtab ? 16.f * gtab[u.idx * 256 + ai * HALF + wr * 64 + m * 16 + fr] : 16.f;
                    float h[8];
#pragma unroll
                    for (int n = 0; n < 2; ++n)
#pragma unroll
                        for (int e = 0; e < 4; ++e) { const float a = acc[ai][0][m][n][e] * sc, b = acc[ai][1][m][n][e] * sc;
                            h[n * 4 + e] = a * __builtin_amdgcn_rcpf(1.0f + __builtin_amdgcn_exp2f(-1.4426950408889634f * a)) * b; }
                    if constexpr (OUT8) { w8[mi].x = pack_fp8x4(h[0] * g16, h[1] * g16, h[2] * g16, h[3] * g16); w8[mi].y = pack_fp8x4(h[4] * g16, h[5] * g16, h[6] * g16, h[7] * g16); }
                    else { u32x4 w; w.x = cvtpk(h[0], h[1]); w.y = cvtpk(h[2], h[3]); w.z = cvtpk(h[4], h[5]); w.w = cvtpk(h[6], h[7]); *(u32x4*)((bf16*)O + eoff) = w; }
                }
                if constexpr (OUT8) { const u32x4 w16 = widen16(w8[0], w8[1]);
                    const int m = 2 * mp + (fq & 1);
                    *(u32x4*)((unsigned char*)O + (size_t)(u.pm * BM + ai * HALF + wr * 64 + m * 16 + fr) * DE + u.pn * HALF + wc * 32 + 8 * (fq & ~1)) = w16; }
            }
    }
};
struct EpiGate {
    static constexpr bool PERM = true;
    bf16* O; const LAS float* gtab;
    __device__ __forceinline__ void operator()(const f32x4 (&acc)[2][2][4][2], const Unit& u, int wr, int wc, int fr, int fq) const {
#pragma unroll
        for (int ai = 0; ai < 2; ++ai)
#pragma unroll
            for (int m = 0; m < 4; ++m) {
                const int rl = ai * HALF + wr * 64 + m * 16 + fr;
                const float gt = gtab[u.idx * 256 + rl];
                const size_t eoff = (size_t)(u.pm * BM + rl) * D + u.pn * BM + wc * 32 + 8 * fq;
                u32x2 w8[2];
#pragma unroll
                for (int bj = 0; bj < 2; ++bj) { const f32x4 v0 = acc[ai][bj][m][0] * gt, v1 = acc[ai][bj][m][1] * gt;
                    if (FP8_YS) { w8[bj].x = pack_fp8x4(v0.x, v0.y, v0.z, v0.w); w8[bj].y = pack_fp8x4(v1.x, v1.y, v1.z, v1.w); }
                    else { u32x4 w; w.x = cvtpk(v0.x, v0.y); w.y = cvtpk(v0.z, v0.w); w.z = cvtpk(v1.x, v1.y); w.w = cvtpk(v1.z, v1.w); *(u32x4*)(O + eoff + bj * HALF) = w; } }
                if (FP8_YS) { const u32x4 w16 = widen16(w8[0], w8[1]);
                    *(u32x4*)((unsigned char*)O + (size_t)(u.pm * BM + rl) * D + u.pn * BM + wc * 32 + 8 * (fq & ~1) + (fq & 1) * HALF) = w16; }
            }
    }
};

template <bool F8_>
struct MoeProb1T {
    static constexpr bool F8 = F8_;
    const void* A; const void* Bt; int K; const LAS int* tb; const LAS unsigned* aofs;
    __device__ __forceinline__ void a_offs(int i, const Unit&, const int (&R)[2], const int (&C)[2], unsigned (&o0)[2], unsigned (&o1)[2]) const {
#pragma unroll
        for (int k = 0; k < 2; ++k) { o0[k] = aofs[i * 256 + R[k]] + (unsigned)C[k] * 2u; o1[k] = aofs[i * 256 + 128 + R[k]] + (unsigned)C[k] * 2u; }
    }
    __device__ __forceinline__ unsigned b_off(const Unit& u) const {
        int e = 0;
#pragma unroll
        for (int k = 1; k < NE; ++k) e += (u.pm >= tb[k]) ? 1 : 0;
        return (unsigned)((e * 1024 + u.pn * 256) * 1024 * (F8 ? 1 : 2));
    }
};
template <bool F8_>
struct MoeProb2T {
    static constexpr bool F8 = F8_;
    const void* A; const void* Bt; int K; const LAS int* tb;
    __device__ __forceinline__ void a_offs(int, const Unit& u, const int (&R)[2], const int (&C)[2], unsigned (&o0)[2], unsigned (&o1)[2]) const {
        constexpr int esz = F8 ? 1 : 2;
#pragma unroll
        for (int k = 0; k < 2; ++k) { const unsigned b = (unsigned)((u.pm * BM + R[k]) * DE * esz + C[k] * 2); o0[k] = b; o1[k] = b + (unsigned)(HALF * DE * esz); }
    }
    __device__ __forceinline__ unsigned b_off(const Unit& u) const {
        int e = 0;
#pragma unroll
        for (int k = 1; k < NE; ++k) e += (u.pm >= tb[k]) ? 1 : 0;
        return (unsigned)((e * 1024 + u.pn * 256) * DE * (F8 ? 1 : 2));
    }
};
struct FoldOrder { int G, c; __device__ __forceinline__ bool next(int i, Unit& u) const { const int L = i * G + c; if (L >= 16) return false; u.pm = L >> 2; u.pn = L & 3; return true; } };


#define XB_TMO      128
#define XB_XCNT(j)  (256  + 64 * (j))
#define XB_XSUB(j)  (1280 + 64 * (j))
#define XB_XGEN(j)  (2304 + 64 * (j))
#define XB_TOP      3328
#define XB_TOPGEN   3392
#define XCD_BAR_WORDS 3456
#define XB_SPIN_CAP (1u << 18)
#ifndef XB_FLAT_RELEASE
#define XB_FLAT_RELEASE 1
#endif
__device__ __forceinline__ unsigned xb_ld(unsigned* p)              { return __hip_atomic_load(p, __ATOMIC_RELAXED, __HIP_MEMORY_SCOPE_AGENT); }
__device__ __forceinline__ unsigned xb_add(unsigned* p, unsigned v) { return __hip_atomic_fetch_add(p, v, __ATOMIC_RELAXED, __HIP_MEMORY_SCOPE_AGENT); }
__device__ __forceinline__ unsigned xb_xcc_id() { return (unsigned)__builtin_amdgcn_s_getreg((3 << 11) | 20) & 0xFu; }
#define XB_SPIN(cond, bar) do { unsigned _sp = 0; while (cond) { __builtin_amdgcn_s_sleep(1); \
    if ((++_sp & 255u) == 0u) { if (xb_ld(&(bar)[XB_TMO])) break; if (_sp > XB_SPIN_CAP) { atomicAdd(&(bar)[XB_TMO], 1u); break; } } } } while (0)
struct XcdBarrier { unsigned* bar; unsigned x; volatile LAS unsigned* st; };
__device__ __forceinline__ XcdBarrier xcd_barrier_post(unsigned* bar, volatile LAS unsigned* st) {
    XcdBarrier b; b.bar = bar; b.x = xb_xcc_id(); b.st = st;
    if (threadIdx.x == 0) (void)xb_add(&bar[XB_XCNT(b.x)], 1u);
    return b;
}
__device__ __forceinline__ void xcd_barrier_complete(unsigned* bar, unsigned x, unsigned& nloc, unsigned& nx) {
    const unsigned G = gridDim.x * gridDim.y * gridDim.z;
    unsigned sum, cnt, mine, sp = 0u;
    for (;;) {
        sum = 0u; cnt = 0u; mine = 0u;
#pragma unroll
        for (unsigned j = 0; j < 16; ++j) { const unsigned c = xb_ld(&bar[XB_XCNT(j)]); sum += c; cnt += (c > 0u) ? 1u : 0u; mine = (j == x) ? c : mine; }
        if (sum == G) break;
        __builtin_amdgcn_s_sleep(1);
        if ((++sp & 255u) == 0u) { if (xb_ld(&bar[XB_TMO])) break; if (sp > XB_SPIN_CAP) { atomicAdd(&bar[XB_TMO], 1u); break; } }
    }
    nloc = mine > 0u ? mine : 1u; nx = cnt > 0u ? cnt : 1u;
}
__device__ __forceinline__ void xcd_barrier(const XcdBarrier& b) {
    asm volatile("s_waitcnt vmcnt(0)" ::: "memory");
    __syncthreads();
    if (threadIdx.x == 0) {
        unsigned* bar = b.bar;
        __builtin_amdgcn_s_waitcnt(0);
        unsigned nloc = b.st[0], nx = b.st[1];
        if (nloc == 0u) { xcd_barrier_complete(bar, b.x, nloc, nx); b.st[0] = nloc; b.st[1] = nx; }
        const unsigned old = xb_add(&bar[XB_XSUB(b.x)], 1u);
        const unsigned gen = old / nloc;
        if (old + 1u == (gen + 1u) * nloc) {
            __builtin_amdgcn_fence(__ATOMIC_RELEASE, "agent");
            asm volatile("s_waitcnt vmcnt(0)" ::: "memory");
            const unsigned og = xb_add(&bar[XB_TOP], 1u);
            const unsigned tg = og / nx;
            if (og + 1u == (tg + 1u) * nx) xb_add(&bar[XB_TOPGEN], 1u);
            else XB_SPIN(xb_ld(&bar[XB_TOPGEN]) == tg, bar);
            __builtin_amdgcn_fence(__ATOMIC_ACQUIRE, "agent");
            if (!XB_FLAT_RELEASE) { xb_add(&bar[XB_XGEN(b.x)], 1u); asm volatile("s_waitcnt vmcnt(0)" ::: "memory"); }
        } else {
            if (XB_FLAT_RELEASE) XB_SPIN(xb_ld(&bar[XB_TOPGEN]) == gen, bar);
            else XB_SPIN(xb_ld(&bar[XB_XGEN(b.x)]) == gen, bar);
            __builtin_amdgcn_fence(__ATOMIC_ACQUIRE, "agent");
            asm volatile("s_waitcnt vmcnt(0)" ::: "memory");
        }
    }
    __syncthreads();
}

constexpr int N_PHASES = 16;

template <int W>
__device__ __forceinline__ void seam_fix(const bf16* HALO_, bf16* POOLED_, int b, int ch) {
    u32x4 hrow[W - 1], prow[W - 1];
#pragma unroll
    for (int i = 0; i < W - 1; ++i) hrow[i] = *(const u32x4*)(HALO_ + ((size_t)(b - 1) * 15 + (16 - W + i)) * D + ch);
#pragma unroll
    for (int r = 0; r < W - 1; ++r) prow[r] = FP8_POOL2 ? *(const u32x4*)(HALO_ + (size_t)8 * 1024 * 1024 + ((size_t)b * 15 + r) * D + ch) : *(const u32x4*)(POOLED_ + (size_t)(b * 64 + r) * D + ch);
    const float invw = 1.0f / (float)W;
    float sum[8];
#pragma unroll
    for (int k = 0; k < 8; ++k) sum[k] = 0.f;
#pragma unroll
    for (int r = W - 2; r >= 0; --r) {
#pragma unroll
        for (int k = 0; k < 4; ++k) { sum[2 * k] += bf_lo(hrow[r][k]); sum[2 * k + 1] += bf_hi(hrow[r][k]); }
        if (FP8_POOL2) { float v[8];
#pragma unroll
            for (int k = 0; k < 4; ++k) { v[2 * k] = (bf_lo(prow[r][k]) + sum[2 * k] * invw) * 16.f; v[2 * k + 1] = (bf_hi(prow[r][k]) + sum[2 * k + 1] * invw) * 16.f; }
            u32x2 w8; w8.x = pack_fp8x4(v[0], v[1], v[2], v[3]); w8.y = pack_fp8x4(v[4], v[5], v[6], v[7]);
            *(u32x2*)((unsigned char*)POOLED_ + (size_t)(b * 64 + r) * D + ch) = w8;
        } else {
        u32x4 w;
#pragma unroll
        for (int k = 0; k < 4; ++k) w[k] = cvtpk(bf_lo(prow[r][k]) + sum[2 * k] * invw, bf_hi(prow[r][k]) + sum[2 * k + 1] * invw);
        *(u32x4*)(POOLED_ + (size_t)(b * 64 + r) * D + ch) = w; }
    }
}
typedef const __attribute__((address_space(4))) Params* KParamsPtr;
__device__ __forceinline__ KParamsPtr kparams() { KParamsPtr q = (KParamsPtr)__builtin_amdgcn_kernarg_segment_ptr(); asm volatile("" : "+s"(q)); return q; }
#ifndef H_FROM_Y
#define H_FROM_Y 1
#endif
struct ConvDesc { const float* src; unsigned char* dst; const float* ks; int ldw, Kb, f8; };
constexpr int CI_IN = (D / 64) * (QKVW / 32), CI_OUT = (AW / 64) * (D / 32), CI_PIN = (D / 64) * (D / 32), CI_W1 = (D / 64) * (DE / 32), CI_W2 = (DE / 64) * (D / 32);
constexpr int CI_TOTAL = CI_IN + CI_OUT + 2 * CI_PIN + 32 * (2 * CI_W1 + CI_W2);
__device__ __forceinline__ ConvDesc conv_desc(KParamsPtr kp, int it) {
    int r = it - CI_IN; const float* W; const float* ksb = nullptr; int ldw, K, nblk, f8, rowadd = 0, w13 = 0; size_t wt;
    if (r < CI_OUT) { W = kp->attn_w_out; ldw = D; K = AW; nblk = D / 32; f8 = FP8_OUT; wt = WS_WOUT; }
    else if ((r -= CI_OUT) < CI_PIN) { W = kp->pool_w_in; ldw = D; K = D; nblk = D / 32; f8 = 0; wt = WS_WPIN; ksb = H_FROM_Y ? kp->norm_mix + D : nullptr; }
    else if ((r -= CI_PIN) < CI_PIN) { W = kp->pool_w_out; ldw = D; K = D; nblk = D / 32; f8 = 0; wt = WS_WPO; }
    else { r -= CI_PIN; const int le = r / (2 * CI_W1 + CI_W2); r -= le * (2 * CI_W1 + CI_W2);
        if (r < 2 * CI_W1) { const int third = r >= CI_W1; r -= third * CI_W1; W = (third ? kp->expert_w3 : kp->expert_w1) + (size_t)le * D * DE; ldw = DE; K = D; nblk = DE / 32; f8 = FP8_MOE1; rowadd = third * 128; w13 = 1;
            wt = WS_W13 + (size_t)le * 1024 * 1024 * (FP8_MOE1 ? 1 : 2); }
        else { r -= 2 * CI_W1; W = kp->expert_w2 + (size_t)le * DE * D; ldw = D; K = DE; nblk = D / 32; f8 = FP8_MOE2; wt = WS_W2 + (size_t)le * 1024 * DE * (FP8_MOE2 ? 1 : 2); } }
    const int k0 = 64 * (r / nblk), n0 = 32 * (r % nblk), esz = f8 ? 1 : 2;
    const int row = w13 ? ((n0 >> 7) * 256 + rowadd + (n0 & 127)) : n0;
    ConvDesc d; d.src = W + (size_t)k0 * ldw + n0; d.dst = kp->ws + wt + ((size_t)row * K + k0) * esz; d.ldw = ldw; d.Kb = K * esz; d.f8 = f8; d.ks = ksb ? ksb + k0 : nullptr; return d;
}
#define CONV_ISSUE(d, v) do { _Pragma("unroll") for (int i_ = 0; i_ < 32; ++i_) (v)[i_] = __builtin_nontemporal_load((d).src + (size_t)(2 * i_ + (lane_ >> 5)) * (d).ldw + (lane_ & 31)); } while (0)
#define CONV_FINISH(d, v) do { \
        _Pragma("unroll") for (int i_ = 0; i_ < 32; ++i_) scr_[(2 * i_ + (lane_ >> 5)) * 33 + (lane_ & 31)] = (v)[i_]; \
        asm volatile("s_waitcnt lgkmcnt(0)" ::: "memory"); \
        const int c_ = lane_ & 7; \
        _Pragma("unroll") for (int j_ = 0; j_ < 4; ++j_) { const int n_ = (lane_ >> 3) + 8 * j_; const LAS float* s_ = scr_ + (8 * c_) * 33 + n_; \
            if ((d).f8) { u32x2 o_; o_.x = pack_fp8x4(s_[0 * 33] * 32.f, s_[1 * 33] * 32.f, s_[2 * 33] * 32.f, s_[3 * 33] * 32.f); o_.y = pack_fp8x4(s_[4 * 33] * 32.f, s_[5 * 33] * 32.f, s_[6 * 33] * 32.f, s_[7 * 33] * 32.f); \
                *(u32x2*)((d).dst + (size_t)n_ * (d).Kb + 8 * c_) = o_; } \
            else { f32x4 k0_ = {1.f, 1.f, 1.f, 1.f}, k1_ = k0_; if ((d).ks) { k0_ = *(const f32x4*)((d).ks + 8 * c_); k1_ = *(const f32x4*)((d).ks + 8 * c_ + 4); } \
                u32x4 o_; o_.x = cvtpk(s_[0 * 33] * k0_.x, s_[1 * 33] * k0_.y); o_.y = cvtpk(s_[2 * 33] * k0_.z, s_[3 * 33] * k0_.w); o_.z = cvtpk(s_[4 * 33] * k1_.x, s_[5 * 33] * k1_.y); o_.w = cvtpk(s_[6 * 33] * k1_.z, s_[7 * 33] * k1_.w); \
                *(u32x4*)((d).dst + (size_t)n_ * (d).Kb + 16 * c_) = o_; } } \
        asm volatile("s_waitcnt lgkmcnt(0)" ::: "memory"); } while (0)
__device__ __forceinline__ void conv_pipelined(KParamsPtr kp, LAS float* scr_, int gw, int ngw, int lane_) {
    int it = CI_IN + gw;
    float va[32], vb[32]; ConvDesc da, db;
    bool ha = it < CI_TOTAL; if (ha) { da = conv_desc(kp, it); CONV_ISSUE(da, va); }
    while (ha) {
        const int i1 = it + ngw; const bool hb = i1 < CI_TOTAL;
        if (hb) { db = conv_desc(kp, i1); CONV_ISSUE(db, vb); }
        CONV_FINISH(da, va);
        if (!hb) break;
        const int i2 = i1 + ngw; ha = i2 < CI_TOTAL;
        if (ha) { da = conv_desc(kp, i2); CONV_ISSUE(da, va); }
        CONV_FINISH(db, vb);
        it = i2;
    }
}
#undef CONV_ISSUE
#undef CONV_FINISH
__global__ void __launch_bounds__(NTHREADS, 2) fwd_kernel(Params p) {
    extern __shared__ __attribute__((aligned(16))) unsigned char lds_raw[];
    LAS unsigned char* lds = (LAS unsigned char*)lds_raw;
    const int tid = threadIdx.x, lane = tid & 63, wave = __builtin_amdgcn_readfirstlane(tid >> 6);
    const int G = gridDim.x, bx = blockIdx.x;
    const int vcu = (G % 8 == 0) ? (bx % 8) * (G / 8) + bx / 8 : bx;
#define KP() kparams()
#define WSB() ((unsigned char*)KP()->ws)
#define G_ctl ((int*)(WSB() + WS_CTL))
#define G_cs ((float*)(WSB() + WS_CS))
#define G_lse ((float*)(WSB() + WS_LSE))
#define G_slotref ((int*)(WSB() + WS_SLOTREF))
#define Wgs ((bf16*)(WSB() + WS_WGS))
#define G_list ((int*)(WSB() + WS_LIST))
#define G_gatel ((float*)(WSB() + WS_GATEL))
#define Win_t ((bf16*)(WSB() + WS_WIN))
#define Wout_t ((bf16*)(WSB() + WS_WOUT))
#define Wpin_t ((bf16*)(WSB() + WS_WPIN))
#define Wc_t ((bf16*)(WSB() + WS_WC))
#define Wpo_t ((bf16*)(WSB() + WS_WPO))
#define W13 ((bf16*)(WSB() + WS_W13))
#define W2 ((bf16*)(WSB() + WS_W2))
#define Y ((bf16*)(WSB() + WS_Y))
#define QKV ((bf16*)(WSB() + WS_BIG))
#define OM ((bf16*)(WSB() + WS_OM))
#define HMID ((bf16*)(WSB() + WS_HMID))
#define YS ((bf16*)(WSB() + WS_YS))
#define U ((bf16*)(WSB() + WS_U))
#define POOLED ((bf16*)(WSB() + WS_POOLED))
#define OG ((bf16*)KP()->out)
#define H ((bf16*)(WSB() + WS_H))
    LAS int* tb = (LAS int*)(lds + MISC_OFF);
    LAS unsigned* aofs = (LAS unsigned*)(lds + AOFS_OFF);

    const int lo = p.ph_lo, hi = p.ph_hi;
#if MK_N_LAUNCHES == 1
    cg::grid_group grid = cg::this_grid();
    if (tid < 2) ((volatile LAS unsigned*)(lds + MISC_OFF))[64 + tid] = 0u;
    __syncthreads();
    const XcdBarrier xbar = xcd_barrier_post((unsigned*)(G_ctl + CW_BAR), (volatile LAS unsigned*)(lds + MISC_OFF) + 64);
#define GRID_BAR(k) do { if ((k) == CG_SEAM) grid.sync(); else xcd_barrier(xbar); } while (0)
#else
#define GRID_BAR(k) do { } while (0)
#endif
#ifndef PHASE_MASK
#define PHASE_MASK 0xffff
#endif
#ifndef CONV_PIPE
#define CONV_PIPE 1
#endif
#ifndef CONV_IN_P1
#define CONV_IN_P1 1
#endif
#ifndef REPEAT_MASK
#define REPEAT_MASK 0x0
#endif
#define REP(k) for (int rep_ = 0; rep_ <= ((REPEAT_MASK >> (k)) & 1); ++rep_)
#define IN(k) (((PHASE_MASK >> (k)) & 1) && lo <= (k) && (k) < hi)
#ifndef DOUBLE_BAR
#define DOUBLE_BAR 0
#endif
#ifndef PROBE_PHASE
#define PROBE_PHASE (-1)
#endif
#define PT0(k) if (PROBE_PHASE == (k)) pt0 = __builtin_amdgcn_s_memrealtime();
#define PT1(k) if (PROBE_PHASE == (k)) { const unsigned long long t1_ = __builtin_amdgcn_s_memrealtime(), d_ = t1_ - pt0; while (__builtin_amdgcn_s_memrealtime() - t1_ < d_) __builtin_amdgcn_s_sleep(8); }
#define SEAM(k) do { if (IN(k) && IN((k) + 1)) { _Pragma("unroll 1") for (int nb_ = 0; nb_ < 1 + (DOUBLE_BAR ? (hi > 0 ? 1 : 0) : 0); ++nb_) GRID_BAR(k); } } while (0)

    unsigned long long pt0 = 0;
    constexpr int I_IN = (D / 64) * (QKVW / 32);
    constexpr int I_OUT = (AW / 64) * (D / 32);
    constexpr int I_PIN = (D / 64) * (D / 32);
    constexpr int I_PO = I_PIN;
    constexpr int I_W1 = (D / 64) * (DE / 32);
    constexpr int I_W2 = (DE / 64) * (D / 32);
    constexpr int NITEMS = I_IN + I_OUT + I_PIN + I_PO + 32 * (2 * I_W1 + I_W2);
#define CONV_ITEMS(CONV_LO, CONV_HI, gw_, NGW_, scr_, lane_) do { \
        for (int it = CONV_LO + gw_; it < CONV_HI; it += NGW_) { \
            int r = it; \
            if (r < I_IN) { const int nblk = QKVW / 32; \
                if (FP8_QKV) transpose_item8(KP()->attn_w_in, QKVW, D, (unsigned char*)Win_t, MapQKV{}, 32.f, scr_, 64 * (r / nblk), 32 * (r % nblk), lane_); \
                else transpose_item(KP()->attn_w_in, QKVW, D, Win_t, MapQKV{}, scr_, 64 * (r / nblk), 32 * (r % nblk), lane_); \
                continue; } r -= I_IN; \
            if (r < I_OUT) { const int nblk = D / 32; \
                if (FP8_OUT) transpose_item8(KP()->attn_w_out, D, AW, (unsigned char*)Wout_t, MapId{}, 32.f, scr_, 64 * (r / nblk), 32 * (r % nblk), lane_); \
                else transpose_item(KP()->attn_w_out, D, AW, Wout_t, MapId{}, scr_, 64 * (r / nblk), 32 * (r % nblk), lane_); \
                continue; } r -= I_OUT; \
            if (r < I_PIN) { const int nblk = D / 32; transpose_item(KP()->pool_w_in, D, D, Wpin_t, MapId{}, scr_, 64 * (r / nblk), 32 * (r % nblk), lane_); continue; } r -= I_PIN; \
            if (r < I_PO) { const int nblk = D / 32; transpose_item(KP()->pool_w_out, D, D, Wpo_t, MapId{}, scr_, 64 * (r / nblk), 32 * (r % nblk), lane_); continue; } r -= I_PO; \
            const int le = r / (2 * I_W1 + I_W2); r -= le * (2 * I_W1 + I_W2);            \
            if (r < I_W1) { const int nblk = DE / 32; \
                if (FP8_MOE1) transpose_item8(KP()->expert_w1 + (size_t)le * D * DE, DE, D, (unsigned char*)W13 + (size_t)le * 1024 * 1024, MapW13{0}, 32.f, scr_, 64 * (r / nblk), 32 * (r % nblk), lane_); \
                else transpose_item(KP()->expert_w1 + (size_t)le * D * DE, DE, D, W13 + (size_t)le * 1024 * 1024, MapW13{0}, scr_, 64 * (r / nblk), 32 * (r % nblk), lane_); \
                continue; } r -= I_W1; \
            if (r < I_W1) { const int nblk = DE / 32; \
                if (FP8_MOE1) transpose_item8(KP()->expert_w3 + (size_t)le * D * DE, DE, D, (unsigned char*)W13 + (size_t)le * 1024 * 1024, MapW13{128}, 32.f, scr_, 64 * (r / nblk), 32 * (r % nblk), lane_); \
                else transpose_item(KP()->expert_w3 + (size_t)le * D * DE, DE, D, W13 + (size_t)le * 1024 * 1024, MapW13{128}, scr_, 64 * (r / nblk), 32 * (r % nblk), lane_); \
                continue; } r -= I_W1; \
            { const int nblk = D / 32; \
                if (FP8_MOE2) transpose_item8(KP()->expert_w2 + (size_t)le * DE * D, D, DE, (unsigned char*)W2 + (size_t)le * 1024 * DE, MapId{}, 32.f, scr_, 64 * (r / nblk), 32 * (r % nblk), lane_); \
                else transpose_item(KP()->expert_w2 + (size_t)le * DE * D, D, DE, W2 + (size_t)le * 1024 * DE, MapId{}, scr_, 64 * (r / nblk), 32 * (r % nblk), lane_); } \
        } \
    } while (0)
    PT0(0)
    if (IN(0)) REP(0) {
        LAS float* scr = (LAS float*)(lds + wave * 16384);
        const int gw = vcu * NWAVES + wave, NGW = G * NWAVES;
        CONV_ITEMS(0, (CONV_IN_P1 ? I_IN : NITEMS), gw, NGW, scr, lane);
        for (int i = vcu * NTHREADS + tid; i < 4 * 256 * 256 / 4; i += G * NTHREADS) {
            const int e4 = (i & 63) * 4, gidx = i >> 14;
            const f32x4 wv = *(const f32x4*)(KP()->pool_w_group + (size_t)i * 4); const f32x4 sc = *(const f32x4*)(KP()->pool_scale + gidx * 256 + e4);
            u32x2 o; o.x = cvtpk(wv.x * sc.x, wv.y * sc.y); o.y = cvtpk(wv.z * sc.z, wv.w * sc.w); *(u32x2*)(Wgs + (size_t)i * 4) = o;
        }
        for (int i = vcu * NTHREADS + tid; i < T * 8; i += G * NTHREADS) {
            const int tok = i >> 3, f = i & 7;
            const float invf = exp2f(-(float)f * (0.125f * 18.931568569324174f));
            const float ang = (float)KP()->positions[tok] * invf;
            float sn, cn; sincosf(ang, &sn, &cn);
            G_cs[(size_t)i * 2] = cn; G_cs[(size_t)i * 2 + 1] = sn;
        }
        RowPassCfg c{}; c.hin = KP()->x; c.gain = KP()->norm_mix; if (FP8_QKV) c.yout8 = (unsigned char*)Y; else c.yout = Y;
        row_pass<false, false, false>(lds, c, vcu, wave);
    }
    SEAM(0); PT1(0)
    PT0(1)
    if (IN(1)) REP(1) {
        if (CONV_IN_P1 && (vcu & 1) == 0) {
            int tq_ = threadIdx.x; asm volatile("" : "+v"(tq_)); const int ln_ = tq_ & 63, wv_ = __builtin_amdgcn_readfirstlane(tq_ >> 6);
            LAS float* scr_ = (LAS float*)(lds + wv_ * 16384);
            if (CONV_PIPE) conv_pipelined(KP(), scr_, vcu * NWAVES + wv_, G * NWAVES, ln_); else CONV_ITEMS(I_IN, NITEMS, vcu * NWAVES + wv_, G * NWAVES, scr_, ln_);
            __syncthreads();
        }
        {
        pg8::DenseProbT<FP8_QKV != 0> P{Y, Win_t, D, D, 0, (size_t)256 * D};
        pg8::StaticOrder S; S.init(T / 256, QKVW / 256, G, bx);
        EpiQKV E{QKV, G_cs, FP8_QKV ? (1.0f / 32.0f) : 1.0f};
        pg8::gemm_phase<pg8::DenseProbT<FP8_QKV != 0>, EpiQKV, pg8::StaticOrder, true>(lds, P, S, E);
        }
        if (CONV_IN_P1 && (vcu & 1) != 0) {
            __syncthreads();
            int tq_ = threadIdx.x; asm volatile("" : "+v"(tq_)); const int ln_ = tq_ & 63, wv_ = __builtin_amdgcn_readfirstlane(tq_ >> 6);
            LAS float* scr_ = (LAS float*)(lds + wv_ * 16384);
            if (CONV_PIPE) conv_pipelined(KP(), scr_, vcu * NWAVES + wv_, G * NWAVES, ln_); else CONV_ITEMS(I_IN, NITEMS, vcu * NWAVES + wv_, G * NWAVES, scr_, ln_);
        }
    }
    SEAM(1); PT1(1)
    PT0(2)
    if (IN(2)) REP(2) {
#ifndef ATT_PROBE_MODE
#define ATT_PROBE_MODE 0
#endif
        if (ATT_PROBE_MODE == 1) att::attn_phase<1>(lds, QKV, OG, G_lse, vcu, G);
        if (ATT_PROBE_MODE == 2) att::attn_phase<2>(lds, QKV, OG, G_lse, vcu, G);
        if (ATT_PROBE_MODE == 3) att::attn_phase<3>(lds, QKV, OG, G_lse, vcu, G);
        att::attn_phase<0>(lds, QKV, OG, G_lse, vcu, G);
    }
    SEAM(2); PT1(2)
    PT0(3)
    if (IN(3)) REP(3) {
        for (int row = vcu * NWAVES + wave; row < T; row += G * NWAVES) {
            const int h = lane >> 3;
            const float l0 = G_lse[(size_t)row * 24 + h], l1 = G_lse[(size_t)row * 24 + 8 + h], l2 = G_lse[(size_t)row * 24 + 16 + h];
            const float mx = fmaxf(l0, fmaxf(l1, l2));
            float w0 = __expf(l0 - mx), w1 = __expf(l1 - mx), w2 = __expf(l2 - mx); const float inv = 1.0f / (w0 + w1 + w2); w0 *= inv; w1 *= inv; w2 *= inv;
            u32x4 o;
            if (FP8_OG) {
                const unsigned char* src = (const unsigned char*)OG + (size_t)row * 1536 + lane * 8;
                const u32x2 a = __builtin_nontemporal_load((const u32x2*)(src)), b = __builtin_nontemporal_load((const u32x2*)(src + 512)), c = __builtin_nontemporal_load((const u32x2*)(src + 1024));
                if (!FP8_OUT) { w0 *= (1.0f / 16.0f); w1 *= (1.0f / 16.0f); w2 *= (1.0f / 16.0f); }
#define MRGF_(WA, WB, WC, SEL, I) (w0 * __builtin_amdgcn_cvt_pk_f32_fp8((int)(WA), SEL)[I] + w1 * __builtin_amdgcn_cvt_pk_f32_fp8((int)(WB), SEL)[I] + w2 * __builtin_amdgcn_cvt_pk_f32_fp8((int)(WC), SEL)[I])
                if (FP8_OUT) {
                    u32x2 o8; o8.x = pack_fp8x4(MRGF_(a.x, b.x, c.x, false, 0), MRGF_(a.x, b.x, c.x, false, 1), MRGF_(a.x, b.x, c.x, true, 0), MRGF_(a.x, b.x, c.x, true, 1));
                    o8.y = pack_fp8x4(MRGF_(a.y, b.y, c.y, false, 0), MRGF_(a.y, b.y, c.y, false, 1), MRGF_(a.y, b.y, c.y, true, 0), MRGF_(a.y, b.y, c.y, true, 1));
                    *(u32x2*)((unsigned char*)OM + (size_t)row * AW + lane * 8) = o8; continue;
                }
#define MRG_(WA, WB, WC, SEL) cvtpk(w0 * __builtin_amdgcn_cvt_pk_f32_fp8((int)(WA), SEL)[0] + w1 * __builtin_amdgcn_cvt_pk_f32_fp8((int)(WB), SEL)[0] + w2 * __builtin_amdgcn_cvt_pk_f32_fp8((int)(WC), SEL)[0], \
                                    w0 * __builtin_amdgcn_cvt_pk_f32_fp8((int)(WA), SEL)[1] + w1 * __builtin_amdgcn_cvt_pk_f32_fp8((int)(WB), SEL)[1] + w2 * __builtin_amdgcn_cvt_pk_f32_fp8((int)(WC), SEL)[1])
                o[0] = MRG_(a.x, b.x, c.x, false); o[1] = MRG_(a.x, b.x, c.x, true); o[2] = MRG_(a.y, b.y, c.y, false); o[3] = MRG_(a.y, b.y, c.y, true);
#undef MRG_
#undef MRGF_
            } else {
            const bf16* src = OG + (size_t)row * 1536 + lane * 8;
            const u32x4 a = *(const u32x4*)(src), b = *(const u32x4*)(src + 512), c = *(const u32x4*)(src + 1024);
#pragma unroll
            for (int k = 0; k < 4; ++k) { const float lo_ = w0 * bf_lo(a[k]) + w1 * bf_lo(b[k]) + w2 * bf_lo(c[k]), hi_ = w0 * bf_hi(a[k]) + w1 * bf_hi(b[k]) + w2 * bf_hi(c[k]); o[k] = cvtpk(lo_, hi_); }
            }
            *(u32x4*)(OM + (size_t)row * AW + lane * 8) = o;
        }
    }
    SEAM(3); PT1(3)
    PT0(4)
    if (IN(4)) REP(4) {
        pg8::DenseProbT<FP8_OUT != 0> P{OM, Wout_t, AW, AW, 0, (size_t)256 * AW};
        pg8::StaticOrder S; S.init(T / 256, D / 256, G, bx);
        EpiResBf16<true> E{KP()->x, H, FP8_OUT ? (1.0f / 512.0f) : 1.0f};
        pg8::gemm_phase<pg8::DenseProbT<FP8_OUT != 0>, EpiResBf16<true>, pg8::StaticOrder, true>(lds, P, S, E);
    }
    SEAM(4); PT1(4)
#pragma unroll 1
    for (int L = 0; L < 2; ++L) {
        const int pb = (L == 0) ? 5 : 12;
        int* cnt = G_ctl + CW_CNT + L * NE;
        PT0(pb)
        if (IN(pb)) {
            RowPassCfg c{}; c.hin16 = H; c.gain = KP()->norm_ffn + L * D; if (FP8_MOE1) c.yout8 = (unsigned char*)Y; else c.yout = Y;
            c.rgw = KP()->router_group_w + (size_t)L * D * 4; c.rgb = KP()->router_group_b + L * 4; c.rew = KP()->router_expert_w + (size_t)L * 4 * D * 4; c.reb = KP()->router_expert_b + L * 16;
            c.cnt = cnt; c.list = G_list + (size_t)L * NE * T; c.gatel = G_gatel + (size_t)L * NE * T; c.slotref_out = G_slotref + (size_t)L * T * 2;
            if ((REPEAT_MASK >> pb) & 1) {
                RowPassCfg c2 = c; c2.cnt = G_ctl + 64 + L * NE; c2.list = (int*)(WSB() + WS_BIG + 200 * MiB); c2.gatel = (float*)(WSB() + WS_BIG + 204 * MiB); c2.slotref_out = (int*)(WSB() + WS_BIG + 208 * MiB);
                if (ROUTER_MFMA) router_pass(lds, c2, vcu, wave); else row_pass<false, true, true>(lds, c2, vcu, wave);
            }
            if (ROUTER_MFMA) router_pass(lds, c, vcu, wave); else row_pass<false, true, true>(lds, c, vcu, wave);
        }
        SEAM(pb); PT1(pb)
        PT0(pb + 1)
        if (IN(pb + 1) || IN(pb + 2)) {
            build_tile_base(tb, cnt, tid);
            __syncthreads();
        }
        if (IN(pb + 1)) REP(pb + 1) {
            const int NT = tb[NE];
            pg8::StaticOrder S; S.init(NT, 4, G, bx);
            int tq6 = threadIdx.x; asm volatile("" : "+v"(tq6));
            for (int i = 0; i < 8; ++i) { Unit u; if (!S.next(i, u)) break;
                int e = 0;
                for (int k = 1; k < NE; ++k) e += (u.pm >= tb[k]) ? 1 : 0;
                if (tq6 < 256) { const int li = (u.pm - tb[e]) * 256 + tq6; const bool ok_ = li < tb[32 + e]; const int tok = ok_ ? G_list[((size_t)L * NE + e) * T + li] : 0; aofs[i * 256 + tq6] = (unsigned)tok * (unsigned)(D * (FP8_MOE1 ? 1 : 2));
                    if (GATE_FOLD && FP8_MOE2) ((LAS float*)(lds + MISC_OFF + 1024))[i * 256 + tq6] = ok_ ? G_gatel[((size_t)L * NE + e) * T + li] : 0.f; } }
            __syncthreads();
            MoeProb1T<FP8_MOE1 != 0> P{Y, (const unsigned char*)W13 + (size_t)L * NE * 1024 * 1024 * (FP8_MOE1 ? 1 : 2), D, tb, aofs};
            EpiSwiGLU<FP8_MOE2 != 0> E{HMID, FP8_MOE1 ? (1.0f / 32.0f) : 1.0f};
            if (GATE_FOLD && FP8_MOE2) E.gtab = (const LAS float*)(lds + MISC_OFF + 1024);
            pg8::gemm_phase<MoeProb1T<FP8_MOE1 != 0>, EpiSwiGLU<FP8_MOE2 != 0>, pg8::StaticOrder, true>(lds, P, S, E);
            if (L == 0) {
                pg8::DenseProb Pf{Wpo_t, Wgs, 256, D, 256, (size_t)256 * 256};
                FoldOrder Sf{G, G - 1 - bx};
                if (FP8_POOL2) { EpiFp8 Ef{(unsigned char*)Wc_t, D, 32.f}; pg8::gemm_phase<pg8::DenseProb, EpiFp8, FoldOrder, true>(lds, Pf, Sf, Ef); }
                else { EpiBf16 Ef{Wc_t, D}; pg8::gemm_phase<pg8::DenseProb, EpiBf16, FoldOrder, true>(lds, Pf, Sf, Ef); }
            }
        }
        SEAM(pb + 1); PT1(pb + 1)
        PT0(pb + 2)
        if (IN(pb + 2)) REP(pb + 2) {
            const int NT = tb[NE];
            pg8::StaticOrder S; S.init(NT, 4, G, bx);
            MoeProb2T<FP8_MOE2 != 0> P{HMID, (const unsigned char*)W2 + (size_t)L * NE * 1024 * DE * (FP8_MOE2 ? 1 : 2), DE, tb};
            if (GATE_FOLD && FP8_MOE2 && FP8_YS) {
                EpiFp8 E{(unsigned char*)YS, D, 64.0f / 512.0f};
                pg8::gemm_phase<MoeProb2T<FP8_MOE2 != 0>, EpiFp8, pg8::StaticOrder, true>(lds, P, S, E);
            } else {
            { const float gsc = (FP8_MOE2 ? (1.0f / 512.0f) : 1.0f) * (FP8_YS ? 64.0f : 1.0f);
              for (int i = 0; i < 8; ++i) { Unit u; if (!S.next(i, u)) break;
                int e = 0;
                for (int k = 1; k < NE; ++k) e += (u.pm >= tb[k]) ? 1 : 0;
                if (tid < 256) { const int li = (u.pm - tb[e]) * 256 + tid; ((LAS float*)aofs)[i * 256 + tid] = (li < tb[32 + e]) ? G_gatel[((size_t)L * NE + e) * T + li] * gsc : 0.f; } }
              __syncthreads(); }
            EpiGate E{YS, (const LAS float*)aofs};
            pg8::gemm_phase<MoeProb2T<FP8_MOE2 != 0>, EpiGate, pg8::StaticOrder, true>(lds, P, S, E);
            }
        }
        SEAM(pb + 2); PT1(pb + 2)
        if (L == 0) {
            PT0(8)
            if (IN(8)) {
                RowPassCfg c{}; c.hin16 = H; c.ys = YS; c.slotref = G_slotref; c.cnt_prev = cnt; c.yout = Y;
                if (H_FROM_Y) c.rms_out = G_lse; else { c.hout = H; c.gain = KP()->norm_mix + D; }
                if ((REPEAT_MASK >> 8) & 1) { RowPassCfg c2 = c; c2.hout = nullptr; row_pass<true, false, true>(lds, c2, vcu, wave); }
                row_pass<true, false, true>(lds, c, vcu, wave);
            }
            SEAM(8); PT1(8)
            PT0(9)
            if (IN(9)) REP(9) {
                pg8::DenseProb P{Y, Wpin_t, D, D, 0, (size_t)256 * D};
                pg8::StaticOrder S; S.init(T / 256, D / 256, G, bx);
                if (POOL_FUSED) { EpiPool E{POOLED, U};
                    pg8::gemm_phase<pg8::DenseProb, EpiPool, pg8::StaticOrder, true>(lds, P, S, E); }
                else { EpiBf16 E{U, D};
                    pg8::gemm_phase<pg8::DenseProb, EpiBf16, pg8::StaticOrder, true>(lds, P, S, E); }
            }
            SEAM(9); PT1(9)
            PT0(10)
            if (IN(10) && POOL_FUSED) {
                int tq10 = threadIdx.x; asm volatile("" : "+v"(tq10));
                if (tq10 < 256) for (int v = vcu; v < (T / 64) / 2; v += G) {
                    const int grp = tq10 >> 6, b = 2 * v + ((tq10 >> 5) & 1), ch = grp * 256 + (tq10 & 31) * 8;
                    if ((b & 31) == 0) continue;
                    switch (grp) { case 0: seam_fix<2>(U, POOLED, b, ch); break; case 1: seam_fix<4>(U, POOLED, b, ch); break; case 2: seam_fix<8>(U, POOLED, b, ch); break; default: seam_fix<16>(U, POOLED, b, ch); break; }
                }
            }
            if (IN(10) && !POOL_FUSED) REP(10) {
                int tq10 = threadIdx.x; asm volatile("" : "+v"(tq10));
                for (int it = vcu * NTHREADS + tq10; it < (T / 32) * 128; it += G * NTHREADS) {
                    const int ch = (it & 127) * 8, run = it >> 7, t0 = run * 32, s0 = t0 & (SEQ - 1);
                    const int wdw = 2 << (ch >> 8);
                    float sum[8];
#pragma unroll
                    for (int k = 0; k < 8; ++k) sum[k] = 0.f;
                    for (int i = 1; i < wdw; ++i) { if (s0 - i < 0) break; const u32x4 a = *(const u32x4*)(U + (size_t)(t0 - i) * D + ch);
#pragma unroll
                        for (int k = 0; k < 4; ++k) { sum[2 * k] += bf_lo(a[k]); sum[2 * k + 1] += bf_hi(a[k]); } }
                    for (int i0 = 0; i0 < 32; i0 += 8) {
                        u32x4 a8[8], o8[8];
#pragma unroll
                        for (int i = 0; i < 8; ++i) { const int tk = t0 + i0 + i, sq = s0 + i0 + i;
                            a8[i] = *(const u32x4*)(U + (size_t)tk * D + ch);
                            const int tko = tk - wdw + 1; const unsigned msk = (sq - wdw + 1 >= 0) ? 0xffffffffu : 0u;
                            const u32x4 ov = *(const u32x4*)(U + (size_t)(tko < 0 ? 0 : tko) * D + ch); o8[i] = (u32x4){ov.x & msk, ov.y & msk, ov.z & msk, ov.w & msk}; }
#pragma unroll
                        for (int i = 0; i < 8; ++i) { const int tk = t0 + i0 + i, sq = s0 + i0 + i;
                            float cur[8];
#pragma unroll
                            for (int k = 0; k < 4; ++k) { cur[2 * k] = bf_lo(a8[i][k]); cur[2 * k + 1] = bf_hi(a8[i][k]); }
#pragma unroll
                            for (int k = 0; k < 8; ++k) sum[k] += cur[k];
                            const float invc = 1.0f / (float)((sq + 1) < wdw ? (sq + 1) : wdw);
                            u32x4 w;
#pragma unroll
                            for (int k = 0; k < 4; ++k) w[k] = cvtpk(sum[2 * k] * invc - cur[2 * k], sum[2 * k + 1] * invc - cur[2 * k + 1]);
                            *(u32x4*)(POOLED + (size_t)tk * D + ch) = w;
#pragma unroll
                            for (int k = 0; k < 4; ++k) { sum[2 * k] -= bf_lo(o8[i][k]); sum[2 * k + 1] -= bf_hi(o8[i][k]); }
                        }
                    }
                }
            }
            SEAM(10); PT1(10)
            PT0(11)
            if (IN(11)) REP(11) {
                pg8::DenseProbT<FP8_POOL2 != 0> P{POOLED, Wc_t, D, D, 0, (size_t)256 * D};
                pg8::StaticOrder S; S.init(T / 256, D / 256, G, bx);
                EpiResBf16<false> E{H_FROM_Y ? (const void*)Y : (const void*)H, (((REPEAT_MASK >> 11) & 1) && rep_ == 0) ? (bf16*)(WSB() + WS_BIG + 136 * MiB) : H, FP8_POOL2 ? (1.0f / 512.0f) : 1.0f};
                if (H_FROM_Y) E.rrms = G_lse;
                pg8::gemm_phase<pg8::DenseProbT<FP8_POOL2 != 0>, EpiResBf16<false>, pg8::StaticOrder, true>(lds, P, S, E);
            }
            SEAM(11); PT1(11)
        }
    }
    PT0(15)
    if (IN(15)) {
        RowPassCfg c{}; c.hin16 = H; c.ys = YS; c.slotref = G_slotref + (size_t)T * 2; c.cnt_prev = G_ctl + CW_CNT + NE; c.gain = KP()->norm_final; c.fout = KP()->out;
        if ((REPEAT_MASK >> 15) & 1) { RowPassCfg c2 = c; c2.fout = nullptr; c2.yout = Y; row_pass<true, false, true>(lds, c2, vcu, wave); }
        row_pass<true, false, true>(lds, c, vcu, wave);
    }
    PT1(15)
#undef IN
#undef SEAM
#undef GRID_BAR
}

#undef KP
#undef WSB
#undef G_ctl
#undef G_cs
#undef G_lse
#undef G_slotref
#undef Wgs
#undef G_list
#undef G_gatel
#undef Win_t
#undef Wout_t
#undef Wpin_t
#undef Wc_t
#undef Wpo_t
#undef W13
#undef W2
#undef Y
#undef QKV
#undef OM
#undef HMID
#undef YS
#undef U
#undef POOLED
#undef OG
#undef H
extern "C" void kernel_launch(void* const* d_in, const int* in_sizes, int n_in, void* d_out, int out_size, void* d_ws, size_t ws_size, hipStream_t stream) {
    static int grid = 0;
    if (grid == 0) {
        if (n_in != 18 || in_sizes[0] != T * D || out_size != T * D || ws_size < WS_END) { fprintf(stderr, "kernel_launch: unexpected shapes (n_in %d, in0 %d, out %d, ws %zu)\n", n_in, n_in > 0 ? in_sizes[0] : -1, out_size, ws_size); grid = -1; return; }
        int dev = 0, cus = 0, per_cu = 0;
        if (hipGetDevice(&dev) != hipSuccess || hipDeviceGetAttribute(&cus, hipDeviceAttributeMultiprocessorCount, dev) != hipSuccess) { grid = -1; return; }
        if (hipFuncSetAttribute((const void*)fwd_kernel, hipFuncAttributeMaxDynamicSharedMemorySize, LDS_BYTES) != hipSuccess) { fprintf(stderr, "kernel_launch: hipFuncSetAttribute failed\n"); grid = -1; return; }
        if (hipOccupancyMaxActiveBlocksPerMultiprocessor(&per_cu, (const void*)fwd_kernel, NTHREADS, LDS_BYTES) != hipSuccess || per_cu < 1) { fprintf(stderr, "kernel_launch: occupancy query says %d\n", per_cu); per_cu = 1; }
        (void)hipGetLastError();
        grid = cus;
    }
    if (grid < 0) return;
    (void)hipMemsetAsync((char*)d_ws + WS_CTL, 0, CTL_ZERO_BYTES, stream);
    Params p{};
    p.x = (const float*)d_in[0]; p.positions = (const int*)d_in[1]; p.norm_mix = (const float*)d_in[2]; p.norm_ffn = (const float*)d_in[3]; p.norm_final = (const float*)d_in[4];
    p.attn_w_in = (const float*)d_in[5]; p.attn_w_out = (const float*)d_in[6]; p.pool_w_in = (const float*)d_in[7]; p.pool_w_group = (const float*)d_in[8]; p.pool_scale = (const float*)d_in[9]; p.pool_w_out = (const float*)d_in[10];
    p.router_group_w = (const float*)d_in[11]; p.router_group_b = (const float*)d_in[12]; p.router_expert_w = (const float*)d_in[13]; p.router_expert_b = (const float*)d_in[14];
    p.expert_w1 = (const float*)d_in[15]; p.expert_w3 = (const float*)d_in[16]; p.expert_w2 = (const float*)d_in[17];
    p.out = (float*)d_out; p.ws = (unsigned char*)d_ws;
#if MK_N_LAUNCHES == 1
    p.ph_lo = 0; p.ph_hi = N_PHASES;
    void* args[] = {&p};
    hipError_t e = hipLaunchCooperativeKernel((const void*)fwd_kernel, dim3(grid), dim3(NTHREADS), args, LDS_BYTES, stream);
    if (e != hipSuccess) fprintf(stderr, "cooperative launch failed: %s (grid %d)\n", hipGetErrorString(e), grid);
#else
    for (int ph = 0; ph < N_PHASES; ++ph) {
        p.ph_lo = ph; p.ph_hi = ph + 1;
        hipLaunchKernelGGL(fwd_kernel, dim3(grid), dim3(NTHREADS), LDS_BYTES, stream, p);
    }
#endif
}
```
